# Optimizing an MI355X kernel written in HIP

```python
import functools
import jax, jax.numpy as jnp
from jax import lax
import numpy as np

D_MODEL = 2048
BATCH = 1
SEQ = 8192
DEPTH = 2
DEC_BATCH = 128
DEC_SEQ = 1
PAST_LEN = 8192
PAGE_SIZE = 128

SSM_EXPAND = 2
D_INNER = SSM_EXPAND * D_MODEL
SSM_HEADDIM = 64
N_SSM_HEADS = D_INNER // SSM_HEADDIM
D_STATE = 128
N_GROUPS = 8
HEADS_PER_GROUP = N_SSM_HEADS // N_GROUPS
CONV_W = 4
CONV_DIM = D_INNER + 2 * N_GROUPS * D_STATE
SSD_CHUNK = 128
HEAD_DIM = 64
N_HEADS = D_MODEL // HEAD_DIM
N_KV_HEADS = 8
Q_PER_KV = N_HEADS // N_KV_HEADS
ATTN_DIM = N_HEADS * HEAD_DIM
KV_DIM = N_KV_HEADS * HEAD_DIM
WINDOW = 128
ATTN_BLOCK = WINDOW
D_FF = ((8 * D_MODEL // 3 + 255) // 256) * 256
IN_SPLITS = (D_INNER, CONV_DIM, N_SSM_HEADS, ATTN_DIM, KV_DIM, KV_DIM, D_MODEL, D_MODEL)
IN_DIM = sum(IN_SPLITS)
EPS = 1e-6

kernel_name = "hybrid_ssd_swa_sink_gated_decoder_step"


def split_cols(t, sizes):
    out, start = [], 0
    for s in sizes:
        out.append(t[..., start:start + s])
        start += s
    return out


def rmsnorm(x, g):
    x32 = x.astype(jnp.float32)
    y = x32 * lax.rsqrt(jnp.mean(x32 * x32, axis=-1, keepdims=True) + EPS)
    return (y * g.astype(jnp.float32)).astype(x.dtype)


def gated_rmsnorm(y, z, g):
    h = (y.astype(jnp.float32) * jax.nn.silu(z.astype(jnp.float32)))
    hg = h.reshape(h.shape[:-1] + (N_GROUPS, D_INNER // N_GROUPS))
    hg = hg * lax.rsqrt(jnp.mean(hg * hg, axis=-1, keepdims=True) + EPS)
    return (hg.reshape(h.shape) * g.astype(jnp.float32)).astype(y.dtype)


def causal_conv(xbc, buf, w, b):
    L = xbc.shape[1]
    xp = jnp.concatenate([buf.astype(xbc.dtype), xbc], axis=1)
    out = b + sum(xp[:, k:k + L] * w[k] for k in range(CONV_W))
    return jax.nn.silu(out), xp[:, -(CONV_W - 1):]


def ssd_scan(x, dt, A, B, C, h0):
    b, L = x.shape[:2]
    cl = SSD_CHUNK if L >= SSD_CHUNK else L
    nc = -(-L // cl)
    pad = nc * cl - L
    if pad:
        padw = lambda t: jnp.pad(t, [(0, 0), (0, pad)] + [(0, 0)] * (t.ndim - 2))
        x, dt, B, C = padw(x), padw(dt), padw(B), padw(C)
    G, R = N_GROUPS, HEADS_PER_GROUP
    x = x.reshape(b, nc, cl, G, R, SSM_HEADDIM)
    dt = dt.reshape(b, nc, cl, G, R)
    B = B.reshape(b, nc, cl, G, D_STATE)
    C = C.reshape(b, nc, cl, G, D_STATE)
    a = dt * A.reshape(G, R)
    a_cs = jnp.cumsum(a, axis=2)
    xdt = x * dt[..., None]
    causal = jnp.tril(jnp.ones((cl, cl), dtype=bool))
    seg = a_cs[:, :, :, None] - a_cs[:, :, None, :]
    decay = jnp.exp(jnp.where(causal[None, None, :, :, None, None], seg, -jnp.inf))
    cb = jnp.einsum("bclgn,bcsgn->bclsg", C, B)
    y_diag = jnp.einsum("bclsgr,bcsgrp->bclgrp", cb[..., None] * decay, xdt)
    to_end = jnp.exp(a_cs[:, :, -1:] - a_cs)
    states = jnp.einsum("bclgn,bclgrp->bcgrpn", B, xdt * to_end[..., None])
    chunk_decay = jnp.exp(a_cs[:, :, -1])

    def step(h, inp):
        dec, st = inp
        return dec[..., None, None] * h + st, h

    h_final, h_start = lax.scan(
        step, h0.reshape(b, G, R, SSM_HEADDIM, D_STATE),
        (jnp.moveaxis(chunk_decay, 1, 0), jnp.moveaxis(states, 1, 0)))
    h_start = jnp.moveaxis(h_start, 0, 1)
    y_off = jnp.einsum("bclgn,bcgrpn->bclgrp", C, h_start) * jnp.exp(a_cs)[..., None]
    y = (y_diag + y_off).reshape(b, nc * cl, N_SSM_HEADS, SSM_HEADDIM)[:, :L]
    return y, h_final.reshape(b, N_SSM_HEADS, SSM_HEADDIM, D_STATE)


def mamba_branch(z, xbc, dt_raw, conv_buf, h0, p):
    b, L = z.shape[:2]
    xbc, buf_new = causal_conv(xbc, conv_buf, p["conv_w"], p["conv_b"])
    xs, Bm, Cm = split_cols(xbc, (D_INNER, N_GROUPS * D_STATE, N_GROUPS * D_STATE))
    xs = xs.reshape(b, L, N_SSM_HEADS, SSM_HEADDIM).astype(jnp.float32)
    Bm = Bm.reshape(b, L, N_GROUPS, D_STATE).astype(jnp.float32)
    Cm = Cm.reshape(b, L, N_GROUPS, D_STATE).astype(jnp.float32)
    dt = jax.nn.softplus(dt_raw.astype(jnp.float32) + p["dt_bias"].astype(jnp.float32))
    A = -jnp.exp(p["a_log"].astype(jnp.float32))
    y, h_new = ssd_scan(xs, dt, A, Bm, Cm, h0.astype(jnp.float32))
    y = y + p["d_skip"].astype(jnp.float32)[:, None] * xs
    y = y.reshape(b, L, D_INNER).astype(z.dtype)
    return gated_rmsnorm(y, z, p["ssm_norm"]), h_new.astype(h0.dtype), buf_new


def sink_attend(q, k, v, q_pos, k_pos, sinks):
    s = jnp.einsum("bnqkgd,bnskd->bnkgqs", q, k).astype(jnp.float32) * (HEAD_DIM ** -0.5)
    kp, qp = k_pos[:, None, :], q_pos[:, :, None]
    mask = (kp <= qp) & (kp >= qp - WINDOW) & (kp >= 0)
    s = jnp.where(mask[None, :, None, None], s, -jnp.inf)
    sink = sinks.astype(jnp.float32).reshape(1, 1, N_KV_HEADS, Q_PER_KV, 1, 1)
    m = jnp.maximum(jnp.max(s, axis=-1, keepdims=True), sink)
    pr = jnp.exp(s - m)
    pr = pr / (jnp.sum(pr, axis=-1, keepdims=True) + jnp.exp(sink - m))
    return jnp.einsum("bnkgqs,bnskd->bnqkgd", pr.astype(v.dtype), v)


def prompt_attention(q, k, v, sinks):
    b, L = q.shape[:2]
    nb = L // ATTN_BLOCK
    qb = q.reshape(b, nb, ATTN_BLOCK, N_KV_HEADS, Q_PER_KV, HEAD_DIM)

    def band(t):
        tp = jnp.concatenate([jnp.zeros((b, WINDOW, N_KV_HEADS, HEAD_DIM), t.dtype), t], axis=1)
        tp = tp.reshape(b, nb + 1, ATTN_BLOCK, N_KV_HEADS, HEAD_DIM)
        return jnp.concatenate([tp[:, :-1], tp[:, 1:]], axis=2)

    q_pos = jnp.arange(L, dtype=jnp.int32).reshape(nb, ATTN_BLOCK)
    kp = jnp.arange(-WINDOW, L, dtype=jnp.int32).reshape(nb + 1, ATTN_BLOCK)
    k_pos = jnp.concatenate([kp[:-1], kp[1:]], axis=1)
    o = sink_attend(qb, band(k), band(v), q_pos, k_pos, sinks).reshape(b, L, ATTN_DIM)
    return o, k[:, L - WINDOW:], v[:, L - WINDOW:]


def sample_attention(q, k, v, sinks, cache_k, cache_v):
    b, L = q.shape[:2]
    keys = jnp.concatenate([cache_k.astype(k.dtype), k], axis=1)
    vals = jnp.concatenate([cache_v.astype(v.dtype), v], axis=1)
    q_pos = PAST_LEN + jnp.arange(L, dtype=jnp.int32)
    k_pos = jnp.concatenate([PAST_LEN - WINDOW + jnp.arange(WINDOW, dtype=jnp.int32), q_pos])
    qb = q.reshape(b, 1, L, N_KV_HEADS, Q_PER_KV, HEAD_DIM)
    o = sink_attend(qb, keys[:, None], vals[:, None], q_pos[None], k_pos[None], sinks)
    return o.reshape(b, L, ATTN_DIM), keys[:, -WINDOW:], vals[:, -WINDOW:]


def mixer_layer(x, p, conv_buf, h0, attend):
    b, L, _ = x.shape
    xn = rmsnorm(x, p["norm_mix"])
    z, xbc, dt_raw, q, k, v, g_ssm, g_attn = split_cols(xn @ p["w_in"], IN_SPLITS)
    y_ssm, h_new, buf_new = mamba_branch(z, xbc, dt_raw, conv_buf, h0, p)
    o, k_new, v_new = attend(q.reshape(b, L, N_HEADS, HEAD_DIM),
                             k.reshape(b, L, N_KV_HEADS, HEAD_DIM),
                             v.reshape(b, L, N_KV_HEADS, HEAD_DIM), p["attn_sinks"])
    merged = (jax.nn.sigmoid(g_ssm) * (y_ssm @ p["w_ssm_proj"])
              + jax.nn.sigmoid(g_attn) * (o @ p["w_attn_proj"]))
    return x + merged @ p["w_out"], h_new, buf_new, k_new, v_new


def swiglu_ffn(x, p):
    xn = rmsnorm(x, p["norm_ffn"])
    return x + (jax.nn.silu(xn @ p["w_gate"]) * (xn @ p["w_up"])) @ p["w_down"]


def setup_inputs(seed: int = 0) -> dict:
    key = jax.random.key(seed)
    ks = jax.random.split(key, 24)
    f32 = jnp.float32
    nrm = lambda k, shape, s=1.0: jax.random.normal(k, shape, f32) * s
    dt0 = jnp.exp(jax.random.uniform(ks[9], (DEPTH, N_SSM_HEADS), f32, np.log(1e-3), np.log(1e-1)))
    return {
        "x_prompt": nrm(ks[0], (BATCH, SEQ, D_MODEL)),
        "x_sample": nrm(ks[1], (DEC_BATCH, DEC_SEQ, D_MODEL)),
        "state_ssm": nrm(ks[2], (DEPTH, DEC_BATCH, N_SSM_HEADS, SSM_HEADDIM, D_STATE), 0.5),
        "state_conv": nrm(ks[3], (DEPTH, DEC_BATCH, CONV_W - 1, CONV_DIM)),
        "cache_k": nrm(ks[4], (DEPTH, DEC_BATCH, WINDOW, N_KV_HEADS, HEAD_DIM)),
        "cache_v": nrm(ks[5], (DEPTH, DEC_BATCH, WINDOW, N_KV_HEADS, HEAD_DIM)),
        "norm_mix": 1.0 + nrm(ks[6], (DEPTH, D_MODEL), 0.02),
        "w_in": nrm(ks[7], (DEPTH, D_MODEL, IN_DIM), D_MODEL ** -0.5),
        "conv_w": nrm(ks[8], (DEPTH, CONV_W, CONV_DIM), CONV_W ** -0.5),
        "conv_b": nrm(ks[10], (DEPTH, CONV_DIM), 0.02),
        "dt_bias": dt0 + jnp.log(-jnp.expm1(-dt0)),
        "a_log": jnp.log(jax.random.uniform(ks[11], (DEPTH, N_SSM_HEADS), f32, 1.0, 16.0)),
        "d_skip": 1.0 + nrm(ks[12], (DEPTH, N_SSM_HEADS), 0.1),
        "ssm_norm": 1.0 + nrm(ks[13], (DEPTH, D_INNER), 0.02),
        "w_ssm_proj": nrm(ks[14], (DEPTH, D_INNER, D_MODEL), D_INNER ** -0.5),
        "w_attn_proj": nrm(ks[15], (DEPTH, ATTN_DIM, D_MODEL), ATTN_DIM ** -0.5),
        "attn_sinks": nrm(ks[16], (DEPTH, N_HEADS)),
        "w_out": nrm(ks[17], (DEPTH, D_MODEL, D_MODEL), D_MODEL ** -0.5),
        "norm_ffn": 1.0 + nrm(ks[18], (DEPTH, D_MODEL), 0.02),
        "w_gate": nrm(ks[19], (DEPTH, D_MODEL, D_FF), D_MODEL ** -0.5),
        "w_up": nrm(ks[20], (DEPTH, D_MODEL, D_FF), D_MODEL ** -0.5),
        "w_down": nrm(ks[21], (DEPTH, D_FF, D_MODEL), D_FF ** -0.5),
        "norm_final": 1.0 + nrm(ks[22], (D_MODEL,), 0.02),
    }


def reference(x_prompt, x_sample, state_ssm, state_conv, cache_k, cache_v,
              norm_mix, w_in, conv_w, conv_b, dt_bias, a_log, d_skip, ssm_norm,
              w_ssm_proj, w_attn_proj, attn_sinks, w_out, norm_ffn, w_gate, w_up,
              w_down, norm_final):
    yp, ys = x_prompt, x_sample
    bp = x_prompt.shape[0]
    p_ssm, p_conv, p_k, p_v = [], [], [], []
    s_ssm, s_conv, s_k, s_v = [], [], [], []
    for l in range(DEPTH):
        p = {
            "norm_mix": norm_mix[l], "w_in": w_in[l], "conv_w": conv_w[l], "conv_b": conv_b[l],
            "dt_bias": dt_bias[l], "a_log": a_log[l], "d_skip": d_skip[l], "ssm_norm": ssm_norm[l],
            "w_ssm_proj": w_ssm_proj[l], "w_attn_proj": w_attn_proj[l], "attn_sinks": attn_sinks[l],
            "w_out": w_out[l], "norm_ffn": norm_ffn[l], "w_gate": w_gate[l], "w_up": w_up[l],
            "w_down": w_down[l],
        }
        conv0 = jnp.zeros((bp, CONV_W - 1, CONV_DIM), x_prompt.dtype)
        h0 = jnp.zeros((bp, N_SSM_HEADS, SSM_HEADDIM, D_STATE), x_prompt.dtype)
        yp, h_p, buf_p, k_pn, v_pn = mixer_layer(yp, p, conv0, h0, prompt_attention)
        yp = swiglu_ffn(yp, p)
        attend_s = functools.partial(sample_attention, cache_k=cache_k[l], cache_v=cache_v[l])
        ys, h_s, buf_s, k_sn, v_sn = mixer_layer(ys, p, state_conv[l], state_ssm[l], attend_s)
        ys = swiglu_ffn(ys, p)
        p_ssm.append(h_p); p_conv.append(buf_p); p_k.append(k_pn); p_v.append(v_pn)
        s_ssm.append(h_s); s_conv.append(buf_s); s_k.append(k_sn); s_v.append(v_sn)
    y_prompt = rmsnorm(yp, norm_final)
    y_sample = rmsnorm(ys, norm_final)
    return (y_prompt, y_sample,
            jnp.stack(p_ssm), jnp.stack(p_conv), jnp.stack(p_k), jnp.stack(p_v),
            jnp.stack(s_ssm), jnp.stack(s_conv), jnp.stack(s_k), jnp.stack(s_v))
```

```cpp
#include <hip/hip_runtime.h>
#include <cstdio>
#include <cstdint>

constexpr int DM = 2048, SEQ = 8192, NB = 128, DEPTH = 2;
constexpr int MV = SEQ + NB;
constexpr int MP = 8448;
constexpr int DI = 4096, NH = 64, HP = 64, DS = 128, NG = 8, CD = 6144, CW = 4;
constexpr int AH = 32, KVH = 8, AD = 64, WIN = 128;
constexpr int FF = 5632;
constexpr int IN_DIM = 17472;
constexpr float EPS = 1e-6f;
constexpr int UZ = 0, UXBC = 4096, UQ = 10240, UK = 12288, UV = 12800, UGS = 13312, UGA = 15360, LDU = 17408;
constexpr int NU = 17664;
constexpr int KCAT = DI + DM;
constexpr int NGU = 2 * FF;

constexpr size_t O_YP = 0;
constexpr size_t O_YS = O_YP + (size_t)SEQ * DM;
constexpr size_t O_PSSM = O_YS + (size_t)NB * DM;
constexpr size_t O_PCONV = O_PSSM + (size_t)DEPTH * NH * HP * DS;
constexpr size_t O_PK = O_PCONV + (size_t)DEPTH * 3 * CD;
constexpr size_t O_PV = O_PK + (size_t)DEPTH * WIN * KVH * AD;
constexpr size_t O_SSSM = O_PV + (size_t)DEPTH * WIN * KVH * AD;
constexpr size_t O_SCONV = O_SSSM + (size_t)DEPTH * NB * NH * HP * DS;
constexpr size_t O_SK = O_SCONV + (size_t)DEPTH * NB * 3 * CD;
constexpr size_t O_SV = O_SK + (size_t)DEPTH * NB * WIN * KVH * AD;
constexpr size_t O_END = O_SV + (size_t)DEPTH * NB * WIN * KVH * AD;
static_assert(O_END == 190877696ull, "output size");

constexpr size_t al256(size_t x) { return (x + 255) & ~(size_t)255; }
constexpr size_t WS_CTL = 0, CTL_ZERO_BYTES = 1u << 20;
constexpr size_t SZ_WIN = (size_t)NU * DM * 2, SZ_WCAT = (size_t)DM * KCAT * 2, SZ_WOUT = (size_t)DM * DM * 2, SZ_WGU = (size_t)NGU * DM * 2, SZ_WDN = (size_t)DM * FF * 2;
constexpr size_t WS_WIN = 1u << 20;
constexpr size_t WS_WCAT = WS_WIN + DEPTH * SZ_WIN;
constexpr size_t WS_WOUT = WS_WCAT + DEPTH * SZ_WCAT;
constexpr size_t WS_WGU = WS_WOUT + DEPTH * SZ_WOUT;
constexpr size_t WS_WDN = WS_WGU + DEPTH * SZ_WGU;
constexpr size_t WS_X = WS_WDN + DEPTH * SZ_WDN;
constexpr size_t WS_XN = WS_X + (size_t)MP * DM * 4;
constexpr size_t WS_U = WS_XN + (size_t)MP * DM * 2;
constexpr size_t WS_DT = WS_U + (size_t)MP * LDU * 2;
constexpr size_t WS_YO = WS_DT + (size_t)MP * 64 * 4;
constexpr size_t WS_MRG = WS_YO + (size_t)MP * KCAT * 2;
constexpr size_t WS_HB = WS_MRG + (size_t)MP * DM * 2;
constexpr size_t WS_XT = WS_HB + (size_t)MP * FF * 2;
constexpr size_t WS_BRM = WS_XT + (size_t)64 * 64 * 64 * 128 * 2;
constexpr size_t WS_BT = WS_BRM + (size_t)64 * 8 * 128 * 128 * 2;
constexpr size_t WS_CRM = WS_BT + (size_t)64 * 8 * 128 * 128 * 2;
constexpr size_t WS_DTT = WS_CRM + (size_t)64 * 8 * 128 * 128 * 2;
constexpr size_t WS_ACS = WS_DTT + (size_t)64 * 64 * 128 * 4;
constexpr size_t WS_VT = WS_ACS + (size_t)64 * 64 * 128 * 4;
constexpr size_t WS_ST = WS_VT + (size_t)8 * 64 * 8192 * 2;
constexpr size_t WS_HS = WS_ST + (size_t)64 * 64 * 64 * 128 * 4;
constexpr size_t WS_END = WS_HS + (size_t)64 * 64 * 64 * 128 * 2;
static_assert(WS_WIN % 256 == 0 && WS_X % 256 == 0 && WS_U % 256 == 0 && WS_YO % 256 == 0 && WS_HB % 256 == 0 && WS_XT % 256 == 0 && WS_ST % 256 == 0, "ws alignment");
constexpr int CW_BAR = 4096;

constexpr int RING_OFF = 0, RING_BYTES = 131072;
constexpr int LDSCTL_OFF = RING_BYTES, MISC_OFF = LDSCTL_OFF + 320;
constexpr int LDS_BYTES = 147456;
constexpr int NWAVES = 8;
#define MK_SPLIT 0
namespace pg8 {
#define PG8_LAS __attribute__((address_space(3)))
typedef unsigned short bf16_t;
typedef short bf16x8 __attribute__((ext_vector_type(8)));
typedef float f32x4 __attribute__((ext_vector_type(4)));
typedef unsigned u32x4 __attribute__((ext_vector_type(4)));
constexpr int BM = 256, BK = 64, HALF = 128, HTB = HALF * BK * 2  , STAGE_BYTES = 8 * HTB, NXCD = 8, WGM = 8;

__host__ __device__ __forceinline__ int lds_byte(int r, int c) { const int st = (r >> 4) * 2 + (c >> 5), rr = r & 15, cc = c & 31, ob = rr * 64 + cc * 2; return st * 1024 + (ob ^ (((ob >> 9) & 1) << 5)); }
__host__ __device__ __forceinline__ void stage_rc(int b, int& R, int& C) { const int st = b / 1024, sb = b % 1024, swz = sb ^ (((sb >> 9) & 1) << 5); R = (st >> 1) * 16 + swz / 64; C = (st & 1) * 32 + (swz % 64) / 2; }
__host__ __device__ __forceinline__ int perm32(int rho) { const int n = rho >> 4, i = rho & 15; return 8 * (i >> 2) + 4 * n + (i & 3); }

struct Unit { int pm, pn; };
struct Gemm { const bf16_t* A; const bf16_t* Bt; int M, N, K; };

struct StaticOrder {
    int nM, nN, nwg, G, c;
    __host__ __device__ void init(int M, int N, int G_, int c_) { nM = M / BM; nN = N / BM; nwg = nM * nN; G = G_; c = c_; }
    __host__ __device__ bool next(int i, Unit& u) const {
        const long L = (long)i * G + c; if (L >= nwg) return false;
        int wgid = (int)L; { const int q = nwg / NXCD, r = nwg % NXCD, xcd = wgid % NXCD, off = wgid / NXCD; wgid = (xcd < r ? xcd * (q + 1) : r * (q + 1) + (xcd - r) * q) + off; }
        const int nig = WGM * nN, gid = wgid / nig, fm = gid * WGM, gsz = (nM - fm) < WGM ? (nM - fm) : WGM;
        u.pm = fm + ((wgid % nig) % gsz); u.pn = (wgid % nig) / gsz; return true;
    }
    __device__ __forceinline__ void a_ready(const Unit&) const {}
    __device__ __forceinline__ void done(const Unit&) const {}
};
__device__ __forceinline__ unsigned cvt_pk_bf16(float lo, float hi) { unsigned r; asm volatile("v_cvt_pk_bf16_f32 %0, %1, %2" : "=v"(r) : "v"(lo), "v"(hi)); return r; }
__device__ __forceinline__ float bf_lo(unsigned w) { return __uint_as_float(w << 16); }
__device__ __forceinline__ float bf_hi(unsigned w) { return __uint_as_float(w & 0xffff0000u); }
__device__ __forceinline__ float sigmoidf_(float x) { return 1.0f / (1.0f + __expf(-x)); }
constexpr int E_MV = 8320, E_LDU = 17408, E_UGS = 13312, E_UGA = 15360;
struct EpiU {
    static constexpr bool PERM = true, AFTER_DRAIN = false, HOOK = false; static constexpr int HOOK_T = -1;
    bf16_t* U; float* DT;
    __device__ __forceinline__ void hook(f32x4 (&)[2][2][4][2], const Unit&, int, int, int, int) const {}
    __device__ __forceinline__ void operator()(const f32x4 (&acc)[2][2][4][2], const Unit& u, int wr, int wc, int fr, int fq) const {
        const int row0 = u.pm * BM + wr * 64 + fr;
        if (u.pn == 68) {
            if (wc < 2) {
#pragma unroll
                for (int ai = 0; ai < 2; ++ai) { if (u.pm * BM + ai * HALF >= E_MV) continue;
#pragma unroll
                    for (int m = 0; m < 4; ++m) { float* p = DT + (size_t)(row0 + ai * HALF + m * 16) * 64 + wc * 32 + 8 * fq;
                        *(f32x4*)p = acc[ai][0][m][0]; *(f32x4*)(p + 4) = acc[ai][0][m][1]; } }
            }
            return;
        }
        const bool sig = u.pn >= 52;
        const int col0 = u.pn * BM + wc * 32 + 8 * fq;
#pragma unroll
        for (int ai = 0; ai < 2; ++ai) { if (u.pm * BM + ai * HALF >= E_MV) continue;
#pragma unroll
            for (int m = 0; m < 4; ++m) { bf16_t* rowp = U + (size_t)(row0 + ai * HALF + m * 16) * E_LDU + col0;
#pragma unroll
                for (int bj = 0; bj < 2; ++bj) { f32x4 v0 = acc[ai][bj][m][0], v1 = acc[ai][bj][m][1];
                    if (sig) {
#pragma unroll
                        for (int e = 0; e < 4; ++e) { v0[e] = sigmoidf_(v0[e]); v1[e] = sigmoidf_(v1[e]); } }
                    u32x4 w; w.x = cvt_pk_bf16(v0[0], v0[1]); w.y = cvt_pk_bf16(v0[2], v0[3]); w.z = cvt_pk_bf16(v1[0], v1[1]); w.w = cvt_pk_bf16(v1[2], v1[3]);
                    *(u32x4*)(rowp + bj * HALF) = w; } } }
    }
};
struct EpiMerge {
    static constexpr bool PERM = true, AFTER_DRAIN = false, HOOK = true; static constexpr int HOOK_T = 64;
    const bf16_t* U; bf16_t* O;
    __device__ __forceinline__ void hook(f32x4 (&acc)[2][2][4][2], const Unit& u, int wr, int wc, int fr, int fq) const {
        asm volatile("" : "+v"(fr), "+v"(fq));
        const int row0 = u.pm * BM + wr * 64 + fr, col0 = u.pn * BM + wc * 32 + 8 * fq;
#pragma unroll
        for (int ai = 0; ai < 2; ++ai) { if (u.pm * BM + ai * HALF >= E_MV) continue;
#pragma unroll
            for (int m = 0; m < 4; ++m) { const bf16_t* rowp = U + (size_t)(row0 + ai * HALF + m * 16) * E_LDU + col0;
#pragma unroll
                for (int bj = 0; bj < 2; ++bj) { const u32x4 gs = *(const u32x4*)(rowp + E_UGS + bj * HALF), ga = *(const u32x4*)(rowp + E_UGA + bj * HALF);
                    f32x4 r0, r1;
                    r0[0] = bf_lo(gs.x) / fmaxf(bf_lo(ga.x), 1e-20f); r0[1] = bf_hi(gs.x) / fmaxf(bf_hi(ga.x), 1e-20f); r0[2] = bf_lo(gs.y) / fmaxf(bf_lo(ga.y), 1e-20f); r0[3] = bf_hi(gs.y) / fmaxf(bf_hi(ga.y), 1e-20f);
                    r1[0] = bf_lo(gs.z) / fmaxf(bf_lo(ga.z), 1e-20f); r1[1] = bf_hi(gs.z) / fmaxf(bf_hi(ga.z), 1e-20f); r1[2] = bf_lo(gs.w) / fmaxf(bf_lo(ga.w), 1e-20f); r1[3] = bf_hi(gs.w) / fmaxf(bf_hi(ga.w), 1e-20f);
                    acc[ai][bj][m][0] *= r0; acc[ai][bj][m][1] *= r1; }
                asm volatile("" : "+v"(acc[ai][0][m][0]), "+v"(acc[ai][0][m][1]), "+v"(acc[ai][1][m][0]), "+v"(acc[ai][1][m][1]) :: "memory"); } }
    }
    __device__ __forceinline__ void operator()(const f32x4 (&acc)[2][2][4][2], const Unit& u, int wr, int wc, int fr, int fq) const {
        const int row0 = u.pm * BM + wr * 64 + fr, col0 = u.pn * BM + wc * 32 + 8 * fq;
#pragma unroll
        for (int ai = 0; ai < 2; ++ai) { if (u.pm * BM + ai * HALF >= E_MV) continue;
#pragma unroll
            for (int m = 0; m < 4; ++m) { const size_t r = (size_t)(row0 + ai * HALF + m * 16);
#pragma unroll
                for (int bj = 0; bj < 2; ++bj) { const u32x4 ga = *(const u32x4*)(U + r * E_LDU + E_UGA + col0 + bj * HALF);
                    const f32x4 v0 = acc[ai][bj][m][0], v1 = acc[ai][bj][m][1];
                    u32x4 w; w.x = cvt_pk_bf16(v0[0] * bf_lo(ga.x), v0[1] * bf_hi(ga.x)); w.y = cvt_pk_bf16(v0[2] * bf_lo(ga.y), v0[3] * bf_hi(ga.y));
                    w.z = cvt_pk_bf16(v1[0] * bf_lo(ga.z), v1[1] * bf_hi(ga.z)); w.w = cvt_pk_bf16(v1[2] * bf_lo(ga.w), v1[3] * bf_hi(ga.w));
                    *(u32x4*)(O + r * 2048 + col0 + bj * HALF) = w; } } }
    }
};
struct EpiResid {
    static constexpr bool PERM = false, AFTER_DRAIN = false, HOOK = false; static constexpr int HOOK_T = -1;
    float* X;
    __device__ __forceinline__ void hook(f32x4 (&)[2][2][4][2], const Unit&, int, int, int, int) const {}
    __device__ __forceinline__ void operator()(const f32x4 (&acc)[2][2][4][2], const Unit& u, int wr, int wc, int fr, int fq) const {
        const int row0 = u.pm * BM + wr * 64 + fr, col0 = u.pn * BM + wc * 32 + 4 * fq;
#pragma unroll
        for (int ai = 0; ai < 2; ++ai) { if (u.pm * BM + ai * HALF >= E_MV) continue;
#pragma unroll
            for (int m = 0; m < 4; ++m) { float* rowp = X + (size_t)(row0 + ai * HALF + m * 16) * 2048 + col0;
#pragma unroll
                for (int bj = 0; bj < 2; ++bj)
#pragma unroll
                    for (int n = 0; n < 2; ++n) { f32x4* p = (f32x4*)(rowp + bj * HALF + n * 16); *p = *p + acc[ai][bj][m][n]; } } }
    }
};
struct EpiSwiGLU {
    static constexpr bool PERM = true, AFTER_DRAIN = false, HOOK = false; static constexpr int HOOK_T = -1;
    bf16_t* H;
    __device__ __forceinline__ void hook(f32x4 (&)[2][2][4][2], const Unit&, int, int, int, int) const {}
    __device__ __forceinline__ void operator()(const f32x4 (&acc)[2][2][4][2], const Unit& u, int wr, int wc, int fr, int fq) const {
        const int row0 = u.pm * BM + wr * 64 + fr, col0 = u.pn * 128 + wc * 16 + 4 * fq;
#pragma unroll
        for (int ai = 0; ai < 2; ++ai) { if (u.pm * BM + ai * HALF >= E_MV) continue;
#pragma unroll
            for (int m = 0; m < 4; ++m) { bf16_t* rowp = H + (size_t)(row0 + ai * HALF + m * 16) * 5632 + col0;
#pragma unroll
                for (int bj = 0; bj < 2; ++bj) { const f32x4 g = acc[ai][bj][m][0], up = acc[ai][bj][m][1]; float h[4];
#pragma unroll
                    for (int e = 0; e < 4; ++e) h[e] = g[e] / (1.0f + __expf(-g[e])) * up[e];
                    typedef unsigned u32x2v __attribute__((ext_vector_type(2))); u32x2v w; w.x = cvt_pk_bf16(h[0], h[1]); w.y = cvt_pk_bf16(h[2], h[3]);
                    *(u32x2v*)(rowp + bj * 64) = w; } } }
    }
};
template <class Epi, class Sched, bool ALIGN_EPI = false, bool SP2 = false>
__device__ __forceinline__ void gemm_phase(PG8_LAS unsigned char* lds, const Gemm g, const Sched& S, const Epi& E) {
    int tid_l = threadIdx.x; asm volatile("" : "+v"(tid_l));
    const int tid = tid_l, wid = __builtin_amdgcn_readfirstlane(tid >> 6), lane = tid & 63, wr = wid >> 2, wc = wid & 3, fr = lane & 15, fq = lane >> 4;
    const int K = g.K, nt = K / BK;
    unsigned voffA[2], voffB[2];
#pragma unroll
    for (int i = 0; i < 2; ++i) { int R, C; stage_rc(tid * 16 + i * 8192, R, C); const int Rb = Epi::PERM ? ((R & ~31) + perm32(R & 31)) : R;
        voffA[i] = (unsigned)(R * K + C) * 2u; voffB[i] = (unsigned)(Rb * K + C) * 2u; }
    const size_t kstep = (size_t)(BK * 2);
    const size_t hstep = (size_t)HALF * K * 2;
    const size_t tstep = 2 * hstep;
    const unsigned ldsw = (unsigned)wid * 1024u;
    const int aoff = lds_byte(wr * 64 + fr, fq * 8), boff = lds_byte(wc * 32 + fr, fq * 8);
#define PG8_SA(b, h) (((b) * 2 + (h)) * HTB)
#define PG8_SB(b, h) ((4 + (b) * 2 + (h)) * HTB)
#define PG8_STAGE(bufoff, gbase, voff) do { _Pragma("unroll") for (int _i = 0; _i < 2; ++_i) \
        __builtin_amdgcn_global_load_lds((const unsigned*)((const char*)(gbase) + (voff)[_i]), (PG8_LAS unsigned*)(lds + (bufoff) + ldsw + _i * 8192), 16, 0, 0); } while (0)
#define PG8_LDA(dst, b, h) do { _Pragma("unroll") for (int m = 0; m < 4; ++m) _Pragma("unroll") for (int k = 0; k < 2; ++k) dst[m][k] = *(const PG8_LAS bf16x8*)(lds + PG8_SA(b, h) + aoff + m * 2048 + k * 1024); } while (0)
#define PG8_LDB(dst, b, h) do { _Pragma("unroll") for (int n = 0; n < 2; ++n) _Pragma("unroll") for (int k = 0; k < 2; ++k) dst[n][k] = *(const PG8_LAS bf16x8*)(lds + PG8_SB(b, h) + boff + n * 2048 + k * 1024); } while (0)
#define PG8_MMA(ai, bj, At, Bt) do { __builtin_amdgcn_s_setprio(1); _Pragma("unroll") for (int m = 0; m < 4; ++m) _Pragma("unroll") for (int n = 0; n < 2; ++n) _Pragma("unroll") for (int k = 0; k < 2; ++k) \
        acc[ai][bj][m][n] = __builtin_amdgcn_mfma_f32_16x16x32_bf16(Bt[n][k], At[m][k], acc[ai][bj][m][n], 0, 0, 0); __builtin_amdgcn_s_setprio(0); } while (0)
#define PG8_WAIT_V(n) asm volatile("s_waitcnt vmcnt(" #n ")" ::: "memory")
#define PG8_WAIT_L(n) asm volatile("s_waitcnt lgkmcnt(" #n ")" ::: "memory")
#define PG8_BAR __builtin_amdgcn_s_barrier()
#define PG8_SCHED __builtin_amdgcn_sched_barrier(0)
    Unit cur, nxt; int ui = 0;
    if (!S.next(0, cur)) return;
    f32x4 acc[2][2][4][2];
#pragma unroll
    for (int a = 0; a < 2; ++a)
#pragma unroll
        for (int b = 0; b < 2; ++b)
#pragma unroll
            for (int m = 0; m < 4; ++m)
#pragma unroll
                for (int n = 0; n < 2; ++n) acc[a][b][m][n] = (f32x4){0.f, 0.f, 0.f, 0.f};
    bf16x8 At[4][2], B0[2][2], B1[2][2];
    const char* cA = (const char*)g.A + (size_t)cur.pm * tstep; const char* cB = (const char*)g.Bt + (size_t)cur.pn * tstep;
    S.a_ready(cur);
    if constexpr (SP2) {
        PG8_STAGE(PG8_SB(0, 0), cB, voffB); PG8_STAGE(PG8_SB(0, 1), cB + hstep, voffB); PG8_STAGE(PG8_SA(0, 0), cA, voffA); PG8_STAGE(PG8_SA(0, 1), cA + hstep, voffA);
        if (wr == 1) PG8_BAR;
        PG8_WAIT_V(2); PG8_BAR;
        PG8_STAGE(PG8_SB(1, 0), cB + kstep, voffB); PG8_STAGE(PG8_SA(1, 0), cA + kstep, voffA); PG8_STAGE(PG8_SB(1, 1), cB + hstep + kstep, voffB);
        PG8_WAIT_V(6); PG8_BAR;
    } else {
        PG8_STAGE(PG8_SB(0, 0), cB, voffB); PG8_STAGE(PG8_SA(0, 0), cA, voffA); PG8_STAGE(PG8_SB(0, 1), cB + hstep, voffB); PG8_STAGE(PG8_SA(0, 1), cA + hstep, voffA);
        if (wr == 1) PG8_BAR;
        PG8_WAIT_V(4); PG8_BAR;
        PG8_STAGE(PG8_SB(1, 0), cB + kstep, voffB); PG8_STAGE(PG8_SA(1, 0), cA + kstep, voffA); PG8_STAGE(PG8_SB(1, 1), cB + hstep + kstep, voffB);
        PG8_WAIT_V(6); PG8_BAR;
    }
    for (;;) {
        const bool has_next = S.next(ui + 1, nxt);
        const char* nA = has_next ? (const char*)g.A + (size_t)nxt.pm * tstep : cA; const char* nB = has_next ? (const char*)g.Bt + (size_t)nxt.pn * tstep : cB;
        for (int t = 0; t < nt; t += 2) {
            const bool last = (t == nt - 2);
            const char* a1 = cA + (size_t)(t + 1) * kstep;
            const char* a2 = last ? nA : cA + (size_t)(t + 2) * kstep; const char* b2 = last ? nB : cB + (size_t)(t + 2) * kstep;
            const char* a3 = a2 + kstep; const char* b3 = b2 + kstep;
            if (last && has_next) S.a_ready(nxt);
            if constexpr (Epi::HOOK) { if (t == Epi::HOOK_T) E.hook(acc, cur, wr, wc, fr, fq); }
            if constexpr (SP2) {
            PG8_LDB(B0, 0, 0); PG8_LDB(B1, 0, 1); PG8_SCHED; PG8_LDA(At, 0, 0); PG8_STAGE(PG8_SA(1, 1), a1 + hstep, voffA);
            PG8_WAIT_V(8); PG8_WAIT_L(0); PG8_BAR; PG8_MMA(0, 0, At, B0); PG8_MMA(0, 1, At, B1); PG8_BAR; PG8_SCHED;
            PG8_LDA(At, 0, 1); PG8_STAGE(PG8_SB(0, 0), b2, voffB); PG8_STAGE(PG8_SB(0, 1), b2 + hstep, voffB); PG8_STAGE(PG8_SA(0, 0), a2, voffA);
            PG8_WAIT_V(8); PG8_WAIT_L(0); PG8_BAR; PG8_MMA(1, 0, At, B0); PG8_MMA(1, 1, At, B1); PG8_BAR; PG8_SCHED;
            PG8_LDB(B0, 1, 0); PG8_LDB(B1, 1, 1); PG8_SCHED; PG8_LDA(At, 1, 0); PG8_STAGE(PG8_SA(0, 1), a2 + hstep, voffA);
            PG8_WAIT_V(8); PG8_WAIT_L(0); PG8_BAR; PG8_MMA(0, 0, At, B0); PG8_MMA(0, 1, At, B1); PG8_BAR; PG8_SCHED;
            PG8_LDA(At, 1, 1); PG8_STAGE(PG8_SB(1, 0), b3, voffB); PG8_STAGE(PG8_SB(1, 1), b3 + hstep, voffB); PG8_STAGE(PG8_SA(1, 0), a3, voffA);
            PG8_WAIT_V(8); PG8_WAIT_L(0); PG8_BAR; PG8_MMA(1, 0, At, B0); PG8_MMA(1, 1, At, B1); PG8_BAR; PG8_SCHED;
            } else {
            PG8_LDB(B0, 0, 0); PG8_SCHED; PG8_LDA(At, 0, 0); PG8_STAGE(PG8_SA(1, 1), a1 + hstep, voffA);
            PG8_WAIT_L(8); PG8_BAR; PG8_WAIT_L(0); PG8_MMA(0, 0, At, B0); PG8_BAR; PG8_SCHED;
            PG8_LDB(B1, 0, 1); PG8_STAGE(PG8_SB(0, 0), b2, voffB);
            PG8_BAR; PG8_WAIT_L(0); PG8_MMA(0, 1, At, B1); PG8_BAR;
            PG8_LDA(At, 0, 1); PG8_STAGE(PG8_SA(0, 0), a2, voffA);
            PG8_BAR; PG8_WAIT_L(0); PG8_MMA(1, 0, At, B0); PG8_BAR; PG8_SCHED;
            PG8_STAGE(PG8_SB(0, 1), b2 + hstep, voffB);
            PG8_WAIT_V(6); PG8_BAR; PG8_MMA(1, 1, At, B1); PG8_BAR;
            PG8_LDB(B0, 1, 0); PG8_SCHED; PG8_LDA(At, 1, 0); PG8_STAGE(PG8_SA(0, 1), a2 + hstep, voffA);
            PG8_WAIT_L(8); PG8_BAR; PG8_WAIT_L(0); PG8_MMA(0, 0, At, B0); PG8_BAR; PG8_SCHED;
            PG8_LDB(B1, 1, 1); PG8_STAGE(PG8_SB(1, 0), b3, voffB);
            PG8_BAR; PG8_WAIT_L(0); PG8_MMA(0, 1, At, B1); PG8_BAR;
            PG8_LDA(At, 1, 1); PG8_STAGE(PG8_SA(1, 0), a3, voffA);
            PG8_BAR; PG8_WAIT_L(0); PG8_MMA(1, 0, At, B0); PG8_BAR; PG8_SCHED;
            PG8_STAGE(PG8_SB(1, 1), b3 + hstep, voffB);
            PG8_WAIT_V(6); PG8_BAR; PG8_MMA(1, 1, At, B1); PG8_BAR;
            }
        }
        if constexpr (ALIGN_EPI) { if (wr == 0) PG8_BAR; }
        if constexpr (!Epi::AFTER_DRAIN) { E(acc, cur, wr, wc, fr, fq); S.done(cur); }
        if (!has_next) break;
#pragma unroll
        for (int a = 0; a < 2; ++a)
#pragma unroll
            for (int b = 0; b < 2; ++b)
#pragma unroll
                for (int m = 0; m < 4; ++m)
#pragma unroll
                    for (int n = 0; n < 2; ++n) acc[a][b][m][n] = (f32x4){0.f, 0.f, 0.f, 0.f};
        cur = nxt; cA = nA; cB = nB; ++ui;
        if constexpr (ALIGN_EPI) { if (wr == 1) PG8_BAR; }
    }
    PG8_WAIT_V(0);
    if constexpr (!ALIGN_EPI) { if (wr == 0) PG8_BAR; }
    PG8_BAR;
    if constexpr (Epi::AFTER_DRAIN) { E.fused(acc, cur, wr, wc, fr, fq, lds, wid, lane); S.done(cur); }
#undef PG8_SA
#undef PG8_SB
#undef PG8_STAGE
#undef PG8_LDA
#undef PG8_LDB
#undef PG8_MMA
#undef PG8_WAIT_V
#undef PG8_WAIT_L
#undef PG8_BAR
#undef PG8_SCHED
}
}
#define GAS __attribute__((address_space(1)))
#define LAS __attribute__((address_space(3)))
typedef unsigned short bf16;
typedef unsigned v4u __attribute__((ext_vector_type(4)));
typedef float f32x4 __attribute__((ext_vector_type(4)));
typedef short bf16x8 __attribute__((ext_vector_type(8)));
typedef GAS unsigned gu32;
typedef GAS unsigned long long gu64;
#define RLX_AGENT __ATOMIC_RELAXED, __HIP_MEMORY_SCOPE_AGENT
#define LDS_WAIT() asm volatile("s_waitcnt lgkmcnt(0)" ::: "memory")
#define VM_WAIT() asm volatile("s_waitcnt vmcnt(0)" ::: "memory")
__device__ __forceinline__ unsigned long long rt() { return __builtin_amdgcn_s_memrealtime(); }
__device__ __forceinline__ unsigned f2bf(float f) { unsigned u = __builtin_bit_cast(unsigned, f); return (u + 0x7fffu + ((u >> 16) & 1u)) >> 16; }
__device__ __forceinline__ unsigned pk2(float lo, float hi) { return f2bf(lo) | (f2bf(hi) << 16); }

#define XB_TMO      128
#define XB_XCNT(j)  (256  + 64 * (j))
#define XB_XSUB(j)  (1280 + 64 * (j))
#define XB_XGEN(j)  (2304 + 64 * (j))
#define XB_TOP      3328
#define XB_TOPGEN   3392
#define XCD_BAR_WORDS 3456
#define XB_SPIN_CAP (1u << 18)

__device__ __forceinline__ unsigned xb_ld(unsigned* p)              { return __hip_atomic_load(p, __ATOMIC_RELAXED, __HIP_MEMORY_SCOPE_AGENT); }
__device__ __forceinline__ unsigned xb_add(unsigned* p, unsigned v) { return __hip_atomic_fetch_add(p, v, __ATOMIC_RELAXED, __HIP_MEMORY_SCOPE_AGENT); }
__device__ __forceinline__ unsigned xb_xcc_id() { return (unsigned)__builtin_amdgcn_s_getreg((3 << 11) | 20) & 0xFu; }
#define XB_SPIN(cond, bar) do { unsigned _sp = 0; while (cond) { __builtin_amdgcn_s_sleep(1); \
    if ((++_sp & 255u) == 0u) { if (xb_ld(&(bar)[XB_TMO])) break; if (_sp > XB_SPIN_CAP) { atomicAdd(&(bar)[XB_TMO], 1u); break; } } } } while (0)

struct XcdBarrier {
    unsigned* bar; unsigned x;
    volatile LAS unsigned* st;
};

__device__ __forceinline__ XcdBarrier xcd_barrier_post(unsigned* bar, volatile LAS unsigned* st) {
    XcdBarrier b; b.bar = bar; b.x = xb_xcc_id(); b.st = st;
    if (threadIdx.x == 0) (void)xb_add(&bar[XB_XCNT(b.x)], 1u);
    return b;
}
__device__ __forceinline__ void xcd_barrier_complete(unsigned* bar, unsigned x, unsigned& nloc, unsigned& nx) {
    const unsigned G = gridDim.x * gridDim.y * gridDim.z;
    unsigned sum, cnt, mine, sp = 0u;
    for (;;) {
        sum = 0u; cnt = 0u; mine = 0u;
#pragma unroll
        for (unsigned j = 0; j < 16; ++j) { const unsigned c = xb_ld(&bar[XB_XCNT(j)]); sum += c; cnt += (c > 0u) ? 1u : 0u; mine = (j == x) ? c : mine; }
        if (sum == G) break;
        __builtin_amdgcn_s_sleep(1);
        if ((++sp & 255u) == 0u) { if (xb_ld(&bar[XB_TMO])) break; if (sp > XB_SPIN_CAP) { atomicAdd(&bar[XB_TMO], 1u); break; } }
    }
    nloc = mine > 0u ? mine : 1u; nx = cnt > 0u ? cnt : 1u;
}

__device__ __forceinline__ void xcd_barrier(const XcdBarrier& b) {
    asm volatile("s_waitcnt vmcnt(0)" ::: "memory");
    __syncthreads();
    if (threadIdx.x == 0) {
        unsigned* bar = b.bar;
        __builtin_amdgcn_s_waitcnt(0);
        unsigned nloc = b.st[0], nx = b.st[1];
        if (nloc == 0u) { xcd_barrier_complete(bar, b.x, nloc, nx); b.st[0] = nloc; b.st[1] = nx; }
        const unsigned old = xb_add(&bar[XB_XSUB(b.x)], 1u);
        const unsigned gen = old / nloc;
        if (old + 1u == (gen + 1u) * nloc) {
            __builtin_amdgcn_fence(__ATOMIC_RELEASE, "agent");
            asm volatile("s_waitcnt vmcnt(0)" ::: "memory");
            const unsigned og = xb_add(&bar[XB_TOP], 1u);
            const unsigned tg = og / nx;
            if (og + 1u == (tg + 1u) * nx) xb_add(&bar[XB_TOPGEN], 1u);
            else XB_SPIN(xb_ld(&bar[XB_TOPGEN]) == tg, bar);
            __builtin_amdgcn_fence(__ATOMIC_ACQUIRE, "agent");
            xb_add(&bar[XB_XGEN(b.x)], 1u);
            asm volatile("s_waitcnt vmcnt(0)" ::: "memory");
        } else {
            XB_SPIN(xb_ld(&bar[XB_XGEN(b.x)]) == gen, bar);
            __builtin_amdgcn_fence(__ATOMIC_ACQUIRE, "agent");
            asm volatile("s_waitcnt vmcnt(0)" ::: "memory");
        }
    }
    __syncthreads();
}
typedef float f32x16 __attribute__((ext_vector_type(16)));
typedef unsigned u32x2 __attribute__((ext_vector_type(2)));
__device__ __forceinline__ float bf2f(bf16 v) { return __uint_as_float(((unsigned)v) << 16); }
__device__ __forceinline__ float bflo(unsigned w) { return __uint_as_float(w << 16); }
__device__ __forceinline__ float bfhi(unsigned w) { return __uint_as_float(w & 0xffff0000u); }
__device__ __forceinline__ float wave_sum(float v) {
#pragma unroll
    for (int o = 1; o < 64; o <<= 1) v += __shfl_xor(v, o);
    return v;
}
__device__ __forceinline__ float wave_max(float v) {
#pragma unroll
    for (int o = 1; o < 64; o <<= 1) v = fmaxf(v, __shfl_xor(v, o));
    return v;
}
__device__ __forceinline__ float siluf_(float x) { return x / (1.0f + __expf(-x)); }
__device__ __forceinline__ float softplusf_(float x) { return x > 20.0f ? x : log1pf(__expf(x)); }

struct Args { const float* in[23]; float* out; unsigned char* ws; int ph_lo, ph_hi, use_bar, pad; };
typedef const __attribute__((address_space(4))) Args* KArgs;
struct Ctx { LAS unsigned char* lds; int tid, lane, wave, G, bid; KArgs a; };

__device__ __forceinline__ void transpose_item(const float* sp, int ldn, int K, bf16* WT, int k0, int R0, LAS float* scr, int lane) {
#pragma unroll 8
    for (int i = 0; i < 32; ++i) { const int kk = 2 * i + (lane >> 5); scr[kk * 33 + (lane & 31)] = sp ? sp[(size_t)(k0 + kk) * ldn] : 0.0f; }
    LDS_WAIT(); asm volatile("" ::: "memory");
    const int c = lane & 7;
#pragma unroll
    for (int j = 0; j < 4; ++j) { const int n = (lane >> 3) + 8 * j; const LAS float* s = scr + (8 * c) * 33 + n;
        v4u o; o.x = pk2(s[0 * 33], s[1 * 33]); o.y = pk2(s[2 * 33], s[3 * 33]); o.z = pk2(s[4 * 33], s[5 * 33]); o.w = pk2(s[6 * 33], s[7 * 33]);
        *(GAS v4u*)(WT + (size_t)(R0 + n) * K + k0 + 8 * c) = o; }
    LDS_WAIT(); asm volatile("" ::: "memory");
}
constexpr int IT_IN = (DM / 64) * (NU / 32), IT_CAT = (KCAT / 64) * (DM / 32), IT_OUT = (DM / 64) * (DM / 32), IT_GU = (DM / 64) * (NGU / 32), IT_DN = (FF / 64) * (DM / 32);
constexpr int IT_LAYER = IT_IN + IT_CAT + IT_OUT + IT_GU + IT_DN;
__device__ __forceinline__ void p0_weights(const Ctx& C) {
    LAS float* scr = (LAS float*)(C.lds + RING_OFF + C.wave * 16384);
    const int gw = C.bid * NWAVES + C.wave, NGW = C.G * NWAVES, r = C.lane & 31;
    for (int it = gw; it < DEPTH * IT_LAYER; it += NGW) {
        const int l = it / IT_LAYER; int q = it % IT_LAYER;
        if (q < IT_IN) { const int nblk = NU / 32, kb = q / nblk, nb = q % nblk, R = 32 * nb + r;
            int col = R < 10240 ? R : (R < 17408 ? R + 64 : (R < 17472 ? 10240 + (R - 17408) : -1));
            const float* sp = col >= 0 ? (C.a->in[7]) + (size_t)l * DM * IN_DIM + col : nullptr;
            transpose_item(sp, IN_DIM, DM, ((bf16*)(C.a->ws + WS_WIN)) + (size_t)l * NU * DM, 64 * kb, 32 * nb, scr, C.lane); continue; }
        q -= IT_IN;
        if (q < IT_CAT) { const int nblk = DM / 32, kb = q / nblk, nb = q % nblk, R = 32 * nb + r, k0 = 64 * kb;
            const float* sp = k0 < DI ? (C.a->in[14]) + (size_t)l * DI * DM + R : (C.a->in[15]) + (size_t)l * DM * DM + R - (size_t)DI * DM;
            transpose_item(sp, DM, KCAT, ((bf16*)(C.a->ws + WS_WCAT)) + (size_t)l * DM * KCAT, k0, 32 * nb, scr, C.lane); continue; }
        q -= IT_CAT;
        if (q < IT_OUT) { const int nblk = DM / 32, kb = q / nblk, nb = q % nblk, R = 32 * nb + r;
            transpose_item((C.a->in[17]) + (size_t)l * DM * DM + R, DM, DM, ((bf16*)(C.a->ws + WS_WOUT)) + (size_t)l * DM * DM, 64 * kb, 32 * nb, scr, C.lane); continue; }
        q -= IT_OUT;
        if (q < IT_GU) { const int nblk = NGU / 32, kb = q / nblk, nb = q % nblk, R = 32 * nb + r, col = 4 * (R >> 3) + (R & 3);
            const float* sp = (((R >> 2) & 1) ? (C.a->in[20]) : (C.a->in[19])) + (size_t)l * DM * FF + col;
            transpose_item(sp, FF, DM, ((bf16*)(C.a->ws + WS_WGU)) + (size_t)l * NGU * DM, 64 * kb, 32 * nb, scr, C.lane); continue; }
        q -= IT_GU;
        { const int nblk = DM / 32, kb = q / nblk, nb = q % nblk, R = 32 * nb + r;
            transpose_item((C.a->in[21]) + (size_t)l * FF * DM + R, DM, FF, ((bf16*)(C.a->ws + WS_WDN)) + (size_t)l * DM * FF, 64 * kb, 32 * nb, scr, C.lane); }
    }
}
__device__ __forceinline__ void norm_row(const float* src, const float* gain, float* xcopy, bf16* xn, float* fdst, int lane) {
    const GAS f32x4* xr = (const GAS f32x4*)src + lane; const GAS f32x4* gr = (const GAS f32x4*)gain + lane;
    f32x4 v[8]; float s = 0.f;
#pragma unroll
    for (int j = 0; j < 8; ++j) { v[j] = xr[64 * j]; s += (v[j].x * v[j].x + v[j].y * v[j].y) + (v[j].z * v[j].z + v[j].w * v[j].w); }
    const float rstd = rsqrtf(wave_sum(s) * (1.0f / DM) + EPS);
    if (xcopy) { GAS f32x4* xc = (GAS f32x4*)xcopy + lane;
#pragma unroll
        for (int j = 0; j < 8; ++j) xc[64 * j] = v[j]; }
#pragma unroll
    for (int j = 0; j < 8; ++j) { const f32x4 g = gr[64 * j]; f32x4 o = v[j] * rstd; o = o * g;
        if (xn) { u32x2 w; w.x = pk2(o.x, o.y); w.y = pk2(o.z, o.w); *((GAS u32x2*)xn + lane + 64 * j) = w; }
        if (fdst) *((GAS f32x4*)fdst + lane + 64 * j) = o; }
}
__device__ __forceinline__ void p0_xinit(const Ctx& C) {
    const int gw = C.bid * NWAVES + C.wave, NGW = C.G * NWAVES;
    for (int m = gw; m < MV; m += NGW) { const float* src = m < SEQ ? (C.a->in[0]) + (size_t)m * DM : (C.a->in[1]) + (size_t)(m - SEQ) * DM;
        norm_row(src, (C.a->in[6]), ((float*)(C.a->ws + WS_X)) + (size_t)m * DM, ((bf16*)(C.a->ws + WS_XN)) + (size_t)m * DM, nullptr, C.lane); }
}
__device__ __forceinline__ void norm_phase(const Ctx& C, const float* gain, bool final_) {
    const int gw = C.bid * NWAVES + C.wave, NGW = C.G * NWAVES;
    for (int m = gw; m < MV; m += NGW) {
        if (final_) norm_row(((float*)(C.a->ws + WS_X)) + (size_t)m * DM, gain, nullptr, nullptr, (C.a->out) + O_YP + (size_t)m * DM, C.lane);
        else norm_row(((float*)(C.a->ws + WS_X)) + (size_t)m * DM, gain, nullptr, ((bf16*)(C.a->ws + WS_XN)) + (size_t)m * DM, nullptr, C.lane); }
}

__device__ __forceinline__ void naive_ssd_prompt(const Ctx& C, int l, int g) {
    const int tid = C.tid, hl = tid >> 6, p = tid & 63, h = 8 * g + hl, chx = h * 64 + p;
    const float* cw = (C.a->in[8]) + (size_t)l * CW * CD; const float* cb = (C.a->in[9]) + (size_t)l * CD;
    const float wx0 = cw[chx], wx1 = cw[CD + chx], wx2 = cw[2 * CD + chx], wx3 = cw[3 * CD + chx], bx = cb[chx];
    const int chb = tid < 128 ? DI + g * 128 + tid : DI + 1024 + g * 128 + ((tid - 128) & 127);
    const float wb0 = cw[chb], wb1 = cw[CD + chb], wb2 = cw[2 * CD + chb], wb3 = cw[3 * CD + chb], bb = cb[chb];
    const float A = -__expf((C.a->in[11])[l * NH + h]), dtb = (C.a->in[10])[l * NH + h], Dh = (C.a->in[12])[l * NH + h], nw = (C.a->in[13])[(size_t)l * DI + chx];
    float hreg[128];
#pragma unroll
    for (int n = 0; n < 128; ++n) hreg[n] = 0.f;
    float x1 = 0.f, x2 = 0.f, x3 = 0.f, b1 = 0.f, b2 = 0.f, b3 = 0.f;
    LAS float* BC = (LAS float*)(C.lds + RING_OFF); LAS float* red = (LAS float*)(C.lds + RING_OFF + 4096);
    const bf16* Ux = ((bf16*)(C.a->ws + WS_U)) + UXBC + chx; const bf16* Ub = ((bf16*)(C.a->ws + WS_U)) + UXBC + chb; const bf16* Uz = ((bf16*)(C.a->ws + WS_U)) + UZ + chx; const float* Dt = ((float*)(C.a->ws + WS_DT)) + h;
    bf16 nx = Ux[0], nb = Ub[0], nz = Uz[0]; float ndt = Dt[0];
    for (int tk = 0; tk < SEQ; ++tk) {
        const float xv = bf2f(nx), bv = bf2f(nb), zv = bf2f(nz), dtr = ndt;
        if (tk + 1 < SEQ) { const size_t o = (size_t)(tk + 1) * LDU; nx = Ux[o]; nb = Ub[o]; nz = Uz[o]; ndt = Dt[(size_t)(tk + 1) * 64]; }
        const int buf = tk & 1;
        const float xc = siluf_(bx + wx0 * x3 + wx1 * x2 + wx2 * x1 + wx3 * xv); x3 = x2; x2 = x1; x1 = xv;
        if (tid < 256) { const float bc = siluf_(bb + wb0 * b3 + wb1 * b2 + wb2 * b1 + wb3 * bv); b3 = b2; b2 = b1; b1 = bv; BC[buf * 256 + tid] = bc; }
        const float dt = softplusf_(dtr + dtb), dA = __expf(dt * A);
        __syncthreads();
        const float dtx = dt * xc; float y = 0.f;
        const LAS f32x4* B4 = (const LAS f32x4*)(BC + buf * 256); const LAS f32x4* C4 = B4 + 32;
#pragma unroll
        for (int n4 = 0; n4 < 32; ++n4) { const f32x4 Bv = B4[n4], Cv = C4[n4];
#pragma unroll
            for (int e = 0; e < 4; ++e) { hreg[4 * n4 + e] = dA * hreg[4 * n4 + e] + dtx * Bv[e]; y += hreg[4 * n4 + e] * Cv[e]; } }
        y += Dh * xc;
        const float gv = y * siluf_(zv);
        const float ss = wave_sum(gv * gv); if (C.lane == 0) red[buf * 8 + hl] = ss;
        __syncthreads();
        float tot = 0.f;
#pragma unroll
        for (int k = 0; k < 8; ++k) tot += red[buf * 8 + k];
        const float rstd = rsqrtf(tot * (1.0f / 512.0f) + EPS);
        ((bf16*)(C.a->ws + WS_YO))[(size_t)tk * KCAT + chx] = (bf16)f2bf(gv * rstd * nw);
    }
    float* ps = (C.a->out) + O_PSSM + (((size_t)l * NH + h) * HP + p) * DS;
#pragma unroll
    for (int n4 = 0; n4 < 32; ++n4) *((GAS f32x4*)ps + n4) = (f32x4){hreg[4 * n4], hreg[4 * n4 + 1], hreg[4 * n4 + 2], hreg[4 * n4 + 3]};
    __syncthreads();
}

__device__ __forceinline__ void naive_attn_prompt(const Ctx& C, int l, int vb, int nvb) {
    for (int idx = vb * 512 + C.tid; idx < SEQ * AH; idx += nvb * 512) {
        const int hq = idx / SEQ, t = idx % SEQ, kh = hq >> 2;
        float q[64], o[64];
        { const GAS v4u* qp = (const GAS v4u*)(((bf16*)(C.a->ws + WS_U)) + (size_t)t * LDU + UQ + hq * 64);
#pragma unroll
          for (int c = 0; c < 8; ++c) { const v4u w = qp[c]; q[8 * c] = bflo(w.x); q[8 * c + 1] = bfhi(w.x); q[8 * c + 2] = bflo(w.y); q[8 * c + 3] = bfhi(w.y); q[8 * c + 4] = bflo(w.z); q[8 * c + 5] = bfhi(w.z); q[8 * c + 6] = bflo(w.w); q[8 * c + 7] = bfhi(w.w); } }
#pragma unroll
        for (int d = 0; d < 64; ++d) o[d] = 0.f;
        float m = (C.a->in[16])[l * AH + hq], ls = 1.0f;
        const int j0 = t - WIN < 0 ? 0 : t - WIN;
        for (int j = j0; j <= t; ++j) {
            const GAS v4u* kp = (const GAS v4u*)(((bf16*)(C.a->ws + WS_U)) + (size_t)j * LDU + UK + kh * 64); const GAS v4u* vp = (const GAS v4u*)(((bf16*)(C.a->ws + WS_U)) + (size_t)j * LDU + UV + kh * 64);
            float s = 0.f;
#pragma unroll
            for (int c = 0; c < 8; ++c) { const v4u w = kp[c];
                s += q[8 * c] * bflo(w.x) + q[8 * c + 1] * bfhi(w.x) + q[8 * c + 2] * bflo(w.y) + q[8 * c + 3] * bfhi(w.y) + q[8 * c + 4] * bflo(w.z) + q[8 * c + 5] * bfhi(w.z) + q[8 * c + 6] * bflo(w.w) + q[8 * c + 7] * bfhi(w.w); }
            s *= 0.125f;
            const float mn = fmaxf(m, s), cf = __expf(m - mn), pj = __expf(s - mn);
            ls = ls * cf + pj; m = mn;
#pragma unroll
            for (int c = 0; c < 8; ++c) { const v4u w = vp[c];
                o[8 * c] = o[8 * c] * cf + pj * bflo(w.x); o[8 * c + 1] = o[8 * c + 1] * cf + pj * bfhi(w.x); o[8 * c + 2] = o[8 * c + 2] * cf + pj * bflo(w.y); o[8 * c + 3] = o[8 * c + 3] * cf + pj * bfhi(w.y);
                o[8 * c + 4] = o[8 * c + 4] * cf + pj * bflo(w.z); o[8 * c + 5] = o[8 * c + 5] * cf + pj * bfhi(w.z); o[8 * c + 6] = o[8 * c + 6] * cf + pj * bflo(w.w); o[8 * c + 7] = o[8 * c + 7] * cf + pj * bfhi(w.w); }
        }
        const float inv = 1.0f / ls;
        GAS v4u* op = (GAS v4u*)(((bf16*)(C.a->ws + WS_YO)) + (size_t)t * KCAT + DI + hq * 64);
#pragma unroll
        for (int c = 0; c < 8; ++c) { v4u w; w.x = pk2(o[8 * c] * inv, o[8 * c + 1] * inv); w.y = pk2(o[8 * c + 2] * inv, o[8 * c + 3] * inv); w.z = pk2(o[8 * c + 4] * inv, o[8 * c + 5] * inv); w.w = pk2(o[8 * c + 6] * inv, o[8 * c + 7] * inv); op[c] = w; }
    }
}

__device__ __forceinline__ void sample_ssd_unit(const Ctx& C, int l, int b, int g) {
    const int tid = C.tid, row = SEQ + b;
    LAS float* xs = (LAS float*)(C.lds + RING_OFF); LAS float* Bs = xs + 512; LAS float* Cs = xs + 640; LAS float* ysm = xs + 768; LAS float* red = xs + 1280;
    const float* cw = (C.a->in[8]) + (size_t)l * CW * CD; const float* cb = (C.a->in[9]) + (size_t)l * CD;
    const float* sc = (C.a->in[3]) + ((size_t)l * NB + b) * 3 * CD;
    { const int ch = g * 512 + tid;
      const float v = cb[ch] + cw[ch] * sc[ch] + cw[CD + ch] * sc[CD + ch] + cw[2 * CD + ch] * sc[2 * CD + ch] + cw[3 * CD + ch] * bf2f(((bf16*)(C.a->ws + WS_U))[(size_t)row * LDU + UXBC + ch]);
      xs[tid] = siluf_(v); }
    if (tid < 256) { const int ch = tid < 128 ? DI + g * 128 + tid : DI + 1024 + g * 128 + (tid - 128);
      const float v = cb[ch] + cw[ch] * sc[ch] + cw[CD + ch] * sc[CD + ch] + cw[2 * CD + ch] * sc[2 * CD + ch] + cw[3 * CD + ch] * bf2f(((bf16*)(C.a->ws + WS_U))[(size_t)row * LDU + UXBC + ch]);
      Bs[tid] = siluf_(v); }
    __syncthreads();
    const int n4 = tid & 31, pr = tid >> 5;
    const f32x4 Bv = *((const LAS f32x4*)Bs + n4), Cv = *((const LAS f32x4*)Cs + n4);
#pragma unroll 2
    for (int j = 0; j < 8; ++j) { const int h = 8 * g + j;
        const float dt = softplusf_(((float*)(C.a->ws + WS_DT))[(size_t)row * 64 + h] + (C.a->in[10])[l * NH + h]), dA = __expf(-__expf((C.a->in[11])[l * NH + h]) * dt), Dh = (C.a->in[12])[l * NH + h];
        const size_t sbase = (((size_t)l * NB + b) * NH + h) * HP * DS;
#pragma unroll
        for (int pp = 0; pp < 4; ++pp) { const int p = pr + 16 * pp; const float xv = xs[j * 64 + p], dtx = dt * xv;
            const f32x4 hv = *((const GAS f32x4*)((C.a->in[2]) + sbase + (size_t)p * DS) + n4);
            f32x4 hn; hn.x = dA * hv.x + dtx * Bv.x; hn.y = dA * hv.y + dtx * Bv.y; hn.z = dA * hv.z + dtx * Bv.z; hn.w = dA * hv.w + dtx * Bv.w;
            *((GAS f32x4*)((C.a->out) + O_SSSM + sbase + (size_t)p * DS) + n4) = hn;
            float yp = (hn.x * Cv.x + hn.y * Cv.y) + (hn.z * Cv.z + hn.w * Cv.w);
#pragma unroll
            for (int o = 1; o < 32; o <<= 1) yp += __shfl_xor(yp, o);
            if (n4 == 0) ysm[j * 64 + p] = yp + Dh * xv; }
    }
    __syncthreads();
    { const int ch = g * 512 + tid; const float gv = ysm[tid] * siluf_(bf2f(((bf16*)(C.a->ws + WS_U))[(size_t)row * LDU + UZ + ch]));
      const float ss = wave_sum(gv * gv); if (C.lane == 0) red[C.wave] = ss;
      __syncthreads();
      float tot = 0.f;
#pragma unroll
      for (int k = 0; k < 8; ++k) tot += red[k];
      ((bf16*)(C.a->ws + WS_YO))[(size_t)row * KCAT + ch] = (bf16)f2bf(gv * rsqrtf(tot * (1.0f / 512.0f) + EPS) * (C.a->in[13])[(size_t)l * DI + ch]); }
    __syncthreads();
}

__device__ __forceinline__ void sample_attn_unit(const Ctx& C, int l, int b, int kh) {
    const int tid = C.tid, row = SEQ + b;
    LAS float* qs = (LAS float*)(C.lds + RING_OFF); LAS float* sc = qs + 256; LAS float* knew = qs + 256 + 4 * 132; LAS float* vnew = knew + 64;
    const bf16* Ur = ((bf16*)(C.a->ws + WS_U)) + (size_t)row * LDU;
    if (tid < 256) qs[tid] = bf2f(Ur[UQ + kh * 256 + tid]);
    else if (tid < 320) knew[tid - 256] = bf2f(Ur[UK + kh * 64 + (tid - 256)]);
    else if (tid < 384) vnew[tid - 320] = bf2f(Ur[UV + kh * 64 + (tid - 320)]);
    __syncthreads();
    const size_t cbase = ((size_t)l * NB + b) * WIN * (KVH * AD) + (size_t)kh * AD;
    { const int w = tid >> 2, hq = tid & 3; const GAS f32x4* kp = (const GAS f32x4*)((C.a->in[4]) + cbase + (size_t)w * (KVH * AD)); const LAS f32x4* qp = (const LAS f32x4*)(qs + hq * 64);
      float s = 0.f;
#pragma unroll
      for (int c = 0; c < 16; ++c) { const f32x4 kv = kp[c], qv = qp[c]; s += (kv.x * qv.x + kv.y * qv.y) + (kv.z * qv.z + kv.w * qv.w); }
      sc[hq * 132 + w] = s * 0.125f; }
    if (tid < 4) { float s = 0.f;
      for (int d = 0; d < 64; ++d) s += qs[tid * 64 + d] * knew[d];
      sc[tid * 132 + 128] = s * 0.125f; }
    __syncthreads();
    if (C.wave < 4) { const int hq = C.wave; const float sink = (C.a->in[16])[l * AH + 4 * kh + hq];
      const float v0 = sc[hq * 132 + C.lane], v1 = sc[hq * 132 + 64 + C.lane], v2 = C.lane == 0 ? sc[hq * 132 + 128] : -__builtin_inff();
      const float m = fmaxf(wave_max(fmaxf(fmaxf(v0, v1), v2)), sink);
      const float e0 = __expf(v0 - m), e1 = __expf(v1 - m), e2 = C.lane == 0 ? __expf(v2 - m) : 0.f;
      const float inv = 1.0f / (wave_sum(e0 + e1 + e2) + __expf(sink - m));
      sc[hq * 132 + C.lane] = e0 * inv; sc[hq * 132 + 64 + C.lane] = e1 * inv; if (C.lane == 0) sc[hq * 132 + 128] = e2 * inv; }
    __syncthreads();
    if (tid < 256) { const int hq = tid >> 6, d = tid & 63; const float* vp = (C.a->in[5]) + cbase + d; float o = sc[hq * 132 + 128] * vnew[d];
#pragma unroll 8
      for (int w = 0; w < WIN; ++w) o += sc[hq * 132 + w] * vp[(size_t)w * (KVH * AD)];
      ((bf16*)(C.a->ws + WS_YO))[(size_t)row * KCAT + DI + (4 * kh + hq) * 64 + d] = (bf16)f2bf(o); }
    for (int i = tid; i < WIN * 16; i += 512) { const int w = i >> 4, c4 = i & 15;
        f32x4 kv, vv;
        if (w < WIN - 1) { kv = *((const GAS f32x4*)((C.a->in[4]) + cbase + (size_t)(w + 1) * (KVH * AD)) + c4); vv = *((const GAS f32x4*)((C.a->in[5]) + cbase + (size_t)(w + 1) * (KVH * AD)) + c4); }
        else { kv = *((const LAS f32x4*)knew + c4); vv = *((const LAS f32x4*)vnew + c4); }
        *((GAS f32x4*)((C.a->out) + O_SK + cbase + (size_t)w * (KVH * AD)) + c4) = kv; *((GAS f32x4*)((C.a->out) + O_SV + cbase + (size_t)w * (KVH * AD)) + c4) = vv; }
    __syncthreads();
}

__device__ __forceinline__ void copy_outs(const Ctx& C, int l, int vb, int nvb) {
    const int gt = vb * 512 + C.tid, NT = nvb * 512;
    for (int i = gt; i < WIN * KVH * AD; i += NT) { const int w = i >> 9, c = i & 511; const bf16* Ur = ((bf16*)(C.a->ws + WS_U)) + (size_t)(SEQ - WIN + w) * LDU;
        (C.a->out)[O_PK + (size_t)l * WIN * KVH * AD + i] = bf2f(Ur[UK + c]); (C.a->out)[O_PV + (size_t)l * WIN * KVH * AD + i] = bf2f(Ur[UV + c]); }
    for (int i = gt; i < 3 * CD; i += NT) { const int j = i / CD, ch = i % CD; (C.a->out)[O_PCONV + (size_t)l * 3 * CD + i] = bf2f(((bf16*)(C.a->ws + WS_U))[(size_t)(SEQ - 3 + j) * LDU + UXBC + ch]); }
    for (int i = gt; i < NB * 3 * CD; i += NT) { const int b = i / (3 * CD), r = i % (3 * CD), j = r / CD, ch = r % CD;
        (C.a->out)[O_SCONV + (size_t)l * NB * 3 * CD + i] = j < 2 ? (C.a->in[3])[((size_t)l * NB + b) * 3 * CD + (j + 1) * CD + ch] : bf2f(((bf16*)(C.a->ws + WS_U))[(size_t)(SEQ + b) * LDU + UXBC + ch]); }
}
constexpr int NPL = 8;
constexpr int NPH = 1 + DEPTH * NPL;
#ifndef MK_SPLIT
#define MK_SPLIT 0
#endif
__global__ void __launch_bounds__(NWAVES * 64, 2) fwd(Args args) {
    extern __shared__ __attribute__((aligned(16))) unsigned char lds_raw[];
    LAS unsigned char* const lds = (LAS unsigned char*)lds_raw;
    unsigned char* ws = args.ws;
#define FRESH_CTX() Ctx C; { int t_ = threadIdx.x; asm volatile("" : "+v"(t_)); int b_ = blockIdx.x, g_ = gridDim.x; asm volatile("" : "+s"(b_), "+s"(g_)); \
        KArgs kp_ = (KArgs)__builtin_amdgcn_kernarg_segment_ptr(); asm volatile("" : "+s"(kp_)); \
        C.lds = lds; C.tid = t_; C.lane = t_ & 63; C.wave = __builtin_amdgcn_readfirstlane(t_ >> 6); C.G = g_; C.bid = b_; C.a = kp_; }
    for (int u = threadIdx.x; u < (LDS_BYTES - LDSCTL_OFF) / 4; u += NWAVES * 64) ((LAS unsigned*)(lds + LDSCTL_OFF))[u] = 0u;
    __syncthreads();
    volatile LAS unsigned* MISC = (volatile LAS unsigned*)(lds + MISC_OFF);
    unsigned* barw = (unsigned*)(ws + WS_CTL) + CW_BAR;
    XcdBarrier bar; bar.bar = barw; bar.x = 0; bar.st = nullptr;
    if (args.use_bar) bar = xcd_barrier_post(barw, MISC + 8);
    const int lo = args.ph_lo, hi = args.ph_hi;
#define IN(k) (lo <= (k) && (k) < hi)
#define SEAM(k) do { if (IN((k) + 1)) xcd_barrier(bar); } while (0)

#ifndef NO_P0
    if (IN(0)) { FRESH_CTX(); p0_weights(C); p0_xinit(C); SEAM(0); }
#endif

#pragma nounroll
    for (int l = 0; l < DEPTH; ++l) {
        const int pb = 1 + l * NPL;
#ifndef NO_G1
        if (IN(pb + 0)) {
            FRESH_CTX();
            pg8::Gemm g{((bf16*)(C.a->ws + WS_XN)), ((bf16*)(C.a->ws + WS_WIN)) + (size_t)l * NU * DM, MP, NU, DM}; pg8::StaticOrder S; S.init(MP, NU, C.G, C.bid);
            pg8::EpiU E{((bf16*)(C.a->ws + WS_U)), ((float*)(C.a->ws + WS_DT))};
            pg8::gemm_phase<pg8::EpiU, pg8::StaticOrder, true, true>(C.lds + RING_OFF, g, S, E);
            SEAM(pb + 0);
        }
#endif
        if (IN(pb + 1)) {
            FRESH_CTX();
#ifndef NO_NSSD
            if (C.bid < NG) naive_ssd_prompt(C, l, C.bid);
            else
#endif
            {
                const int vb = C.bid - NG, nvb = C.G - NG;
#ifndef NO_SSSD
                for (int u = vb; u < NB * NG; u += nvb) sample_ssd_unit(C, l, u >> 3, u & 7);
#endif
#ifndef NO_SATT
                for (int u = vb; u < NB * KVH; u += nvb) sample_attn_unit(C, l, u >> 3, u & 7);
#endif
#ifndef NO_NATT
                naive_attn_prompt(C, l, vb, nvb);
#endif
                copy_outs(C, l, vb, nvb);
            }
            SEAM(pb + 1);
        }
#ifndef NO_G2
        if (IN(pb + 2)) {
            FRESH_CTX();
            pg8::Gemm g{((bf16*)(C.a->ws + WS_YO)), ((bf16*)(C.a->ws + WS_WCAT)) + (size_t)l * DM * KCAT, MP, DM, KCAT}; pg8::StaticOrder S; S.init(MP, DM, C.G, C.bid);
            pg8::EpiMerge E{((bf16*)(C.a->ws + WS_U)), ((bf16*)(C.a->ws + WS_MRG))};
            pg8::gemm_phase<pg8::EpiMerge, pg8::StaticOrder, true, true>(C.lds + RING_OFF, g, S, E);
            SEAM(pb + 2);
        }
#endif
#ifndef NO_G3
        if (IN(pb + 3)) {
            FRESH_CTX();
            pg8::Gemm g{((bf16*)(C.a->ws + WS_MRG)), ((bf16*)(C.a->ws + WS_WOUT)) + (size_t)l * DM * DM, MP, DM, DM}; pg8::StaticOrder S; S.init(MP, DM, C.G, C.bid);
            pg8::EpiResid E{((float*)(C.a->ws + WS_X))};
            pg8::gemm_phase<pg8::EpiResid, pg8::StaticOrder, true, true>(C.lds + RING_OFF, g, S, E);
            SEAM(pb + 3);
        }
#endif
        if (IN(pb + 4)) { FRESH_CTX(); norm_phase(C, (C.a->in[18]) + (size_t)l * DM, false); SEAM(pb + 4); }
#ifndef NO_G4
        if (IN(pb + 5)) {
            FRESH_CTX();
            pg8::Gemm g{((bf16*)(C.a->ws + WS_XN)), ((bf16*)(C.a->ws + WS_WGU)) + (size_t)l * NGU * DM, MP, NGU, DM}; pg8::StaticOrder S; S.init(MP, NGU, C.G, C.bid);
            pg8::EpiSwiGLU E{((bf16*)(C.a->ws + WS_HB))};
            pg8::gemm_phase<pg8::EpiSwiGLU, pg8::StaticOrder, true, true>(C.lds + RING_OFF, g, S, E);
            SEAM(pb + 5);
        }
#endif
#ifndef NO_G5
        if (IN(pb + 6)) {
            FRESH_CTX();
            pg8::Gemm g{((bf16*)(C.a->ws + WS_HB)), ((bf16*)(C.a->ws + WS_WDN)) + (size_t)l * DM * FF, MP, DM, FF}; pg8::StaticOrder S; S.init(MP, DM, C.G, C.bid);
            pg8::EpiResid E{((float*)(C.a->ws + WS_X))};
            pg8::gemm_phase<pg8::EpiResid, pg8::StaticOrder, true, true>(C.lds + RING_OFF, g, S, E);
            SEAM(pb + 6);
        }
#endif
        if (IN(pb + 7)) {
            FRESH_CTX();
            if (l + 1 < DEPTH) norm_phase(C, (C.a->in[6]) + (size_t)(l + 1) * DM, false); else norm_phase(C, (C.a->in[22]), true);
            SEAM(pb + 7);
        }
    }
#undef IN
#undef SEAM
}

extern "C" void kernel_launch(void* const* d_in, const int* in_sizes, int n_in, void* d_out, int out_size, void* d_ws, size_t ws_size, hipStream_t stream) {
    static int grid = 0;
    if (grid == 0) {
        if (n_in != 23 || (size_t)out_size != O_END || ws_size < WS_END) { fprintf(stderr, "kernel_launch: unexpected problem (n_in %d, out %d, ws %zu; need ws >= %zu); nothing launched\n", n_in, out_size, ws_size, (size_t)WS_END); grid = -1; return; }
        int dev = 0, cus = 0, per_cu = 0;
        if (hipGetDevice(&dev) != hipSuccess || hipDeviceGetAttribute(&cus, hipDeviceAttributeMultiprocessorCount, dev) != hipSuccess) { grid = -1; return; }
        if (hipFuncSetAttribute((const void*)fwd, hipFuncAttributeMaxDynamicSharedMemorySize, LDS_BYTES) != hipSuccess) { fprintf(stderr, "kernel_launch: hipFuncSetAttribute failed\n"); grid = -1; return; }
        if (hipOccupancyMaxActiveBlocksPerMultiprocessor(&per_cu, (const void*)fwd, NWAVES * 64, LDS_BYTES) != hipSuccess || per_cu < 1) { fprintf(stderr, "kernel_launch: occupancy query says %d blocks per CU\n", per_cu); }
        (void)hipGetLastError();
        grid = cus;
    }
    if (grid < 0) return;
    if (hipMemsetAsync((char*)d_ws + WS_CTL, 0, CTL_ZERO_BYTES, stream) != hipSuccess) return;
    Args a{};
    for (int i = 0; i < 23; ++i) a.in[i] = (const float*)d_in[i];
    a.out = (float*)d_out; a.ws = (unsigned char*)d_ws; a.pad = 0;
#if MK_SPLIT
    for (int p = 0; p < NPH; ++p) { a.ph_lo = p; a.ph_hi = p + 1; a.use_bar = 0; hipLaunchKernelGGL(fwd, dim3(grid), dim3(NWAVES * 64), LDS_BYTES, stream, a); }
#else
    a.ph_lo = 0; a.ph_hi = NPH; a.use_bar = 1;
    hipLaunchKernelGGL(fwd, dim3(grid), dim3(NWAVES * 64), LDS_BYTES, stream, a);
#endif
    const hipError_t le = hipPeekAtLastError();
    if (le != hipSuccess) fprintf(stderr, "kernel_launch: launch failed: %s\n", hipGetErrorName(le));
}
```

```cpp
#include <hip/hip_runtime.h>
#include <cstdio>
#include <cstdint>

constexpr int DM = 2048, SEQ = 8192, NB = 128, DEPTH = 2;
constexpr int MV = SEQ + NB;
constexpr int MP = 8448;
constexpr int DI = 4096, NH = 64, HP = 64, DS = 128, NG = 8, CD = 6144, CW = 4;
constexpr int AH = 32, KVH = 8, AD = 64, WIN = 128;
constexpr int FF = 5632;
constexpr int IN_DIM = 17472;
constexpr float EPS = 1e-6f;
constexpr int UZ = 0, UXBC = 4096, UQ = 10240, UK = 12288, UV = 12800, UGS = 13312, UGA = 15360, LDU = 17408;
__host__ __device__ __forceinline__ constexpr size_t UIDX(int row, int col) { return ((size_t)(row >> 7) * (LDU / 64) + (size_t)(col >> 6)) * 8192 + (size_t)(((row & 127) << 6) + (col & 63)); }
constexpr int NU = 17664;
constexpr int KCAT = DI + DM;
constexpr int NGU = 2 * FF;

constexpr size_t O_YP = 0;
constexpr size_t O_YS = O_YP + (size_t)SEQ * DM;
constexpr size_t O_PSSM = O_YS + (size_t)NB * DM;
constexpr size_t O_PCONV = O_PSSM + (size_t)DEPTH * NH * HP * DS;
constexpr size_t O_PK = O_PCONV + (size_t)DEPTH * 3 * CD;
constexpr size_t O_PV = O_PK + (size_t)DEPTH * WIN * KVH * AD;
constexpr size_t O_SSSM = O_PV + (size_t)DEPTH * WIN * KVH * AD;
constexpr size_t O_SCONV = O_SSSM + (size_t)DEPTH * NB * NH * HP * DS;
constexpr size_t O_SK = O_SCONV + (size_t)DEPTH * NB * 3 * CD;
constexpr size_t O_SV = O_SK + (size_t)DEPTH * NB * WIN * KVH * AD;
constexpr size_t O_END = O_SV + (size_t)DEPTH * NB * WIN * KVH * AD;
static_assert(O_END == 190877696ull, "output size");

constexpr size_t al256(size_t x) { return (x + 255) & ~(size_t)255; }
constexpr size_t WS_CTL = 0, CTL_ZERO_BYTES = 1u << 20;
constexpr size_t SZ_WIN = (size_t)NU * DM * 2, SZ_WCAT = (size_t)DM * KCAT * 2, SZ_WOUT = (size_t)DM * DM * 2, SZ_WGU = (size_t)NGU * DM * 2, SZ_WDN = (size_t)DM * FF * 2;
constexpr size_t WS_WIN = 1u << 20;
constexpr size_t WS_WCAT = WS_WIN + DEPTH * SZ_WIN;
constexpr size_t WS_WOUT = WS_WCAT + DEPTH * SZ_WCAT;
constexpr size_t WS_WGU = WS_WOUT + DEPTH * SZ_WOUT;
constexpr size_t WS_WDN = WS_WGU + DEPTH * SZ_WGU;
constexpr size_t WS_X = WS_WDN + DEPTH * SZ_WDN;
constexpr size_t WS_XN = WS_X + (size_t)MP * DM * 4;
constexpr size_t WS_U = WS_XN + (size_t)MP * DM * 2;
constexpr size_t WS_DT = WS_U + (size_t)MP * LDU * 2;
constexpr size_t WS_YO = WS_DT + (size_t)MP * 64 * 4;
constexpr size_t WS_MRG = WS_YO + (size_t)MP * KCAT * 2;
constexpr size_t WS_HB = WS_MRG + (size_t)MP * DM * 2;
constexpr size_t WS_XT = WS_HB + (size_t)MP * FF * 2;
constexpr size_t WS_BRM = WS_XT + (size_t)64 * 64 * 64 * 128 * 2;
constexpr size_t WS_BT = WS_BRM + (size_t)64 * 8 * 128 * 128 * 2;
constexpr size_t WS_CRM = WS_BT + (size_t)64 * 8 * 128 * 128 * 2;
constexpr size_t WS_DTT = WS_CRM + (size_t)64 * 8 * 128 * 128 * 2;
constexpr size_t WS_ACS = WS_DTT + (size_t)64 * 64 * 128 * 4;
constexpr size_t WS_VT = WS_ACS + (size_t)64 * 64 * 128 * 4;
constexpr size_t WS_ST = WS_VT + (size_t)8 * 64 * 8192 * 2;
constexpr size_t WS_HS = WS_ST + (size_t)64 * 64 * 64 * 128 * 4;
constexpr size_t WS_MS = WS_HS + (size_t)64 * 64 * 64 * 128 * 2;
constexpr size_t WS_RSA = WS_MS + (size_t)NB * DM * 4;
constexpr size_t WS_RSB = WS_RSA + (size_t)MP * 4;
constexpr size_t WS_END = WS_RSB + (size_t)MP * 4;
static_assert(WS_WIN % 256 == 0 && WS_X % 256 == 0 && WS_U % 256 == 0 && WS_YO % 256 == 0 && WS_HB % 256 == 0 && WS_XT % 256 == 0 && WS_ST % 256 == 0, "ws alignment");
constexpr int CW_BAR = 4096;

constexpr int RING_OFF = 0, RING_BYTES = 131072;
constexpr int PC_B = 0, PC_C = 34816, PC_Y = 69632, PC_SSQ = 139264, PC_AD = 143360, PC_END = 151552;
constexpr int LDSCTL_OFF = PC_END, MISC_OFF = LDSCTL_OFF + 320;
constexpr int LDS_BYTES = 155648;
constexpr int NWAVES = 8;
#define MK_SPLIT 0
namespace pg8 {
#define PG8_LAS __attribute__((address_space(3)))
typedef unsigned short bf16_t;
typedef short bf16x8 __attribute__((ext_vector_type(8)));
typedef float f32x4 __attribute__((ext_vector_type(4)));
typedef unsigned u32x4 __attribute__((ext_vector_type(4)));
constexpr int BM = 256, BK = 64, HALF = 128, HTB = HALF * BK * 2  , STAGE_BYTES = 8 * HTB, NXCD = 8, WGM = 8;

__host__ __device__ __forceinline__ int lds_byte(int r, int c) { const int st = (r >> 4) * 2 + (c >> 5), rr = r & 15, cc = c & 31, ob = rr * 64 + cc * 2; return st * 1024 + (ob ^ (((ob >> 9) & 1) << 5)); }
__host__ __device__ __forceinline__ void stage_rc(int b, int& R, int& C) { const int st = b / 1024, sb = b % 1024, swz = sb ^ (((sb >> 9) & 1) << 5); R = (st >> 1) * 16 + swz / 64; C = (st & 1) * 32 + (swz % 64) / 2; }
__host__ __device__ __forceinline__ int perm32(int rho) { const int n = rho >> 4, i = rho & 15; return 8 * (i >> 2) + 4 * n + (i & 3); }

struct Unit { int pm, pn; };
struct Gemm { const bf16_t* A; const bf16_t* Bt; int M, N, K; };

struct StaticOrder {
    int nM, nN, nwg, G, c;
    __host__ __device__ void init(int M, int N, int G_, int c_) { nM = M / BM; nN = N / BM; nwg = nM * nN; G = G_; c = c_; }
    __host__ __device__ bool next(int i, Unit& u) const {
        const long L = (long)i * G + c; if (L >= nwg) return false;
        int wgid = (int)L; { const int q = nwg / NXCD, r = nwg % NXCD, xcd = wgid % NXCD, off = wgid / NXCD; wgid = (xcd < r ? xcd * (q + 1) : r * (q + 1) + (xcd - r) * q) + off; }
        const int nig = WGM * nN, gid = wgid / nig, fm = gid * WGM, gsz = (nM - fm) < WGM ? (nM - fm) : WGM;
        u.pm = fm + ((wgid % nig) % gsz); u.pn = (wgid % nig) / gsz; return true;
    }
    __device__ __forceinline__ void a_ready(const Unit&) const {}
    __device__ __forceinline__ void done(const Unit&) const {}
};
__device__ __forceinline__ unsigned cvt_pk_bf16(float lo, float hi) { unsigned r; asm volatile("v_cvt_pk_bf16_f32 %0, %1, %2" : "=v"(r) : "v"(lo), "v"(hi)); return r; }
__device__ __forceinline__ float bf_lo(unsigned w) { return __uint_as_float(w << 16); }
__device__ __forceinline__ float bf_hi(unsigned w) { return __uint_as_float(w & 0xffff0000u); }
__device__ __forceinline__ float sigmoidf_(float x) { return __builtin_amdgcn_rcpf(1.0f + __expf(-x)); }
constexpr int E_MV = 8320, E_LDU = 17408, E_UGS = 13312, E_UGA = 15360;
__device__ __forceinline__ size_t e_uidx(int row, int col) { return ((size_t)(row >> 7) * (E_LDU / 64) + (size_t)(col >> 6)) * 8192 + (size_t)(((row & 127) << 6) + (col & 63)); }
struct EpiU {
    static constexpr bool PERM = true, AFTER_DRAIN = false, HOOK = false; static constexpr int HOOK_T = -1;
    bf16_t* U; float* DT; const float* dtb; const float* RS;
    __device__ __forceinline__ float rstd_(int row) const { return rsqrtf(RS[row] * (1.0f / 2048.0f) + 1e-6f); }
    __device__ __forceinline__ void hook(f32x4 (&)[2][2][4][2], const Unit&, int, int, int, int) const {}
    __device__ __forceinline__ static float softplus_(float x) { return x > 20.0f ? x : log1pf(__expf(x)); }
    __device__ __forceinline__ void operator()(const f32x4 (&acc)[2][2][4][2], const Unit& u, int wr, int wc, int fr, int fq) const {
        const int row0 = u.pm * BM + wr * 64 + fr;
        if (u.pn == 68) {
            if (wc < 2) { const f32x4 b0 = *(const f32x4*)(dtb + wc * 32 + 8 * fq), b1 = *(const f32x4*)(dtb + wc * 32 + 8 * fq + 4);
#pragma unroll
                for (int ai = 0; ai < 2; ++ai) { if (u.pm * BM + ai * HALF >= E_MV) continue;
#pragma unroll
                    for (int m = 0; m < 4; ++m) { float* p = DT + (size_t)(row0 + ai * HALF + m * 16) * 64 + wc * 32 + 8 * fq; const float rs = rstd_(row0 + ai * HALF + m * 16); f32x4 v0 = acc[ai][0][m][0] * rs + b0, v1 = acc[ai][0][m][1] * rs + b1;
#pragma unroll
                        for (int e = 0; e < 4; ++e) { v0[e] = softplus_(v0[e]); v1[e] = softplus_(v1[e]); }
                        *(f32x4*)p = v0; *(f32x4*)(p + 4) = v1; } }
            }
            return;
        }
        const bool sig = u.pn >= 52, zsilu = u.pn < 16;
        const int col0 = u.pn * BM + wc * 32 + 8 * fq;
#pragma unroll
        for (int ai = 0; ai < 2; ++ai) { if (u.pm * BM + ai * HALF >= E_MV) continue;
#pragma unroll
            for (int m = 0; m < 4; ++m) { const int rr = row0 + ai * HALF + m * 16; const float rs = rstd_(rr);
#pragma unroll
                for (int bj = 0; bj < 2; ++bj) { f32x4 v0 = acc[ai][bj][m][0] * rs, v1 = acc[ai][bj][m][1] * rs;
                    if (sig) {
#pragma unroll
                        for (int e = 0; e < 4; ++e) { v0[e] = sigmoidf_(v0[e]); v1[e] = sigmoidf_(v1[e]); } }
                    if (zsilu) {
#pragma unroll
                        for (int e = 0; e < 4; ++e) { v0[e] = v0[e] * sigmoidf_(v0[e]); v1[e] = v1[e] * sigmoidf_(v1[e]); } }
                    u32x4 w; w.x = cvt_pk_bf16(v0[0], v0[1]); w.y = cvt_pk_bf16(v0[2], v0[3]); w.z = cvt_pk_bf16(v1[0], v1[1]); w.w = cvt_pk_bf16(v1[2], v1[3]);
                    *(u32x4*)(U + e_uidx(rr, col0 + bj * HALF)) = w; } } }
    }
};
struct EpiMerge {
    static constexpr bool PERM = true, AFTER_DRAIN = false, HOOK = true; static constexpr int HOOK_T = 64;
    const bf16_t* U; bf16_t* O;
    __device__ __forceinline__ void hook(f32x4 (&acc)[2][2][4][2], const Unit& u, int wr, int wc, int fr, int fq) const {
        asm volatile("" : "+v"(fr), "+v"(fq));
        const int row0 = u.pm * BM + wr * 64 + fr, col0 = u.pn * BM + wc * 32 + 8 * fq;
#pragma unroll
        for (int ai = 0; ai < 2; ++ai) { if (u.pm * BM + ai * HALF >= E_MV) continue;
#pragma unroll
            for (int mp = 0; mp < 2; ++mp) {
                u32x4 gs[2][2], ga[2][2];
#pragma unroll
                for (int mm = 0; mm < 2; ++mm) { const int rr = row0 + ai * HALF + (2 * mp + mm) * 16;
#pragma unroll
                    for (int bj = 0; bj < 2; ++bj) { gs[mm][bj] = *(const u32x4*)(U + e_uidx(rr, E_UGS + col0 + bj * HALF)); ga[mm][bj] = *(const u32x4*)(U + e_uidx(rr, E_UGA + col0 + bj * HALF)); } }
#pragma unroll
                for (int mm = 0; mm < 2; ++mm) { const int m = 2 * mp + mm;
#pragma unroll
                    for (int bj = 0; bj < 2; ++bj) { const u32x4 s = gs[mm][bj], a = ga[mm][bj]; f32x4 r0, r1;
                        r0[0] = bf_lo(s.x) * __builtin_amdgcn_rcpf(fmaxf(bf_lo(a.x), 1e-20f)); r0[1] = bf_hi(s.x) * __builtin_amdgcn_rcpf(fmaxf(bf_hi(a.x), 1e-20f)); r0[2] = bf_lo(s.y) * __builtin_amdgcn_rcpf(fmaxf(bf_lo(a.y), 1e-20f)); r0[3] = bf_hi(s.y) * __builtin_amdgcn_rcpf(fmaxf(bf_hi(a.y), 1e-20f));
                        r1[0] = bf_lo(s.z) * __builtin_amdgcn_rcpf(fmaxf(bf_lo(a.z), 1e-20f)); r1[1] = bf_hi(s.z) * __builtin_amdgcn_rcpf(fmaxf(bf_hi(a.z), 1e-20f)); r1[2] = bf_lo(s.w) * __builtin_amdgcn_rcpf(fmaxf(bf_lo(a.w), 1e-20f)); r1[3] = bf_hi(s.w) * __builtin_amdgcn_rcpf(fmaxf(bf_hi(a.w), 1e-20f));
                        acc[ai][bj][m][0] *= r0; acc[ai][bj][m][1] *= r1; }
                    asm volatile("" : "+v"(acc[ai][0][m][0]), "+v"(acc[ai][0][m][1]), "+v"(acc[ai][1][m][0]), "+v"(acc[ai][1][m][1]) :: "memory"); } } }
    }
    __device__ __forceinline__ void operator()(const f32x4 (&acc)[2][2][4][2], const Unit& u, int wr, int wc, int fr, int fq) const {
        const int row0 = u.pm * BM + wr * 64 + fr, col0 = u.pn * BM + wc * 32 + 8 * fq;
#pragma unroll
        for (int ai = 0; ai < 2; ++ai) { if (u.pm * BM + ai * HALF >= E_MV) continue;
#pragma unroll
            for (int m = 0; m < 4; ++m) { const size_t r = (size_t)(row0 + ai * HALF + m * 16);
#pragma unroll
                for (int bj = 0; bj < 2; ++bj) { const u32x4 ga = *(const u32x4*)(U + e_uidx((int)r, E_UGA + col0 + bj * HALF));
                    const f32x4 v0 = acc[ai][bj][m][0], v1 = acc[ai][bj][m][1];
                    u32x4 w; w.x = cvt_pk_bf16(v0[0] * bf_lo(ga.x), v0[1] * bf_hi(ga.x)); w.y = cvt_pk_bf16(v0[2] * bf_lo(ga.y), v0[3] * bf_hi(ga.y));
                    w.z = cvt_pk_bf16(v1[0] * bf_lo(ga.z), v1[1] * bf_hi(ga.z)); w.w = cvt_pk_bf16(v1[2] * bf_lo(ga.w), v1[3] * bf_hi(ga.w));
                    *(u32x4*)(O + r * 2048 + col0 + bj * HALF) = w; } } }
    }
};
struct EpiResid {
    static constexpr bool PERM = true, AFTER_DRAIN = false, HOOK = false; static constexpr int HOOK_T = -1;
    const float* Xf; bf16_t* XB; float* RS;
    __device__ __forceinline__ void hook(f32x4 (&)[2][2][4][2], const Unit&, int, int, int, int) const {}
    __device__ __forceinline__ void operator()(const f32x4 (&acc)[2][2][4][2], const Unit& u, int wr, int wc, int fr, int fq) const {
        const int row0 = u.pm * BM + wr * 64 + fr, col0 = u.pn * BM + wc * 32 + 8 * fq;
#pragma unroll
        for (int ai = 0; ai < 2; ++ai) { if (u.pm * BM + ai * HALF >= E_MV) continue;
#pragma unroll
            for (int m = 0; m < 4; ++m) { const size_t ro = (size_t)(row0 + ai * HALF + m * 16) * 2048 + col0; float ss = 0.f;
#pragma unroll
                for (int bj = 0; bj < 2; ++bj) { f32x4 x0, x1;
                    if (Xf) { x0 = *(const f32x4*)(Xf + ro + bj * HALF); x1 = *(const f32x4*)(Xf + ro + bj * HALF + 4); }
                    else { const u32x4 w = *(const u32x4*)(XB + ro + bj * HALF); x0 = (f32x4){bf_lo(w.x), bf_hi(w.x), bf_lo(w.y), bf_hi(w.y)}; x1 = (f32x4){bf_lo(w.z), bf_hi(w.z), bf_lo(w.w), bf_hi(w.w)}; }
                    x0 = x0 + acc[ai][bj][m][0]; x1 = x1 + acc[ai][bj][m][1];
                    ss += ((x0[0] * x0[0] + x0[1] * x0[1]) + (x0[2] * x0[2] + x0[3] * x0[3])) + ((x1[0] * x1[0] + x1[1] * x1[1]) + (x1[2] * x1[2] + x1[3] * x1[3]));
                    u32x4 o; o.x = cvt_pk_bf16(x0[0], x0[1]); o.y = cvt_pk_bf16(x0[2], x0[3]); o.z = cvt_pk_bf16(x1[0], x1[1]); o.w = cvt_pk_bf16(x1[2], x1[3]);
                    *(u32x4*)(XB + ro + bj * HALF) = o; }
                ss += __shfl_xor(ss, 16); ss += __shfl_xor(ss, 32);
                if (fq == 0) unsafeAtomicAdd(RS + row0 + ai * HALF + m * 16, ss); } }
    }
};
struct EpiSwiGLU {
    static constexpr bool PERM = true, AFTER_DRAIN = false, HOOK = false; static constexpr int HOOK_T = -1;
    bf16_t* H; const float* RS;
    __device__ __forceinline__ void hook(f32x4 (&)[2][2][4][2], const Unit&, int, int, int, int) const {}
    __device__ __forceinline__ void operator()(const f32x4 (&acc)[2][2][4][2], const Unit& u, int wr, int wc, int fr, int fq) const {
        const int row0 = u.pm * BM + wr * 64 + fr, col0 = u.pn * 128 + wc * 16 + 4 * fq;
#pragma unroll
        for (int ai = 0; ai < 2; ++ai) { if (u.pm * BM + ai * HALF >= E_MV) continue;
#pragma unroll
            for (int m = 0; m < 4; ++m) { bf16_t* rowp = H + (size_t)(row0 + ai * HALF + m * 16) * 5632 + col0; const float rs = rsqrtf(RS[row0 + ai * HALF + m * 16] * (1.0f / 2048.0f) + 1e-6f);
#pragma unroll
                for (int bj = 0; bj < 2; ++bj) { const f32x4 g = acc[ai][bj][m][0] * rs, up = acc[ai][bj][m][1] * rs; float h[4];
#pragma unroll
                    for (int e = 0; e < 4; ++e) h[e] = g[e] * __builtin_amdgcn_rcpf(1.0f + __expf(-g[e])) * up[e];
                    typedef unsigned u32x2v __attribute__((ext_vector_type(2))); u32x2v w; w.x = cvt_pk_bf16(h[0], h[1]); w.y = cvt_pk_bf16(h[2], h[3]);
                    *(u32x2v*)(rowp + bj * 64) = w; } } }
    }
};
template <class Epi, class Sched, bool ALIGN_EPI = false, bool SP2 = false>
__device__ __forceinline__ void gemm_phase(PG8_LAS unsigned char* lds, const Gemm g, const Sched& S, const Epi& E, int tid_in) {
    int tid_l = tid_in; asm volatile("" : "+v"(tid_l));
    const int tid = tid_l, wid = __builtin_amdgcn_readfirstlane(tid >> 6), lane = tid & 63, wr = wid >> 2, wc = wid & 3, fr = lane & 15, fq = lane >> 4;
    const int K = g.K, nt = K / BK;
    unsigned voffA[2], voffB[2];
#pragma unroll
    for (int i = 0; i < 2; ++i) { int R, C; stage_rc(tid * 16 + i * 8192, R, C); const int Rb = Epi::PERM ? ((R & ~31) + perm32(R & 31)) : R;
        voffA[i] = (unsigned)(R * K + C) * 2u; voffB[i] = (unsigned)(Rb * K + C) * 2u; }
    const size_t kstep = (size_t)(BK * 2);
    const size_t hstep = (size_t)HALF * K * 2;
    const size_t tstep = 2 * hstep;
    const unsigned ldsw = (unsigned)wid * 1024u;
    const int aoff = lds_byte(wr * 64 + fr, fq * 8), boff = lds_byte(wc * 32 + fr, fq * 8);
#define PG8_SA(b, h) (((b) * 2 + (h)) * HTB)
#define PG8_SB(b, h) ((4 + (b) * 2 + (h)) * HTB)
#define PG8_STAGE(bufoff, gbase, voff) do { _Pragma("unroll") for (int _i = 0; _i < 2; ++_i) \
        __builtin_amdgcn_global_load_lds((const unsigned*)((const char*)(gbase) + (voff)[_i]), (PG8_LAS unsigned*)(lds + (bufoff) + ldsw + _i * 8192), 16, 0, 0); } while (0)
#define PG8_LDA(dst, b, h) do { _Pragma("unroll") for (int m = 0; m < 4; ++m) _Pragma("unroll") for (int k = 0; k < 2; ++k) dst[m][k] = *(const PG8_LAS bf16x8*)(lds + PG8_SA(b, h) + aoff + m * 2048 + k * 1024); } while (0)
#define PG8_LDB(dst, b, h) do { _Pragma("unroll") for (int n = 0; n < 2; ++n) _Pragma("unroll") for (int k = 0; k < 2; ++k) dst[n][k] = *(const PG8_LAS bf16x8*)(lds + PG8_SB(b, h) + boff + n * 2048 + k * 1024); } while (0)
#define PG8_MMA(ai, bj, At, Bt) do { __builtin_amdgcn_s_setprio(1); _Pragma("unroll") for (int m = 0; m < 4; ++m) _Pragma("unroll") for (int n = 0; n < 2; ++n) _Pragma("unroll") for (int k = 0; k < 2; ++k) \
        acc[ai][bj][m][n] = __builtin_amdgcn_mfma_f32_16x16x32_bf16(Bt[n][k], At[m][k], acc[ai][bj][m][n], 0, 0, 0); __builtin_amdgcn_s_setprio(0); } while (0)
#define PG8_WAIT_V(n) asm volatile("s_waitcnt vmcnt(" #n ")" ::: "memory")
#define PG8_WAIT_L(n) asm volatile("s_waitcnt lgkmcnt(" #n ")" ::: "memory")
#define PG8_BAR __builtin_amdgcn_s_barrier()
#define PG8_SCHED __builtin_amdgcn_sched_barrier(0)
    Unit cur, nxt; int ui = 0;
    if (!S.next(0, cur)) return;
    f32x4 acc[2][2][4][2];
#pragma unroll
    for (int a = 0; a < 2; ++a)
#pragma unroll
        for (int b = 0; b < 2; ++b)
#pragma unroll
            for (int m = 0; m < 4; ++m)
#pragma unroll
                for (int n = 0; n < 2; ++n) acc[a][b][m][n] = (f32x4){0.f, 0.f, 0.f, 0.f};
    bf16x8 At[4][2], B0[2][2], B1[2][2];
    const char* cA = (const char*)g.A + (size_t)cur.pm * tstep; const char* cB = (const char*)g.Bt + (size_t)cur.pn * tstep;
    S.a_ready(cur);
    if constexpr (SP2) {
        PG8_STAGE(PG8_SB(0, 0), cB, voffB); PG8_STAGE(PG8_SB(0, 1), cB + hstep, voffB); PG8_STAGE(PG8_SA(0, 0), cA, voffA); PG8_STAGE(PG8_SA(0, 1), cA + hstep, voffA);
        if (wr == 1) PG8_BAR;
        PG8_WAIT_V(2); PG8_BAR;
        PG8_STAGE(PG8_SB(1, 0), cB + kstep, voffB); PG8_STAGE(PG8_SA(1, 0), cA + kstep, voffA); PG8_STAGE(PG8_SB(1, 1), cB + hstep + kstep, voffB);
        PG8_WAIT_V(6); PG8_BAR;
    } else {
        PG8_STAGE(PG8_SB(0, 0), cB, voffB); PG8_STAGE(PG8_SA(0, 0), cA, voffA); PG8_STAGE(PG8_SB(0, 1), cB + hstep, voffB); PG8_STAGE(PG8_SA(0, 1), cA + hstep, voffA);
        if (wr == 1) PG8_BAR;
        PG8_WAIT_V(4); PG8_BAR;
        PG8_STAGE(PG8_SB(1, 0), cB + kstep, voffB); PG8_STAGE(PG8_SA(1, 0), cA + kstep, voffA); PG8_STAGE(PG8_SB(1, 1), cB + hstep + kstep, voffB);
        PG8_WAIT_V(6); PG8_BAR;
    }
    for (;;) {
        const bool has_next = S.next(ui + 1, nxt);
        const char* nA = has_next ? (const char*)g.A + (size_t)nxt.pm * tstep : cA; const char* nB = has_next ? (const char*)g.Bt + (size_t)nxt.pn * tstep : cB;
        for (int t = 0; t < nt; t += 2) {
            const bool last = (t == nt - 2);
            const char* a1 = cA + (size_t)(t + 1) * kstep;
            const char* a2 = last ? nA : cA + (size_t)(t + 2) * kstep; const char* b2 = last ? nB : cB + (size_t)(t + 2) * kstep;
            const char* a3 = a2 + kstep; const char* b3 = b2 + kstep;
            if (last && has_next) S.a_ready(nxt);
            if constexpr (Epi::HOOK) { if (t == Epi::HOOK_T) E.hook(acc, cur, wr, wc, fr, fq); }
            if constexpr (SP2) {
            PG8_LDB(B0, 0, 0); PG8_LDB(B1, 0, 1); PG8_SCHED; PG8_LDA(At, 0, 0); PG8_STAGE(PG8_SA(1, 1), a1 + hstep, voffA);
            PG8_WAIT_V(8); PG8_WAIT_L(0); PG8_BAR; PG8_MMA(0, 0, At, B0); PG8_MMA(0, 1, At, B1); PG8_BAR; PG8_SCHED;
            PG8_LDA(At, 0, 1); PG8_STAGE(PG8_SB(0, 0), b2, voffB); PG8_STAGE(PG8_SB(0, 1), b2 + hstep, voffB); PG8_STAGE(PG8_SA(0, 0), a2, voffA);
            PG8_WAIT_V(8); PG8_WAIT_L(0); PG8_BAR; PG8_MMA(1, 0, At, B0); PG8_MMA(1, 1, At, B1); PG8_BAR; PG8_SCHED;
            PG8_LDB(B0, 1, 0); PG8_LDB(B1, 1, 1); PG8_SCHED; PG8_LDA(At, 1, 0); PG8_STAGE(PG8_SA(0, 1), a2 + hstep, voffA);
            PG8_WAIT_V(8); PG8_WAIT_L(0); PG8_BAR; PG8_MMA(0, 0, At, B0); PG8_MMA(0, 1, At, B1); PG8_BAR; PG8_SCHED;
            PG8_LDA(At, 1, 1); PG8_STAGE(PG8_SB(1, 0), b3, voffB); PG8_STAGE(PG8_SB(1, 1), b3 + hstep, voffB); PG8_STAGE(PG8_SA(1, 0), a3, voffA);
            PG8_WAIT_V(8); PG8_WAIT_L(0); PG8_BAR; PG8_MMA(1, 0, At, B0); PG8_MMA(1, 1, At, B1); PG8_BAR; PG8_SCHED;
            } else {
            PG8_LDB(B0, 0, 0); PG8_SCHED; PG8_LDA(At, 0, 0); PG8_STAGE(PG8_SA(1, 1), a1 + hstep, voffA);
            PG8_WAIT_L(8); PG8_BAR; PG8_WAIT_L(0); PG8_MMA(0, 0, At, B0); PG8_BAR; PG8_SCHED;
            PG8_LDB(B1, 0, 1); PG8_STAGE(PG8_SB(0, 0), b2, voffB);
            PG8_BAR; PG8_WAIT_L(0); PG8_MMA(0, 1, At, B1); PG8_BAR;
            PG8_LDA(At, 0, 1); PG8_STAGE(PG8_SA(0, 0), a2, voffA);
            PG8_BAR; PG8_WAIT_L(0); PG8_MMA(1, 0, At, B0); PG8_BAR; PG8_SCHED;
            PG8_STAGE(PG8_SB(0, 1), b2 + hstep, voffB);
            PG8_WAIT_V(6); PG8_BAR; PG8_MMA(1, 1, At, B1); PG8_BAR;
            PG8_LDB(B0, 1, 0); PG8_SCHED; PG8_LDA(At, 1, 0); PG8_STAGE(PG8_SA(0, 1), a2 + hstep, voffA);
            PG8_WAIT_L(8); PG8_BAR; PG8_WAIT_L(0); PG8_MMA(0, 0, At, B0); PG8_BAR; PG8_SCHED;
            PG8_LDB(B1, 1, 1); PG8_STAGE(PG8_SB(1, 0), b3, voffB);
            PG8_BAR; PG8_WAIT_L(0); PG8_MMA(0, 1, At, B1); PG8_BAR;
            PG8_LDA(At, 1, 1); PG8_STAGE(PG8_SA(1, 0), a3, voffA);
            PG8_BAR; PG8_WAIT_L(0); PG8_MMA(1, 0, At, B0); PG8_BAR; PG8_SCHED;
            PG8_STAGE(PG8_SB(1, 1), b3 + hstep, voffB);
            PG8_WAIT_V(6); PG8_BAR; PG8_MMA(1, 1, At, B1); PG8_BAR;
            }
        }
        if constexpr (ALIGN_EPI) { if (wr == 0) PG8_BAR; }
        if constexpr (!Epi::AFTER_DRAIN) { E(acc, cur, wr, wc, fr, fq); S.done(cur); }
        if (!has_next) break;
#pragma unroll
        for (int a = 0; a < 2; ++a)
#pragma unroll
            for (int b = 0; b < 2; ++b)
#pragma unroll
                for (int m = 0; m < 4; ++m)
#pragma unroll
                    for (int n = 0; n < 2; ++n) acc[a][b][m][n] = (f32x4){0.f, 0.f, 0.f, 0.f};
        cur = nxt; cA = nA; cB = nB; ++ui;
        if constexpr (ALIGN_EPI) { if (wr == 1) PG8_BAR; }
    }
    PG8_WAIT_V(0);
    if constexpr (!ALIGN_EPI) { if (wr == 0) PG8_BAR; }
    PG8_BAR;
    if constexpr (Epi::AFTER_DRAIN) { E.fused(acc, cur, wr, wc, fr, fq, lds, wid, lane); S.done(cur); }
#undef PG8_SA
#undef PG8_SB
#undef PG8_STAGE
#undef PG8_LDA
#undef PG8_LDB
#undef PG8_MMA
#undef PG8_WAIT_V
#undef PG8_WAIT_L
#undef PG8_BAR
#undef PG8_SCHED
}
}
#define GAS __attribute__((address_space(1)))
#define LAS __attribute__((address_space(3)))
typedef unsigned short bf16;
typedef unsigned v4u __attribute__((ext_vector_type(4)));
typedef float f32x4 __attribute__((ext_vector_type(4)));
typedef short bf16x8 __attribute__((ext_vector_type(8)));
typedef GAS unsigned gu32;
typedef GAS unsigned long long gu64;
#define RLX_AGENT __ATOMIC_RELAXED, __HIP_MEMORY_SCOPE_AGENT
#define LDS_WAIT() asm volatile("s_waitcnt lgkmcnt(0)" ::: "memory")
#define VM_WAIT() asm volatile("s_waitcnt vmcnt(0)" ::: "memory")
__device__ __forceinline__ unsigned long long rt() { return __builtin_amdgcn_s_memrealtime(); }
__device__ __forceinline__ unsigned f2bf(float f) { unsigned u = __builtin_bit_cast(unsigned, f); return (u + 0x7fffu + ((u >> 16) & 1u)) >> 16; }
__device__ __forceinline__ unsigned pk2(float lo, float hi) { return f2bf(lo) | (f2bf(hi) << 16); }

#define XB_TMO      128
#define XB_XCNT(j)  (256  + 64 * (j))
#define XB_XSUB(j)  (1280 + 64 * (j))
#define XB_XGEN(j)  (2304 + 64 * (j))
#define XB_TOP      3328
#define XB_TOPGEN   3392
#define XCD_BAR_WORDS 3456
#define XB_SPIN_CAP (1u << 18)

__device__ __forceinline__ unsigned xb_ld(unsigned* p)              { return __hip_atomic_load(p, __ATOMIC_RELAXED, __HIP_MEMORY_SCOPE_AGENT); }
__device__ __forceinline__ unsigned xb_add(unsigned* p, unsigned v) { return __hip_atomic_fetch_add(p, v, __ATOMIC_RELAXED, __HIP_MEMORY_SCOPE_AGENT); }
__device__ __forceinline__ unsigned xb_xcc_id() { return (unsigned)__builtin_amdgcn_s_getreg((3 << 11) | 20) & 0xFu; }
#define XB_SPIN(cond, bar) do { unsigned _sp = 0; while (cond) { __builtin_amdgcn_s_sleep(1); \
    if ((++_sp & 255u) == 0u) { if (xb_ld(&(bar)[XB_TMO])) break; if (_sp > XB_SPIN_CAP) { atomicAdd(&(bar)[XB_TMO], 1u); break; } } } } while (0)

struct XcdBarrier {
    unsigned* bar; unsigned x;
    volatile LAS unsigned* st;
};

__device__ __forceinline__ XcdBarrier xcd_barrier_post(unsigned* bar, volatile LAS unsigned* st) {
    XcdBarrier b; b.bar = bar; b.x = xb_xcc_id(); b.st = st;
    if (threadIdx.x == 0) (void)xb_add(&bar[XB_XCNT(b.x)], 1u);
    return b;
}
__device__ __forceinline__ void xcd_barrier_complete(unsigned* bar, unsigned x, unsigned& nloc, unsigned& nx) {
    const unsigned G = gridDim.x * gridDim.y * gridDim.z;
    unsigned sum, cnt, mine, sp = 0u;
    for (;;) {
        sum = 0u; cnt = 0u; mine = 0u;
#pragma unroll
        for (unsigned j = 0; j < 16; ++j) { const unsigned c = xb_ld(&bar[XB_XCNT(j)]); sum += c; cnt += (c > 0u) ? 1u : 0u; mine = (j == x) ? c : mine; }
        if (sum == G) break;
        __builtin_amdgcn_s_sleep(1);
        if ((++sp & 255u) == 0u) { if (xb_ld(&bar[XB_TMO])) break; if (sp > XB_SPIN_CAP) { atomicAdd(&bar[XB_TMO], 1u); break; } }
    }
    nloc = mine > 0u ? mine : 1u; nx = cnt > 0u ? cnt : 1u;
}

__device__ __forceinline__ void xcd_barrier(const XcdBarrier& b) {
    asm volatile("s_waitcnt vmcnt(0)" ::: "memory");
    __syncthreads();
    if (threadIdx.x == 0) {
        unsigned* bar = b.bar;
        __builtin_amdgcn_s_waitcnt(0);
        unsigned nloc = b.st[0], nx = b.st[1];
        if (nloc == 0u) { xcd_barrier_complete(bar, b.x, nloc, nx); b.st[0] = nloc; b.st[1] = nx; }
        const unsigned old = xb_add(&bar[XB_XSUB(b.x)], 1u);
        const unsigned gen = old / nloc;
        if (old + 1u == (gen + 1u) * nloc) {
            __builtin_amdgcn_fence(__ATOMIC_RELEASE, "agent");
            asm volatile("s_waitcnt vmcnt(0)" ::: "memory");
            const unsigned og = xb_add(&bar[XB_TOP], 1u);
            const unsigned tg = og / nx;
            if (og + 1u == (tg + 1u) * nx) xb_add(&bar[XB_TOPGEN], 1u);
            else XB_SPIN(xb_ld(&bar[XB_TOPGEN]) == tg, bar);
            __builtin_amdgcn_fence(__ATOMIC_ACQUIRE, "agent");
            xb_add(&bar[XB_XGEN(b.x)], 1u);
            asm volatile("s_waitcnt vmcnt(0)" ::: "memory");
        } else {
            XB_SPIN(xb_ld(&bar[XB_XGEN(b.x)]) == gen, bar);
            __builtin_amdgcn_fence(__ATOMIC_ACQUIRE, "agent");
            asm volatile("s_waitcnt vmcnt(0)" ::: "memory");
        }
    }
    __syncthreads();
}
typedef float f32x16 __attribute__((ext_vector_type(16)));
typedef unsigned u32x2 __attribute__((ext_vector_type(2)));
__device__ __forceinline__ float bf2f(bf16 v) { return __uint_as_float(((unsigned)v) << 16); }
__device__ __forceinline__ float bflo(unsigned w) { return __uint_as_float(w << 16); }
__device__ __forceinline__ float bfhi(unsigned w) { return __uint_as_float(w & 0xffff0000u); }
__device__ __forceinline__ float wave_sum(float v) {
#pragma unroll
    for (int o = 1; o < 64; o <<= 1) v += __shfl_xor(v, o);
    return v;
}
__device__ __forceinline__ float wave_max(float v) {
#pragma unroll
    for (int o = 1; o < 64; o <<= 1) v = fmaxf(v, __shfl_xor(v, o));
    return v;
}
__device__ __forceinline__ float siluf_(float x) { return x * __builtin_amdgcn_rcpf(1.0f + __expf(-x)); }
__device__ __forceinline__ float softplusf_(float x) { return x > 20.0f ? x : log1pf(__expf(x)); }

struct Args { const float* in[23]; float* out; unsigned char* ws; int ph_lo, ph_hi, use_bar, pad; };
typedef const __attribute__((address_space(4))) Args* KArgs;
struct Ctx { LAS unsigned char* lds; int tid, lane, wave, G, bid; KArgs a; };

__device__ __forceinline__ int lane_now() { int t; asm volatile("v_mbcnt_lo_u32_b32 %0, -1, 0\n\tv_mbcnt_hi_u32_b32 %0, -1, %0" : "=v"(t)); return t; }
struct TItem { const float* sp; const float* gn; bf16* WT; int ldn, rowl, K, k0, R0; };
__device__ __forceinline__ void titem_load(const TItem& t, f32x4 (&v)[16], int) {
    const int kk = lane_now() >> 4;
    if (t.sp) {
#pragma unroll
        for (int i = 0; i < 16; ++i) v[i] = __builtin_nontemporal_load((const GAS f32x4*)(t.sp + (size_t)(t.k0 + 4 * i + kk) * t.ldn));
        if (t.gn) {
#pragma unroll
            for (int i = 0; i < 16; ++i) v[i] = v[i] * t.gn[t.k0 + 4 * i + kk]; }
    } else {
#pragma unroll
        for (int i = 0; i < 16; ++i) { float z0 = 0.f; asm volatile("" : "+v"(z0)); v[i] = (f32x4){z0, z0, z0, z0}; }
    }
}
__device__ __forceinline__ void titem_store(const TItem& t, const f32x4 (&v)[16], LAS unsigned short* T, int) {
    const int lane = lane_now(), kk = lane >> 4;
#pragma unroll
    for (int i = 0; i < 16; ++i) { const int k = 4 * i + kk;
        T[(t.rowl + 0) * 66 + k] = (unsigned short)f2bf(v[i].x); T[(t.rowl + 1) * 66 + k] = (unsigned short)f2bf(v[i].y); T[(t.rowl + 2) * 66 + k] = (unsigned short)f2bf(v[i].z); T[(t.rowl + 3) * 66 + k] = (unsigned short)f2bf(v[i].w); }
    LDS_WAIT(); asm volatile("" ::: "memory");
    const int ch = lane & 7, nr = lane >> 3;
#pragma unroll
    for (int it = 0; it < 8; ++it) { const int n = nr + 8 * it; const LAS unsigned* tp = (const LAS unsigned*)(T + n * 66 + 8 * ch);
        v4u o; o.x = tp[0]; o.y = tp[1]; o.z = tp[2]; o.w = tp[3];
        *(GAS v4u*)(t.WT + (size_t)(t.R0 + n) * t.K + t.k0 + 8 * ch) = o; }
    LDS_WAIT(); asm volatile("" ::: "memory");
}
constexpr int IT_IN = (DM / 64) * (NU / 64), IT_CAT = (KCAT / 64) * (DM / 64), IT_OUT = (DM / 64) * (DM / 64), IT_GU = (DM / 64) * (NGU / 64), IT_DN = (FF / 64) * (DM / 64);
constexpr int IT_LAYER = IT_IN + IT_CAT + IT_OUT + IT_GU + IT_DN;
__device__ __forceinline__ TItem titem_decode(const Ctx& C, int it) {
    const int c4 = lane_now() & 15, l = it / IT_LAYER; int q = it % IT_LAYER; TItem t;
    if (q < IT_IN) { const int nblk = NU / 64, kb = q / nblk, nb = q % nblk, R = 64 * nb + 4 * c4;
        const int col = R < 10240 ? R : (R < 17408 ? R + 64 : (R < 17472 ? 10240 + (R - 17408) : -1));
        t.sp = col >= 0 ? (C.a->in[7]) + (size_t)l * DM * IN_DIM + col : nullptr; t.gn = (C.a->in[6]) + (size_t)l * DM; t.ldn = IN_DIM; t.rowl = 4 * c4; t.K = DM; t.WT = ((bf16*)(C.a->ws + WS_WIN)) + (size_t)l * NU * DM; t.k0 = 64 * kb; t.R0 = 64 * nb; return t; }
    q -= IT_IN;
    if (q < IT_CAT) { const int nblk = DM / 64, kb = q / nblk, nb = q % nblk, R = 64 * nb + 4 * c4, k0 = 64 * kb;
        t.sp = k0 < DI ? (C.a->in[14]) + (size_t)l * DI * DM + R : (C.a->in[15]) + (size_t)l * DM * DM + R - (size_t)DI * DM;
        t.gn = nullptr; t.ldn = DM; t.rowl = 4 * c4; t.K = KCAT; t.WT = ((bf16*)(C.a->ws + WS_WCAT)) + (size_t)l * DM * KCAT; t.k0 = k0; t.R0 = 64 * nb; return t; }
    q -= IT_CAT;
    if (q < IT_OUT) { const int nblk = DM / 64, kb = q / nblk, nb = q % nblk, R = 64 * nb + 4 * c4;
        t.sp = (C.a->in[17]) + (size_t)l * DM * DM + R; t.gn = nullptr; t.ldn = DM; t.rowl = 4 * c4; t.K = DM; t.WT = ((bf16*)(C.a->ws + WS_WOUT)) + (size_t)l * DM * DM; t.k0 = 64 * kb; t.R0 = 64 * nb; return t; }
    q -= IT_OUT;
    if (q < IT_GU) { const int nblk = NGU / 64, kb = q / nblk, nb = q % nblk;
        const int up = c4 >> 3, cg = c4 & 7;
        t.sp = (up ? (C.a->in[20]) : (C.a->in[19])) + (size_t)l * DM * FF + 32 * nb + 4 * cg; t.gn = (C.a->in[18]) + (size_t)l * DM; t.ldn = FF; t.rowl = 8 * cg + 4 * up; t.K = DM; t.WT = ((bf16*)(C.a->ws + WS_WGU)) + (size_t)l * NGU * DM; t.k0 = 64 * kb; t.R0 = 64 * nb; return t; }
    q -= IT_GU;
    { const int nblk = DM / 64, kb = q / nblk, nb = q % nblk, R = 64 * nb + 4 * c4;
        t.sp = (C.a->in[21]) + (size_t)l * FF * DM + R; t.gn = nullptr; t.ldn = DM; t.rowl = 4 * c4; t.K = FF; t.WT = ((bf16*)(C.a->ws + WS_WDN)) + (size_t)l * DM * FF; t.k0 = 64 * kb; t.R0 = 64 * nb; return t; }
}
__device__ __forceinline__ void p0_weights(const Ctx& C, int it_lo, int it_hi, int gw, int NGW) {
    LAS unsigned short* T = (LAS unsigned short*)(C.lds + RING_OFF + C.wave * 16384);
    int it = it_lo + gw; if (it >= it_hi) return;
    TItem cur = titem_decode(C, it); f32x4 va[16], vb[16];
    titem_load(cur, va, C.lane);
    for (;;) {
        int nit = it + NGW; TItem nxt = cur; const bool hn = nit < it_hi;
        if (hn) { nxt = titem_decode(C, nit); titem_load(nxt, vb, C.lane); }
        titem_store(cur, va, T, C.lane);
        if (!hn) break;
        it = nit + NGW; cur = nxt; const bool hn2 = it < it_hi;
        if (hn2) { cur = titem_decode(C, it); titem_load(cur, va, C.lane); }
        titem_store(nxt, vb, T, C.lane);
        if (!hn2) break;
    }
}
__device__ __forceinline__ void norm_row(const float* src, const float* gain, float* xcopy, bf16* xb, float* rs, float* fdst, int lane) {
    const GAS f32x4* xr = (const GAS f32x4*)src + lane;
    f32x4 v[8]; float s = 0.f;
#pragma unroll
    for (int j = 0; j < 8; ++j) { v[j] = xr[64 * j]; s += (v[j].x * v[j].x + v[j].y * v[j].y) + (v[j].z * v[j].z + v[j].w * v[j].w); }
    s = wave_sum(s);
    if (rs && lane == 0) *rs = s;
    if (xcopy) { GAS f32x4* xc = (GAS f32x4*)xcopy + lane;
#pragma unroll
        for (int j = 0; j < 8; ++j) xc[64 * j] = v[j]; }
    if (xb) {
#pragma unroll
        for (int j = 0; j < 8; ++j) { u32x2 w; w.x = pk2(v[j].x, v[j].y); w.y = pk2(v[j].z, v[j].w); *((GAS u32x2*)xb + lane + 64 * j) = w; } }
    if (fdst) { const float rstd = rsqrtf(s * (1.0f / DM) + EPS); const GAS f32x4* gr = (const GAS f32x4*)gain + lane;
#pragma unroll
        for (int j = 0; j < 8; ++j) { const f32x4 g = gr[64 * j]; f32x4 o = v[j] * rstd; o = o * g; *((GAS f32x4*)fdst + lane + 64 * j) = o; } }
}
__device__ __forceinline__ void p0_xinit(const Ctx& C) {
    const int gw = C.bid * NWAVES + C.wave, NGW = C.G * NWAVES;
    for (int m = gw; m < MV; m += NGW) { const float* src = m < SEQ ? (C.a->in[0]) + (size_t)m * DM : (C.a->in[1]) + (size_t)(m - SEQ) * DM;
        norm_row(src, nullptr, m < SEQ ? nullptr : ((float*)(C.a->ws + WS_X)) + (size_t)m * DM, ((bf16*)(C.a->ws + WS_XN)) + (size_t)m * DM, ((float*)(C.a->ws + WS_RSA)) + m, nullptr, C.lane); }
}
__device__ __forceinline__ void sample_rows_phase(const Ctx& C, float* RS) {
    const int gw = C.bid * NWAVES + C.wave, NGW = C.G * NWAVES;
    for (int m = SEQ + gw; m < MV; m += NGW) norm_row(((float*)(C.a->ws + WS_X)) + (size_t)m * DM, nullptr, nullptr, ((bf16*)(C.a->ws + WS_XN)) + (size_t)m * DM, RS + m, nullptr, C.lane);
}
__device__ __forceinline__ void final_norm_phase(const Ctx& C) {
    const int gw = C.bid * NWAVES + C.wave, NGW = C.G * NWAVES, lane = C.lane;
    for (int m = gw; m < MV; m += NGW) {
        if (m >= SEQ) { norm_row(((float*)(C.a->ws + WS_X)) + (size_t)m * DM, (C.a->in[22]), nullptr, nullptr, nullptr, (C.a->out) + O_YP + (size_t)m * DM, lane); continue; }
        const GAS v4u* xr = (const GAS v4u*)(((bf16*)(C.a->ws + WS_XN)) + (size_t)m * DM) + lane; v4u w[4]; float s = 0.f;
#pragma unroll
        for (int j = 0; j < 4; ++j) { w[j] = xr[64 * j]; const float a0 = bflo(w[j].x), a1 = bfhi(w[j].x), a2 = bflo(w[j].y), a3 = bfhi(w[j].y), a4 = bflo(w[j].z), a5 = bfhi(w[j].z), a6 = bflo(w[j].w), a7 = bfhi(w[j].w);
            s += ((a0 * a0 + a1 * a1) + (a2 * a2 + a3 * a3)) + ((a4 * a4 + a5 * a5) + (a6 * a6 + a7 * a7)); }
        const float rstd = rsqrtf(wave_sum(s) * (1.0f / DM) + EPS);
        const GAS f32x4* gr = (const GAS f32x4*)(C.a->in[22]) + 2 * lane; GAS f32x4* op = (GAS f32x4*)((C.a->out) + O_YP + (size_t)m * DM) + 2 * lane;
#pragma unroll
        for (int j = 0; j < 4; ++j) { const f32x4 g0 = gr[128 * j], g1 = gr[128 * j + 1];
            op[128 * j] = (f32x4){bflo(w[j].x) * rstd * g0.x, bfhi(w[j].x) * rstd * g0.y, bflo(w[j].y) * rstd * g0.z, bfhi(w[j].y) * rstd * g0.w};
            op[128 * j + 1] = (f32x4){bflo(w[j].z) * rstd * g1.x, bfhi(w[j].z) * rstd * g1.y, bflo(w[j].w) * rstd * g1.z, bfhi(w[j].w) * rstd * g1.w}; }
    }
}
__device__ __forceinline__ void zero_f32(const Ctx& C, float* p, int n, int vb, int nvb) { float z0 = 0.f; asm volatile("" : "+v"(z0)); for (int i = vb * 512 + C.tid; i < n; i += nvb * 512) p[i] = z0; }

__device__ __forceinline__ void sample_ssd_wave_unit(const Ctx& C, int l, int b, int g, LAS float* wsc) {
    const int lane = lane_now();
    const int row = SEQ + b, n4 = lane & 31, prh = lane >> 5;
    LAS float* xs = wsc; LAS float* Bs = wsc + 512; LAS float* ys = wsc + 768;
    const float* cw = (C.a->in[8]) + (size_t)l * CW * CD; const float* cb = (C.a->in[9]) + (size_t)l * CD;
    const float* sc = (C.a->in[3]) + ((size_t)l * NB + b) * 3 * CD; const bf16* U = ((bf16*)(C.a->ws + WS_U));
    { const int ch = g * 512 + 8 * lane; const v4u un = *(const GAS v4u*)(U + UIDX(row, UXBC + ch)); const float nv[8] = {bflo(un.x), bfhi(un.x), bflo(un.y), bfhi(un.y), bflo(un.z), bfhi(un.z), bflo(un.w), bfhi(un.w)};
#pragma unroll
      for (int q = 0; q < 2; ++q) { const f32x4 bb = *(const GAS f32x4*)(cb + ch + 4 * q), w0 = *(const GAS f32x4*)(cw + ch + 4 * q), w1 = *(const GAS f32x4*)(cw + CD + ch + 4 * q), w2 = *(const GAS f32x4*)(cw + 2 * CD + ch + 4 * q), w3 = *(const GAS f32x4*)(cw + 3 * CD + ch + 4 * q);
          const f32x4 s0 = *(const GAS f32x4*)(sc + ch + 4 * q), s1 = *(const GAS f32x4*)(sc + CD + ch + 4 * q), s2 = *(const GAS f32x4*)(sc + 2 * CD + ch + 4 * q);
          f32x4 o;
#pragma unroll
          for (int e = 0; e < 4; ++e) o[e] = siluf_(bb[e] + w0[e] * s0[e] + w1[e] * s1[e] + w2[e] * s2[e] + w3[e] * nv[4 * q + e]);
          *(LAS f32x4*)(xs + 8 * lane + 4 * q) = o; } }
    { const int ch = (lane < 32 ? DI + g * 128 : DI + 1024 + g * 128 - 128) + 4 * lane;
      const u32x2 un = *(const GAS u32x2*)(U + UIDX(row, UXBC + ch)); const float nv[4] = {bflo(un.x), bfhi(un.x), bflo(un.y), bfhi(un.y)};
      const f32x4 bb = *(const GAS f32x4*)(cb + ch), w0 = *(const GAS f32x4*)(cw + ch), w1 = *(const GAS f32x4*)(cw + CD + ch), w2 = *(const GAS f32x4*)(cw + 2 * CD + ch), w3 = *(const GAS f32x4*)(cw + 3 * CD + ch);
      const f32x4 s0 = *(const GAS f32x4*)(sc + ch), s1 = *(const GAS f32x4*)(sc + CD + ch), s2 = *(const GAS f32x4*)(sc + 2 * CD + ch);
      f32x4 o;
#pragma unroll
      for (int e = 0; e < 4; ++e) o[e] = siluf_(bb[e] + w0[e] * s0[e] + w1[e] * s1[e] + w2[e] * s2[e] + w3[e] * nv[e]);
      *(LAS f32x4*)(Bs + 4 * lane) = o; }
    LDS_WAIT(); asm volatile("" ::: "memory");
    const f32x4 Bv = *((const LAS f32x4*)Bs + n4), Cv = *((const LAS f32x4*)(Bs + 128) + n4);
    const size_t sbase = (((size_t)l * NB + b) * NH + 8 * g) * HP * DS;
    for (int j = 0; j < 8; ++j) { const int h = 8 * g + j;
        const GAS f32x4* sp = (const GAS f32x4*)((C.a->in[2]) + sbase + (size_t)j * HP * DS + (size_t)prh * DS) + n4;
        GAS f32x4* op = (GAS f32x4*)((C.a->out) + O_SSSM + sbase + (size_t)j * HP * DS + (size_t)prh * DS) + n4;
        f32x4 hv[32];
#pragma unroll
        for (int i = 0; i < 32; ++i) hv[i] = __builtin_nontemporal_load(sp + (size_t)i * (2 * DS / 4));
        const float dt = ((float*)(C.a->ws + WS_DT))[(size_t)row * 64 + h], dA = __expf(-__expf((C.a->in[11])[l * NH + h]) * dt), Dh = (C.a->in[12])[l * NH + h];
#pragma unroll
        for (int i = 0; i < 32; ++i) { const int p = prh + 2 * i; const float xv = xs[j * 64 + p], dtx = dt * xv; const f32x4 h0 = hv[i];
            f32x4 hn; hn.x = dA * h0.x + dtx * Bv.x; hn.y = dA * h0.y + dtx * Bv.y; hn.z = dA * h0.z + dtx * Bv.z; hn.w = dA * h0.w + dtx * Bv.w;
            __builtin_nontemporal_store(hn, op + (size_t)i * (2 * DS / 4));
            float yp = (hn.x * Cv.x + hn.y * Cv.y) + (hn.z * Cv.z + hn.w * Cv.w);
#pragma unroll
            for (int o = 1; o < 32; o <<= 1) yp += __shfl_xor(yp, o);
            if (n4 == 0) ys[j * 64 + p] = yp + Dh * xv; }
    }
    LDS_WAIT(); asm volatile("" ::: "memory");
    { const int ch = g * 512 + 8 * lane; const v4u zw = *(const GAS v4u*)(U + UIDX(row, UZ + ch)); const f32x4 y0 = *(const LAS f32x4*)(ys + 8 * lane), y1 = *(const LAS f32x4*)(ys + 8 * lane + 4);
      float gv[8] = {y0.x * bflo(zw.x), y0.y * bfhi(zw.x), y0.z * bflo(zw.y), y0.w * bfhi(zw.y), y1.x * bflo(zw.z), y1.y * bfhi(zw.z), y1.z * bflo(zw.w), y1.w * bfhi(zw.w)};
      float ss = 0.f;
#pragma unroll
      for (int e = 0; e < 8; ++e) ss += gv[e] * gv[e];
      const float rstd = rsqrtf(wave_sum(ss) * (1.0f / 512.0f) + EPS);
      const f32x4 n0 = *(const GAS f32x4*)((C.a->in[13]) + (size_t)l * DI + ch), n1 = *(const GAS f32x4*)((C.a->in[13]) + (size_t)l * DI + ch + 4);
      v4u o; o.x = pk2(gv[0] * rstd * n0.x, gv[1] * rstd * n0.y); o.y = pk2(gv[2] * rstd * n0.z, gv[3] * rstd * n0.w); o.z = pk2(gv[4] * rstd * n1.x, gv[5] * rstd * n1.y); o.w = pk2(gv[6] * rstd * n1.z, gv[7] * rstd * n1.w);
      *(GAS v4u*)(((bf16*)(C.a->ws + WS_YO)) + (size_t)row * KCAT + ch) = o; }
    LDS_WAIT(); asm volatile("" ::: "memory");
}

__device__ __forceinline__ void sample_attn_unit(const Ctx& C, int l, int b, int kh) {
    const int tid = C.tid, row = SEQ + b;
    constexpr int KP = 68;
    LAS float* Ks = (LAS float*)(C.lds + RING_OFF); LAS float* Vs = Ks + 128 * KP; LAS float* qs = Vs + 128 * KP; LAS float* sc = qs + 256; LAS float* knew = sc + 4 * 132; LAS float* vnew = knew + 64;
    const bf16* U = ((bf16*)(C.a->ws + WS_U));
    const size_t cbase = ((size_t)l * NB + b) * WIN * (KVH * AD) + (size_t)kh * AD;
    { f32x4 kv[4], vv[4];
#pragma unroll
      for (int i = 0; i < 4; ++i) { const int idx = tid + 512 * i, w = idx >> 4, c4 = idx & 15;
          kv[i] = __builtin_nontemporal_load((const GAS f32x4*)((C.a->in[4]) + cbase + (size_t)w * (KVH * AD)) + c4); vv[i] = __builtin_nontemporal_load((const GAS f32x4*)((C.a->in[5]) + cbase + (size_t)w * (KVH * AD)) + c4); }
      if (tid < 256) qs[tid] = bf2f(U[UIDX(row, UQ + kh * 256 + tid)]);
      else if (tid < 320) knew[tid - 256] = bf2f(U[UIDX(row, UK + kh * 64 + (tid - 256))]);
      else if (tid < 384) vnew[tid - 320] = bf2f(U[UIDX(row, UV + kh * 64 + (tid - 320))]);
#pragma unroll
      for (int i = 0; i < 4; ++i) { const int idx = tid + 512 * i, w = idx >> 4, c4 = idx & 15;
          *((LAS f32x4*)(Ks + w * KP) + c4) = kv[i]; *((LAS f32x4*)(Vs + w * KP) + c4) = vv[i];
 } }
    __syncthreads();
    if (tid < 16) { *((GAS f32x4*)((C.a->out) + O_SK + cbase + (size_t)(WIN - 1) * (KVH * AD)) + tid) = *((const LAS f32x4*)knew + tid); }
    else if (tid < 32) { *((GAS f32x4*)((C.a->out) + O_SV + cbase + (size_t)(WIN - 1) * (KVH * AD)) + (tid - 16)) = *((const LAS f32x4*)vnew + (tid - 16)); }
    { const int w = tid >> 2, hq = tid & 3; const LAS f32x4* kp = (const LAS f32x4*)(Ks + w * KP); const LAS f32x4* qp = (const LAS f32x4*)(qs + hq * 64);
      float s = 0.f;
#pragma unroll
      for (int c = 0; c < 16; ++c) { const f32x4 kv = kp[c], qv = qp[c]; s += (kv.x * qv.x + kv.y * qv.y) + (kv.z * qv.z + kv.w * qv.w); }
      sc[hq * 132 + w] = s * 0.125f; }
    if (tid < 4) { float s = 0.f;
      for (int d = 0; d < 64; ++d) s += qs[tid * 64 + d] * knew[d];
      sc[tid * 132 + 128] = s * 0.125f; }
    __syncthreads();
    if (C.wave < 4) { const int hq = C.wave; const float sink = (C.a->in[16])[l * AH + 4 * kh + hq];
      const float v0 = sc[hq * 132 + C.lane], v1 = sc[hq * 132 + 64 + C.lane], v2 = C.lane == 0 ? sc[hq * 132 + 128] : -__builtin_inff();
      const float m = fmaxf(wave_max(fmaxf(fmaxf(v0, v1), v2)), sink);
      const float e0 = __expf(v0 - m), e1 = __expf(v1 - m), e2 = C.lane == 0 ? __expf(v2 - m) : 0.f;
      const float inv = 1.0f / (wave_sum(e0 + e1 + e2) + __expf(sink - m));
      sc[hq * 132 + C.lane] = e0 * inv; sc[hq * 132 + 64 + C.lane] = e1 * inv; if (C.lane == 0) sc[hq * 132 + 128] = e2 * inv; }
    __syncthreads();
    if (tid < 256) { const int hq = tid >> 6, d = tid & 63; float o = sc[hq * 132 + 128] * vnew[d];
#pragma unroll 16
      for (int w = 0; w < WIN; ++w) o += sc[hq * 132 + w] * Vs[w * KP + d];
      ((bf16*)(C.a->ws + WS_YO))[(size_t)row * KCAT + DI + (4 * kh + hq) * 64 + d] = (bf16)f2bf(o); }
    __syncthreads();
}

__device__ __forceinline__ void cache_shift(const Ctx& C, int l, int vb, int nvb) {
    constexpr int ROWF4 = (WIN - 1) * KVH * AD / 4;
    for (int u = vb; u < NB * 2; u += nvb) { const int b = u >> 1, kv = u & 1;
        const GAS f32x4* src = (const GAS f32x4*)((kv ? (C.a->in[5]) : (C.a->in[4])) + ((size_t)l * NB + b) * WIN * (KVH * AD) + KVH * AD);
        GAS f32x4* dst = (GAS f32x4*)((C.a->out) + (kv ? O_SV : O_SK) + ((size_t)l * NB + b) * WIN * (KVH * AD));
        for (int i = C.tid; i < ROWF4; i += 512 * 8) { f32x4 v[8];
#pragma unroll
            for (int j = 0; j < 8; ++j) if (i + 512 * j < ROWF4) v[j] = __builtin_nontemporal_load(src + i + 512 * j);
#pragma unroll
            for (int j = 0; j < 8; ++j) if (i + 512 * j < ROWF4) __builtin_nontemporal_store(v[j], dst + i + 512 * j); } }
}

__device__ __forceinline__ void copy_outs(const Ctx& C, int l, int vb, int nvb) {
    const bf16* U = ((bf16*)(C.a->ws + WS_U)); const int gt = vb * 512 + C.tid, NT = nvb * 512;
    for (int i = gt; i < WIN * KVH * AD / 8; i += NT) { const int w = i >> 6, c = (i & 63) * 8, ur = SEQ - WIN + w;
        const v4u kw = *(const GAS v4u*)(U + UIDX(ur, UK + c)), vw = *(const GAS v4u*)(U + UIDX(ur, UV + c));
        GAS f32x4* pk = (GAS f32x4*)((C.a->out) + O_PK + (size_t)l * WIN * KVH * AD + (size_t)w * (KVH * AD) + c); GAS f32x4* pv = (GAS f32x4*)((C.a->out) + O_PV + (size_t)l * WIN * KVH * AD + (size_t)w * (KVH * AD) + c);
        pk[0] = (f32x4){bflo(kw.x), bfhi(kw.x), bflo(kw.y), bfhi(kw.y)}; pk[1] = (f32x4){bflo(kw.z), bfhi(kw.z), bflo(kw.w), bfhi(kw.w)};
        pv[0] = (f32x4){bflo(vw.x), bfhi(vw.x), bflo(vw.y), bfhi(vw.y)}; pv[1] = (f32x4){bflo(vw.z), bfhi(vw.z), bflo(vw.w), bfhi(vw.w)}; }
    constexpr int C8 = CD / 8;
    for (int i = gt; i < 3 * C8; i += NT) { const int j = i / C8, ch = (i - j * C8) * 8; const v4u w = *(const GAS v4u*)(U + UIDX(SEQ - 3 + j, UXBC + ch));
        GAS f32x4* po = (GAS f32x4*)((C.a->out) + O_PCONV + (size_t)l * 3 * CD + (size_t)j * CD + ch);
        po[0] = (f32x4){bflo(w.x), bfhi(w.x), bflo(w.y), bfhi(w.y)}; po[1] = (f32x4){bflo(w.z), bfhi(w.z), bflo(w.w), bfhi(w.w)}; }
    for (int i = gt; i < NB * C8; i += NT) { const int b = i / C8, ch = (i - b * C8) * 8;
        const GAS f32x4* si = (const GAS f32x4*)((C.a->in[3]) + ((size_t)l * NB + b) * 3 * CD + ch); GAS f32x4* so = (GAS f32x4*)((C.a->out) + O_SCONV + ((size_t)l * NB + b) * 3 * CD + ch);
        const f32x4 r10 = si[CD / 4], r11 = si[CD / 4 + 1], r20 = si[2 * CD / 4], r21 = si[2 * CD / 4 + 1]; const v4u w = *(const GAS v4u*)(U + UIDX(SEQ + b, UXBC + ch));
        so[0] = r10; so[1] = r11; so[CD / 4] = r20; so[CD / 4 + 1] = r21;
        so[2 * CD / 4] = (f32x4){bflo(w.x), bfhi(w.x), bflo(w.y), bfhi(w.y)}; so[2 * CD / 4 + 1] = (f32x4){bflo(w.z), bfhi(w.z), bflo(w.w), bfhi(w.w)}; }
}
typedef float f32x2_t __attribute__((ext_vector_type(2))); typedef __bf16 bf16x2_t __attribute__((ext_vector_type(2)));
__device__ __forceinline__ unsigned cvtpk(float lo, float hi) { f32x2_t v = {lo, hi}; bf16x2_t b = __builtin_convertvector(v, bf16x2_t); return __builtin_bit_cast(unsigned, b); }
__device__ __forceinline__ int crow(int reg, int hh) { return (reg & 3) + 8 * (reg >> 2) + 4 * hh; }
#define MFMA32(a, b, c) __builtin_amdgcn_mfma_f32_32x32x16_bf16((a), (b), (c), 0, 0, 0)
__device__ __forceinline__ bf16x8 ld16(const bf16* p) { return *(const GAS bf16x8*)p; }
__device__ __forceinline__ bf16x8 ld8x2(const bf16* p) {
    const u32x2 lo = *(const GAS u32x2*)p, hi = *(const GAS u32x2*)(p + 8); v4u w; w.x = lo.x; w.y = lo.y; w.z = hi.x; w.w = hi.y; return __builtin_bit_cast(bf16x8, w); }
#define PACK8(X, s) __builtin_bit_cast(bf16x8, (v4u){cvtpk((X)[8 * (s)], (X)[8 * (s) + 1]), cvtpk((X)[8 * (s) + 2], (X)[8 * (s) + 3]), cvtpk((X)[8 * (s) + 4], (X)[8 * (s) + 5]), cvtpk((X)[8 * (s) + 6], (X)[8 * (s) + 7])})

__device__ __forceinline__ void reformat_conv_item(const Ctx& C, int l, int c, int cblk) {
    const int co = C.lane & 7, rg = C.lane >> 3, ch0 = cblk * 64 + co * 8;
    const float* cw = (C.a->in[8]) + (size_t)l * CW * CD + ch0; const float* cb = (C.a->in[9]) + (size_t)l * CD + ch0;
    float w0[8], w1[8], w2[8], w3[8], bs[8];
#pragma unroll
    for (int j = 0; j < 8; ++j) { w0[j] = cw[j]; w1[j] = cw[CD + j]; w2[j] = cw[2 * CD + j]; w3[j] = cw[3 * CD + j]; bs[j] = cb[j]; }
    const bf16* U = ((bf16*)(C.a->ws + WS_U));
    const int row0 = 128 * c + 16 * rg;
    v4u raw[19];
    unsigned zu = 0u; asm volatile("" : "+v"(zu));
#pragma unroll
    for (int i = 0; i < 19; ++i) { const int rr = row0 - 3 + i; raw[i] = rr >= 0 ? *(const GAS v4u*)(U + UIDX(rr, UXBC + ch0)) : (v4u){zu, zu, zu, zu}; }
    unsigned tp[8][8];
    bf16* rm = nullptr; bf16* tr = nullptr;
    if (cblk < 64) tr = ((bf16*)(C.a->ws + WS_XT)) + (((size_t)c * 64 + cblk) * 64 + co * 8) * 128 + 16 * rg;
    else if (cblk < 80) { const int g = (cblk - 64) >> 1, hf = (cblk - 64) & 1;
        rm = ((bf16*)(C.a->ws + WS_BRM)) + (((size_t)c * 8 + g) * 128 + 16 * rg) * 128 + hf * 64 + co * 8;
        tr = ((bf16*)(C.a->ws + WS_BT)) + (((size_t)c * 8 + g) * 128 + hf * 64 + co * 8) * 128 + 16 * rg; }
    else { const int g = (cblk - 80) >> 1, hf = (cblk - 80) & 1;
        rm = ((bf16*)(C.a->ws + WS_CRM)) + (((size_t)c * 8 + g) * 128 + 16 * rg) * 128 + hf * 64 + co * 8; }
#define RAWF(i, j) (((j) & 1) ? bfhi(((j) >> 1) == 0 ? raw[i].x : (((j) >> 1) == 1 ? raw[i].y : (((j) >> 1) == 2 ? raw[i].z : raw[i].w))) : bflo(((j) >> 1) == 0 ? raw[i].x : (((j) >> 1) == 1 ? raw[i].y : (((j) >> 1) == 2 ? raw[i].z : raw[i].w))))
#pragma unroll
    for (int i2 = 0; i2 < 8; ++i2) {
        float oa[8], ob[8];
#pragma unroll
        for (int j = 0; j < 8; ++j) { oa[j] = siluf_(bs[j] + w0[j] * RAWF(2 * i2, j) + w1[j] * RAWF(2 * i2 + 1, j) + w2[j] * RAWF(2 * i2 + 2, j) + w3[j] * RAWF(2 * i2 + 3, j));
                                      ob[j] = siluf_(bs[j] + w0[j] * RAWF(2 * i2 + 1, j) + w1[j] * RAWF(2 * i2 + 2, j) + w2[j] * RAWF(2 * i2 + 3, j) + w3[j] * RAWF(2 * i2 + 4, j)); }
        if (rm) { v4u w; w.x = cvtpk(oa[0], oa[1]); w.y = cvtpk(oa[2], oa[3]); w.z = cvtpk(oa[4], oa[5]); w.w = cvtpk(oa[6], oa[7]); *(GAS v4u*)(rm + (size_t)(2 * i2) * 128) = w;
                  w.x = cvtpk(ob[0], ob[1]); w.y = cvtpk(ob[2], ob[3]); w.z = cvtpk(ob[4], ob[5]); w.w = cvtpk(ob[6], ob[7]); *(GAS v4u*)(rm + (size_t)(2 * i2 + 1) * 128) = w; }
#pragma unroll
        for (int j = 0; j < 8; ++j) tp[j][i2] = cvtpk(oa[j], ob[j]);
    }
#undef RAWF
    if (tr) {
#pragma unroll
        for (int j = 0; j < 8; ++j) { *(GAS v4u*)(tr + (size_t)j * 128) = (v4u){tp[j][0], tp[j][1], tp[j][2], tp[j][3]}; *(GAS v4u*)(tr + (size_t)j * 128 + 8) = (v4u){tp[j][4], tp[j][5], tp[j][6], tp[j][7]}; }
    }
}
__device__ __forceinline__ void reformat_dt_item(const Ctx& C, int l, int c) {
    const int h = C.lane; const float A = -__expf((C.a->in[11])[l * NH + h]);
    const float* D = ((float*)(C.a->ws + WS_DT)) + (size_t)(128 * c) * 64 + h;
    float* dto = ((float*)(C.a->ws + WS_DTT)) + ((size_t)c * 64 + h) * 128; float* aco = ((float*)(C.a->ws + WS_ACS)) + ((size_t)c * 64 + h) * 128;
    float cs = 0.f;
#pragma unroll
    for (int l0 = 0; l0 < 128; l0 += 64) { float dv[64];
#pragma unroll
        for (int i = 0; i < 64; ++i) dv[i] = D[(size_t)(l0 + i) * 64];
#pragma unroll
        for (int q = 0; q < 16; ++q) { f32x4 av;
#pragma unroll
            for (int e = 0; e < 4; ++e) { cs += dv[4 * q + e] * A; av[e] = cs; }
            *(GAS f32x4*)(dto + l0 + 4 * q) = (f32x4){dv[4 * q], dv[4 * q + 1], dv[4 * q + 2], dv[4 * q + 3]}; *(GAS f32x4*)(aco + l0 + 4 * q) = av; } }
}
__device__ __forceinline__ void reformat_vt_item(const Ctx& C, int tb, int kh) {
    const int co = C.lane & 7, rg = C.lane >> 3; const bf16* U = ((bf16*)(C.a->ws + WS_U)) + UIDX(128 * tb + 16 * rg, UV + kh * 64 + co * 8);
    unsigned tp[8][8];
#pragma unroll
    for (int i = 0; i < 16; ++i) { const v4u a = *(const GAS v4u*)(U + (size_t)i * 64); const unsigned w[4] = {a.x, a.y, a.z, a.w};
#pragma unroll
        for (int j = 0; j < 8; ++j) { const unsigned hb = (j & 1) ? (w[j >> 1] >> 16) : (w[j >> 1] & 0xffffu); if (i & 1) tp[j][i >> 1] |= hb << 16; else tp[j][i >> 1] = hb; } }
    bf16* tr = ((bf16*)(C.a->ws + WS_VT)) + ((size_t)kh * 64 + co * 8) * SEQ + 128 * tb + 16 * rg;
#pragma unroll
    for (int j = 0; j < 8; ++j) { *(GAS v4u*)(tr + (size_t)j * SEQ) = (v4u){tp[j][0], tp[j][1], tp[j][2], tp[j][3]}; *(GAS v4u*)(tr + (size_t)j * SEQ + 8) = (v4u){tp[j][4], tp[j][5], tp[j][6], tp[j][7]}; }
}
constexpr int RF_ITEMS = 64 * 96 + 64 + 64 * 8;
__device__ __forceinline__ void reformat_item(const Ctx& C, int l, int it) {
    constexpr int N1 = 64 * 96, N2 = 64;
    if (it < N1) reformat_conv_item(C, l, it / 96, it % 96);
    else if (it < N1 + N2) reformat_dt_item(C, l, it - N1);
    else reformat_vt_item(C, (it - N1 - N2) >> 3, (it - N1 - N2) & 7);
}

constexpr int AT_K = 0, AT_V = 36864, AT_KP = 144, AT_VP = 528;
__device__ __forceinline__ void attn_prompt_unit(const Ctx& C, int l, int qb, int kh) {
    const int lane_ = lane_now();
    const int r = lane_ & 31, hh = lane_ >> 5, hq = 4 * kh + (C.wave >> 1), rh = C.wave & 1, tid = C.wave * 64 + lane_;
    const bf16* U = ((bf16*)(C.a->ws + WS_U)); const bf16* VT = ((bf16*)(C.a->ws + WS_VT)) + (size_t)kh * 64 * SEQ; bf16* YO = ((bf16*)(C.a->ws + WS_YO));
    LAS unsigned char* Ks = C.lds + AT_K; LAS unsigned char* Vs = C.lds + AT_V;
    const int key0 = 128 * (qb - 1);
    { v4u tk[4], tv[4]; unsigned zu = 0u; asm volatile("" : "+v"(zu));
#pragma unroll
      for (int i = 0; i < 4; ++i) { const int idx = tid + 512 * i, kr = idx >> 3, ch = idx & 7, key = key0 + kr;
          tk[i] = key >= 0 ? *(const GAS v4u*)(U + UIDX(key, UK + kh * 64 + 8 * ch)) : (v4u){zu, zu, zu, zu};
          const int d = idx >> 5, c5 = idx & 31, kk = key0 + 8 * c5;
          tv[i] = kk >= 0 ? *(const GAS v4u*)(VT + (size_t)d * SEQ + kk) : (v4u){zu, zu, zu, zu}; }
#pragma unroll
      for (int i = 0; i < 4; ++i) { const int idx = tid + 512 * i; *(LAS v4u*)(Ks + (idx >> 3) * AT_KP + (idx & 7) * 16) = tk[i]; *(LAS v4u*)(Vs + (idx >> 5) * AT_VP + (idx & 31) * 16) = tv[i]; } }
    bf16x8 bq[2][4];
#pragma unroll
    for (int qt = 0; qt < 2; ++qt)
#pragma unroll
        for (int ks = 0; ks < 4; ++ks) bq[qt][ks] = ld16(U + UIDX(128 * qb + 32 * (2 * rh + qt) + r, UQ + hq * 64 + 16 * ks + 8 * hh));
    const float sink = (C.a->in[16])[l * AH + hq];
    __syncthreads();
#pragma unroll
    for (int qt = 0; qt < 2; ++qt) {
        const int ai = 2 * rh + qt, q0 = 128 * qb + 32 * ai, t = q0 + r;
        f32x16 S[5]; float mx = sink;
#pragma unroll
        for (int v = 0; v < 5; ++v) { const int kt = ai + v; const bool vis = qb > 0 || kt >= 4;
            if (vis) { const int kb = key0 + 32 * kt; f32x16 s;
#pragma unroll
                for (int e = 0; e < 16; ++e) s[e] = 0.f;
                const LAS unsigned char* kp = Ks + (32 * kt + r) * AT_KP + 16 * hh;
#pragma unroll
                for (int ks = 0; ks < 4; ++ks) { const bf16x8 a = *(const LAS bf16x8*)(kp + 32 * ks); s = MFMA32(a, bq[qt][ks], s); }
#pragma unroll
                for (int e = 0; e < 16; ++e) { const int j = kb + crow(e, hh); const bool ok = (j <= t) && (j >= t - WIN); const float x = ok ? s[e] * 0.125f : -__builtin_inff(); s[e] = x; mx = fmaxf(mx, x); }
                S[v] = s; }
        }
        mx = fmaxf(mx, __shfl_xor(mx, 32));
        float sum = 0.f;
#pragma unroll
        for (int v = 0; v < 5; ++v) { const int kt = ai + v; const bool vis = qb > 0 || kt >= 4;
            if (vis) {
#pragma unroll
                for (int e = 0; e < 16; ++e) { const float p = __expf(S[v][e] - mx); S[v][e] = p; sum += p; } } }
        sum += __shfl_xor(sum, 32); sum += __expf(sink - mx);
        f32x16 O[2];
#pragma unroll
        for (int e = 0; e < 16; ++e) { O[0][e] = 0.f; O[1][e] = 0.f; }
#pragma unroll
        for (int v = 0; v < 5; ++v) { const int kt = ai + v; const bool vis = qb > 0 || kt >= 4;
            if (vis) {
#pragma unroll
                for (int ss = 0; ss < 2; ++ss) { const bf16x8 pb = PACK8(S[v], ss);
#pragma unroll
                    for (int dt = 0; dt < 2; ++dt) { const LAS unsigned char* vp = Vs + (32 * dt + r) * AT_VP + (32 * kt + 16 * ss + 4 * hh) * 2;
                        const u32x2 lo = *(const LAS u32x2*)vp, hi = *(const LAS u32x2*)(vp + 16);
                        const bf16x8 va = __builtin_bit_cast(bf16x8, (v4u){lo.x, lo.y, hi.x, hi.y}); O[dt] = MFMA32(va, pb, O[dt]); } } } }
        const float inv = 1.0f / sum;
        bf16* op = YO + (size_t)t * KCAT + DI + hq * 64;
#pragma unroll
        for (int dt = 0; dt < 2; ++dt)
#pragma unroll
            for (int g4 = 0; g4 < 4; ++g4) { u32x2 w; w.x = cvtpk(O[dt][4 * g4] * inv, O[dt][4 * g4 + 1] * inv); w.y = cvtpk(O[dt][4 * g4 + 2] * inv, O[dt][4 * g4 + 3] * inv);
                *(GAS u32x2*)(op + 32 * dt + 8 * g4 + 4 * hh) = w; }
    }
    __syncthreads();
}

__device__ __forceinline__ void ssd_states_unit(const Ctx& C, int c, int g) {
    const int lane_ = lane_now();
    const int r = lane_ & 31, hh = lane_ >> 5, h = 8 * g + C.wave, tid = C.wave * 64 + lane_;
    const bf16* xT = ((bf16*)(C.a->ws + WS_XT)) + ((size_t)c * 64 + h) * 64 * 128; const bf16* bT = ((bf16*)(C.a->ws + WS_BT)) + ((size_t)c * 8 + g) * 128 * 128;
    const float* dtT = ((float*)(C.a->ws + WS_DTT)) + ((size_t)c * 64 + h) * 128; const float* acs = ((float*)(C.a->ws + WS_ACS)) + ((size_t)c * 64 + h) * 128;
    LAS unsigned char* Bs = C.lds + PC_B;
    { v4u tb[4];
#pragma unroll
      for (int i = 0; i < 4; ++i) tb[i] = *(const GAS v4u*)(bT + (size_t)(tid + 512 * i) * 8);
#pragma unroll
      for (int i = 0; i < 4; ++i) { const int idx = tid + 512 * i; *(LAS v4u*)(Bs + (idx >> 4) * 272 + (idx & 15) * 16) = tb[i]; } }
    const float aend = acs[127];
    bf16x8 a[2][8];
#pragma unroll
    for (int ks = 0; ks < 8; ++ks) { const int l0 = 16 * ks + 8 * hh;
        const f32x4 d0 = *(const GAS f32x4*)(dtT + l0), d1 = *(const GAS f32x4*)(dtT + l0 + 4), a0 = *(const GAS f32x4*)(acs + l0), a1 = *(const GAS f32x4*)(acs + l0 + 4);
        float sc[8];
#pragma unroll
        for (int j = 0; j < 4; ++j) { sc[j] = d0[j] * __expf(aend - a0[j]); sc[4 + j] = d1[j] * __expf(aend - a1[j]); }
#pragma unroll
        for (int pt = 0; pt < 2; ++pt) { const v4u w = *(const GAS v4u*)(xT + (size_t)(32 * pt + r) * 128 + l0);
            v4u o; o.x = cvtpk(bflo(w.x) * sc[0], bfhi(w.x) * sc[1]); o.y = cvtpk(bflo(w.y) * sc[2], bfhi(w.y) * sc[3]); o.z = cvtpk(bflo(w.z) * sc[4], bfhi(w.z) * sc[5]); o.w = cvtpk(bflo(w.w) * sc[6], bfhi(w.w) * sc[7]);
            a[pt][ks] = __builtin_bit_cast(bf16x8, o); } }
    __syncthreads();
    bf16* st = ((bf16*)(C.a->ws + WS_ST)) + ((size_t)c * 64 + h) * 64 * 128;
#pragma unroll
    for (int nt = 0; nt < 4; ++nt) {
        f32x16 acc[2];
#pragma unroll
        for (int e = 0; e < 16; ++e) { acc[0][e] = 0.f; acc[1][e] = 0.f; }
        const LAS unsigned char* bp = Bs + (32 * nt + r) * 272 + 16 * hh;
#pragma unroll
        for (int ks = 0; ks < 8; ++ks) { const bf16x8 b = *(const LAS bf16x8*)(bp + 32 * ks); acc[0] = MFMA32(b, a[0][ks], acc[0]); acc[1] = MFMA32(b, a[1][ks], acc[1]); }
#pragma unroll
        for (int pt = 0; pt < 2; ++pt)
#pragma unroll
            for (int q4 = 0; q4 < 4; ++q4) { u32x2 w; w.x = cvtpk(acc[pt][4 * q4], acc[pt][4 * q4 + 1]); w.y = cvtpk(acc[pt][4 * q4 + 2], acc[pt][4 * q4 + 3]);
                *(GAS u32x2*)(st + (size_t)(32 * pt + r) * 128 + 32 * nt + 8 * q4 + 4 * hh) = w; }
    }
    __syncthreads();
}

__device__ __forceinline__ void ssd_scan_phase(const Ctx& C, int l) {
    const bf16* ST = ((bf16*)(C.a->ws + WS_ST)); bf16* HS = ((bf16*)(C.a->ws + WS_HS)); const float* acs = ((float*)(C.a->ws + WS_ACS));
    for (int idx = C.bid * 512 + C.tid; idx < 64 * 64 * 128 / 4; idx += C.G * 512) { const int h = idx >> 11;
        f32x4 hc = (f32x4){0.f, 0.f, 0.f, 0.f};
        for (int c0 = 0; c0 < 64; c0 += 16) { u32x2 sw[16]; float av[16];
#pragma unroll
            for (int j = 0; j < 16; ++j) { sw[j] = *((const GAS u32x2*)(ST + (size_t)(c0 + j) * 64 * 64 * 128) + idx); av[j] = acs[((size_t)(c0 + j) * 64 + h) * 128 + 127]; }
#pragma unroll
            for (int j = 0; j < 16; ++j) {
                u32x2 w; w.x = cvtpk(hc.x, hc.y); w.y = cvtpk(hc.z, hc.w); *((GAS u32x2*)(HS + (size_t)(c0 + j) * 64 * 64 * 128) + idx) = w;
                const f32x4 s = (f32x4){bflo(sw[j].x), bfhi(sw[j].x), bflo(sw[j].y), bfhi(sw[j].y)}; const float dec = __expf(av[j]);
                hc = hc * dec + s; } }
        *((GAS f32x4*)((C.a->out) + O_PSSM + (size_t)l * NH * HP * DS) + idx) = hc; }
}

__device__ __forceinline__ void ssd_out_unit(const Ctx& C, int l, int c, int g) {
    const int lane_ = lane_now();
    const int r = lane_ & 31, hh = lane_ >> 5, h = 8 * g + C.wave, tid = C.wave * 64 + lane_;
    LAS unsigned char* Bs = C.lds + PC_B; LAS unsigned char* Cs = C.lds + PC_C; LAS float* Ysm = (LAS float*)(C.lds + PC_Y + C.wave * 8704);
    LAS float* ssq = (LAS float*)(C.lds + PC_SSQ); LAS float* acsS = (LAS float*)(C.lds + PC_AD + C.wave * 1024); LAS float* dtS = acsS + 128;
    const bf16* cR = ((bf16*)(C.a->ws + WS_CRM)) + ((size_t)c * 8 + g) * 128 * 128; const bf16* bR = ((bf16*)(C.a->ws + WS_BRM)) + ((size_t)c * 8 + g) * 128 * 128;
    const bf16* hS = ((bf16*)(C.a->ws + WS_HS)) + ((size_t)c * 64 + h) * 64 * 128; const bf16* xT = ((bf16*)(C.a->ws + WS_XT)) + ((size_t)c * 64 + h) * 64 * 128;
    { v4u tb[4], tc[4];
#pragma unroll
      for (int i = 0; i < 4; ++i) { const int idx = tid + 512 * i; tb[i] = *(const GAS v4u*)(bR + (size_t)idx * 8); tc[i] = *(const GAS v4u*)(cR + (size_t)idx * 8); }
      const float a0 = (((float*)(C.a->ws + WS_ACS)) + ((size_t)c * 64 + h) * 128)[lane_], a1 = (((float*)(C.a->ws + WS_ACS)) + ((size_t)c * 64 + h) * 128)[64 + lane_];
      const float d0 = (((float*)(C.a->ws + WS_DTT)) + ((size_t)c * 64 + h) * 128)[lane_], d1 = (((float*)(C.a->ws + WS_DTT)) + ((size_t)c * 64 + h) * 128)[64 + lane_];
#pragma unroll
      for (int i = 0; i < 4; ++i) { const int idx = tid + 512 * i, row = idx >> 4, ch = idx & 15; *(LAS v4u*)(Bs + row * 272 + ch * 16) = tb[i]; *(LAS v4u*)(Cs + row * 272 + ch * 16) = tc[i]; }
      acsS[lane_] = a0; acsS[64 + lane_] = a1; dtS[lane_] = d0; dtS[64 + lane_] = d1; }
    bf16x8 hb[2][8], xb[4][2][2];
#pragma unroll
    for (int pt = 0; pt < 2; ++pt)
#pragma unroll
        for (int ks = 0; ks < 8; ++ks) hb[pt][ks] = ld16(hS + (size_t)(32 * pt + r) * 128 + 16 * ks + 8 * hh);
#pragma unroll
    for (int st = 0; st < 4; ++st)
#pragma unroll
        for (int ss = 0; ss < 2; ++ss)
#pragma unroll
            for (int pt = 0; pt < 2; ++pt) xb[st][ss][pt] = ld8x2(xT + (size_t)(32 * pt + r) * 128 + 32 * st + 16 * ss + 4 * hh);
    const float Dh = (C.a->in[12])[l * NH + h];
    __syncthreads();
    const bf16* Uz = ((bf16*)(C.a->ws + WS_U)) + UIDX(128 * c + (lane_ >> 1), UZ + h * 64 + 32 * (lane_ & 1));
    bf16* YOw = ((bf16*)(C.a->ws + WS_YO)) + (size_t)(128 * c + (lane_ >> 1)) * KCAT + h * 64 + 32 * (lane_ & 1);
    const float* nwp = (C.a->in[13]) + (size_t)l * DI + h * 64 + 32 * (lane_ & 1);
#pragma unroll
    for (int lt = 0; lt < 4; ++lt) {
        v4u zw[4];
        { const GAS v4u* zp = (const GAS v4u*)(Uz + (size_t)(32 * lt) * 64);
#pragma unroll
          for (int i = 0; i < 4; ++i) zw[i] = zp[i]; }
        f32x16 y[2];
#pragma unroll
        for (int e = 0; e < 16; ++e) { y[0][e] = 0.f; y[1][e] = 0.f; }
        const LAS unsigned char* crow_p = Cs + (32 * lt + r) * 272 + 16 * hh;
#pragma unroll
        for (int ks = 0; ks < 8; ++ks) { if ((ks & 3) == 0) asm volatile("" ::: "memory");
            const bf16x8 a = *(const LAS bf16x8*)(crow_p + 32 * ks); y[0] = MFMA32(a, hb[0][ks], y[0]); y[1] = MFMA32(a, hb[1][ks], y[1]); }
#pragma unroll
        for (int q4 = 0; q4 < 4; ++q4) { const f32x4 av = *(const LAS f32x4*)(acsS + 32 * lt + 8 * q4 + 4 * hh);
#pragma unroll
            for (int e = 0; e < 4; ++e) { const float f = __expf(av[e]); y[0][4 * q4 + e] *= f; y[1][4 * q4 + e] *= f; } }
        const float al = acsS[32 * lt + r];
#pragma unroll
        for (int st = 0; st < 4; ++st) { if (st > lt) continue;
            f32x16 X;
#pragma unroll
            for (int e = 0; e < 16; ++e) X[e] = 0.f;
            const LAS unsigned char* brow_p = Bs + (32 * st + r) * 272 + 16 * hh;
#pragma unroll
            for (int ks = 0; ks < 8; ++ks) { if ((ks & 1) == 0) asm volatile("" ::: "memory");
                const bf16x8 a = *(const LAS bf16x8*)(brow_p + 32 * ks), b = *(const LAS bf16x8*)(crow_p + 32 * ks); X = MFMA32(a, b, X); }
#pragma unroll
            for (int q4 = 0; q4 < 4; ++q4) { const f32x4 as = *(const LAS f32x4*)(acsS + 32 * st + 8 * q4 + 4 * hh), ds = *(const LAS f32x4*)(dtS + 32 * st + 8 * q4 + 4 * hh);
#pragma unroll
                for (int e = 0; e < 4; ++e) { const int s = 32 * st + 8 * q4 + 4 * hh + e, lrow = 32 * lt + r; const float wgt = (s <= lrow) ? ds[e] * __expf(al - as[e]) : 0.f; X[4 * q4 + e] *= wgt; } }
#pragma unroll
            for (int ss = 0; ss < 2; ++ss) { const bf16x8 xa = PACK8(X, ss); y[0] = MFMA32(xa, xb[st][ss][0], y[0]); y[1] = MFMA32(xa, xb[st][ss][1], y[1]); }
        }
#pragma unroll
        for (int pt = 0; pt < 2; ++pt)
#pragma unroll
            for (int e = 0; e < 16; ++e) { const int q4 = e >> 2; const v4u xw = __builtin_bit_cast(v4u, xb[lt][q4 >> 1][pt]); const unsigned w = (q4 & 1) ? ((e & 2) ? xw.w : xw.z) : ((e & 2) ? xw.y : xw.x);
                const float xv = (e & 1) ? bfhi(w) : bflo(w);
                Ysm[crow(e, hh) * 68 + 32 * pt + r] = y[pt][e] + Dh * xv; }
        { const LAS f32x4* yr = (const LAS f32x4*)(Ysm + (lane_ >> 1) * 68 + 32 * (lane_ & 1));
          float gq[32]; float sq = 0.f;
#pragma unroll
          for (int i = 0; i < 4; ++i) { const f32x4 ya = yr[2 * i], yb = yr[2 * i + 1];
              gq[8 * i + 0] = ya.x * bflo(zw[i].x); gq[8 * i + 1] = ya.y * bfhi(zw[i].x); gq[8 * i + 2] = ya.z * bflo(zw[i].y); gq[8 * i + 3] = ya.w * bfhi(zw[i].y);
              gq[8 * i + 4] = yb.x * bflo(zw[i].z); gq[8 * i + 5] = yb.y * bfhi(zw[i].z); gq[8 * i + 6] = yb.z * bflo(zw[i].w); gq[8 * i + 7] = yb.w * bfhi(zw[i].w);
#pragma unroll
              for (int e = 0; e < 8; ++e) sq += gq[8 * i + e] * gq[8 * i + e]; }
          sq += __shfl_xor(sq, 1);
          if ((lane_ & 1) == 0) ssq[(32 * lt + (lane_ >> 1)) * 8 + C.wave] = sq;
          __syncthreads();
          const LAS f32x4* sp = (const LAS f32x4*)(ssq + (32 * lt + (lane_ >> 1)) * 8); const f32x4 s0 = sp[0], s1 = sp[1];
          const float rstd = rsqrtf(((s0.x + s0.y) + (s0.z + s0.w) + (s1.x + s1.y) + (s1.z + s1.w)) * (1.0f / 512.0f) + EPS);
          GAS v4u* op = (GAS v4u*)(YOw + (size_t)(32 * lt) * KCAT);
#pragma unroll
          for (int i = 0; i < 4; ++i) { const f32x4 na = *(const GAS f32x4*)(nwp + 8 * i), nb = *(const GAS f32x4*)(nwp + 8 * i + 4);
              op[i] = (v4u){cvtpk(gq[8 * i] * rstd * na.x, gq[8 * i + 1] * rstd * na.y), cvtpk(gq[8 * i + 2] * rstd * na.z, gq[8 * i + 3] * rstd * na.w), cvtpk(gq[8 * i + 4] * rstd * nb.x, gq[8 * i + 5] * rstd * nb.y), cvtpk(gq[8 * i + 6] * rstd * nb.z, gq[8 * i + 7] * rstd * nb.w)}; } }
    }
    __syncthreads();
}

template <int MODE> __device__ __forceinline__ void mini_unit(const Ctx& C, int l, int mu) {
    constexpr int K = MODE == 0 ? KCAT : (MODE == 1 ? DM : FF), KS = MODE == 0 ? 1024 : (MODE == 1 ? 256 : 704);
    const int lane_ = lane_now();
    const int r = lane_ & 31, hh = lane_ >> 5, ct = mu & 31, sp = mu >> 5, rt = C.wave & 3, n0 = 64 * ct + 32 * (C.wave >> 2), k0 = KS * sp + 8 * hh;
    const bf16* Bt = (MODE == 0 ? ((bf16*)(C.a->ws + WS_WCAT)) + (size_t)l * DM * KCAT : (MODE == 1 ? ((bf16*)(C.a->ws + WS_WOUT)) + (size_t)l * DM * DM : ((bf16*)(C.a->ws + WS_WDN)) + (size_t)l * DM * FF)) + (size_t)(n0 + r) * K + k0;
    const bf16* Ab = (MODE == 0 ? ((bf16*)(C.a->ws + WS_YO)) + (size_t)(SEQ + 32 * rt + r) * KCAT : ((bf16*)(C.a->ws + WS_HB)) + (size_t)(SEQ + 32 * rt + r) * FF) + k0;
    const float* Af = ((float*)(C.a->ws + WS_MS)) + (size_t)(32 * rt + r) * DM + k0;
    f32x16 acc;
#pragma unroll
    for (int e = 0; e < 16; ++e) acc[e] = 0.f;
#pragma unroll(MODE == 1 ? 8 : 16)
    for (int ks = 0; ks < KS / 16; ++ks) { bf16x8 a; const bf16x8 b = ld16(Bt + 16 * ks);
        if (MODE == 1) { const f32x4 v0 = *(const GAS f32x4*)(Af + 16 * ks), v1 = *(const GAS f32x4*)(Af + 16 * ks + 4);
            a = __builtin_bit_cast(bf16x8, (v4u){cvtpk(v0.x, v0.y), cvtpk(v0.z, v0.w), cvtpk(v1.x, v1.y), cvtpk(v1.z, v1.w)}); }
        else a = ld16(Ab + 16 * ks);
        acc = MFMA32(a, b, acc); }
    float* dst = (MODE == 0 ? ((float*)(C.a->ws + WS_MS)) : ((float*)(C.a->ws + WS_X)) + (size_t)SEQ * DM) + n0 + r;
    const bf16* gp = ((bf16*)(C.a->ws + WS_U)) + UIDX(SEQ, (sp < 4 ? UGS : UGA) + n0 + r);
#pragma unroll
    for (int e = 0; e < 16; ++e) { const int row = 32 * rt + crow(e, hh); float v = acc[e];
        if (MODE == 0) v *= bf2f(gp[(size_t)row * 64]);
        unsafeAtomicAdd(dst + (size_t)row * DM, v); }
}
template <int MODE> __device__ __forceinline__ void mini_phase(const Ctx& C, int l) {
    constexpr int NMU = 32 * (MODE == 0 ? 6 : 8);
    for (int mu = C.bid; mu < NMU; mu += C.G) mini_unit<MODE>(C, l, mu);
}
constexpr int NPL = 11;
constexpr int NPH = 1 + DEPTH * NPL;
#ifndef REP_P0
#define REP_P0 1
#endif
#ifndef REP_0
#define REP_0 1
#endif
#ifndef REP_1
#define REP_1 1
#endif
#ifndef REP_2
#define REP_2 1
#endif
#ifndef REP_3
#define REP_3 1
#endif
#ifndef REP_4
#define REP_4 1
#endif
#ifndef REP_5
#define REP_5 1
#endif
#ifndef REP_6
#define REP_6 1
#endif
#ifndef REP_7
#define REP_7 1
#endif
#ifndef REP_8
#define REP_8 1
#endif
#ifndef REP_9
#define REP_9 1
#endif
#ifndef REP_10
#define REP_10 1
#endif
#ifndef REP_RF
#define REP_RF 1
#endif
#ifndef REP_SSD
#define REP_SSD 1
#endif
#ifndef REP_SATT
#define REP_SATT 1
#endif
#ifndef GEMM_ALIGN
#define GEMM_ALIGN true
#endif
#ifndef GEMM_SP2
#define GEMM_SP2 true
#endif
#ifndef PROBE_LO
#define PROBE_LO -1
#define PROBE_HI -1
#endif
#ifndef PROBE_AMP
#define PROBE_AMP 2
#endif
#ifndef NW_SSD
#define NW_SSD 2
#endif
#ifndef PROBE_SUB
#define PROBE_SUB 0
#endif
#ifndef PROBE_CLK
#define PROBE_CLK 0
#endif
#ifndef REP_ATT
#define REP_ATT 1
#endif
#ifndef REP_PA
#define REP_PA 1
#endif
#ifndef NSP_G1
#define NSP_G1 49
#endif
#ifndef MK_SPLIT
#define MK_SPLIT 0
#endif
__global__ void __launch_bounds__(NWAVES * 64, 2) fwd(Args args) {
    extern __shared__ __attribute__((aligned(16))) unsigned char lds_raw[];
    LAS unsigned char* const lds = (LAS unsigned char*)lds_raw;
    const int wave_s = __builtin_amdgcn_readfirstlane(threadIdx.x >> 6);
    unsigned char* ws = args.ws;
#define FRESH_CTX() Ctx C; { int t_; asm volatile("v_mbcnt_lo_u32_b32 %0, -1, 0\n\tv_mbcnt_hi_u32_b32 %0, -1, %0" : "=v"(t_)); t_ += wave_s * 64; int b_ = blockIdx.x, g_ = gridDim.x; asm volatile("" : "+s"(b_), "+s"(g_)); \
        KArgs kp_ = (KArgs)__builtin_amdgcn_kernarg_segment_ptr(); asm volatile("" : "+s"(kp_)); \
        C.lds = lds; C.tid = t_; C.lane = t_ & 63; C.wave = __builtin_amdgcn_readfirstlane(t_ >> 6); C.G = g_; C.bid = b_; C.a = kp_; }
    for (int u = threadIdx.x; u < (LDS_BYTES - LDSCTL_OFF) / 4; u += NWAVES * 64) ((LAS unsigned*)(lds + LDSCTL_OFF))[u] = 0u;
    __syncthreads();
    volatile LAS unsigned* MISC = (volatile LAS unsigned*)(lds + MISC_OFF);
    unsigned* barw = (unsigned*)(ws + WS_CTL) + CW_BAR;
    XcdBarrier bar; bar.bar = barw; bar.x = 0; bar.st = nullptr;
    if (args.use_bar) bar = xcd_barrier_post(barw, MISC + 8);
    const int lo = args.ph_lo, hi = args.ph_hi;
#define IN(k) (lo <= (k) && (k) < hi)
#define SEAM(k) do { if (IN((k) + 1)) xcd_barrier(bar); } while (0)

#ifndef NO_P0
    if (IN(0)) { for (int rep_ = 0; rep_ < REP_P0; ++rep_) { FRESH_CTX(); p0_weights(C, 0, (C.G >= 64 && NSP_G1 > 0) ? IT_IN : DEPTH * IT_LAYER, C.bid * NWAVES + C.wave, C.G * NWAVES); p0_xinit(C); if (rep_ + 1 < REP_P0) xcd_barrier(bar); } SEAM(0); }
#endif

    unsigned long long probe_acc = 0ull, probe_t0 = 0ull;
    if (PROBE_CLK && threadIdx.x == 0) { const unsigned long long c0_ = __builtin_amdgcn_s_memtime(), r0_ = __builtin_amdgcn_s_memrealtime(); MISC[16] = (unsigned)c0_; MISC[17] = (unsigned)(c0_ >> 32); MISC[18] = (unsigned)r0_; MISC[19] = (unsigned)(r0_ >> 32); }
#define PROBE_BEGIN(j) do { if (PROBE_LO >= 0 && (j) == PROBE_LO) probe_t0 = __builtin_amdgcn_s_memrealtime(); } while (0)
#define PROBE_END(j) do { if (PROBE_LO >= 0 && (j) == PROBE_HI) probe_acc += __builtin_amdgcn_s_memrealtime() - probe_t0; } while (0)
#pragma nounroll
    for (int l = 0; l < DEPTH; ++l) {
        const int pb = 1 + l * NPL;
#ifndef NO_G1
        PROBE_BEGIN(0);
        if (IN(pb + 0)) { for (int rep_ = 0; rep_ < REP_0; ++rep_) {
            FRESH_CTX();
            const int nsp = (l == 0 && C.G >= 64) ? (C.G * NSP_G1) / 256 : 0, gG = C.G - nsp;
            if (C.bid < gG) {
            pg8::Gemm g{((bf16*)(C.a->ws + WS_XN)), ((bf16*)(C.a->ws + WS_WIN)) + (size_t)l * NU * DM, MP, NU, DM}; pg8::StaticOrder S; S.init(MP, NU, gG, C.bid);
            pg8::EpiU E{((bf16*)(C.a->ws + WS_U)), ((float*)(C.a->ws + WS_DT)), (C.a->in[10]) + l * NH, ((float*)(C.a->ws + WS_RSA))};
            pg8::gemm_phase<pg8::EpiU, pg8::StaticOrder, GEMM_ALIGN, GEMM_SP2>(C.lds + RING_OFF, g, S, E, C.tid);
            } else p0_weights(C, IT_IN, DEPTH * IT_LAYER, (C.bid - gG) * NWAVES + C.wave, nsp * NWAVES);
            if (rep_ + 1 < REP_0) xcd_barrier(bar); }
            SEAM(pb + 0);
        }
        PROBE_END(0);
#endif
        PROBE_BEGIN(1);
        if (IN(pb + 1)) { for (int rep_ = 0; rep_ < REP_1; ++rep_) {
            FRESH_CTX();
            { volatile LAS unsigned* qctr = (volatile LAS unsigned*)(C.lds + MISC_OFF) + 24;
              if (C.tid == 0) qctr[0] = 0u;
              __syncthreads();
              const int nS = (NB * NG - C.bid + C.G - 1) / C.G, nR = (RF_ITEMS - C.bid + C.G - 1) / C.G;
              LAS float* wsc = (LAS float*)(C.lds + RING_OFF + C.wave * 8192);
              for (;;) { unsigned idx = 0u; if (C.lane == 0) idx = __hip_atomic_fetch_add((LAS unsigned*)qctr, 1u, __ATOMIC_RELAXED, __HIP_MEMORY_SCOPE_WORKGROUP);
                  idx = (unsigned)__builtin_amdgcn_readfirstlane((int)idx);
                  if ((int)idx >= nS + nR) break;
                  if ((int)idx < nS) { const int u = C.bid + C.G * (int)idx; sample_ssd_wave_unit(C, l, u >> 3, u & 7, wsc); }
                  else reformat_item(C, l, C.bid + C.G * ((int)idx - nS)); } }
            __syncthreads();
            if (PROBE_SUB == 1) probe_acc += __builtin_amdgcn_s_memrealtime() - probe_t0;
            if (PROBE_SUB == 2) probe_t0 = __builtin_amdgcn_s_memrealtime();
            zero_f32(C, ((float*)(C.a->ws + WS_RSB)), SEQ, C.bid, C.G);
            { float z0 = 0.f; asm volatile("" : "+v"(z0));
              for (int i = C.bid * 512 + C.tid; i < NB * DM / 4; i += C.G * 512) ((GAS f32x4*)(C.a->ws + WS_MS))[i] = (f32x4){z0, z0, z0, z0}; }
            for (int rr_ = 0; rr_ < REP_SATT; ++rr_) for (int u = C.bid; u < NB * KVH; u += C.G) sample_attn_unit(C, l, u >> 3, u & 7);
            if (PROBE_SUB == 2) probe_acc += __builtin_amdgcn_s_memrealtime() - probe_t0;
            if (PROBE_SUB == 3) probe_t0 = __builtin_amdgcn_s_memrealtime();
            if (PROBE_SUB == 3) { __syncthreads(); probe_acc += __builtin_amdgcn_s_memrealtime() - probe_t0; }
            if (rep_ + 1 < REP_1) xcd_barrier(bar); }
            SEAM(pb + 1);
        }
        PROBE_END(1);
        PROBE_BEGIN(2);
        if (IN(pb + 2)) { for (int rep_ = 0; rep_ < REP_2; ++rep_) {
            FRESH_CTX();
#ifdef USE_NSSD
            if (C.bid < NG) naive_ssd_prompt(C, l, C.bid);
            else {
                const int vb = C.bid - NG, nvb = C.G - NG;
                for (int u = vb; u < 64 * KVH; u += nvb) attn_prompt_unit(C, l, u >> 3, u & 7);
                for (int u = vb; u < 64 * NG; u += nvb) ssd_states_unit(C, u >> 3, u & 7);
            }
#else
            for (int rr_ = 0; rr_ < REP_ATT; ++rr_) for (int u = C.bid; u < 64 * KVH; u += C.G) attn_prompt_unit(C, l, u >> 3, u & 7);
            for (int rr_ = 0; rr_ < REP_PA; ++rr_) for (int u = C.bid; u < 64 * NG; u += C.G) ssd_states_unit(C, u >> 3, u & 7);
#endif
            if (rep_ + 1 < REP_2) xcd_barrier(bar); }
            SEAM(pb + 2);
        }
        PROBE_END(2);
        PROBE_BEGIN(3);
        if (IN(pb + 3)) { for (int rep_ = 0; rep_ < REP_3; ++rep_) { FRESH_CTX(); ssd_scan_phase(C, l); if (rep_ + 1 < REP_3) xcd_barrier(bar); } SEAM(pb + 3); }
        PROBE_END(3);
        PROBE_BEGIN(4);
        if (IN(pb + 4)) { for (int rep_ = 0; rep_ < REP_4; ++rep_) {
            FRESH_CTX();
#ifndef USE_NSSD
            for (int u = C.bid; u < 64 * NG; u += C.G) ssd_out_unit(C, l, u >> 3, u & 7);
#endif
            if (rep_ + 1 < REP_4) xcd_barrier(bar); }
            SEAM(pb + 4);
        }
        PROBE_END(4);
#ifndef NO_G2
        PROBE_BEGIN(5);
        if (IN(pb + 5)) { for (int rep_ = 0; rep_ < REP_5; ++rep_) {
            FRESH_CTX();
            pg8::Gemm g{((bf16*)(C.a->ws + WS_YO)), ((bf16*)(C.a->ws + WS_WCAT)) + (size_t)l * DM * KCAT, SEQ, DM, KCAT}; pg8::StaticOrder S; S.init(SEQ, DM, C.G, C.bid);
            pg8::EpiMerge E{((bf16*)(C.a->ws + WS_U)), ((bf16*)(C.a->ws + WS_MRG))};
            pg8::gemm_phase<pg8::EpiMerge, pg8::StaticOrder, true, true>(C.lds + RING_OFF, g, S, E, C.tid);
            mini_phase<0>(C, l);
            if (rep_ + 1 < REP_5) xcd_barrier(bar); }
            SEAM(pb + 5);
        }
        PROBE_END(5);
#endif
#ifndef NO_G3
        PROBE_BEGIN(6);
        if (IN(pb + 6)) { for (int rep_ = 0; rep_ < REP_6; ++rep_) {
            FRESH_CTX();
            pg8::Gemm g{((bf16*)(C.a->ws + WS_MRG)), ((bf16*)(C.a->ws + WS_WOUT)) + (size_t)l * DM * DM, SEQ, DM, DM}; pg8::StaticOrder S; S.init(SEQ, DM, C.G, C.bid);
            pg8::EpiResid E{l == 0 ? (C.a->in[0]) : (const float*)nullptr, ((bf16*)(C.a->ws + WS_XN)), ((float*)(C.a->ws + WS_RSB))};
            pg8::gemm_phase<pg8::EpiResid, pg8::StaticOrder, true, true>(C.lds + RING_OFF, g, S, E, C.tid);
            mini_phase<1>(C, l);
            if (rep_ + 1 < REP_6) xcd_barrier(bar); }
            SEAM(pb + 6);
        }
        PROBE_END(6);
#endif
        PROBE_BEGIN(7);
        if (IN(pb + 7)) { for (int rep_ = 0; rep_ < REP_7; ++rep_) { FRESH_CTX(); sample_rows_phase(C, ((float*)(C.a->ws + WS_RSB))); if (rep_ + 1 < REP_7) xcd_barrier(bar); } SEAM(pb + 7); }
        PROBE_END(7);
#ifndef NO_G4
        PROBE_BEGIN(8);
        if (IN(pb + 8)) { for (int rep_ = 0; rep_ < REP_8; ++rep_) {
            FRESH_CTX();
            const int nsp = C.G >= 64 ? (C.G * 14) / 256 : 0, gG = C.G - nsp;
            if (C.bid < gG) {
            pg8::Gemm g{((bf16*)(C.a->ws + WS_XN)), ((bf16*)(C.a->ws + WS_WGU)) + (size_t)l * NGU * DM, MP, NGU, DM}; pg8::StaticOrder S; S.init(MP, NGU, gG, C.bid);
            pg8::EpiSwiGLU E{((bf16*)(C.a->ws + WS_HB)), ((float*)(C.a->ws + WS_RSB))};
            pg8::gemm_phase<pg8::EpiSwiGLU, pg8::StaticOrder, GEMM_ALIGN, GEMM_SP2>(C.lds + RING_OFF, g, S, E, C.tid);
            } else { zero_f32(C, ((float*)(C.a->ws + WS_RSA)), SEQ, C.bid - gG, nsp); copy_outs(C, l, C.bid - gG, nsp); cache_shift(C, l, C.bid - gG, nsp); }
            if (nsp == 0) { zero_f32(C, ((float*)(C.a->ws + WS_RSA)), SEQ, C.bid, C.G); copy_outs(C, l, C.bid, C.G); cache_shift(C, l, C.bid, C.G); }
            if (rep_ + 1 < REP_8) xcd_barrier(bar); }
            SEAM(pb + 8);
        }
        PROBE_END(8);
#endif
#ifndef NO_G5
        PROBE_BEGIN(9);
        if (IN(pb + 9)) { for (int rep_ = 0; rep_ < REP_9; ++rep_) {
            FRESH_CTX();
            pg8::Gemm g{((bf16*)(C.a->ws + WS_HB)), ((bf16*)(C.a->ws + WS_WDN)) + (size_t)l * DM * FF, SEQ, DM, FF}; pg8::StaticOrder S; S.init(SEQ, DM, C.G, C.bid);
            pg8::EpiResid E{(const float*)nullptr, ((bf16*)(C.a->ws + WS_XN)), ((float*)(C.a->ws + WS_RSA))};
            pg8::gemm_phase<pg8::EpiResid, pg8::StaticOrder, true, true>(C.lds + RING_OFF, g, S, E, C.tid);
            mini_phase<2>(C, l);
            if (rep_ + 1 < REP_9) xcd_barrier(bar); }
            SEAM(pb + 9);
        }
        PROBE_END(9);
#endif
        PROBE_BEGIN(10);
        if (IN(pb + 10)) { for (int rep_ = 0; rep_ < REP_10; ++rep_) {
            FRESH_CTX();
            if (l + 1 < DEPTH) sample_rows_phase(C, ((float*)(C.a->ws + WS_RSA))); else final_norm_phase(C);
            if (rep_ + 1 < REP_10) xcd_barrier(bar); }
            SEAM(pb + 10);
        }
        PROBE_END(10);
    }
    if (PROBE_CLK && blockIdx.x == 0 && wave_s == 0 && lane_now() == 0) { const unsigned long long c1 = __builtin_amdgcn_s_memtime(), r1 = __builtin_amdgcn_s_memrealtime(); const unsigned long long clk_c0 = ((unsigned long long)MISC[17] << 32) | MISC[16], clk_r0 = ((unsigned long long)MISC[19] << 32) | MISC[18]; const unsigned long long dc = (c1 - clk_c0) * 10000ull, dr = r1 - clk_r0;
        while ((__builtin_amdgcn_s_memrealtime() - r1) * dr < dc) __builtin_amdgcn_s_sleep(8); }
    if (PROBE_LO >= 0 && blockIdx.x == 0 && wave_s == 0 && lane_now() == 0) { const unsigned long long t1 = __builtin_amdgcn_s_memrealtime(); while (__builtin_amdgcn_s_memrealtime() - t1 < (unsigned long long)PROBE_AMP * probe_acc) __builtin_amdgcn_s_sleep(8); }
#undef IN
#undef SEAM
}

extern "C" void kernel_launch(void* const* d_in, const int* in_sizes, int n_in, void* d_out, int out_size, void* d_ws, size_t ws_size, hipStream_t stream) {
    static int grid = 0;
    if (grid == 0) {
        if (n_in != 23 || (size_t)out_size != O_END || ws_size < WS_END) { fprintf(stderr, "kernel_launch: unexpected problem (n_in %d, out %d, ws %zu; need ws >= %zu); nothing launched\n", n_in, out_size, ws_size, (size_t)WS_END); grid = -1; return; }
        int dev = 0, cus = 0, per_cu = 0;
        if (hipGetDevice(&dev) != hipSuccess || hipDeviceGetAttribute(&cus, hipDeviceAttributeMultiprocessorCount, dev) != hipSuccess) { grid = -1; return; }
        if (hipFuncSetAttribute((const void*)fwd, hipFuncAttributeMaxDynamicSharedMemorySize, LDS_BYTES) != hipSuccess) { fprintf(stderr, "kernel_launch: hipFuncSetAttribute failed\n"); grid = -1; return; }
        if (hipOccupancyMaxActiveBlocksPerMultiprocessor(&per_cu, (const void*)fwd, NWAVES * 64, LDS_BYTES) != hipSuccess || per_cu < 1) { fprintf(stderr, "kernel_launch: occupancy query says %d blocks per CU\n", per_cu); }
        (void)hipGetLastError();
        grid = cus;
    }
    if (grid < 0) return;
    if (hipMemsetAsync((char*)d_ws + WS_CTL, 0, CTL_ZERO_BYTES, stream) != hipSuccess) return;
    Args a{};
    for (int i = 0; i < 23; ++i) a.in[i] = (const float*)d_in[i];
    a.out = (float*)d_out; a.ws = (unsigned char*)d_ws; a.pad = 0;
#if MK_SPLIT
    for (int p = 0; p < NPH; ++p) { a.ph_lo = p; a.ph_hi = p + 1; a.use_bar = 0; hipLaunchKernelGGL(fwd, dim3(grid), dim3(NWAVES * 64), LDS_BYTES, stream, a); }
#else
    a.ph_lo = 0; a.ph_hi = NPH; a.use_bar = 1;
    hipLaunchKernelGGL(fwd, dim3(grid), dim3(NWAVES * 64), LDS_BYTES, stream, a);
#endif
    const hipError_t le = hipPeekAtLastError();
    if (le != hipSuccess) fprintf(stderr, "kernel_launch: launch failed: %s\n", hipGetErrorName(le));
}
```

```cpp
#include <hip/hip_runtime.h>
#include <cstdio>
#include <cstdint>

constexpr int DM = 2048, SEQ = 8192, NB = 128, DEPTH = 2;
constexpr int MV = SEQ + NB;
constexpr int MP = 8448;
constexpr int DI = 4096, NH = 64, HP = 64, DS = 128, NG = 8, CD = 6144, CW = 4;
constexpr int AH = 32, KVH = 8, AD = 64, WIN = 128;
constexpr int FF = 5632;
constexpr int IN_DIM = 17472;
constexpr float EPS = 1e-6f;
constexpr int UZ = 0, UXBC = 4096, UQ = 10240, UK = 12288, UV = 12800, UGS = 13312, UGA = 15360, LDU = 17408;
__host__ __device__ __forceinline__ constexpr size_t UIDX(int row, int col) { return ((size_t)(row >> 7) * (LDU / 64) + (size_t)(col >> 6)) * 8192 + (size_t)(((row & 127) << 6) + (col & 63)); }
constexpr int NU = 17664;
constexpr int KCAT = DI + DM;
constexpr int NGU = 2 * FF;

constexpr size_t O_YP = 0;
constexpr size_t O_YS = O_YP + (size_t)SEQ * DM;
constexpr size_t O_PSSM = O_YS + (size_t)NB * DM;
constexpr size_t O_PCONV = O_PSSM + (size_t)DEPTH * NH * HP * DS;
constexpr size_t O_PK = O_PCONV + (size_t)DEPTH * 3 * CD;
constexpr size_t O_PV = O_PK + (size_t)DEPTH * WIN * KVH * AD;
constexpr size_t O_SSSM = O_PV + (size_t)DEPTH * WIN * KVH * AD;
constexpr size_t O_SCONV = O_SSSM + (size_t)DEPTH * NB * NH * HP * DS;
constexpr size_t O_SK = O_SCONV + (size_t)DEPTH * NB * 3 * CD;
constexpr size_t O_SV = O_SK + (size_t)DEPTH * NB * WIN * KVH * AD;
constexpr size_t O_END = O_SV + (size_t)DEPTH * NB * WIN * KVH * AD;
static_assert(O_END == 190877696ull, "output size");

constexpr size_t al256(size_t x) { return (x + 255) & ~(size_t)255; }
constexpr size_t WS_CTL = 0, CTL_ZERO_BYTES = 1u << 20;
constexpr size_t SZ_WIN = (size_t)NU * DM * 2, SZ_WCAT = (size_t)DM * KCAT * 2, SZ_WOUT = (size_t)DM * DM * 2, SZ_WGU = (size_t)NGU * DM * 2, SZ_WDN = (size_t)DM * FF * 2;
constexpr size_t WS_WIN = 1u << 20;
constexpr size_t WS_WCAT = WS_WIN + DEPTH * SZ_WIN;
constexpr size_t WS_WOUT = WS_WCAT + DEPTH * SZ_WCAT;
constexpr size_t WS_WGU = WS_WOUT + DEPTH * SZ_WOUT;
constexpr size_t WS_WDN = WS_WGU + DEPTH * SZ_WGU;
constexpr size_t WS_X = WS_WDN + DEPTH * SZ_WDN;
constexpr size_t WS_XN = WS_X + (size_t)MP * DM * 4;
constexpr size_t WS_U = WS_XN + (size_t)MP * DM * 2;
constexpr size_t WS_DT = WS_U + (size_t)MP * LDU * 2;
constexpr size_t WS_YO = WS_DT + (size_t)MP * 64 * 4;
constexpr size_t WS_MRG = WS_YO + (size_t)MP * KCAT * 2;
constexpr size_t WS_HB = WS_MRG + (size_t)MP * DM * 2;
constexpr size_t WS_XT = WS_HB + (size_t)MP * FF * 2;
constexpr size_t WS_BRM = WS_XT + (size_t)64 * 64 * 64 * 128 * 2;
constexpr size_t WS_BT = WS_BRM + (size_t)64 * 8 * 128 * 128 * 2;
constexpr size_t WS_CRM = WS_BT + (size_t)64 * 8 * 128 * 128 * 2;
constexpr size_t WS_DTT = WS_CRM + (size_t)64 * 8 * 128 * 128 * 2;
constexpr size_t WS_ACS = WS_DTT + (size_t)64 * 64 * 128 * 4;
constexpr size_t WS_VT = WS_ACS + (size_t)64 * 64 * 128 * 4;
constexpr size_t WS_ST = WS_VT + (size_t)8 * 64 * 8192 * 2;
constexpr size_t WS_HS = WS_ST + (size_t)64 * 64 * 64 * 128 * 4;
constexpr size_t WS_MS = WS_HS + (size_t)64 * 64 * 64 * 128 * 2;
constexpr size_t WS_RSA = WS_MS + (size_t)NB * DM * 4;
constexpr size_t WS_RSB = WS_RSA + (size_t)MP * 4;
constexpr size_t WS_END = WS_RSB + (size_t)MP * 4;
static_assert(WS_WIN % 256 == 0 && WS_X % 256 == 0 && WS_U % 256 == 0 && WS_YO % 256 == 0 && WS_HB % 256 == 0 && WS_XT % 256 == 0 && WS_ST % 256 == 0, "ws alignment");
constexpr int CW_BAR = 4096;

constexpr int RING_OFF = 0, RING_BYTES = 131072;
constexpr int PC_B = 0, PC_C = 34816, PC_Y = 69632, PC_SSQ = 139264, PC_AD = 143360, PC_END = 151552;
constexpr int LDSCTL_OFF = PC_END, MISC_OFF = LDSCTL_OFF + 320;
constexpr int LDS_BYTES = 155648;
constexpr int NWAVES = 8;
#define MK_SPLIT 0
namespace pg8 {
#define PG8_LAS __attribute__((address_space(3)))
typedef unsigned short bf16_t;
typedef short bf16x8 __attribute__((ext_vector_type(8)));
typedef float f32x4 __attribute__((ext_vector_type(4)));
typedef unsigned u32x4 __attribute__((ext_vector_type(4)));
constexpr int BM = 256, BK = 64, HALF = 128, HTB = HALF * BK * 2  , STAGE_BYTES = 8 * HTB, NXCD = 8, WGM = 8;

__host__ __device__ __forceinline__ int lds_byte(int r, int c) { const int st = (r >> 4) * 2 + (c >> 5), rr = r & 15, cc = c & 31, ob = rr * 64 + cc * 2; return st * 1024 + (ob ^ (((ob >> 9) & 1) << 5)); }
__host__ __device__ __forceinline__ void stage_rc(int b, int& R, int& C) { const int st = b / 1024, sb = b % 1024, swz = sb ^ (((sb >> 9) & 1) << 5); R = (st >> 1) * 16 + swz / 64; C = (st & 1) * 32 + (swz % 64) / 2; }
__host__ __device__ __forceinline__ int perm32(int rho) { const int n = rho >> 4, i = rho & 15; return 8 * (i >> 2) + 4 * n + (i & 3); }

struct Unit { int pm, pn; };
struct Gemm { const bf16_t* A; const bf16_t* Bt; int M, N, K; };

struct StaticOrder {
    int nM, nN, nwg, G, c;
    __host__ __device__ void init(int M, int N, int G_, int c_) { nM = M / BM; nN = N / BM; nwg = nM * nN; G = G_; c = c_; }
    __host__ __device__ bool next(int i, Unit& u) const {
        const long L = (long)i * G + c; if (L >= nwg) return false;
        int wgid = (int)L; { const int q = nwg / NXCD, r = nwg % NXCD, xcd = wgid % NXCD, off = wgid / NXCD; wgid = (xcd < r ? xcd * (q + 1) : r * (q + 1) + (xcd - r) * q) + off; }
        const int nig = WGM * nN, gid = wgid / nig, fm = gid * WGM, gsz = (nM - fm) < WGM ? (nM - fm) : WGM;
        u.pm = fm + ((wgid % nig) % gsz); u.pn = (wgid % nig) / gsz; return true;
    }
    __device__ __forceinline__ void a_ready(const Unit&) const {}
    __device__ __forceinline__ void done(const Unit&) const {}
};
__device__ __forceinline__ unsigned cvt_pk_bf16(float lo, float hi) { unsigned r; asm volatile("v_cvt_pk_bf16_f32 %0, %1, %2" : "=v"(r) : "v"(lo), "v"(hi)); return r; }
__device__ __forceinline__ float bf_lo(unsigned w) { return __uint_as_float(w << 16); }
__device__ __forceinline__ float bf_hi(unsigned w) { return __uint_as_float(w & 0xffff0000u); }
__device__ __forceinline__ float sigmoidf_(float x) { return __builtin_amdgcn_rcpf(1.0f + __expf(-x)); }
constexpr int E_MV = 8320, E_LDU = 17408, E_UGS = 13312, E_UGA = 15360;
__device__ __forceinline__ size_t e_uidx(int row, int col) { return ((size_t)(row >> 7) * (E_LDU / 64) + (size_t)(col >> 6)) * 8192 + (size_t)(((row & 127) << 6) + (col & 63)); }
struct EpiU {
    static constexpr bool PERM = true, AFTER_DRAIN = false, HOOK = false, RSLDS = true; static constexpr int HOOK_T = -1;
    bf16_t* U; float* DT; const float* dtb; const float* RS;
    __device__ __forceinline__ void hook(f32x4 (&)[2][2][4][2], const Unit&, int, int, int, int) const {}
    __device__ __forceinline__ static float softplus_(float x) { return x > 20.0f ? x : log1pf(__expf(x)); }
    __device__ __forceinline__ void operator()(const f32x4 (&acc)[2][2][4][2], const Unit& u, int wr, int wc, int fr, int fq, const float (&rsv)[8]) const {
        const int row0 = u.pm * BM + wr * 64 + fr;
        auto rstd_ = [&](int q) { return rsqrtf(rsv[q] * (1.0f / 2048.0f) + 1e-6f); };
        if (u.pn == 68) {
            if (wc < 2) { const f32x4 b0 = *(const f32x4*)(dtb + wc * 32 + 8 * fq), b1 = *(const f32x4*)(dtb + wc * 32 + 8 * fq + 4);
#pragma unroll
                for (int ai = 0; ai < 2; ++ai) { if (u.pm * BM + ai * HALF >= E_MV) continue;
#pragma unroll
                    for (int m = 0; m < 4; ++m) { float* p = DT + (size_t)(row0 + ai * HALF + m * 16) * 64 + wc * 32 + 8 * fq; const float rs = rstd_(ai * 4 + m); f32x4 v0 = acc[ai][0][m][0] * rs + b0, v1 = acc[ai][0][m][1] * rs + b1;
#pragma unroll
                        for (int e = 0; e < 4; ++e) { v0[e] = softplus_(v0[e]); v1[e] = softplus_(v1[e]); }
                        *(f32x4*)p = v0; *(f32x4*)(p + 4) = v1; } }
            }
            return;
        }
        const bool sig = u.pn >= 52, zsilu = u.pn < 16;
        const int col0 = u.pn * BM + wc * 32 + 8 * fq;
#pragma unroll
        for (int ai = 0; ai < 2; ++ai) { if (u.pm * BM + ai * HALF >= E_MV) continue;
#pragma unroll
            for (int m = 0; m < 4; ++m) { const int rr = row0 + ai * HALF + m * 16; const float rs = rstd_(ai * 4 + m);
#pragma unroll
                for (int bj = 0; bj < 2; ++bj) { f32x4 v0 = acc[ai][bj][m][0] * rs, v1 = acc[ai][bj][m][1] * rs;
                    if (sig) {
#pragma unroll
                        for (int e = 0; e < 4; ++e) { v0[e] = sigmoidf_(v0[e]); v1[e] = sigmoidf_(v1[e]); } }
                    if (zsilu) {
#pragma unroll
                        for (int e = 0; e < 4; ++e) { v0[e] = v0[e] * sigmoidf_(v0[e]); v1[e] = v1[e] * sigmoidf_(v1[e]); } }
                    u32x4 w; w.x = cvt_pk_bf16(v0[0], v0[1]); w.y = cvt_pk_bf16(v0[2], v0[3]); w.z = cvt_pk_bf16(v1[0], v1[1]); w.w = cvt_pk_bf16(v1[2], v1[3]);
                    *(u32x4*)(U + e_uidx(rr, col0 + bj * HALF)) = w; } } }
    }
};
struct EpiMerge {
    static constexpr bool PERM = true, AFTER_DRAIN = false, HOOK = true, RSLDS = false; static constexpr int HOOK_T = 64;
    const bf16_t* U; bf16_t* O;
    __device__ __forceinline__ void hook(f32x4 (&acc)[2][2][4][2], const Unit& u, int wr, int wc, int fr, int fq) const {
        asm volatile("" : "+v"(fr), "+v"(fq));
        const int row0 = u.pm * BM + wr * 64 + fr, col0 = u.pn * BM + wc * 32 + 8 * fq;
#pragma unroll
        for (int ai = 0; ai < 2; ++ai) { if (u.pm * BM + ai * HALF >= E_MV) continue;
#pragma unroll
            for (int mp = 0; mp < 2; ++mp) {
                u32x4 gs[2][2], ga[2][2];
#pragma unroll
                for (int mm = 0; mm < 2; ++mm) { const int rr = row0 + ai * HALF + (2 * mp + mm) * 16;
#pragma unroll
                    for (int bj = 0; bj < 2; ++bj) { gs[mm][bj] = *(const u32x4*)(U + e_uidx(rr, E_UGS + col0 + bj * HALF)); ga[mm][bj] = *(const u32x4*)(U + e_uidx(rr, E_UGA + col0 + bj * HALF)); } }
#pragma unroll
                for (int mm = 0; mm < 2; ++mm) { const int m = 2 * mp + mm;
#pragma unroll
                    for (int bj = 0; bj < 2; ++bj) { const u32x4 s = gs[mm][bj], a = ga[mm][bj]; f32x4 r0, r1;
                        r0[0] = bf_lo(s.x) * __builtin_amdgcn_rcpf(fmaxf(bf_lo(a.x), 1e-20f)); r0[1] = bf_hi(s.x) * __builtin_amdgcn_rcpf(fmaxf(bf_hi(a.x), 1e-20f)); r0[2] = bf_lo(s.y) * __builtin_amdgcn_rcpf(fmaxf(bf_lo(a.y), 1e-20f)); r0[3] = bf_hi(s.y) * __builtin_amdgcn_rcpf(fmaxf(bf_hi(a.y), 1e-20f));
                        r1[0] = bf_lo(s.z) * __builtin_amdgcn_rcpf(fmaxf(bf_lo(a.z), 1e-20f)); r1[1] = bf_hi(s.z) * __builtin_amdgcn_rcpf(fmaxf(bf_hi(a.z), 1e-20f)); r1[2] = bf_lo(s.w) * __builtin_amdgcn_rcpf(fmaxf(bf_lo(a.w), 1e-20f)); r1[3] = bf_hi(s.w) * __builtin_amdgcn_rcpf(fmaxf(bf_hi(a.w), 1e-20f));
                        acc[ai][bj][m][0] *= r0; acc[ai][bj][m][1] *= r1; }
                    asm volatile("" : "+v"(acc[ai][0][m][0]), "+v"(acc[ai][0][m][1]), "+v"(acc[ai][1][m][0]), "+v"(acc[ai][1][m][1]) :: "memory"); } } }
    }
    __device__ __forceinline__ void operator()(const f32x4 (&acc)[2][2][4][2], const Unit& u, int wr, int wc, int fr, int fq) const {
        const int row0 = u.pm * BM + wr * 64 + fr, col0 = u.pn * BM + wc * 32 + 8 * fq;
#pragma unroll
        for (int ai = 0; ai < 2; ++ai) { if (u.pm * BM + ai * HALF >= E_MV) continue;
#pragma unroll
            for (int m = 0; m < 4; ++m) { const size_t r = (size_t)(row0 + ai * HALF + m * 16);
#pragma unroll
                for (int bj = 0; bj < 2; ++bj) { const u32x4 ga = *(const u32x4*)(U + e_uidx((int)r, E_UGA + col0 + bj * HALF));
                    const f32x4 v0 = acc[ai][bj][m][0], v1 = acc[ai][bj][m][1];
                    u32x4 w; w.x = cvt_pk_bf16(v0[0] * bf_lo(ga.x), v0[1] * bf_hi(ga.x)); w.y = cvt_pk_bf16(v0[2] * bf_lo(ga.y), v0[3] * bf_hi(ga.y));
                    w.z = cvt_pk_bf16(v1[0] * bf_lo(ga.z), v1[1] * bf_hi(ga.z)); w.w = cvt_pk_bf16(v1[2] * bf_lo(ga.w), v1[3] * bf_hi(ga.w));
                    *(u32x4*)(O + r * 2048 + col0 + bj * HALF) = w; } } }
    }
};
struct EpiResid {
    static constexpr bool PERM = true, AFTER_DRAIN = false, HOOK = false, RSLDS = false; static constexpr int HOOK_T = -1;
    const float* Xf; bf16_t* XB; float* RS;
    __device__ __forceinline__ void hook(f32x4 (&)[2][2][4][2], const Unit&, int, int, int, int) const {}
    __device__ __forceinline__ void operator()(const f32x4 (&acc)[2][2][4][2], const Unit& u, int wr, int wc, int fr, int fq) const {
        const int row0 = u.pm * BM + wr * 64 + fr, col0 = u.pn * BM + wc * 32 + 8 * fq;
#pragma unroll
        for (int ai = 0; ai < 2; ++ai) { if (u.pm * BM + ai * HALF >= E_MV) continue;
#pragma unroll
            for (int m = 0; m < 4; ++m) { const size_t ro = (size_t)(row0 + ai * HALF + m * 16) * 2048 + col0; float ss = 0.f;
#pragma unroll
                for (int bj = 0; bj < 2; ++bj) { f32x4 x0, x1;
                    if (Xf) { x0 = *(const f32x4*)(Xf + ro + bj * HALF); x1 = *(const f32x4*)(Xf + ro + bj * HALF + 4); }
                    else { const u32x4 w = *(const u32x4*)(XB + ro + bj * HALF); x0 = (f32x4){bf_lo(w.x), bf_hi(w.x), bf_lo(w.y), bf_hi(w.y)}; x1 = (f32x4){bf_lo(w.z), bf_hi(w.z), bf_lo(w.w), bf_hi(w.w)}; }
                    x0 = x0 + acc[ai][bj][m][0]; x1 = x1 + acc[ai][bj][m][1];
                    ss += ((x0[0] * x0[0] + x0[1] * x0[1]) + (x0[2] * x0[2] + x0[3] * x0[3])) + ((x1[0] * x1[0] + x1[1] * x1[1]) + (x1[2] * x1[2] + x1[3] * x1[3]));
                    u32x4 o; o.x = cvt_pk_bf16(x0[0], x0[1]); o.y = cvt_pk_bf16(x0[2], x0[3]); o.z = cvt_pk_bf16(x1[0], x1[1]); o.w = cvt_pk_bf16(x1[2], x1[3]);
                    *(u32x4*)(XB + ro + bj * HALF) = o; }
                ss += __shfl_xor(ss, 16); ss += __shfl_xor(ss, 32);
                if (fq == 0) unsafeAtomicAdd(RS + row0 + ai * HALF + m * 16, ss); } }
    }
};
struct EpiSwiGLU {
    static constexpr bool PERM = true, AFTER_DRAIN = false, HOOK = false, RSLDS = true; static constexpr int HOOK_T = -1;
    bf16_t* H; const float* RS;
    __device__ __forceinline__ void hook(f32x4 (&)[2][2][4][2], const Unit&, int, int, int, int) const {}
    __device__ __forceinline__ void operator()(const f32x4 (&acc)[2][2][4][2], const Unit& u, int wr, int wc, int fr, int fq, const float (&rsv)[8]) const {
        const int row0 = u.pm * BM + wr * 64 + fr, col0 = u.pn * 128 + wc * 16 + 4 * fq;
#pragma unroll
        for (int ai = 0; ai < 2; ++ai) { if (u.pm * BM + ai * HALF >= E_MV) continue;
#pragma unroll
            for (int m = 0; m < 4; ++m) { bf16_t* rowp = H + (size_t)(row0 + ai * HALF + m * 16) * 5632 + col0; const float rs = rsqrtf(rsv[ai * 4 + m] * (1.0f / 2048.0f) + 1e-6f);
#pragma unroll
                for (int bj = 0; bj < 2; ++bj) { const f32x4 g = acc[ai][bj][m][0] * rs, up = acc[ai][bj][m][1] * rs; float h[4];
#pragma unroll
                    for (int e = 0; e < 4; ++e) h[e] = g[e] * __builtin_amdgcn_rcpf(1.0f + __expf(-g[e])) * up[e];
                    typedef unsigned u32x2v __attribute__((ext_vector_type(2))); u32x2v w; w.x = cvt_pk_bf16(h[0], h[1]); w.y = cvt_pk_bf16(h[2], h[3]);
                    *(u32x2v*)(rowp + bj * 64) = w; } } }
    }
};
template <class Epi, class Sched, bool ALIGN_EPI = false, bool SP2 = false>
__device__ __forceinline__ void gemm_phase(PG8_LAS unsigned char* lds, const Gemm g, const Sched& S, const Epi& E, int tid_in) {
    int tid_l = tid_in; asm volatile("" : "+v"(tid_l));
    const int tid = tid_l, wid = __builtin_amdgcn_readfirstlane(tid >> 6), lane = tid & 63, wr = wid >> 2, wc = wid & 3, fr = lane & 15, fq = lane >> 4;
    const int K = g.K, nt = K / BK;
    unsigned voffA[2], voffB[2];
#pragma unroll
    for (int i = 0; i < 2; ++i) { int R, C; stage_rc(tid * 16 + i * 8192, R, C); const int Rb = Epi::PERM ? ((R & ~31) + perm32(R & 31)) : R;
        voffA[i] = (unsigned)(R * K + C) * 2u; voffB[i] = (unsigned)(Rb * K + C) * 2u; }
    const size_t kstep = (size_t)(BK * 2);
    const size_t hstep = (size_t)HALF * K * 2;
    const size_t tstep = 2 * hstep;
    const unsigned ldsw = (unsigned)wid * 1024u;
    const int aoff = lds_byte(wr * 64 + fr, fq * 8), boff = lds_byte(wc * 32 + fr, fq * 8);
#define PG8_SA(b, h) (((b) * 2 + (h)) * HTB)
#define PG8_SB(b, h) ((4 + (b) * 2 + (h)) * HTB)
#define PG8_STAGE(bufoff, gbase, voff) do { _Pragma("unroll") for (int _i = 0; _i < 2; ++_i) \
        __builtin_amdgcn_global_load_lds((const unsigned*)((const char*)(gbase) + (voff)[_i]), (PG8_LAS unsigned*)(lds + (bufoff) + ldsw + _i * 8192), 16, 0, 0); } while (0)
#define PG8_LDA(dst, b, h) do { _Pragma("unroll") for (int m = 0; m < 4; ++m) _Pragma("unroll") for (int k = 0; k < 2; ++k) dst[m][k] = *(const PG8_LAS bf16x8*)(lds + PG8_SA(b, h) + aoff + m * 2048 + k * 1024); } while (0)
#define PG8_LDB(dst, b, h) do { _Pragma("unroll") for (int n = 0; n < 2; ++n) _Pragma("unroll") for (int k = 0; k < 2; ++k) dst[n][k] = *(const PG8_LAS bf16x8*)(lds + PG8_SB(b, h) + boff + n * 2048 + k * 1024); } while (0)
#define PG8_MMA(ai, bj, At, Bt) do { __builtin_amdgcn_s_setprio(1); _Pragma("unroll") for (int m = 0; m < 4; ++m) _Pragma("unroll") for (int n = 0; n < 2; ++n) _Pragma("unroll") for (int k = 0; k < 2; ++k) \
        acc[ai][bj][m][n] = __builtin_amdgcn_mfma_f32_16x16x32_bf16(Bt[n][k], At[m][k], acc[ai][bj][m][n], 0, 0, 0); __builtin_amdgcn_s_setprio(0); } while (0)
#define PG8_WAIT_V(n) asm volatile("s_waitcnt vmcnt(" #n ")" ::: "memory")
#define PG8_WAIT_L(n) asm volatile("s_waitcnt lgkmcnt(" #n ")" ::: "memory")
#define PG8_BAR __builtin_amdgcn_s_barrier()
#define PG8_SCHED __builtin_amdgcn_sched_barrier(0)
    Unit cur, nxt; int ui = 0;
    if (!S.next(0, cur)) return;
    f32x4 acc[2][2][4][2];
#pragma unroll
    for (int a = 0; a < 2; ++a)
#pragma unroll
        for (int b = 0; b < 2; ++b)
#pragma unroll
            for (int m = 0; m < 4; ++m)
#pragma unroll
                for (int n = 0; n < 2; ++n) acc[a][b][m][n] = (f32x4){0.f, 0.f, 0.f, 0.f};
    bf16x8 At[4][2], B0[2][2], B1[2][2];
    const char* cA = (const char*)g.A + (size_t)cur.pm * tstep; const char* cB = (const char*)g.Bt + (size_t)cur.pn * tstep;
    S.a_ready(cur);
#define PG8_RSDMA(pm_, par_) __builtin_amdgcn_global_load_lds((const unsigned*)(E.RS + (pm_) * BM + wid * 64 + ((fq << 4) | fr)), (PG8_LAS unsigned*)(lds + 131072 + (par_) * 1024 + wid * 256), 4, 0, 0)
    if constexpr (Epi::RSLDS) { if (wid < 4) PG8_RSDMA(cur.pm, 0); }
    if constexpr (SP2) {
        PG8_STAGE(PG8_SB(0, 0), cB, voffB); PG8_STAGE(PG8_SB(0, 1), cB + hstep, voffB); PG8_STAGE(PG8_SA(0, 0), cA, voffA); PG8_STAGE(PG8_SA(0, 1), cA + hstep, voffA);
        if (wr == 1) PG8_BAR;
        PG8_WAIT_V(2); PG8_BAR;
        PG8_STAGE(PG8_SB(1, 0), cB + kstep, voffB); PG8_STAGE(PG8_SA(1, 0), cA + kstep, voffA); PG8_STAGE(PG8_SB(1, 1), cB + hstep + kstep, voffB);
        PG8_WAIT_V(6); PG8_BAR;
    } else {
        PG8_STAGE(PG8_SB(0, 0), cB, voffB); PG8_STAGE(PG8_SA(0, 0), cA, voffA); PG8_STAGE(PG8_SB(0, 1), cB + hstep, voffB); PG8_STAGE(PG8_SA(0, 1), cA + hstep, voffA);
        if (wr == 1) PG8_BAR;
        PG8_WAIT_V(4); PG8_BAR;
        PG8_STAGE(PG8_SB(1, 0), cB + kstep, voffB); PG8_STAGE(PG8_SA(1, 0), cA + kstep, voffA); PG8_STAGE(PG8_SB(1, 1), cB + hstep + kstep, voffB);
        PG8_WAIT_V(6); PG8_BAR;
    }
    for (;;) {
        const bool has_next = S.next(ui + 1, nxt);
        const char* nA = has_next ? (const char*)g.A + (size_t)nxt.pm * tstep : cA; const char* nB = has_next ? (const char*)g.Bt + (size_t)nxt.pn * tstep : cB;
        for (int t = 0; t < nt; t += 2) {
            const bool last = (t == nt - 2);
            const char* a1 = cA + (size_t)(t + 1) * kstep;
            const char* a2 = last ? nA : cA + (size_t)(t + 2) * kstep; const char* b2 = last ? nB : cB + (size_t)(t + 2) * kstep;
            const char* a3 = a2 + kstep; const char* b3 = b2 + kstep;
            if (last && has_next) S.a_ready(nxt);
            if constexpr (Epi::HOOK) { if (t == Epi::HOOK_T) E.hook(acc, cur, wr, wc, fr, fq); }
            if constexpr (SP2) {
            PG8_LDB(B0, 0, 0); PG8_LDB(B1, 0, 1); PG8_SCHED; PG8_LDA(At, 0, 0); PG8_STAGE(PG8_SA(1, 1), a1 + hstep, voffA);
            PG8_WAIT_V(8); PG8_WAIT_L(0); PG8_BAR; PG8_MMA(0, 0, At, B0); PG8_MMA(0, 1, At, B1); PG8_BAR; PG8_SCHED;
            PG8_LDA(At, 0, 1); PG8_STAGE(PG8_SB(0, 0), b2, voffB); PG8_STAGE(PG8_SB(0, 1), b2 + hstep, voffB); PG8_STAGE(PG8_SA(0, 0), a2, voffA);
            PG8_WAIT_V(8); PG8_WAIT_L(0); PG8_BAR; PG8_MMA(1, 0, At, B0); PG8_MMA(1, 1, At, B1); PG8_BAR; PG8_SCHED;
            PG8_LDB(B0, 1, 0); PG8_LDB(B1, 1, 1); PG8_SCHED; PG8_LDA(At, 1, 0); PG8_STAGE(PG8_SA(0, 1), a2 + hstep, voffA);
            PG8_WAIT_V(8); PG8_WAIT_L(0); PG8_BAR; PG8_MMA(0, 0, At, B0); PG8_MMA(0, 1, At, B1); PG8_BAR; PG8_SCHED;
            PG8_LDA(At, 1, 1); PG8_STAGE(PG8_SB(1, 0), b3, voffB); PG8_STAGE(PG8_SB(1, 1), b3 + hstep, voffB); PG8_STAGE(PG8_SA(1, 0), a3, voffA);
            PG8_WAIT_V(8); PG8_WAIT_L(0); PG8_BAR; PG8_MMA(1, 0, At, B0); PG8_MMA(1, 1, At, B1); PG8_BAR; PG8_SCHED;
            } else {
            PG8_LDB(B0, 0, 0); PG8_SCHED; PG8_LDA(At, 0, 0); PG8_STAGE(PG8_SA(1, 1), a1 + hstep, voffA);
            PG8_WAIT_L(8); PG8_BAR; PG8_WAIT_L(0); PG8_MMA(0, 0, At, B0); PG8_BAR; PG8_SCHED;
            PG8_LDB(B1, 0, 1); PG8_STAGE(PG8_SB(0, 0), b2, voffB);
            PG8_BAR; PG8_WAIT_L(0); PG8_MMA(0, 1, At, B1); PG8_BAR;
            PG8_LDA(At, 0, 1); PG8_STAGE(PG8_SA(0, 0), a2, voffA);
            PG8_BAR; PG8_WAIT_L(0); PG8_MMA(1, 0, At, B0); PG8_BAR; PG8_SCHED;
            PG8_STAGE(PG8_SB(0, 1), b2 + hstep, voffB);
            PG8_WAIT_V(6); PG8_BAR; PG8_MMA(1, 1, At, B1); PG8_BAR;
            PG8_LDB(B0, 1, 0); PG8_SCHED; PG8_LDA(At, 1, 0); PG8_STAGE(PG8_SA(0, 1), a2 + hstep, voffA);
            PG8_WAIT_L(8); PG8_BAR; PG8_WAIT_L(0); PG8_MMA(0, 0, At, B0); PG8_BAR; PG8_SCHED;
            PG8_LDB(B1, 1, 1); PG8_STAGE(PG8_SB(1, 0), b3, voffB);
            PG8_BAR; PG8_WAIT_L(0); PG8_MMA(0, 1, At, B1); PG8_BAR;
            PG8_LDA(At, 1, 1); PG8_STAGE(PG8_SA(1, 0), a3, voffA);
            PG8_BAR; PG8_WAIT_L(0); PG8_MMA(1, 0, At, B0); PG8_BAR; PG8_SCHED;
            PG8_STAGE(PG8_SB(1, 1), b3 + hstep, voffB);
            PG8_WAIT_V(6); PG8_BAR; PG8_MMA(1, 1, At, B1); PG8_BAR;
            }
        }
        if constexpr (ALIGN_EPI) { if (wr == 0) PG8_BAR; }
        if constexpr (!Epi::AFTER_DRAIN) {
            if constexpr (Epi::RSLDS) { float rsv[8]; const PG8_LAS float* rsl = (const PG8_LAS float*)(lds + 131072 + (ui & 1) * 1024) + wr * 64 + fr;
#pragma unroll
                for (int q = 0; q < 8; ++q) rsv[q] = rsl[(q >> 2) * HALF + (q & 3) * 16];
                asm volatile("s_waitcnt lgkmcnt(0)" : "+v"(rsv[0]), "+v"(rsv[1]), "+v"(rsv[2]), "+v"(rsv[3]), "+v"(rsv[4]), "+v"(rsv[5]), "+v"(rsv[6]), "+v"(rsv[7]) :: "memory");
                if (has_next && wid < 4) PG8_RSDMA(nxt.pm, (ui + 1) & 1);
                E(acc, cur, wr, wc, fr, fq, rsv);
            } else E(acc, cur, wr, wc, fr, fq);
            S.done(cur); }
        if (!has_next) break;
#pragma unroll
        for (int a = 0; a < 2; ++a)
#pragma unroll
            for (int b = 0; b < 2; ++b)
#pragma unroll
                for (int m = 0; m < 4; ++m)
#pragma unroll
                    for (int n = 0; n < 2; ++n) acc[a][b][m][n] = (f32x4){0.f, 0.f, 0.f, 0.f};
        cur = nxt; cA = nA; cB = nB; ++ui;
        if constexpr (ALIGN_EPI) { if (wr == 1) PG8_BAR; }
    }
    PG8_WAIT_V(0);
    if constexpr (!ALIGN_EPI) { if (wr == 0) PG8_BAR; }
    PG8_BAR;
    if constexpr (Epi::AFTER_DRAIN) { E.fused(acc, cur, wr, wc, fr, fq, lds, wid, lane); S.done(cur); }
#undef PG8_RSDMA
#undef PG8_SA
#undef PG8_SB
#undef PG8_STAGE
#undef PG8_LDA
#undef PG8_LDB
#undef PG8_MMA
#undef PG8_WAIT_V
#undef PG8_WAIT_L
#undef PG8_BAR
#undef PG8_SCHED
}
}
#define GAS __attribute__((address_space(1)))
#define LAS __attribute__((address_space(3)))
typedef unsigned short bf16;
typedef unsigned v4u __attribute__((ext_vector_type(4)));
typedef float f32x4 __attribute__((ext_vector_type(4)));
typedef short bf16x8 __attribute__((ext_vector_type(8)));
typedef GAS unsigned gu32;
typedef GAS unsigned long long gu64;
#define RLX_AGENT __ATOMIC_RELAXED, __HIP_MEMORY_SCOPE_AGENT
#define LDS_WAIT() asm volatile("s_waitcnt lgkmcnt(0)" ::: "memory")
#define VM_WAIT() asm volatile("s_waitcnt vmcnt(0)" ::: "memory")
__device__ __forceinline__ unsigned long long rt() { return __builtin_amdgcn_s_memrealtime(); }
__device__ __forceinline__ unsigned f2bf(float f) { unsigned u = __builtin_bit_cast(unsigned, f); return (u + 0x7fffu + ((u >> 16) & 1u)) >> 16; }
__device__ __forceinline__ unsigned pk2(float lo, float hi) { return f2bf(lo) | (f2bf(hi) << 16); }

#define XB_TMO      128
#define XB_XCNT(j)  (256  + 64 * (j))
#define XB_XSUB(j)  (1280 + 64 * (j))
#define XB_XGEN(j)  (2304 + 64 * (j))
#define XB_TOP      3328
#define XB_TOPGEN   3392
#define XCD_BAR_WORDS 3456
#define XB_SPIN_CAP (1u << 18)

__device__ __forceinline__ unsigned xb_ld(unsigned* p)              { return __hip_atomic_load(p, __ATOMIC_RELAXED, __HIP_MEMORY_SCOPE_AGENT); }
__device__ __forceinline__ unsigned xb_add(unsigned* p, unsigned v) { return __hip_atomic_fetch_add(p, v, __ATOMIC_RELAXED, __HIP_MEMORY_SCOPE_AGENT); }
__device__ __forceinline__ unsigned xb_xcc_id() { return (unsigned)__builtin_amdgcn_s_getreg((3 << 11) | 20) & 0xFu; }
#define XB_SPIN(cond, bar) do { unsigned _sp = 0; while (cond) { __builtin_amdgcn_s_sleep(1); \
    if ((++_sp & 255u) == 0u) { if (xb_ld(&(bar)[XB_TMO])) break; if (_sp > XB_SPIN_CAP) { atomicAdd(&(bar)[XB_TMO], 1u); break; } } } } while (0)

struct XcdBarrier {
    unsigned* bar; unsigned x;
    volatile LAS unsigned* st;
};

__device__ __forceinline__ XcdBarrier xcd_barrier_post(unsigned* bar, volatile LAS unsigned* st) {
    XcdBarrier b; b.bar = bar; b.x = xb_xcc_id(); b.st = st;
    if (threadIdx.x == 0) (void)xb_add(&bar[XB_XCNT(b.x)], 1u);
    return b;
}
__device__ __forceinline__ void xcd_barrier_complete(unsigned* bar, unsigned x, unsigned& nloc, unsigned& nx) {
    const unsigned G = gridDim.x * gridDim.y * gridDim.z;
    unsigned sum, cnt, mine, sp = 0u;
    for (;;) {
        sum = 0u; cnt = 0u; mine = 0u;
#pragma unroll
        for (unsigned j = 0; j < 16; ++j) { const unsigned c = xb_ld(&bar[XB_XCNT(j)]); sum += c; cnt += (c > 0u) ? 1u : 0u; mine = (j == x) ? c : mine; }
        if (sum == G) break;
        __builtin_amdgcn_s_sleep(1);
        if ((++sp & 255u) == 0u) { if (xb_ld(&bar[XB_TMO])) break; if (sp > XB_SPIN_CAP) { atomicAdd(&bar[XB_TMO], 1u); break; } }
    }
    nloc = mine > 0u ? mine : 1u; nx = cnt > 0u ? cnt : 1u;
}

__device__ __forceinline__ void xcd_barrier(const XcdBarrier& b) {
    asm volatile("s_waitcnt vmcnt(0)" ::: "memory");
    __syncthreads();
    if (threadIdx.x == 0) {
        unsigned* bar = b.bar;
        __builtin_amdgcn_s_waitcnt(0);
        unsigned nloc = b.st[0], nx = b.st[1];
        if (nloc == 0u) { xcd_barrier_complete(bar, b.x, nloc, nx); b.st[0] = nloc; b.st[1] = nx; }
        const unsigned old = xb_add(&bar[XB_XSUB(b.x)], 1u);
        const unsigned gen = old / nloc;
        if (old + 1u == (gen + 1u) * nloc) {
            __builtin_amdgcn_fence(__ATOMIC_RELEASE, "agent");
            asm volatile("s_waitcnt vmcnt(0)" ::: "memory");
            const unsigned og = xb_add(&bar[XB_TOP], 1u);
            const unsigned tg = og / nx;
            if (og + 1u == (tg + 1u) * nx) xb_add(&bar[XB_TOPGEN], 1u);
            else XB_SPIN(xb_ld(&bar[XB_TOPGEN]) == tg, bar);
            __builtin_amdgcn_fence(__ATOMIC_ACQUIRE, "agent");
            xb_add(&bar[XB_XGEN(b.x)], 1u);
            asm volatile("s_waitcnt vmcnt(0)" ::: "memory");
        } else {
            XB_SPIN(xb_ld(&bar[XB_XGEN(b.x)]) == gen, bar);
            __builtin_amdgcn_fence(__ATOMIC_ACQUIRE, "agent");
            asm volatile("s_waitcnt vmcnt(0)" ::: "memory");
        }
    }
    __syncthreads();
}
typedef float f32x16 __attribute__((ext_vector_type(16)));
typedef unsigned u32x2 __attribute__((ext_vector_type(2)));
__device__ __forceinline__ float bf2f(bf16 v) { return __uint_as_float(((unsigned)v) << 16); }
__device__ __forceinline__ float bflo(unsigned w) { return __uint_as_float(w << 16); }
__device__ __forceinline__ float bfhi(unsigned w) { return __uint_as_float(w & 0xffff0000u); }
__device__ __forceinline__ float wave_sum(float v) {
#pragma unroll
    for (int o = 1; o < 64; o <<= 1) v += __shfl_xor(v, o);
    return v;
}
__device__ __forceinline__ float wave_max(float v) {
#pragma unroll
    for (int o = 1; o < 64; o <<= 1) v = fmaxf(v, __shfl_xor(v, o));
    return v;
}
__device__ __forceinline__ float siluf_(float x) { return x * __builtin_amdgcn_rcpf(1.0f + __expf(-x)); }
__device__ __forceinline__ float softplusf_(float x) { return x > 20.0f ? x : log1pf(__expf(x)); }

struct Args { const float* in[23]; float* out; unsigned char* ws; int ph_lo, ph_hi, use_bar, pad; };
typedef const __attribute__((address_space(4))) Args* KArgs;
struct Ctx { LAS unsigned char* lds; int tid, lane, wave, G, bid; KArgs a; };

__device__ __forceinline__ int lane_now() { int t; asm volatile("v_mbcnt_lo_u32_b32 %0, -1, 0\n\tv_mbcnt_hi_u32_b32 %0, -1, %0" : "=v"(t)); return t; }
struct TItem { const float* sp; const float* gn; bf16* WT; int ldn, rowl, K, k0, R0; };
__device__ __forceinline__ void titem_load(const TItem& t, f32x4 (&v)[16], int) {
    const int kk = lane_now() >> 4;
    if (t.sp) {
#pragma unroll
        for (int i = 0; i < 16; ++i) v[i] = __builtin_nontemporal_load((const GAS f32x4*)(t.sp + (size_t)(t.k0 + 16 * kk + i) * t.ldn));
        if (t.gn) { const GAS f32x4* gp = (const GAS f32x4*)(t.gn + t.k0 + 16 * kk);
#pragma unroll
            for (int q = 0; q < 4; ++q) { const f32x4 g = gp[q]; v[4 * q] = v[4 * q] * g.x; v[4 * q + 1] = v[4 * q + 1] * g.y; v[4 * q + 2] = v[4 * q + 2] * g.z; v[4 * q + 3] = v[4 * q + 3] * g.w; } }
    } else {
#pragma unroll
        for (int i = 0; i < 16; ++i) { float z0 = 0.f; asm volatile("" : "+v"(z0)); v[i] = (f32x4){z0, z0, z0, z0}; }
    }
}
__device__ __forceinline__ void titem_store(const TItem& t, const f32x4 (&v)[16], LAS unsigned short* T, int) {
    const int lane = lane_now(), kk = lane >> 4;
    LAS unsigned char* Tb = (LAS unsigned char*)T;
#pragma unroll
    for (int j = 0; j < 4; ++j) { const int n = t.rowl + j, sw = (n >> 2) & 7; v4u lo, hi;
        lo.x = pg8::cvt_pk_bf16(v[0][j], v[1][j]); lo.y = pg8::cvt_pk_bf16(v[2][j], v[3][j]); lo.z = pg8::cvt_pk_bf16(v[4][j], v[5][j]); lo.w = pg8::cvt_pk_bf16(v[6][j], v[7][j]);
        hi.x = pg8::cvt_pk_bf16(v[8][j], v[9][j]); hi.y = pg8::cvt_pk_bf16(v[10][j], v[11][j]); hi.z = pg8::cvt_pk_bf16(v[12][j], v[13][j]); hi.w = pg8::cvt_pk_bf16(v[14][j], v[15][j]);
        *(LAS v4u*)(Tb + n * 128 + (((2 * kk) ^ sw) << 4)) = lo; *(LAS v4u*)(Tb + n * 128 + (((2 * kk + 1) ^ sw) << 4)) = hi; }
    LDS_WAIT(); asm volatile("" ::: "memory");
    const int ch = lane & 7, nr = lane >> 3;
#pragma unroll
    for (int it = 0; it < 8; ++it) { const int n = nr + 8 * it;
        const v4u o = *(const LAS v4u*)(Tb + n * 128 + ((ch ^ ((n >> 2) & 7)) << 4));
        *(GAS v4u*)(t.WT + (size_t)(t.R0 + n) * t.K + t.k0 + 8 * ch) = o; }
    LDS_WAIT(); asm volatile("" ::: "memory");
}
constexpr int IT_IN = (DM / 64) * (NU / 64), IT_CAT = (KCAT / 64) * (DM / 64), IT_OUT = (DM / 64) * (DM / 64), IT_GU = (DM / 64) * (NGU / 64), IT_DN = (FF / 64) * (DM / 64);
constexpr int IT_LAYER = IT_IN + IT_CAT + IT_OUT + IT_GU + IT_DN;
__device__ __forceinline__ TItem titem_decode(const Ctx& C, int it) {
    const int c4 = lane_now() & 15, l = it / IT_LAYER; int q = it % IT_LAYER; TItem t;
    if (q < IT_IN) { const int nblk = NU / 64, kb = q / nblk, nb = q % nblk, R = 64 * nb + 4 * c4;
        const int col = R < 10240 ? R : (R < 17408 ? R + 64 : (R < 17472 ? 10240 + (R - 17408) : -1));
        t.sp = col >= 0 ? (C.a->in[7]) + (size_t)l * DM * IN_DIM + col : nullptr; t.gn = (C.a->in[6]) + (size_t)l * DM; t.ldn = IN_DIM; t.rowl = 4 * c4; t.K = DM; t.WT = ((bf16*)(C.a->ws + WS_WIN)) + (size_t)l * NU * DM; t.k0 = 64 * kb; t.R0 = 64 * nb; return t; }
    q -= IT_IN;
    if (q < IT_CAT) { const int nblk = DM / 64, kb = q / nblk, nb = q % nblk, R = 64 * nb + 4 * c4, k0 = 64 * kb;
        t.sp = k0 < DI ? (C.a->in[14]) + (size_t)l * DI * DM + R : (C.a->in[15]) + (size_t)l * DM * DM + R - (size_t)DI * DM;
        t.gn = nullptr; t.ldn = DM; t.rowl = 4 * c4; t.K = KCAT; t.WT = ((bf16*)(C.a->ws + WS_WCAT)) + (size_t)l * DM * KCAT; t.k0 = k0; t.R0 = 64 * nb; return t; }
    q -= IT_CAT;
    if (q < IT_OUT) { const int nblk = DM / 64, kb = q / nblk, nb = q % nblk, R = 64 * nb + 4 * c4;
        t.sp = (C.a->in[17]) + (size_t)l * DM * DM + R; t.gn = nullptr; t.ldn = DM; t.rowl = 4 * c4; t.K = DM; t.WT = ((bf16*)(C.a->ws + WS_WOUT)) + (size_t)l * DM * DM; t.k0 = 64 * kb; t.R0 = 64 * nb; return t; }
    q -= IT_OUT;
    if (q < IT_GU) { const int nblk = NGU / 64, kb = q / nblk, nb = q % nblk;
        const int up = c4 >> 3, cg = c4 & 7;
        t.sp = (up ? (C.a->in[20]) : (C.a->in[19])) + (size_t)l * DM * FF + 32 * nb + 4 * cg; t.gn = (C.a->in[18]) + (size_t)l * DM; t.ldn = FF; t.rowl = 8 * cg + 4 * up; t.K = DM; t.WT = ((bf16*)(C.a->ws + WS_WGU)) + (size_t)l * NGU * DM; t.k0 = 64 * kb; t.R0 = 64 * nb; return t; }
    q -= IT_GU;
    { const int nblk = DM / 64, kb = q / nblk, nb = q % nblk, R = 64 * nb + 4 * c4;
        t.sp = (C.a->in[21]) + (size_t)l * FF * DM + R; t.gn = nullptr; t.ldn = DM; t.rowl = 4 * c4; t.K = FF; t.WT = ((bf16*)(C.a->ws + WS_WDN)) + (size_t)l * DM * FF; t.k0 = 64 * kb; t.R0 = 64 * nb; return t; }
}
__device__ __forceinline__ void p0_weights(const Ctx& C, int it_lo, int it_hi, int gw, int NGW) {
    LAS unsigned short* T = (LAS unsigned short*)(C.lds + RING_OFF + C.wave * 16384);
    int it = it_lo + gw; if (it >= it_hi) return;
    TItem cur = titem_decode(C, it); f32x4 va[16], vb[16];
    titem_load(cur, va, C.lane);
    for (;;) {
        int nit = it + NGW; TItem nxt = cur; const bool hn = nit < it_hi;
        if (hn) { nxt = titem_decode(C, nit); titem_load(nxt, vb, C.lane); }
        titem_store(cur, va, T, C.lane);
        if (!hn) break;
        it = nit + NGW; cur = nxt; const bool hn2 = it < it_hi;
        if (hn2) { cur = titem_decode(C, it); titem_load(cur, va, C.lane); }
        titem_store(nxt, vb, T, C.lane);
        if (!hn2) break;
    }
}
__device__ __forceinline__ void norm_row(const float* src, const float* gain, float* xcopy, bf16* xb, float* rs, float* fdst, int lane) {
    const GAS f32x4* xr = (const GAS f32x4*)src + lane;
    f32x4 v[8]; float s = 0.f;
#pragma unroll
    for (int j = 0; j < 8; ++j) { v[j] = xr[64 * j]; s += (v[j].x * v[j].x + v[j].y * v[j].y) + (v[j].z * v[j].z + v[j].w * v[j].w); }
    s = wave_sum(s);
    if (rs && lane == 0) *rs = s;
    if (xcopy) { GAS f32x4* xc = (GAS f32x4*)xcopy + lane;
#pragma unroll
        for (int j = 0; j < 8; ++j) xc[64 * j] = v[j]; }
    if (xb) {
#pragma unroll
        for (int j = 0; j < 8; ++j) { u32x2 w; w.x = pk2(v[j].x, v[j].y); w.y = pk2(v[j].z, v[j].w); *((GAS u32x2*)xb + lane + 64 * j) = w; } }
    if (fdst) { const float rstd = rsqrtf(s * (1.0f / DM) + EPS); const GAS f32x4* gr = (const GAS f32x4*)gain + lane;
#pragma unroll
        for (int j = 0; j < 8; ++j) { const f32x4 g = gr[64 * j]; f32x4 o = v[j] * rstd; o = o * g; *((GAS f32x4*)fdst + lane + 64 * j) = o; } }
}
__device__ __forceinline__ void p0_xinit(const Ctx& C) {
    const int gw = C.bid * NWAVES + C.wave, NGW = C.G * NWAVES;
    for (int m = gw; m < MV; m += NGW) { const float* src = m < SEQ ? (C.a->in[0]) + (size_t)m * DM : (C.a->in[1]) + (size_t)(m - SEQ) * DM;
        norm_row(src, nullptr, m < SEQ ? nullptr : ((float*)(C.a->ws + WS_X)) + (size_t)m * DM, ((bf16*)(C.a->ws + WS_XN)) + (size_t)m * DM, ((float*)(C.a->ws + WS_RSA)) + m, nullptr, C.lane); }
}
__device__ __forceinline__ void sample_rows_phase(const Ctx& C, float* RS) {
    const int gw = C.bid * NWAVES + C.wave, NGW = C.G * NWAVES;
    for (int m = SEQ + gw; m < MV; m += NGW) norm_row(((float*)(C.a->ws + WS_X)) + (size_t)m * DM, nullptr, nullptr, ((bf16*)(C.a->ws + WS_XN)) + (size_t)m * DM, RS + m, nullptr, C.lane);
}
__device__ __forceinline__ void final_norm_phase(const Ctx& C) {
    const int gw = C.bid * NWAVES + C.wave, NGW = C.G * NWAVES, lane = C.lane;
    for (int m = gw; m < MV; m += NGW) {
        if (m >= SEQ) { norm_row(((float*)(C.a->ws + WS_X)) + (size_t)m * DM, (C.a->in[22]), nullptr, nullptr, nullptr, (C.a->out) + O_YP + (size_t)m * DM, lane); continue; }
        const GAS v4u* xr = (const GAS v4u*)(((bf16*)(C.a->ws + WS_XN)) + (size_t)m * DM) + lane; v4u w[4]; float s = 0.f;
#pragma unroll
        for (int j = 0; j < 4; ++j) { w[j] = xr[64 * j]; const float a0 = bflo(w[j].x), a1 = bfhi(w[j].x), a2 = bflo(w[j].y), a3 = bfhi(w[j].y), a4 = bflo(w[j].z), a5 = bfhi(w[j].z), a6 = bflo(w[j].w), a7 = bfhi(w[j].w);
            s += ((a0 * a0 + a1 * a1) + (a2 * a2 + a3 * a3)) + ((a4 * a4 + a5 * a5) + (a6 * a6 + a7 * a7)); }
        const float rstd = rsqrtf(wave_sum(s) * (1.0f / DM) + EPS);
        const GAS f32x4* gr = (const GAS f32x4*)(C.a->in[22]) + 2 * lane; GAS f32x4* op = (GAS f32x4*)((C.a->out) + O_YP + (size_t)m * DM) + 2 * lane;
#pragma unroll
        for (int j = 0; j < 4; ++j) { const f32x4 g0 = gr[128 * j], g1 = gr[128 * j + 1];
            op[128 * j] = (f32x4){bflo(w[j].x) * rstd * g0.x, bfhi(w[j].x) * rstd * g0.y, bflo(w[j].y) * rstd * g0.z, bfhi(w[j].y) * rstd * g0.w};
            op[128 * j + 1] = (f32x4){bflo(w[j].z) * rstd * g1.x, bfhi(w[j].z) * rstd * g1.y, bflo(w[j].w) * rstd * g1.z, bfhi(w[j].w) * rstd * g1.w}; }
    }
}
__device__ __forceinline__ void zero_f32(const Ctx& C, float* p, int n, int vb, int nvb) { float z0 = 0.f; asm volatile("" : "+v"(z0)); for (int i = vb * 512 + C.tid; i < n; i += nvb * 512) p[i] = z0; }

__device__ __forceinline__ void sample_ssd_wave_unit(const Ctx& C, int l, int b, int g, LAS float* wsc) {
    const int lane = lane_now();
    const int row = SEQ + b, n4 = lane & 31, prh = lane >> 5;
    LAS float* xs = wsc; LAS float* Bs = wsc + 512; LAS float* ys = wsc + 768;
    const float* cw = (C.a->in[8]) + (size_t)l * CW * CD; const float* cb = (C.a->in[9]) + (size_t)l * CD;
    const float* sc = (C.a->in[3]) + ((size_t)l * NB + b) * 3 * CD; const bf16* U = ((bf16*)(C.a->ws + WS_U));
    { const int ch = g * 512 + 8 * lane; const v4u un = *(const GAS v4u*)(U + UIDX(row, UXBC + ch)); const float nv[8] = {bflo(un.x), bfhi(un.x), bflo(un.y), bfhi(un.y), bflo(un.z), bfhi(un.z), bflo(un.w), bfhi(un.w)};
#pragma unroll
      for (int q = 0; q < 2; ++q) { const f32x4 bb = *(const GAS f32x4*)(cb + ch + 4 * q), w0 = *(const GAS f32x4*)(cw + ch + 4 * q), w1 = *(const GAS f32x4*)(cw + CD + ch + 4 * q), w2 = *(const GAS f32x4*)(cw + 2 * CD + ch + 4 * q), w3 = *(const GAS f32x4*)(cw + 3 * CD + ch + 4 * q);
          const f32x4 s0 = *(const GAS f32x4*)(sc + ch + 4 * q), s1 = *(const GAS f32x4*)(sc + CD + ch + 4 * q), s2 = *(const GAS f32x4*)(sc + 2 * CD + ch + 4 * q);
          f32x4 o;
#pragma unroll
          for (int e = 0; e < 4; ++e) o[e] = siluf_(bb[e] + w0[e] * s0[e] + w1[e] * s1[e] + w2[e] * s2[e] + w3[e] * nv[4 * q + e]);
          *(LAS f32x4*)(xs + 8 * lane + 4 * q) = o; } }
    { const int ch = (lane < 32 ? DI + g * 128 : DI + 1024 + g * 128 - 128) + 4 * lane;
      const u32x2 un = *(const GAS u32x2*)(U + UIDX(row, UXBC + ch)); const float nv[4] = {bflo(un.x), bfhi(un.x), bflo(un.y), bfhi(un.y)};
      const f32x4 bb = *(const GAS f32x4*)(cb + ch), w0 = *(const GAS f32x4*)(cw + ch), w1 = *(const GAS f32x4*)(cw + CD + ch), w2 = *(const GAS f32x4*)(cw + 2 * CD + ch), w3 = *(const GAS f32x4*)(cw + 3 * CD + ch);
      const f32x4 s0 = *(const GAS f32x4*)(sc + ch), s1 = *(const GAS f32x4*)(sc + CD + ch), s2 = *(const GAS f32x4*)(sc + 2 * CD + ch);
      f32x4 o;
#pragma unroll
      for (int e = 0; e < 4; ++e) o[e] = siluf_(bb[e] + w0[e] * s0[e] + w1[e] * s1[e] + w2[e] * s2[e] + w3[e] * nv[e]);
      *(LAS f32x4*)(Bs + 4 * lane) = o; }
    LDS_WAIT(); asm volatile("" ::: "memory");
    const f32x4 Bv = *((const LAS f32x4*)Bs + n4), Cv = *((const LAS f32x4*)(Bs + 128) + n4);
    const size_t sbase = (((size_t)l * NB + b) * NH + 8 * g) * HP * DS;
    for (int j = 0; j < 8; ++j) { const int h = 8 * g + j;
        const GAS f32x4* sp = (const GAS f32x4*)((C.a->in[2]) + sbase + (size_t)j * HP * DS + (size_t)prh * DS) + n4;
        GAS f32x4* op = (GAS f32x4*)((C.a->out) + O_SSSM + sbase + (size_t)j * HP * DS + (size_t)prh * DS) + n4;
        f32x4 hv[32];
#pragma unroll
        for (int i = 0; i < 32; ++i) hv[i] = __builtin_nontemporal_load(sp + (size_t)i * (2 * DS / 4));
        const float dt = ((float*)(C.a->ws + WS_DT))[(size_t)row * 64 + h], dA = __expf(-__expf((C.a->in[11])[l * NH + h]) * dt), Dh = (C.a->in[12])[l * NH + h];
#pragma unroll
        for (int i = 0; i < 32; ++i) { const int p = prh + 2 * i; const float xv = xs[j * 64 + p], dtx = dt * xv; const f32x4 h0 = hv[i];
            f32x4 hn; hn.x = dA * h0.x + dtx * Bv.x; hn.y = dA * h0.y + dtx * Bv.y; hn.z = dA * h0.z + dtx * Bv.z; hn.w = dA * h0.w + dtx * Bv.w;
            __builtin_nontemporal_store(hn, op + (size_t)i * (2 * DS / 4));
            float yp = (hn.x * Cv.x + hn.y * Cv.y) + (hn.z * Cv.z + hn.w * Cv.w);
#pragma unroll
            for (int o = 1; o < 32; o <<= 1) yp += __shfl_xor(yp, o);
            if (n4 == 0) ys[j * 64 + p] = yp + Dh * xv; }
    }
    LDS_WAIT(); asm volatile("" ::: "memory");
    { const int ch = g * 512 + 8 * lane; const v4u zw = *(const GAS v4u*)(U + UIDX(row, UZ + ch)); const f32x4 y0 = *(const LAS f32x4*)(ys + 8 * lane), y1 = *(const LAS f32x4*)(ys + 8 * lane + 4);
      float gv[8] = {y0.x * bflo(zw.x), y0.y * bfhi(zw.x), y0.z * bflo(zw.y), y0.w * bfhi(zw.y), y1.x * bflo(zw.z), y1.y * bfhi(zw.z), y1.z * bflo(zw.w), y1.w * bfhi(zw.w)};
      float ss = 0.f;
#pragma unroll
      for (int e = 0; e < 8; ++e) ss += gv[e] * gv[e];
      const float rstd = rsqrtf(wave_sum(ss) * (1.0f / 512.0f) + EPS);
      const f32x4 n0 = *(const GAS f32x4*)((C.a->in[13]) + (size_t)l * DI + ch), n1 = *(const GAS f32x4*)((C.a->in[13]) + (size_t)l * DI + ch + 4);
      v4u o; o.x = pk2(gv[0] * rstd * n0.x, gv[1] * rstd * n0.y); o.y = pk2(gv[2] * rstd * n0.z, gv[3] * rstd * n0.w); o.z = pk2(gv[4] * rstd * n1.x, gv[5] * rstd * n1.y); o.w = pk2(gv[6] * rstd * n1.z, gv[7] * rstd * n1.w);
      *(GAS v4u*)(((bf16*)(C.a->ws + WS_YO)) + (size_t)row * KCAT + ch) = o; }
    LDS_WAIT(); asm volatile("" ::: "memory");
}

__device__ __forceinline__ void sample_attn_phase(const Ctx& C, int l) {
    const int tid = C.tid;
    constexpr int KP = 68;
    LAS float* Ks = (LAS float*)(C.lds + RING_OFF); LAS float* Vs = Ks + 128 * KP; LAS float* qs = Vs + 128 * KP; LAS float* sc = qs + 256; LAS float* knew = sc + 4 * 132; LAS float* vnew = knew + 64;
    const bf16* U = ((bf16*)(C.a->ws + WS_U));
    f32x4 kv[4], vv[4]; float qx = 0.f;
#define SA_LOAD(u_) do { const int b_ = (u_) >> 3, kh_ = (u_) & 7, row_ = SEQ + b_; const size_t cb_ = ((size_t)l * NB + b_) * WIN * (KVH * AD) + (size_t)kh_ * AD; \
        _Pragma("unroll") for (int i = 0; i < 4; ++i) { const int idx = tid + 512 * i, w = idx >> 4, c4 = idx & 15; \
            kv[i] = __builtin_nontemporal_load((const GAS f32x4*)((C.a->in[4]) + cb_ + (size_t)w * (KVH * AD)) + c4); vv[i] = __builtin_nontemporal_load((const GAS f32x4*)((C.a->in[5]) + cb_ + (size_t)w * (KVH * AD)) + c4); } \
        if (tid < 256) qx = bf2f(U[UIDX(row_, UQ + kh_ * 256 + tid)]); else if (tid < 320) qx = bf2f(U[UIDX(row_, UK + kh_ * 64 + (tid - 256))]); else if (tid < 384) qx = bf2f(U[UIDX(row_, UV + kh_ * 64 + (tid - 320))]); } while (0)
    int u = C.bid; if (u >= NB * KVH) return;
    SA_LOAD(u);
    for (; u < NB * KVH; u += C.G) {
        const int b = u >> 3, kh = u & 7, row = SEQ + b;
        const size_t cbase = ((size_t)l * NB + b) * WIN * (KVH * AD) + (size_t)kh * AD;
        if (tid < 256) qs[tid] = qx; else if (tid < 320) knew[tid - 256] = qx; else if (tid < 384) vnew[tid - 320] = qx;
#pragma unroll
        for (int i = 0; i < 4; ++i) { const int idx = tid + 512 * i, w = idx >> 4, c4 = idx & 15; *((LAS f32x4*)(Ks + w * KP) + c4) = kv[i]; *((LAS f32x4*)(Vs + w * KP) + c4) = vv[i]; }
        __syncthreads();
        if (u + C.G < NB * KVH) SA_LOAD(u + C.G);
        if (tid < 16) { *((GAS f32x4*)((C.a->out) + O_SK + cbase + (size_t)(WIN - 1) * (KVH * AD)) + tid) = *((const LAS f32x4*)knew + tid); }
        else if (tid < 32) { *((GAS f32x4*)((C.a->out) + O_SV + cbase + (size_t)(WIN - 1) * (KVH * AD)) + (tid - 16)) = *((const LAS f32x4*)vnew + (tid - 16)); }
        { const int w = tid >> 2, hq = tid & 3; const LAS f32x4* kp = (const LAS f32x4*)(Ks + w * KP); const LAS f32x4* qp = (const LAS f32x4*)(qs + hq * 64);
          float s = 0.f;
    #pragma unroll
          for (int c = 0; c < 16; ++c) { const f32x4 kv = kp[c], qv = qp[c]; s += (kv.x * qv.x + kv.y * qv.y) + (kv.z * qv.z + kv.w * qv.w); }
          sc[hq * 132 + w] = s * 0.125f; }
        if (tid < 4) { float s = 0.f;
          for (int d = 0; d < 64; ++d) s += qs[tid * 64 + d] * knew[d];
          sc[tid * 132 + 128] = s * 0.125f; }
        __syncthreads();
        if (C.wave < 4) { const int hq = C.wave; const float sink = (C.a->in[16])[l * AH + 4 * kh + hq];
          const float v0 = sc[hq * 132 + C.lane], v1 = sc[hq * 132 + 64 + C.lane], v2 = C.lane == 0 ? sc[hq * 132 + 128] : -__builtin_inff();
          const float m = fmaxf(wave_max(fmaxf(fmaxf(v0, v1), v2)), sink);
          const float e0 = __expf(v0 - m), e1 = __expf(v1 - m), e2 = C.lane == 0 ? __expf(v2 - m) : 0.f;
          const float inv = 1.0f / (wave_sum(e0 + e1 + e2) + __expf(sink - m));
          sc[hq * 132 + C.lane] = e0 * inv; sc[hq * 132 + 64 + C.lane] = e1 * inv; if (C.lane == 0) sc[hq * 132 + 128] = e2 * inv; }
        __syncthreads();
        if (tid < 256) { const int hq = tid >> 6, d = tid & 63; float o = sc[hq * 132 + 128] * vnew[d];
    #pragma unroll 16
          for (int w = 0; w < WIN; ++w) o += sc[hq * 132 + w] * Vs[w * KP + d];
          ((bf16*)(C.a->ws + WS_YO))[(size_t)row * KCAT + DI + (4 * kh + hq) * 64 + d] = (bf16)f2bf(o); }
        __syncthreads();
    }
#undef SA_LOAD
}

__device__ __forceinline__ void cache_shift(const Ctx& C, int l, int vb, int nvb) {
    constexpr int ROWF4 = (WIN - 1) * KVH * AD / 4;
    for (int u = vb; u < NB * 2; u += nvb) { const int b = u >> 1, kv = u & 1;
        const GAS f32x4* src = (const GAS f32x4*)((kv ? (C.a->in[5]) : (C.a->in[4])) + ((size_t)l * NB + b) * WIN * (KVH * AD) + KVH * AD);
        GAS f32x4* dst = (GAS f32x4*)((C.a->out) + (kv ? O_SV : O_SK) + ((size_t)l * NB + b) * WIN * (KVH * AD));
        for (int i = C.tid; i < ROWF4; i += 512 * 8) { f32x4 v[8];
#pragma unroll
            for (int j = 0; j < 8; ++j) if (i + 512 * j < ROWF4) v[j] = __builtin_nontemporal_load(src + i + 512 * j);
#pragma unroll
            for (int j = 0; j < 8; ++j) if (i + 512 * j < ROWF4) __builtin_nontemporal_store(v[j], dst + i + 512 * j); } }
}

__device__ __forceinline__ void copy_outs(const Ctx& C, int l, int vb, int nvb) {
    const bf16* U = ((bf16*)(C.a->ws + WS_U)); const int gt = vb * 512 + C.tid, NT = nvb * 512;
    for (int i = gt; i < WIN * KVH * AD / 8; i += NT) { const int w = i >> 6, c = (i & 63) * 8, ur = SEQ - WIN + w;
        const v4u kw = *(const GAS v4u*)(U + UIDX(ur, UK + c)), vw = *(const GAS v4u*)(U + UIDX(ur, UV + c));
        GAS f32x4* pk = (GAS f32x4*)((C.a->out) + O_PK + (size_t)l * WIN * KVH * AD + (size_t)w * (KVH * AD) + c); GAS f32x4* pv = (GAS f32x4*)((C.a->out) + O_PV + (size_t)l * WIN * KVH * AD + (size_t)w * (KVH * AD) + c);
        pk[0] = (f32x4){bflo(kw.x), bfhi(kw.x), bflo(kw.y), bfhi(kw.y)}; pk[1] = (f32x4){bflo(kw.z), bfhi(kw.z), bflo(kw.w), bfhi(kw.w)};
        pv[0] = (f32x4){bflo(vw.x), bfhi(vw.x), bflo(vw.y), bfhi(vw.y)}; pv[1] = (f32x4){bflo(vw.z), bfhi(vw.z), bflo(vw.w), bfhi(vw.w)}; }
    constexpr int C8 = CD / 8;
    for (int i = gt; i < 3 * C8; i += NT) { const int j = i / C8, ch = (i - j * C8) * 8; const v4u w = *(const GAS v4u*)(U + UIDX(SEQ - 3 + j, UXBC + ch));
        GAS f32x4* po = (GAS f32x4*)((C.a->out) + O_PCONV + (size_t)l * 3 * CD + (size_t)j * CD + ch);
        po[0] = (f32x4){bflo(w.x), bfhi(w.x), bflo(w.y), bfhi(w.y)}; po[1] = (f32x4){bflo(w.z), bfhi(w.z), bflo(w.w), bfhi(w.w)}; }
    for (int i = gt; i < NB * C8; i += NT) { const int b = i / C8, ch = (i - b * C8) * 8;
        const GAS f32x4* si = (const GAS f32x4*)((C.a->in[3]) + ((size_t)l * NB + b) * 3 * CD + ch); GAS f32x4* so = (GAS f32x4*)((C.a->out) + O_SCONV + ((size_t)l * NB + b) * 3 * CD + ch);
        const f32x4 r10 = si[CD / 4], r11 = si[CD / 4 + 1], r20 = si[2 * CD / 4], r21 = si[2 * CD / 4 + 1]; const v4u w = *(const GAS v4u*)(U + UIDX(SEQ + b, UXBC + ch));
        so[0] = r10; so[1] = r11; so[CD / 4] = r20; so[CD / 4 + 1] = r21;
        so[2 * CD / 4] = (f32x4){bflo(w.x), bfhi(w.x), bflo(w.y), bfhi(w.y)}; so[2 * CD / 4 + 1] = (f32x4){bflo(w.z), bfhi(w.z), bflo(w.w), bfhi(w.w)}; }
}
typedef float f32x2_t __attribute__((ext_vector_type(2))); typedef __bf16 bf16x2_t __attribute__((ext_vector_type(2)));
__device__ __forceinline__ unsigned cvtpk(float lo, float hi) { f32x2_t v = {lo, hi}; bf16x2_t b = __builtin_convertvector(v, bf16x2_t); return __builtin_bit_cast(unsigned, b); }
__device__ __forceinline__ int crow(int reg, int hh) { return (reg & 3) + 8 * (reg >> 2) + 4 * hh; }
#define MFMA32(a, b, c) __builtin_amdgcn_mfma_f32_32x32x16_bf16((a), (b), (c), 0, 0, 0)
__device__ __forceinline__ bf16x8 ld16(const bf16* p) { return *(const GAS bf16x8*)p; }
__device__ __forceinline__ bf16x8 ld8x2(const bf16* p) {
    const u32x2 lo = *(const GAS u32x2*)p, hi = *(const GAS u32x2*)(p + 8); v4u w; w.x = lo.x; w.y = lo.y; w.z = hi.x; w.w = hi.y; return __builtin_bit_cast(bf16x8, w); }
#define PACK8(X, s) __builtin_bit_cast(bf16x8, (v4u){cvtpk((X)[8 * (s)], (X)[8 * (s) + 1]), cvtpk((X)[8 * (s) + 2], (X)[8 * (s) + 3]), cvtpk((X)[8 * (s) + 4], (X)[8 * (s) + 5]), cvtpk((X)[8 * (s) + 6], (X)[8 * (s) + 7])})

__device__ __forceinline__ void reformat_conv_item(const Ctx& C, int l, int c, int cblk) {
    const int co = C.lane & 7, rg = C.lane >> 3, ch0 = cblk * 64 + co * 8;
    const float* cw = (C.a->in[8]) + (size_t)l * CW * CD + ch0; const float* cb = (C.a->in[9]) + (size_t)l * CD + ch0;
    float w0[8], w1[8], w2[8], w3[8], bs[8];
#pragma unroll
    for (int j = 0; j < 8; ++j) { w0[j] = cw[j]; w1[j] = cw[CD + j]; w2[j] = cw[2 * CD + j]; w3[j] = cw[3 * CD + j]; bs[j] = cb[j]; }
    const bf16* U = ((bf16*)(C.a->ws + WS_U));
    const int row0 = 128 * c + 16 * rg;
    v4u raw[19];
    unsigned zu = 0u; asm volatile("" : "+v"(zu));
#pragma unroll
    for (int i = 0; i < 19; ++i) { const int rr = row0 - 3 + i; raw[i] = rr >= 0 ? *(const GAS v4u*)(U + UIDX(rr, UXBC + ch0)) : (v4u){zu, zu, zu, zu}; }
    unsigned tp[8][8];
    bf16* rm = nullptr; bf16* tr = nullptr;
    if (cblk < 64) tr = ((bf16*)(C.a->ws + WS_XT)) + (((size_t)c * 64 + cblk) * 64 + co * 8) * 128 + 16 * rg;
    else if (cblk < 80) { const int g = (cblk - 64) >> 1, hf = (cblk - 64) & 1;
        rm = ((bf16*)(C.a->ws + WS_BRM)) + (((size_t)c * 8 + g) * 128 + 16 * rg) * 128 + hf * 64 + co * 8;
        tr = ((bf16*)(C.a->ws + WS_BT)) + (((size_t)c * 8 + g) * 128 + hf * 64 + co * 8) * 128 + 16 * rg; }
    else { const int g = (cblk - 80) >> 1, hf = (cblk - 80) & 1;
        rm = ((bf16*)(C.a->ws + WS_CRM)) + (((size_t)c * 8 + g) * 128 + 16 * rg) * 128 + hf * 64 + co * 8; }
#define RAWF(i, j) (((j) & 1) ? bfhi(((j) >> 1) == 0 ? raw[i].x : (((j) >> 1) == 1 ? raw[i].y : (((j) >> 1) == 2 ? raw[i].z : raw[i].w))) : bflo(((j) >> 1) == 0 ? raw[i].x : (((j) >> 1) == 1 ? raw[i].y : (((j) >> 1) == 2 ? raw[i].z : raw[i].w))))
#pragma unroll
    for (int i2 = 0; i2 < 8; ++i2) {
        float oa[8], ob[8];
#pragma unroll
        for (int j = 0; j < 8; ++j) { oa[j] = siluf_(bs[j] + w0[j] * RAWF(2 * i2, j) + w1[j] * RAWF(2 * i2 + 1, j) + w2[j] * RAWF(2 * i2 + 2, j) + w3[j] * RAWF(2 * i2 + 3, j));
                                      ob[j] = siluf_(bs[j] + w0[j] * RAWF(2 * i2 + 1, j) + w1[j] * RAWF(2 * i2 + 2, j) + w2[j] * RAWF(2 * i2 + 3, j) + w3[j] * RAWF(2 * i2 + 4, j)); }
        if (rm) { v4u w; w.x = cvtpk(oa[0], oa[1]); w.y = cvtpk(oa[2], oa[3]); w.z = cvtpk(oa[4], oa[5]); w.w = cvtpk(oa[6], oa[7]); *(GAS v4u*)(rm + (size_t)(2 * i2) * 128) = w;
                  w.x = cvtpk(ob[0], ob[1]); w.y = cvtpk(ob[2], ob[3]); w.z = cvtpk(ob[4], ob[5]); w.w = cvtpk(ob[6], ob[7]); *(GAS v4u*)(rm + (size_t)(2 * i2 + 1) * 128) = w; }
#pragma unroll
        for (int j = 0; j < 8; ++j) tp[j][i2] = cvtpk(oa[j], ob[j]);
    }
#undef RAWF
    if (tr) {
#pragma unroll
        for (int j = 0; j < 8; ++j) { *(GAS v4u*)(tr + (size_t)j * 128) = (v4u){tp[j][0], tp[j][1], tp[j][2], tp[j][3]}; *(GAS v4u*)(tr + (size_t)j * 128 + 8) = (v4u){tp[j][4], tp[j][5], tp[j][6], tp[j][7]}; }
    }
}
__device__ __forceinline__ void reformat_dt_item(const Ctx& C, int l, int c) {
    const int h = C.lane; const float A = -__expf((C.a->in[11])[l * NH + h]);
    const float* D = ((float*)(C.a->ws + WS_DT)) + (size_t)(128 * c) * 64 + h;
    float* dto = ((float*)(C.a->ws + WS_DTT)) + ((size_t)c * 64 + h) * 128; float* aco = ((float*)(C.a->ws + WS_ACS)) + ((size_t)c * 64 + h) * 128;
    float cs = 0.f;
#pragma unroll
    for (int l0 = 0; l0 < 128; l0 += 64) { float dv[64];
#pragma unroll
        for (int i = 0; i < 64; ++i) dv[i] = D[(size_t)(l0 + i) * 64];
#pragma unroll
        for (int q = 0; q < 16; ++q) { f32x4 av;
#pragma unroll
            for (int e = 0; e < 4; ++e) { cs += dv[4 * q + e] * A; av[e] = cs; }
            *(GAS f32x4*)(dto + l0 + 4 * q) = (f32x4){dv[4 * q], dv[4 * q + 1], dv[4 * q + 2], dv[4 * q + 3]}; *(GAS f32x4*)(aco + l0 + 4 * q) = av; } }
}
__device__ __forceinline__ void reformat_vt_item(const Ctx& C, int tb, int kh) {
    const int co = C.lane & 7, rg = C.lane >> 3; const bf16* U = ((bf16*)(C.a->ws + WS_U)) + UIDX(128 * tb + 16 * rg, UV + kh * 64 + co * 8);
    unsigned tp[8][8];
#pragma unroll
    for (int i = 0; i < 16; ++i) { const v4u a = *(const GAS v4u*)(U + (size_t)i * 64); const unsigned w[4] = {a.x, a.y, a.z, a.w};
#pragma unroll
        for (int j = 0; j < 8; ++j) { const unsigned hb = (j & 1) ? (w[j >> 1] >> 16) : (w[j >> 1] & 0xffffu); if (i & 1) tp[j][i >> 1] |= hb << 16; else tp[j][i >> 1] = hb; } }
    bf16* tr = ((bf16*)(C.a->ws + WS_VT)) + ((size_t)kh * 64 + co * 8) * SEQ + 128 * tb + 16 * rg;
#pragma unroll
    for (int j = 0; j < 8; ++j) { *(GAS v4u*)(tr + (size_t)j * SEQ) = (v4u){tp[j][0], tp[j][1], tp[j][2], tp[j][3]}; *(GAS v4u*)(tr + (size_t)j * SEQ + 8) = (v4u){tp[j][4], tp[j][5], tp[j][6], tp[j][7]}; }
}
constexpr int RF_ITEMS = 64 * 96 + 64 + 64 * 8;
__device__ __forceinline__ void reformat_item(const Ctx& C, int l, int it) {
    constexpr int N1 = 64 * 96, N2 = 64;
    if (it < N1) reformat_conv_item(C, l, it / 96, it % 96);
    else if (it < N1 + N2) reformat_dt_item(C, l, it - N1);
    else reformat_vt_item(C, (it - N1 - N2) >> 3, (it - N1 - N2) & 7);
}

constexpr int AT_K = 0, AT_V = 36864, AT_KP = 144, AT_VP = 528;
__device__ __forceinline__ void attn_prompt_unit(const Ctx& C, int l, int qb, int kh) {
    const int lane_ = lane_now();
    const int r = lane_ & 31, hh = lane_ >> 5, hq = 4 * kh + (C.wave >> 1), rh = C.wave & 1, tid = C.wave * 64 + lane_;
    const bf16* U = ((bf16*)(C.a->ws + WS_U)); const bf16* VT = ((bf16*)(C.a->ws + WS_VT)) + (size_t)kh * 64 * SEQ; bf16* YO = ((bf16*)(C.a->ws + WS_YO));
    LAS unsigned char* Ks = C.lds + AT_K; LAS unsigned char* Vs = C.lds + AT_V;
    const int key0 = 128 * (qb - 1);
    { v4u tk[4], tv[4]; unsigned zu = 0u; asm volatile("" : "+v"(zu));
#pragma unroll
      for (int i = 0; i < 4; ++i) { const int idx = tid + 512 * i, kr = idx >> 3, ch = idx & 7, key = key0 + kr;
          tk[i] = key >= 0 ? *(const GAS v4u*)(U + UIDX(key, UK + kh * 64 + 8 * ch)) : (v4u){zu, zu, zu, zu};
          const int d = idx >> 5, c5 = idx & 31, kk = key0 + 8 * c5;
          tv[i] = kk >= 0 ? *(const GAS v4u*)(VT + (size_t)d * SEQ + kk) : (v4u){zu, zu, zu, zu}; }
#pragma unroll
      for (int i = 0; i < 4; ++i) { const int idx = tid + 512 * i; *(LAS v4u*)(Ks + (idx >> 3) * AT_KP + (idx & 7) * 16) = tk[i]; *(LAS v4u*)(Vs + (idx >> 5) * AT_VP + (idx & 31) * 16) = tv[i]; } }
    bf16x8 bq[2][4];
#pragma unroll
    for (int qt = 0; qt < 2; ++qt)
#pragma unroll
        for (int ks = 0; ks < 4; ++ks) bq[qt][ks] = ld16(U + UIDX(128 * qb + 32 * (2 * rh + qt) + r, UQ + hq * 64 + 16 * ks + 8 * hh));
    const float sink = (C.a->in[16])[l * AH + hq];
    __syncthreads();
#pragma unroll
    for (int qt = 0; qt < 2; ++qt) {
        const int ai = 2 * rh + qt, q0 = 128 * qb + 32 * ai, t = q0 + r;
        f32x16 S[5]; float mx = sink;
#pragma unroll
        for (int v = 0; v < 5; ++v) { const int kt = ai + v; const bool vis = qb > 0 || kt >= 4;
            if (vis) { const int kb = key0 + 32 * kt; f32x16 s;
#pragma unroll
                for (int e = 0; e < 16; ++e) s[e] = 0.f;
                const LAS unsigned char* kp = Ks + (32 * kt + r) * AT_KP + 16 * hh;
#pragma unroll
                for (int ks = 0; ks < 4; ++ks) { const bf16x8 a = *(const LAS bf16x8*)(kp + 32 * ks); s = MFMA32(a, bq[qt][ks], s); }
#pragma unroll
                for (int e = 0; e < 16; ++e) { const int j = kb + crow(e, hh); const bool ok = (j <= t) && (j >= t - WIN); const float x = ok ? s[e] * 0.125f : -__builtin_inff(); s[e] = x; mx = fmaxf(mx, x); }
                S[v] = s; }
        }
        mx = fmaxf(mx, __shfl_xor(mx, 32));
        float sum = 0.f;
#pragma unroll
        for (int v = 0; v < 5; ++v) { const int kt = ai + v; const bool vis = qb > 0 || kt >= 4;
            if (vis) {
#pragma unroll
                for (int e = 0; e < 16; ++e) { const float p = __expf(S[v][e] - mx); S[v][e] = p; sum += p; } } }
        sum += __shfl_xor(sum, 32); sum += __expf(sink - mx);
        f32x16 O[2];
#pragma unroll
        for (int e = 0; e < 16; ++e) { O[0][e] = 0.f; O[1][e] = 0.f; }
#pragma unroll
        for (int v = 0; v < 5; ++v) { const int kt = ai + v; const bool vis = qb > 0 || kt >= 4;
            if (vis) {
#pragma unroll
                for (int ss = 0; ss < 2; ++ss) { const bf16x8 pb = PACK8(S[v], ss);
#pragma unroll
                    for (int dt = 0; dt < 2; ++dt) { const LAS unsigned char* vp = Vs + (32 * dt + r) * AT_VP + (32 * kt + 16 * ss + 4 * hh) * 2;
                        const u32x2 lo = *(const LAS u32x2*)vp, hi = *(const LAS u32x2*)(vp + 16);
                        const bf16x8 va = __builtin_bit_cast(bf16x8, (v4u){lo.x, lo.y, hi.x, hi.y}); O[dt] = MFMA32(va, pb, O[dt]); } } } }
        const float inv = 1.0f / sum;
        bf16* op = YO + (size_t)t * KCAT + DI + hq * 64;
#pragma unroll
        for (int dt = 0; dt < 2; ++dt)
#pragma unroll
            for (int g4 = 0; g4 < 4; ++g4) { u32x2 w; w.x = cvtpk(O[dt][4 * g4] * inv, O[dt][4 * g4 + 1] * inv); w.y = cvtpk(O[dt][4 * g4 + 2] * inv, O[dt][4 * g4 + 3] * inv);
                *(GAS u32x2*)(op + 32 * dt + 8 * g4 + 4 * hh) = w; }
    }
    __syncthreads();
}

__device__ __forceinline__ void ssd_states_unit(const Ctx& C, int c, int g) {
    const int lane_ = lane_now();
    const int r = lane_ & 31, hh = lane_ >> 5, h = 8 * g + C.wave, tid = C.wave * 64 + lane_;
    const bf16* xT = ((bf16*)(C.a->ws + WS_XT)) + ((size_t)c * 64 + h) * 64 * 128; const bf16* bT = ((bf16*)(C.a->ws + WS_BT)) + ((size_t)c * 8 + g) * 128 * 128;
    const float* dtT = ((float*)(C.a->ws + WS_DTT)) + ((size_t)c * 64 + h) * 128; const float* acs = ((float*)(C.a->ws + WS_ACS)) + ((size_t)c * 64 + h) * 128;
    LAS unsigned char* Bs = C.lds + PC_B;
    { v4u tb[4];
#pragma unroll
      for (int i = 0; i < 4; ++i) tb[i] = *(const GAS v4u*)(bT + (size_t)(tid + 512 * i) * 8);
#pragma unroll
      for (int i = 0; i < 4; ++i) { const int idx = tid + 512 * i; *(LAS v4u*)(Bs + (idx >> 4) * 272 + (idx & 15) * 16) = tb[i]; } }
    const float aend = acs[127];
    bf16x8 a[2][8];
#pragma unroll
    for (int ks = 0; ks < 8; ++ks) { const int l0 = 16 * ks + 8 * hh;
        const f32x4 d0 = *(const GAS f32x4*)(dtT + l0), d1 = *(const GAS f32x4*)(dtT + l0 + 4), a0 = *(const GAS f32x4*)(acs + l0), a1 = *(const GAS f32x4*)(acs + l0 + 4);
        float sc[8];
#pragma unroll
        for (int j = 0; j < 4; ++j) { sc[j] = d0[j] * __expf(aend - a0[j]); sc[4 + j] = d1[j] * __expf(aend - a1[j]); }
#pragma unroll
        for (int pt = 0; pt < 2; ++pt) { const v4u w = *(const GAS v4u*)(xT + (size_t)(32 * pt + r) * 128 + l0);
            v4u o; o.x = cvtpk(bflo(w.x) * sc[0], bfhi(w.x) * sc[1]); o.y = cvtpk(bflo(w.y) * sc[2], bfhi(w.y) * sc[3]); o.z = cvtpk(bflo(w.z) * sc[4], bfhi(w.z) * sc[5]); o.w = cvtpk(bflo(w.w) * sc[6], bfhi(w.w) * sc[7]);
            a[pt][ks] = __builtin_bit_cast(bf16x8, o); } }
    __syncthreads();
    bf16* st = ((bf16*)(C.a->ws + WS_ST)) + ((size_t)c * 64 + h) * 64 * 128;
#pragma unroll
    for (int nt = 0; nt < 4; ++nt) {
        f32x16 acc[2];
#pragma unroll
        for (int e = 0; e < 16; ++e) { acc[0][e] = 0.f; acc[1][e] = 0.f; }
        const LAS unsigned char* bp = Bs + (32 * nt + r) * 272 + 16 * hh;
#pragma unroll
        for (int ks = 0; ks < 8; ++ks) { const bf16x8 b = *(const LAS bf16x8*)(bp + 32 * ks); acc[0] = MFMA32(b, a[0][ks], acc[0]); acc[1] = MFMA32(b, a[1][ks], acc[1]); }
#pragma unroll
        for (int pt = 0; pt < 2; ++pt)
#pragma unroll
            for (int q4 = 0; q4 < 4; ++q4) { u32x2 w; w.x = cvtpk(acc[pt][4 * q4], acc[pt][4 * q4 + 1]); w.y = cvtpk(acc[pt][4 * q4 + 2], acc[pt][4 * q4 + 3]);
                *(GAS u32x2*)(st + (size_t)(32 * pt + r) * 128 + 32 * nt + 8 * q4 + 4 * hh) = w; }
    }
    __syncthreads();
}

__device__ __forceinline__ void ssd_scan_phase(const Ctx& C, int l) {
    const bf16* ST = ((bf16*)(C.a->ws + WS_ST)); bf16* HS = ((bf16*)(C.a->ws + WS_HS)); const float* acs = ((float*)(C.a->ws + WS_ACS));
    for (int idx = C.bid * 512 + C.tid; idx < 64 * 64 * 128 / 4; idx += C.G * 512) { const int h = idx >> 11;
        f32x4 hc = (f32x4){0.f, 0.f, 0.f, 0.f};
        for (int c0 = 0; c0 < 64; c0 += 16) { u32x2 sw[16]; float av[16];
#pragma unroll
            for (int j = 0; j < 16; ++j) { sw[j] = *((const GAS u32x2*)(ST + (size_t)(c0 + j) * 64 * 64 * 128) + idx); av[j] = acs[((size_t)(c0 + j) * 64 + h) * 128 + 127]; }
#pragma unroll
            for (int j = 0; j < 16; ++j) {
                u32x2 w; w.x = cvtpk(hc.x, hc.y); w.y = cvtpk(hc.z, hc.w); *((GAS u32x2*)(HS + (size_t)(c0 + j) * 64 * 64 * 128) + idx) = w;
                const f32x4 s = (f32x4){bflo(sw[j].x), bfhi(sw[j].x), bflo(sw[j].y), bfhi(sw[j].y)}; const float dec = __expf(av[j]);
                hc = hc * dec + s; } }
        *((GAS f32x4*)((C.a->out) + O_PSSM + (size_t)l * NH * HP * DS) + idx) = hc; }
}

__device__ __forceinline__ void ssd_out_unit(const Ctx& C, int l, int c, int g) {
    const int lane_ = lane_now();
    const int r = lane_ & 31, hh = lane_ >> 5, h = 8 * g + C.wave, tid = C.wave * 64 + lane_;
    LAS unsigned char* Bs = C.lds + PC_B; LAS unsigned char* Cs = C.lds + PC_C; LAS float* Ysm = (LAS float*)(C.lds + PC_Y + C.wave * 8704);
    LAS float* ssq = (LAS float*)(C.lds + PC_SSQ); LAS float* acsS = (LAS float*)(C.lds + PC_AD + C.wave * 1024); LAS float* dtS = acsS + 128;
    const bf16* cR = ((bf16*)(C.a->ws + WS_CRM)) + ((size_t)c * 8 + g) * 128 * 128; const bf16* bR = ((bf16*)(C.a->ws + WS_BRM)) + ((size_t)c * 8 + g) * 128 * 128;
    const bf16* hS = ((bf16*)(C.a->ws + WS_HS)) + ((size_t)c * 64 + h) * 64 * 128; const bf16* xT = ((bf16*)(C.a->ws + WS_XT)) + ((size_t)c * 64 + h) * 64 * 128;
    { v4u tb[4], tc[4];
#pragma unroll
      for (int i = 0; i < 4; ++i) { const int idx = tid + 512 * i; tb[i] = *(const GAS v4u*)(bR + (size_t)idx * 8); tc[i] = *(const GAS v4u*)(cR + (size_t)idx * 8); }
      const float a0 = (((float*)(C.a->ws + WS_ACS)) + ((size_t)c * 64 + h) * 128)[lane_], a1 = (((float*)(C.a->ws + WS_ACS)) + ((size_t)c * 64 + h) * 128)[64 + lane_];
      const float d0 = (((float*)(C.a->ws + WS_DTT)) + ((size_t)c * 64 + h) * 128)[lane_], d1 = (((float*)(C.a->ws + WS_DTT)) + ((size_t)c * 64 + h) * 128)[64 + lane_];
#pragma unroll
      for (int i = 0; i < 4; ++i) { const int idx = tid + 512 * i, row = idx >> 4, ch = idx & 15; *(LAS v4u*)(Bs + row * 272 + ch * 16) = tb[i]; *(LAS v4u*)(Cs + row * 272 + ch * 16) = tc[i]; }
      acsS[lane_] = a0; acsS[64 + lane_] = a1; dtS[lane_] = d0; dtS[64 + lane_] = d1; }
    bf16x8 hb[2][8], xb[4][2][2];
#pragma unroll
    for (int pt = 0; pt < 2; ++pt)
#pragma unroll
        for (int ks = 0; ks < 8; ++ks) hb[pt][ks] = ld16(hS + (size_t)(32 * pt + r) * 128 + 16 * ks + 8 * hh);
#pragma unroll
    for (int st = 0; st < 4; ++st)
#pragma unroll
        for (int ss = 0; ss < 2; ++ss)
#pragma unroll
            for (int pt = 0; pt < 2; ++pt) xb[st][ss][pt] = ld8x2(xT + (size_t)(32 * pt + r) * 128 + 32 * st + 16 * ss + 4 * hh);
    const float Dh = (C.a->in[12])[l * NH + h];
    __syncthreads();
    const bf16* Uz = ((bf16*)(C.a->ws + WS_U)) + UIDX(128 * c + (lane_ >> 1), UZ + h * 64 + 32 * (lane_ & 1));
    bf16* YOw = ((bf16*)(C.a->ws + WS_YO)) + (size_t)(128 * c + (lane_ >> 1)) * KCAT + h * 64 + 32 * (lane_ & 1);
    const float* nwp = (C.a->in[13]) + (size_t)l * DI + h * 64 + 32 * (lane_ & 1);
#pragma unroll
    for (int lt = 0; lt < 4; ++lt) {
        v4u zw[4];
        { const GAS v4u* zp = (const GAS v4u*)(Uz + (size_t)(32 * lt) * 64);
#pragma unroll
          for (int i = 0; i < 4; ++i) zw[i] = zp[i]; }
        f32x16 y[2];
#pragma unroll
        for (int e = 0; e < 16; ++e) { y[0][e] = 0.f; y[1][e] = 0.f; }
        const LAS unsigned char* crow_p = Cs + (32 * lt + r) * 272 + 16 * hh;
#pragma unroll
        for (int ks = 0; ks < 8; ++ks) { if ((ks & 3) == 0) asm volatile("" ::: "memory");
            const bf16x8 a = *(const LAS bf16x8*)(crow_p + 32 * ks); y[0] = MFMA32(a, hb[0][ks], y[0]); y[1] = MFMA32(a, hb[1][ks], y[1]); }
#pragma unroll
        for (int q4 = 0; q4 < 4; ++q4) { const f32x4 av = *(const LAS f32x4*)(acsS + 32 * lt + 8 * q4 + 4 * hh);
#pragma unroll
            for (int e = 0; e < 4; ++e) { const float f = __expf(av[e]); y[0][4 * q4 + e] *= f; y[1][4 * q4 + e] *= f; } }
        const float al = acsS[32 * lt + r];
#pragma unroll
        for (int st = 0; st < 4; ++st) { if (st > lt) continue;
            f32x16 X;
#pragma unroll
            for (int e = 0; e < 16; ++e) X[e] = 0.f;
            const LAS unsigned char* brow_p = Bs + (32 * st + r) * 272 + 16 * hh;
#pragma unroll
            for (int ks = 0; ks < 8; ++ks) { if ((ks & 1) == 0) asm volatile("" ::: "memory");
                const bf16x8 a = *(const LAS bf16x8*)(brow_p + 32 * ks), b = *(const LAS bf16x8*)(crow_p + 32 * ks); X = MFMA32(a, b, X); }
#pragma unroll
            for (int q4 = 0; q4 < 4; ++q4) { const f32x4 as = *(const LAS f32x4*)(acsS + 32 * st + 8 * q4 + 4 * hh), ds = *(const LAS f32x4*)(dtS + 32 * st + 8 * q4 + 4 * hh);
#pragma unroll
                for (int e = 0; e < 4; ++e) { const int s = 32 * st + 8 * q4 + 4 * hh + e, lrow = 32 * lt + r; const float wgt = (s <= lrow) ? ds[e] * __expf(al - as[e]) : 0.f; X[4 * q4 + e] *= wgt; } }
#pragma unroll
            for (int ss = 0; ss < 2; ++ss) { const bf16x8 xa = PACK8(X, ss); y[0] = MFMA32(xa, xb[st][ss][0], y[0]); y[1] = MFMA32(xa, xb[st][ss][1], y[1]); }
        }
#pragma unroll
        for (int pt = 0; pt < 2; ++pt)
#pragma unroll
            for (int e = 0; e < 16; ++e) { const int q4 = e >> 2; const v4u xw = __builtin_bit_cast(v4u, xb[lt][q4 >> 1][pt]); const unsigned w = (q4 & 1) ? ((e & 2) ? xw.w : xw.z) : ((e & 2) ? xw.y : xw.x);
                const float xv = (e & 1) ? bfhi(w) : bflo(w);
                Ysm[crow(e, hh) * 68 + 32 * pt + r] = y[pt][e] + Dh * xv; }
        { const LAS f32x4* yr = (const LAS f32x4*)(Ysm + (lane_ >> 1) * 68 + 32 * (lane_ & 1));
          float gq[32]; float sq = 0.f;
#pragma unroll
          for (int i = 0; i < 4; ++i) { const f32x4 ya = yr[2 * i], yb = yr[2 * i + 1];
              gq[8 * i + 0] = ya.x * bflo(zw[i].x); gq[8 * i + 1] = ya.y * bfhi(zw[i].x); gq[8 * i + 2] = ya.z * bflo(zw[i].y); gq[8 * i + 3] = ya.w * bfhi(zw[i].y);
              gq[8 * i + 4] = yb.x * bflo(zw[i].z); gq[8 * i + 5] = yb.y * bfhi(zw[i].z); gq[8 * i + 6] = yb.z * bflo(zw[i].w); gq[8 * i + 7] = yb.w * bfhi(zw[i].w);
#pragma unroll
              for (int e = 0; e < 8; ++e) sq += gq[8 * i + e] * gq[8 * i + e]; }
          sq += __shfl_xor(sq, 1);
          if ((lane_ & 1) == 0) ssq[(32 * lt + (lane_ >> 1)) * 8 + C.wave] = sq;
          __syncthreads();
          const LAS f32x4* sp = (const LAS f32x4*)(ssq + (32 * lt + (lane_ >> 1)) * 8); const f32x4 s0 = sp[0], s1 = sp[1];
          const float rstd = rsqrtf(((s0.x + s0.y) + (s0.z + s0.w) + (s1.x + s1.y) + (s1.z + s1.w)) * (1.0f / 512.0f) + EPS);
          GAS v4u* op = (GAS v4u*)(YOw + (size_t)(32 * lt) * KCAT);
#pragma unroll
          for (int i = 0; i < 4; ++i) { const f32x4 na = *(const GAS f32x4*)(nwp + 8 * i), nb = *(const GAS f32x4*)(nwp + 8 * i + 4);
              op[i] = (v4u){cvtpk(gq[8 * i] * rstd * na.x, gq[8 * i + 1] * rstd * na.y), cvtpk(gq[8 * i + 2] * rstd * na.z, gq[8 * i + 3] * rstd * na.w), cvtpk(gq[8 * i + 4] * rstd * nb.x, gq[8 * i + 5] * rstd * nb.y), cvtpk(gq[8 * i + 6] * rstd * nb.z, gq[8 * i + 7] * rstd * nb.w)}; } }
    }
    __syncthreads();
}

template <int MODE> __device__ __forceinline__ void mini_unit(const Ctx& C, int l, int mu) {
    constexpr int K = MODE == 0 ? KCAT : (MODE == 1 ? DM : FF), KS = MODE == 0 ? 1024 : (MODE == 1 ? 256 : 704);
    const int lane_ = lane_now();
    const int r = lane_ & 31, hh = lane_ >> 5, ct = mu & 31, sp = mu >> 5, rt = C.wave & 3, n0 = 64 * ct + 32 * (C.wave >> 2), k0 = KS * sp + 8 * hh;
    const bf16* Bt = (MODE == 0 ? ((bf16*)(C.a->ws + WS_WCAT)) + (size_t)l * DM * KCAT : (MODE == 1 ? ((bf16*)(C.a->ws + WS_WOUT)) + (size_t)l * DM * DM : ((bf16*)(C.a->ws + WS_WDN)) + (size_t)l * DM * FF)) + (size_t)(n0 + r) * K + k0;
    const bf16* Ab = (MODE == 0 ? ((bf16*)(C.a->ws + WS_YO)) + (size_t)(SEQ + 32 * rt + r) * KCAT : ((bf16*)(C.a->ws + WS_HB)) + (size_t)(SEQ + 32 * rt + r) * FF) + k0;
    const float* Af = ((float*)(C.a->ws + WS_MS)) + (size_t)(32 * rt + r) * DM + k0;
    f32x16 acc;
#pragma unroll
    for (int e = 0; e < 16; ++e) acc[e] = 0.f;
#pragma unroll(MODE == 1 ? 8 : 16)
    for (int ks = 0; ks < KS / 16; ++ks) { bf16x8 a; const bf16x8 b = ld16(Bt + 16 * ks);
        if (MODE == 1) { const f32x4 v0 = *(const GAS f32x4*)(Af + 16 * ks), v1 = *(const GAS f32x4*)(Af + 16 * ks + 4);
            a = __builtin_bit_cast(bf16x8, (v4u){cvtpk(v0.x, v0.y), cvtpk(v0.z, v0.w), cvtpk(v1.x, v1.y), cvtpk(v1.z, v1.w)}); }
        else a = ld16(Ab + 16 * ks);
        acc = MFMA32(a, b, acc); }
    float* dst = (MODE == 0 ? ((float*)(C.a->ws + WS_MS)) : ((float*)(C.a->ws + WS_X)) + (size_t)SEQ * DM) + n0 + r;
    const bf16* gp = ((bf16*)(C.a->ws + WS_U)) + UIDX(SEQ, (sp < 4 ? UGS : UGA) + n0 + r);
#pragma unroll
    for (int e = 0; e < 16; ++e) { const int row = 32 * rt + crow(e, hh); float v = acc[e];
        if (MODE == 0) v *= bf2f(gp[(size_t)row * 64]);
        unsafeAtomicAdd(dst + (size_t)row * DM, v); }
}
template <int MODE> __device__ __forceinline__ void mini_phase(const Ctx& C, int l) {
    constexpr int NMU = 32 * (MODE == 0 ? 6 : 8);
    for (int mu = C.bid; mu < NMU; mu += C.G) mini_unit<MODE>(C, l, mu);
}
constexpr int NPL = 11;
constexpr int NPH = 1 + DEPTH * NPL;
#ifndef REP_P0
#define REP_P0 1
#endif
#ifndef REP_0
#define REP_0 1
#endif
#ifndef REP_1
#define REP_1 1
#endif
#ifndef REP_2
#define REP_2 1
#endif
#ifndef REP_3
#define REP_3 1
#endif
#ifndef REP_4
#define REP_4 1
#endif
#ifndef REP_5
#define REP_5 1
#endif
#ifndef REP_6
#define REP_6 1
#endif
#ifndef REP_7
#define REP_7 1
#endif
#ifndef REP_8
#define REP_8 1
#endif
#ifndef REP_9
#define REP_9 1
#endif
#ifndef REP_10
#define REP_10 1
#endif
#ifndef REP_RF
#define REP_RF 1
#endif
#ifndef REP_SSD
#define REP_SSD 1
#endif
#ifndef REP_SATT
#define REP_SATT 1
#endif
#ifndef GEMM_ALIGN
#define GEMM_ALIGN true
#endif
#ifndef GEMM_SP2
#define GEMM_SP2 true
#endif
#ifndef PROBE_LO
#define PROBE_LO -1
#define PROBE_HI -1
#endif
#ifndef PROBE_AMP
#define PROBE_AMP 2
#endif
#ifndef NW_SSD
#define NW_SSD 2
#endif
#ifndef PROBE_SUB
#define PROBE_SUB 0
#endif
#ifndef PROBE_CLK
#define PROBE_CLK 0
#endif
#ifndef REP_ATT
#define REP_ATT 1
#endif
#ifndef REP_PA
#define REP_PA 1
#endif
#ifndef NSP_G1
#define NSP_G1 49
#endif
#ifndef MK_SPLIT
#define MK_SPLIT 0
#endif
__global__ void __launch_bounds__(NWAVES * 64, 2) fwd(Args args) {
    extern __shared__ __attribute__((aligned(16))) unsigned char lds_raw[];
    LAS unsigned char* const lds = (LAS unsigned char*)lds_raw;
    const int wave_s = __builtin_amdgcn_readfirstlane(threadIdx.x >> 6);
    unsigned char* ws = args.ws;
#define FRESH_CTX() Ctx C; { int t_; asm volatile("v_mbcnt_lo_u32_b32 %0, -1, 0\n\tv_mbcnt_hi_u32_b32 %0, -1, %0" : "=v"(t_)); t_ += wave_s * 64; int b_ = blockIdx.x, g_ = gridDim.x; asm volatile("" : "+s"(b_), "+s"(g_)); \
        KArgs kp_ = (KArgs)__builtin_amdgcn_kernarg_segment_ptr(); asm volatile("" : "+s"(kp_)); \
        C.lds = lds; C.tid = t_; C.lane = t_ & 63; C.wave = __builtin_amdgcn_readfirstlane(t_ >> 6); C.G = g_; C.bid = b_; C.a = kp_; }
    for (int u = threadIdx.x; u < (LDS_BYTES - LDSCTL_OFF) / 4; u += NWAVES * 64) ((LAS unsigned*)(lds + LDSCTL_OFF))[u] = 0u;
    __syncthreads();
    volatile LAS unsigned* MISC = (volatile LAS unsigned*)(lds + MISC_OFF);
    unsigned* barw = (unsigned*)(ws + WS_CTL) + CW_BAR;
    XcdBarrier bar; bar.bar = barw; bar.x = 0; bar.st = nullptr;
    if (args.use_bar) bar = xcd_barrier_post(barw, MISC + 8);
    const int lo = args.ph_lo, hi = args.ph_hi;
#define IN(k) (lo <= (k) && (k) < hi)
#define SEAM(k) do { if (IN((k) + 1)) xcd_barrier(bar); } while (0)

#ifndef NO_P0
    if (IN(0)) { for (int rep_ = 0; rep_ < REP_P0; ++rep_) { FRESH_CTX(); p0_weights(C, 0, (C.G >= 64 && NSP_G1 > 0) ? IT_IN : DEPTH * IT_LAYER, C.bid * NWAVES + C.wave, C.G * NWAVES); p0_xinit(C); if (rep_ + 1 < REP_P0) xcd_barrier(bar); } SEAM(0); }
#endif

    unsigned long long probe_acc = 0ull, probe_t0 = 0ull;
    if (PROBE_CLK && threadIdx.x == 0) { const unsigned long long c0_ = __builtin_amdgcn_s_memtime(), r0_ = __builtin_amdgcn_s_memrealtime(); MISC[16] = (unsigned)c0_; MISC[17] = (unsigned)(c0_ >> 32); MISC[18] = (unsigned)r0_; MISC[19] = (unsigned)(r0_ >> 32); }
#define PROBE_BEGIN(j) do { if (PROBE_LO >= 0 && (j) == PROBE_LO) probe_t0 = __builtin_amdgcn_s_memrealtime(); } while (0)
#define PROBE_END(j) do { if (PROBE_LO >= 0 && (j) == PROBE_HI) probe_acc += __builtin_amdgcn_s_memrealtime() - probe_t0; } while (0)
#pragma nounroll
    for (int l = 0; l < DEPTH; ++l) {
        const int pb = 1 + l * NPL;
#ifndef NO_G1
        PROBE_BEGIN(0);
        if (IN(pb + 0)) { for (int rep_ = 0; rep_ < REP_0; ++rep_) {
            FRESH_CTX();
            const int nsp = (l == 0 && C.G >= 64) ? (C.G * NSP_G1) / 256 : 0, gG = C.G - nsp;
            if (C.bid < gG) {
            pg8::Gemm g{((bf16*)(C.a->ws + WS_XN)), ((bf16*)(C.a->ws + WS_WIN)) + (size_t)l * NU * DM, MP, NU, DM}; pg8::StaticOrder S; S.init(MP, NU, gG, C.bid);
            pg8::EpiU E{((bf16*)(C.a->ws + WS_U)), ((float*)(C.a->ws + WS_DT)), (C.a->in[10]) + l * NH, ((float*)(C.a->ws + WS_RSA))};
            pg8::gemm_phase<pg8::EpiU, pg8::StaticOrder, GEMM_ALIGN, GEMM_SP2>(C.lds + RING_OFF, g, S, E, C.tid);
            } else p0_weights(C, IT_IN, DEPTH * IT_LAYER, (C.bid - gG) * NWAVES + C.wave, nsp * NWAVES);
            if (rep_ + 1 < REP_0) xcd_barrier(bar); }
            SEAM(pb + 0);
        }
        PROBE_END(0);
#endif
        PROBE_BEGIN(1);
        if (IN(pb + 1)) { for (int rep_ = 0; rep_ < REP_1; ++rep_) {
            FRESH_CTX();
            { volatile LAS unsigned* qctr = (volatile LAS unsigned*)(C.lds + MISC_OFF) + 24;
              if (C.tid == 0) qctr[0] = 0u;
              __syncthreads();
              const int nS = (NB * NG - C.bid + C.G - 1) / C.G, nR = (RF_ITEMS - C.bid + C.G - 1) / C.G;
              LAS float* wsc = (LAS float*)(C.lds + RING_OFF + C.wave * 8192);
              for (;;) { unsigned idx = 0u; if (C.lane == 0) idx = __hip_atomic_fetch_add((LAS unsigned*)qctr, 1u, __ATOMIC_RELAXED, __HIP_MEMORY_SCOPE_WORKGROUP);
                  idx = (unsigned)__builtin_amdgcn_readfirstlane((int)idx);
                  if ((int)idx >= nS + nR) break;
                  if ((int)idx < nS) { const int u = C.bid + C.G * (int)idx; sample_ssd_wave_unit(C, l, u >> 3, u & 7, wsc); }
                  else reformat_item(C, l, C.bid + C.G * ((int)idx - nS)); } }
            __syncthreads();
            if (PROBE_SUB == 1) probe_acc += __builtin_amdgcn_s_memrealtime() - probe_t0;
            if (PROBE_SUB == 2) probe_t0 = __builtin_amdgcn_s_memrealtime();
            zero_f32(C, ((float*)(C.a->ws + WS_RSB)), SEQ, C.bid, C.G);
            { float z0 = 0.f; asm volatile("" : "+v"(z0));
              for (int i = C.bid * 512 + C.tid; i < NB * DM / 4; i += C.G * 512) ((GAS f32x4*)(C.a->ws + WS_MS))[i] = (f32x4){z0, z0, z0, z0}; }
            for (int rr_ = 0; rr_ < REP_SATT; ++rr_) sample_attn_phase(C, l);
            if (PROBE_SUB == 2) probe_acc += __builtin_amdgcn_s_memrealtime() - probe_t0;
            if (PROBE_SUB == 3) probe_t0 = __builtin_amdgcn_s_memrealtime();
            if (PROBE_SUB == 3) { __syncthreads(); probe_acc += __builtin_amdgcn_s_memrealtime() - probe_t0; }
            if (rep_ + 1 < REP_1) xcd_barrier(bar); }
            SEAM(pb + 1);
        }
        PROBE_END(1);
        PROBE_BEGIN(2);
        if (IN(pb + 2)) { for (int rep_ = 0; rep_ < REP_2; ++rep_) {
            FRESH_CTX();
#ifdef USE_NSSD
            if (C.bid < NG) naive_ssd_prompt(C, l, C.bid);
            else {
                const int vb = C.bid - NG, nvb = C.G - NG;
                for (int u = vb; u < 64 * KVH; u += nvb) attn_prompt_unit(C, l, u >> 3, u & 7);
                for (int u = vb; u < 64 * NG; u += nvb) ssd_states_unit(C, u >> 3, u & 7);
            }
#else
            for (int rr_ = 0; rr_ < REP_ATT; ++rr_) for (int u = C.bid; u < 64 * KVH; u += C.G) attn_prompt_unit(C, l, u >> 3, u & 7);
            for (int rr_ = 0; rr_ < REP_PA; ++rr_) for (int u = C.bid; u < 64 * NG; u += C.G) ssd_states_unit(C, u >> 3, u & 7);
#endif
            if (rep_ + 1 < REP_2) xcd_barrier(bar); }
            SEAM(pb + 2);
        }
        PROBE_END(2);
        PROBE_BEGIN(3);
        if (IN(pb + 3)) { for (int rep_ = 0; rep_ < REP_3; ++rep_) { FRESH_CTX(); ssd_scan_phase(C, l); if (rep_ + 1 < REP_3) xcd_barrier(bar); } SEAM(pb + 3); }
        PROBE_END(3);
        PROBE_BEGIN(4);
        if (IN(pb + 4)) { for (int rep_ = 0; rep_ < REP_4; ++rep_) {
            FRESH_CTX();
#ifndef USE_NSSD
            for (int u = C.bid; u < 64 * NG; u += C.G) ssd_out_unit(C, l, u >> 3, u & 7);
#endif
            if (rep_ + 1 < REP_4) xcd_barrier(bar); }
            SEAM(pb + 4);
        }
        PROBE_END(4);
#ifndef NO_G2
        PROBE_BEGIN(5);
        if (IN(pb + 5)) { for (int rep_ = 0; rep_ < REP_5; ++rep_) {
            FRESH_CTX();
            pg8::Gemm g{((bf16*)(C.a->ws + WS_YO)), ((bf16*)(C.a->ws + WS_WCAT)) + (size_t)l * DM * KCAT, SEQ, DM, KCAT}; pg8::StaticOrder S; S.init(SEQ, DM, C.G, C.bid);
            pg8::EpiMerge E{((bf16*)(C.a->ws + WS_U)), ((bf16*)(C.a->ws + WS_MRG))};
            pg8::gemm_phase<pg8::EpiMerge, pg8::StaticOrder, true, true>(C.lds + RING_OFF, g, S, E, C.tid);
            mini_phase<0>(C, l);
            if (rep_ + 1 < REP_5) xcd_barrier(bar); }
            SEAM(pb + 5);
        }
        PROBE_END(5);
#endif
#ifndef NO_G3
        PROBE_BEGIN(6);
        if (IN(pb + 6)) { for (int rep_ = 0; rep_ < REP_6; ++rep_) {
            FRESH_CTX();
            pg8::Gemm g{((bf16*)(C.a->ws + WS_MRG)), ((bf16*)(C.a->ws + WS_WOUT)) + (size_t)l * DM * DM, SEQ, DM, DM}; pg8::StaticOrder S; S.init(SEQ, DM, C.G, C.bid);
            pg8::EpiResid E{l == 0 ? (C.a->in[0]) : (const float*)nullptr, ((bf16*)(C.a->ws + WS_XN)), ((float*)(C.a->ws + WS_RSB))};
            pg8::gemm_phase<pg8::EpiResid, pg8::StaticOrder, true, true>(C.lds + RING_OFF, g, S, E, C.tid);
            mini_phase<1>(C, l);
            if (rep_ + 1 < REP_6) xcd_barrier(bar); }
            SEAM(pb + 6);
        }
        PROBE_END(6);
#endif
        PROBE_BEGIN(7);
        if (IN(pb + 7)) { for (int rep_ = 0; rep_ < REP_7; ++rep_) { FRESH_CTX(); sample_rows_phase(C, ((float*)(C.a->ws + WS_RSB))); if (rep_ + 1 < REP_7) xcd_barrier(bar); } SEAM(pb + 7); }
        PROBE_END(7);
#ifndef NO_G4
        PROBE_BEGIN(8);
        if (IN(pb + 8)) { for (int rep_ = 0; rep_ < REP_8; ++rep_) {
            FRESH_CTX();
            const int nsp = C.G >= 64 ? (C.G * 14) / 256 : 0, gG = C.G - nsp;
            if (C.bid < gG) {
            pg8::Gemm g{((bf16*)(C.a->ws + WS_XN)), ((bf16*)(C.a->ws + WS_WGU)) + (size_t)l * NGU * DM, MP, NGU, DM}; pg8::StaticOrder S; S.init(MP, NGU, gG, C.bid);
            pg8::EpiSwiGLU E{((bf16*)(C.a->ws + WS_HB)), ((float*)(C.a->ws + WS_RSB))};
            pg8::gemm_phase<pg8::EpiSwiGLU, pg8::StaticOrder, GEMM_ALIGN, GEMM_SP2>(C.lds + RING_OFF, g, S, E, C.tid);
            } else { zero_f32(C, ((float*)(C.a->ws + WS_RSA)), SEQ, C.bid - gG, nsp); copy_outs(C, l, C.bid - gG, nsp); cache_shift(C, l, C.bid - gG, nsp); }
            if (nsp == 0) { zero_f32(C, ((float*)(C.a->ws + WS_RSA)), SEQ, C.bid, C.G); copy_outs(C, l, C.bid, C.G); cache_shift(C, l, C.bid, C.G); }
            if (rep_ + 1 < REP_8) xcd_barrier(bar); }
            SEAM(pb + 8);
        }
        PROBE_END(8);
#endif
#ifndef NO_G5
        PROBE_BEGIN(9);
        if (IN(pb + 9)) { for (int rep_ = 0; rep_ < REP_9; ++rep_) {
            FRESH_CTX();
            pg8::Gemm g{((bf16*)(C.a->ws + WS_HB)), ((bf16*)(C.a->ws + WS_WDN)) + (size_t)l * DM * FF, SEQ, DM, FF}; pg8::StaticOrder S; S.init(SEQ, DM, C.G, C.bid);
            pg8::EpiResid E{(const float*)nullptr, ((bf16*)(C.a->ws + WS_XN)), ((float*)(C.a->ws + WS_RSA))};
            pg8::gemm_phase<pg8::EpiResid, pg8::StaticOrder, true, true>(C.lds + RING_OFF, g, S, E, C.tid);
            mini_phase<2>(C, l);
            if (rep_ + 1 < REP_9) xcd_barrier(bar); }
            SEAM(pb + 9);
        }
        PROBE_END(9);
#endif
        PROBE_BEGIN(10);
        if (IN(pb + 10)) { for (int rep_ = 0; rep_ < REP_10; ++rep_) {
            FRESH_CTX();
            if (l + 1 < DEPTH) sample_rows_phase(C, ((float*)(C.a->ws + WS_RSA))); else final_norm_phase(C);
            if (rep_ + 1 < REP_10) xcd_barrier(bar); }
            SEAM(pb + 10);
        }
        PROBE_END(10);
    }
    if (PROBE_CLK && blockIdx.x == 0 && wave_s == 0 && lane_now() == 0) { const unsigned long long c1 = __builtin_amdgcn_s_memtime(), r1 = __builtin_amdgcn_s_memrealtime(); const unsigned long long clk_c0 = ((unsigned long long)MISC[17] << 32) | MISC[16], clk_r0 = ((unsigned long long)MISC[19] << 32) | MISC[18]; const unsigned long long dc = (c1 - clk_c0) * 10000ull, dr = r1 - clk_r0;
        while ((__builtin_amdgcn_s_memrealtime() - r1) * dr < dc) __builtin_amdgcn_s_sleep(8); }
    if (PROBE_LO >= 0 && blockIdx.x == 0 && wave_s == 0 && lane_now() == 0) { const unsigned long long t1 = __builtin_amdgcn_s_memrealtime(); while (__builtin_amdgcn_s_memrealtime() - t1 < (unsigned long long)PROBE_AMP * probe_acc) __builtin_amdgcn_s_sleep(8); }
#undef IN
#undef SEAM
}

extern "C" void kernel_launch(void* const* d_in, const int* in_sizes, int n_in, void* d_out, int out_size, void* d_ws, size_t ws_size, hipStream_t stream) {
    static int grid = 0;
    if (grid == 0) {
        if (n_in != 23 || (size_t)out_size != O_END || ws_size < WS_END) { fprintf(stderr, "kernel_launch: unexpected problem (n_in %d, out %d, ws %zu; need ws >= %zu); nothing launched\n", n_in, out_size, ws_size, (size_t)WS_END); grid = -1; return; }
        int dev = 0, cus = 0, per_cu = 0;
        if (hipGetDevice(&dev) != hipSuccess || hipDeviceGetAttribute(&cus, hipDeviceAttributeMultiprocessorCount, dev) != hipSuccess) { grid = -1; return; }
        if (hipFuncSetAttribute((const void*)fwd, hipFuncAttributeMaxDynamicSharedMemorySize, LDS_BYTES) != hipSuccess) { fprintf(stderr, "kernel_launch: hipFuncSetAttribute failed\n"); grid = -1; return; }
        if (hipOccupancyMaxActiveBlocksPerMultiprocessor(&per_cu, (const void*)fwd, NWAVES * 64, LDS_BYTES) != hipSuccess || per_cu < 1) { fprintf(stderr, "kernel_launch: occupancy query says %d blocks per CU\n", per_cu); }
        (void)hipGetLastError();
        grid = cus;
    }
    if (grid < 0) return;
    if (hipMemsetAsync((char*)d_ws + WS_CTL, 0, CTL_ZERO_BYTES, stream) != hipSuccess) return;
    Args a{};
    for (int i = 0; i < 23; ++i) a.in[i] = (const float*)d_in[i];
    a.out = (float*)d_out; a.ws = (unsigned char*)d_ws; a.pad = 0;
#if MK_SPLIT
    for (int p = 0; p < NPH; ++p) { a.ph_lo = p; a.ph_hi = p + 1; a.use_bar = 0; hipLaunchKernelGGL(fwd, dim3(grid), dim3(NWAVES * 64), LDS_BYTES, stream, a); }
#else
    a.ph_lo = 0; a.ph_hi = NPH; a.use_bar = 1;
    hipLaunchKernelGGL(fwd, dim3(grid), dim3(NWAVES * 64), LDS_BYTES, stream, a);
#endif
    const hipError_t le = hipPeekAtLastError();
    if (le != hipSuccess) fprintf(stderr, "kernel_launch: launch failed: %s\n", hipGetErrorName(le));
}
```

```cpp
#include <hip/hip_runtime.h>
#include <cstdio>
#include <cstdint>

constexpr int DM = 2048, SEQ = 8192, NB = 128, DEPTH = 2;
constexpr int MV = SEQ + NB;
constexpr int MP = 8448;
constexpr int DI = 4096, NH = 64, HP = 64, DS = 128, NG = 8, CD = 6144, CW = 4;
constexpr int AH = 32, KVH = 8, AD = 64, WIN = 128;
constexpr int FF = 5632;
constexpr int IN_DIM = 17472;
constexpr float EPS = 1e-6f;
constexpr int UZ = 0, UXBC = 4096, UQ = 10240, UK = 12288, UV = 12800, UGS = 13312, UGA = 15360, LDU = 17408;
__host__ __device__ __forceinline__ constexpr size_t UIDX(int row, int col) { return ((size_t)(row >> 7) * (LDU / 64) + (size_t)(col >> 6)) * 8192 + (size_t)(((row & 127) << 6) + (col & 63)); }
constexpr int NU = 17664;
constexpr int KCAT = DI + DM;
constexpr int NGU = 2 * FF;

constexpr size_t O_YP = 0;
constexpr size_t O_YS = O_YP + (size_t)SEQ * DM;
constexpr size_t O_PSSM = O_YS + (size_t)NB * DM;
constexpr size_t O_PCONV = O_PSSM + (size_t)DEPTH * NH * HP * DS;
constexpr size_t O_PK = O_PCONV + (size_t)DEPTH * 3 * CD;
constexpr size_t O_PV = O_PK + (size_t)DEPTH * WIN * KVH * AD;
constexpr size_t O_SSSM = O_PV + (size_t)DEPTH * WIN * KVH * AD;
constexpr size_t O_SCONV = O_SSSM + (size_t)DEPTH * NB * NH * HP * DS;
constexpr size_t O_SK = O_SCONV + (size_t)DEPTH * NB * 3 * CD;
constexpr size_t O_SV = O_SK + (size_t)DEPTH * NB * WIN * KVH * AD;
constexpr size_t O_END = O_SV + (size_t)DEPTH * NB * WIN * KVH * AD;
static_assert(O_END == 190877696ull, "output size");

constexpr size_t al256(size_t x) { return (x + 255) & ~(size_t)255; }
constexpr size_t WS_CTL = 0, CTL_ZERO_BYTES = 1u << 20;
constexpr size_t SZ_WIN = (size_t)NU * DM * 2, SZ_WCAT = (size_t)DM * KCAT * 2, SZ_WOUT = (size_t)DM * DM * 2, SZ_WGU = (size_t)NGU * DM * 2, SZ_WDN = (size_t)DM * FF * 2;
constexpr size_t WS_WIN = 1u << 20;
constexpr size_t WS_WCAT = WS_WIN + DEPTH * SZ_WIN;
constexpr size_t WS_WOUT = WS_WCAT + DEPTH * SZ_WCAT;
constexpr size_t WS_WGU = WS_WOUT + DEPTH * SZ_WOUT;
constexpr size_t WS_WDN = WS_WGU + DEPTH * SZ_WGU;
constexpr size_t WS_X = WS_WDN + DEPTH * SZ_WDN;
constexpr size_t WS_XN = WS_X + (size_t)MP * DM * 4;
constexpr size_t WS_U = WS_XN + (size_t)MP * DM * 2;
constexpr size_t WS_DT = WS_U + (size_t)MP * LDU * 2;
constexpr size_t WS_YO = WS_DT + (size_t)MP * 64 * 4;
constexpr size_t WS_MRG = WS_YO + (size_t)MP * KCAT * 2;
constexpr size_t WS_HB = WS_MRG + (size_t)MP * DM * 2;
constexpr size_t WS_XT = WS_HB + (size_t)MP * FF * 2;
constexpr size_t WS_BRM = WS_XT + (size_t)64 * 64 * 64 * 128 * 2;
constexpr size_t WS_BT = WS_BRM + (size_t)64 * 8 * 128 * 128 * 2;
constexpr size_t WS_CRM = WS_BT + (size_t)64 * 8 * 128 * 128 * 2;
constexpr size_t WS_DTT = WS_CRM + (size_t)64 * 8 * 128 * 128 * 2;
constexpr size_t WS_ACS = WS_DTT + (size_t)64 * 64 * 128 * 4;
constexpr size_t WS_VT = WS_ACS + (size_t)64 * 64 * 128 * 4;
constexpr size_t WS_ST = WS_VT + (size_t)8 * 64 * 8192 * 2;
constexpr size_t WS_HS = WS_ST + (size_t)64 * 64 * 64 * 128 * 4;
constexpr size_t WS_MS = WS_HS + (size_t)64 * 64 * 64 * 128 * 2;
constexpr size_t WS_RSA = WS_MS + (size_t)NB * DM * 4;
constexpr size_t WS_RSB = WS_RSA + (size_t)MP * 4;
constexpr size_t WS_END = WS_RSB + (size_t)MP * 4;
static_assert(WS_WIN % 256 == 0 && WS_X % 256 == 0 && WS_U % 256 == 0 && WS_YO % 256 == 0 && WS_HB % 256 == 0 && WS_XT % 256 == 0 && WS_ST % 256 == 0, "ws alignment");
constexpr int CW_BAR = 4096;

constexpr int RING_OFF = 0, RING_BYTES = 131072;
constexpr int PC_B = 0, PC_C = 34816, PC_Y = 69632, PC_SSQ = 139264, PC_AD = 143360, PC_END = 151552;
constexpr int LDSCTL_OFF = PC_END, MISC_OFF = LDSCTL_OFF + 320;
constexpr int LDS_BYTES = 155648;
constexpr int NWAVES = 8;
#define MK_SPLIT 0
namespace pg8 {
#define PG8_LAS __attribute__((address_space(3)))
typedef unsigned short bf16_t;
typedef short bf16x8 __attribute__((ext_vector_type(8)));
typedef float f32x4 __attribute__((ext_vector_type(4)));
typedef unsigned u32x4 __attribute__((ext_vector_type(4)));
constexpr int BM = 256, BK = 64, HALF = 128, HTB = HALF * BK * 2  , STAGE_BYTES = 8 * HTB, NXCD = 8, WGM = 8;

__host__ __device__ __forceinline__ int lds_byte(int r, int c) { const int st = (r >> 4) * 2 + (c >> 5), rr = r & 15, cc = c & 31, ob = rr * 64 + cc * 2; return st * 1024 + (ob ^ (((ob >> 9) & 1) << 5)); }
__host__ __device__ __forceinline__ void stage_rc(int b, int& R, int& C) { const int st = b / 1024, sb = b % 1024, swz = sb ^ (((sb >> 9) & 1) << 5); R = (st >> 1) * 16 + swz / 64; C = (st & 1) * 32 + (swz % 64) / 2; }
__host__ __device__ __forceinline__ int perm32(int rho) { const int n = rho >> 4, i = rho & 15; return 8 * (i >> 2) + 4 * n + (i & 3); }

struct Unit { int pm, pn; };
struct Gemm { const bf16_t* A; const bf16_t* Bt; int M, N, K; };

struct StaticOrder {
    int nM, nN, nwg, G, c;
    __host__ __device__ void init(int M, int N, int G_, int c_) { nM = M / BM; nN = N / BM; nwg = nM * nN; G = G_; c = c_; }
    __host__ __device__ bool next(int i, Unit& u) const {
        const long L = (long)i * G + c; if (L >= nwg) return false;
        int wgid = (int)L; { const int q = nwg / NXCD, r = nwg % NXCD, xcd = wgid % NXCD, off = wgid / NXCD; wgid = (xcd < r ? xcd * (q + 1) : r * (q + 1) + (xcd - r) * q) + off; }
        const int nig = WGM * nN, gid = wgid / nig, fm = gid * WGM, gsz = (nM - fm) < WGM ? (nM - fm) : WGM;
        u.pm = fm + ((wgid % nig) % gsz); u.pn = (wgid % nig) / gsz; return true;
    }
    __device__ __forceinline__ void a_ready(const Unit&) const {}
    __device__ __forceinline__ void done(const Unit&) const {}
};
__device__ __forceinline__ unsigned cvt_pk_bf16(float lo, float hi) { unsigned r; asm volatile("v_cvt_pk_bf16_f32 %0, %1, %2" : "=v"(r) : "v"(lo), "v"(hi)); return r; }
__device__ __forceinline__ float bf_lo(unsigned w) { return __uint_as_float(w << 16); }
__device__ __forceinline__ float bf_hi(unsigned w) { return __uint_as_float(w & 0xffff0000u); }
__device__ __forceinline__ float sigmoidf_(float x) { return __builtin_amdgcn_rcpf(1.0f + __expf(-x)); }
constexpr int E_MV = 8320, E_LDU = 17408, E_UGS = 13312, E_UGA = 15360;
__device__ __forceinline__ size_t e_uidx(int row, int col) { return ((size_t)(row >> 7) * (E_LDU / 64) + (size_t)(col >> 6)) * 8192 + (size_t)(((row & 127) << 6) + (col & 63)); }
struct EpiU {
    static constexpr bool PERM = true, AFTER_DRAIN = false, HOOK = false, RSLDS = true; static constexpr int HOOK_T = -1;
    bf16_t* U; float* DT; const float* dtb; const float* RS;
    __device__ __forceinline__ void hook(f32x4 (&)[2][2][4][2], const Unit&, int, int, int, int) const {}
    __device__ __forceinline__ static float softplus_(float x) { return x > 20.0f ? x : log1pf(__expf(x)); }
    __device__ __forceinline__ void operator()(const f32x4 (&acc)[2][2][4][2], const Unit& u, int wr, int wc, int fr, int fq, const float (&rsv)[8]) const {
        const int row0 = u.pm * BM + wr * 64 + fr;
        auto rstd_ = [&](int q) { return rsqrtf(rsv[q] * (1.0f / 2048.0f) + 1e-6f); };
        if (u.pn == 68) {
            if (wc < 2) { const f32x4 b0 = *(const f32x4*)(dtb + wc * 32 + 8 * fq), b1 = *(const f32x4*)(dtb + wc * 32 + 8 * fq + 4);
#pragma unroll
                for (int ai = 0; ai < 2; ++ai) { if (u.pm * BM + ai * HALF >= E_MV) continue;
#pragma unroll
                    for (int m = 0; m < 4; ++m) { float* p = DT + (size_t)(row0 + ai * HALF + m * 16) * 64 + wc * 32 + 8 * fq; const float rs = rstd_(ai * 4 + m); f32x4 v0 = acc[ai][0][m][0] * rs + b0, v1 = acc[ai][0][m][1] * rs + b1;
#pragma unroll
                        for (int e = 0; e < 4; ++e) { v0[e] = softplus_(v0[e]); v1[e] = softplus_(v1[e]); }
                        *(f32x4*)p = v0; *(f32x4*)(p + 4) = v1; } }
            }
            return;
        }
        const bool sig = u.pn >= 52, zsilu = u.pn < 16;
        const int col0 = u.pn * BM + wc * 32 + 8 * fq;
#pragma unroll
        for (int ai = 0; ai < 2; ++ai) { if (u.pm * BM + ai * HALF >= E_MV) continue;
#pragma unroll
            for (int m = 0; m < 4; ++m) { const int rr = row0 + ai * HALF + m * 16; const float rs = rstd_(ai * 4 + m);
#pragma unroll
                for (int bj = 0; bj < 2; ++bj) { f32x4 v0 = acc[ai][bj][m][0] * rs, v1 = acc[ai][bj][m][1] * rs;
                    if (sig) {
#pragma unroll
                        for (int e = 0; e < 4; ++e) { v0[e] = sigmoidf_(v0[e]); v1[e] = sigmoidf_(v1[e]); } }
                    if (zsilu) {
#pragma unroll
                        for (int e = 0; e < 4; ++e) { v0[e] = v0[e] * sigmoidf_(v0[e]); v1[e] = v1[e] * sigmoidf_(v1[e]); } }
                    u32x4 w; w.x = cvt_pk_bf16(v0[0], v0[1]); w.y = cvt_pk_bf16(v0[2], v0[3]); w.z = cvt_pk_bf16(v1[0], v1[1]); w.w = cvt_pk_bf16(v1[2], v1[3]);
                    *(u32x4*)(U + e_uidx(rr, col0 + bj * HALF)) = w; } } }
    }
};
struct EpiMerge {
    static constexpr bool PERM = true, AFTER_DRAIN = false, HOOK = true, RSLDS = false; static constexpr int HOOK_T = 64;
    const bf16_t* U; bf16_t* O;
    __device__ __forceinline__ void hook(f32x4 (&acc)[2][2][4][2], const Unit& u, int wr, int wc, int fr, int fq) const {
        asm volatile("" : "+v"(fr), "+v"(fq));
        const int row0 = u.pm * BM + wr * 64 + fr, col0 = u.pn * BM + wc * 32 + 8 * fq;
#pragma unroll
        for (int ai = 0; ai < 2; ++ai) { if (u.pm * BM + ai * HALF >= E_MV) continue;
#pragma unroll
            for (int mp = 0; mp < 2; ++mp) {
                u32x4 gs[2][2], ga[2][2];
#pragma unroll
                for (int mm = 0; mm < 2; ++mm) { const int rr = row0 + ai * HALF + (2 * mp + mm) * 16;
#pragma unroll
                    for (int bj = 0; bj < 2; ++bj) { gs[mm][bj] = *(const u32x4*)(U + e_uidx(rr, E_UGS + col0 + bj * HALF)); ga[mm][bj] = *(const u32x4*)(U + e_uidx(rr, E_UGA + col0 + bj * HALF)); } }
#pragma unroll
                for (int mm = 0; mm < 2; ++mm) { const int m = 2 * mp + mm;
#pragma unroll
                    for (int bj = 0; bj < 2; ++bj) { const u32x4 s = gs[mm][bj], a = ga[mm][bj]; f32x4 r0, r1;
                        r0[0] = bf_lo(s.x) * __builtin_amdgcn_rcpf(fmaxf(bf_lo(a.x), 1e-20f)); r0[1] = bf_hi(s.x) * __builtin_amdgcn_rcpf(fmaxf(bf_hi(a.x), 1e-20f)); r0[2] = bf_lo(s.y) * __builtin_amdgcn_rcpf(fmaxf(bf_lo(a.y), 1e-20f)); r0[3] = bf_hi(s.y) * __builtin_amdgcn_rcpf(fmaxf(bf_hi(a.y), 1e-20f));
                        r1[0] = bf_lo(s.z) * __builtin_amdgcn_rcpf(fmaxf(bf_lo(a.z), 1e-20f)); r1[1] = bf_hi(s.z) * __builtin_amdgcn_rcpf(fmaxf(bf_hi(a.z), 1e-20f)); r1[2] = bf_lo(s.w) * __builtin_amdgcn_rcpf(fmaxf(bf_lo(a.w), 1e-20f)); r1[3] = bf_hi(s.w) * __builtin_amdgcn_rcpf(fmaxf(bf_hi(a.w), 1e-20f));
                        acc[ai][bj][m][0] *= r0; acc[ai][bj][m][1] *= r1; }
                    asm volatile("" : "+v"(acc[ai][0][m][0]), "+v"(acc[ai][0][m][1]), "+v"(acc[ai][1][m][0]), "+v"(acc[ai][1][m][1]) :: "memory"); } } }
    }
    __device__ __forceinline__ void operator()(const f32x4 (&acc)[2][2][4][2], const Unit& u, int wr, int wc, int fr, int fq) const {
        const int row0 = u.pm * BM + wr * 64 + fr, col0 = u.pn * BM + wc * 32 + 8 * fq;
        u32x4 gav[2][4][2];
#pragma unroll
        for (int ai = 0; ai < 2; ++ai)
#pragma unroll
            for (int m = 0; m < 4; ++m)
#pragma unroll
                for (int bj = 0; bj < 2; ++bj) gav[ai][m][bj] = *(const u32x4*)(U + e_uidx(row0 + ai * HALF + m * 16, E_UGA + col0 + bj * HALF));
#pragma unroll
        for (int ai = 0; ai < 2; ++ai)
#pragma unroll
            for (int m = 0; m < 4; ++m) { const size_t r = (size_t)(row0 + ai * HALF + m * 16);
#pragma unroll
                for (int bj = 0; bj < 2; ++bj) { const u32x4 ga = gav[ai][m][bj];
                    const f32x4 v0 = acc[ai][bj][m][0], v1 = acc[ai][bj][m][1];
                    u32x4 w; w.x = cvt_pk_bf16(v0[0] * bf_lo(ga.x), v0[1] * bf_hi(ga.x)); w.y = cvt_pk_bf16(v0[2] * bf_lo(ga.y), v0[3] * bf_hi(ga.y));
                    w.z = cvt_pk_bf16(v1[0] * bf_lo(ga.z), v1[1] * bf_hi(ga.z)); w.w = cvt_pk_bf16(v1[2] * bf_lo(ga.w), v1[3] * bf_hi(ga.w));
                    *(u32x4*)(O + r * 2048 + col0 + bj * HALF) = w; } }
    }
};
struct EpiResid {
    static constexpr bool PERM = true, AFTER_DRAIN = false, HOOK = false, RSLDS = false; static constexpr int HOOK_T = -1;
    const float* Xf; bf16_t* XB; float* RS;
    __device__ __forceinline__ void hook(f32x4 (&)[2][2][4][2], const Unit&, int, int, int, int) const {}
    __device__ __forceinline__ void tail_(f32x4 x0, f32x4 x1, float& ss, bf16_t* dst) const {
        ss += ((x0[0] * x0[0] + x0[1] * x0[1]) + (x0[2] * x0[2] + x0[3] * x0[3])) + ((x1[0] * x1[0] + x1[1] * x1[1]) + (x1[2] * x1[2] + x1[3] * x1[3]));
        u32x4 o; o.x = cvt_pk_bf16(x0[0], x0[1]); o.y = cvt_pk_bf16(x0[2], x0[3]); o.z = cvt_pk_bf16(x1[0], x1[1]); o.w = cvt_pk_bf16(x1[2], x1[3]);
        *(u32x4*)dst = o;
    }
    __device__ __forceinline__ void operator()(const f32x4 (&acc)[2][2][4][2], const Unit& u, int wr, int wc, int fr, int fq) const {
        const int row0 = u.pm * BM + wr * 64 + fr, col0 = u.pn * BM + wc * 32 + 8 * fq;
        if (Xf) {
#pragma unroll
            for (int ai = 0; ai < 2; ++ai) { f32x4 xo[4][2][2];
#pragma unroll
                for (int m = 0; m < 4; ++m)
#pragma unroll
                    for (int bj = 0; bj < 2; ++bj) { const float* p = Xf + (size_t)(row0 + ai * HALF + m * 16) * 2048 + col0 + bj * HALF; xo[m][bj][0] = *(const f32x4*)p; xo[m][bj][1] = *(const f32x4*)(p + 4); }
#pragma unroll
                for (int m = 0; m < 4; ++m) { const size_t ro = (size_t)(row0 + ai * HALF + m * 16) * 2048 + col0; float ss = 0.f;
#pragma unroll
                    for (int bj = 0; bj < 2; ++bj) tail_(xo[m][bj][0] + acc[ai][bj][m][0], xo[m][bj][1] + acc[ai][bj][m][1], ss, XB + ro + bj * HALF);
                    ss += __shfl_xor(ss, 16); ss += __shfl_xor(ss, 32);
                    if (fq == 0) unsafeAtomicAdd(RS + row0 + ai * HALF + m * 16, ss); } }
        } else {
            u32x4 xw[2][4][2];
#pragma unroll
            for (int ai = 0; ai < 2; ++ai)
#pragma unroll
                for (int m = 0; m < 4; ++m)
#pragma unroll
                    for (int bj = 0; bj < 2; ++bj) xw[ai][m][bj] = *(const u32x4*)(XB + (size_t)(row0 + ai * HALF + m * 16) * 2048 + col0 + bj * HALF);
#pragma unroll
            for (int ai = 0; ai < 2; ++ai)
#pragma unroll
                for (int m = 0; m < 4; ++m) { const size_t ro = (size_t)(row0 + ai * HALF + m * 16) * 2048 + col0; float ss = 0.f;
#pragma unroll
                    for (int bj = 0; bj < 2; ++bj) { const u32x4 w = xw[ai][m][bj];
                        tail_((f32x4){bf_lo(w.x), bf_hi(w.x), bf_lo(w.y), bf_hi(w.y)} + acc[ai][bj][m][0], (f32x4){bf_lo(w.z), bf_hi(w.z), bf_lo(w.w), bf_hi(w.w)} + acc[ai][bj][m][1], ss, XB + ro + bj * HALF); }
                    ss += __shfl_xor(ss, 16); ss += __shfl_xor(ss, 32);
                    if (fq == 0) unsafeAtomicAdd(RS + row0 + ai * HALF + m * 16, ss); }
        }
    }
};
struct EpiSwiGLU {
    static constexpr bool PERM = true, AFTER_DRAIN = false, HOOK = false, RSLDS = true; static constexpr int HOOK_T = -1;
    bf16_t* H; const float* RS;
    __device__ __forceinline__ void hook(f32x4 (&)[2][2][4][2], const Unit&, int, int, int, int) const {}
    __device__ __forceinline__ void operator()(const f32x4 (&acc)[2][2][4][2], const Unit& u, int wr, int wc, int fr, int fq, const float (&rsv)[8]) const {
        const int row0 = u.pm * BM + wr * 64 + fr, col0 = u.pn * 128 + wc * 16 + 4 * fq;
#pragma unroll
        for (int ai = 0; ai < 2; ++ai) { if (u.pm * BM + ai * HALF >= E_MV) continue;
#pragma unroll
            for (int m = 0; m < 4; ++m) { bf16_t* rowp = H + (size_t)(row0 + ai * HALF + m * 16) * 5632 + col0; const float rs = rsqrtf(rsv[ai * 4 + m] * (1.0f / 2048.0f) + 1e-6f);
#pragma unroll
                for (int bj = 0; bj < 2; ++bj) { const f32x4 g = acc[ai][bj][m][0] * rs, up = acc[ai][bj][m][1] * rs; float h[4];
#pragma unroll
                    for (int e = 0; e < 4; ++e) h[e] = g[e] * __builtin_amdgcn_rcpf(1.0f + __expf(-g[e])) * up[e];
                    typedef unsigned u32x2v __attribute__((ext_vector_type(2))); u32x2v w; w.x = cvt_pk_bf16(h[0], h[1]); w.y = cvt_pk_bf16(h[2], h[3]);
                    *(u32x2v*)(rowp + bj * 64) = w; } } }
    }
};
template <class Epi, class Sched, bool ALIGN_EPI = false, bool SP2 = false>
__device__ __forceinline__ void gemm_phase(PG8_LAS unsigned char* lds, const Gemm g, const Sched& S, const Epi& E, int tid_in) {
    int tid_l = tid_in; asm volatile("" : "+v"(tid_l));
    const int tid = tid_l, wid = __builtin_amdgcn_readfirstlane(tid >> 6), lane = tid & 63, wr = wid >> 2, wc = wid & 3, fr = lane & 15, fq = lane >> 4;
    const int K = g.K, nt = K / BK;
    unsigned voffA[2], voffB[2];
#pragma unroll
    for (int i = 0; i < 2; ++i) { int R, C; stage_rc(tid * 16 + i * 8192, R, C); const int Rb = Epi::PERM ? ((R & ~31) + perm32(R & 31)) : R;
        voffA[i] = (unsigned)(R * K + C) * 2u; voffB[i] = (unsigned)(Rb * K + C) * 2u; }
    const size_t kstep = (size_t)(BK * 2);
    const size_t hstep = (size_t)HALF * K * 2;
    const size_t tstep = 2 * hstep;
    const unsigned ldsw = (unsigned)wid * 1024u;
    const int aoff = lds_byte(wr * 64 + fr, fq * 8), boff = lds_byte(wc * 32 + fr, fq * 8);
#define PG8_SA(b, h) (((b) * 2 + (h)) * HTB)
#define PG8_SB(b, h) ((4 + (b) * 2 + (h)) * HTB)
#define PG8_STAGE(bufoff, gbase, voff) do { _Pragma("unroll") for (int _i = 0; _i < 2; ++_i) \
        __builtin_amdgcn_global_load_lds((const unsigned*)((const char*)(gbase) + (voff)[_i]), (PG8_LAS unsigned*)(lds + (bufoff) + ldsw + _i * 8192), 16, 0, 0); } while (0)
#define PG8_LDA(dst, b, h) do { _Pragma("unroll") for (int m = 0; m < 4; ++m) _Pragma("unroll") for (int k = 0; k < 2; ++k) dst[m][k] = *(const PG8_LAS bf16x8*)(lds + PG8_SA(b, h) + aoff + m * 2048 + k * 1024); } while (0)
#define PG8_LDB(dst, b, h) do { _Pragma("unroll") for (int n = 0; n < 2; ++n) _Pragma("unroll") for (int k = 0; k < 2; ++k) dst[n][k] = *(const PG8_LAS bf16x8*)(lds + PG8_SB(b, h) + boff + n * 2048 + k * 1024); } while (0)
#define PG8_MMA(ai, bj, At, Bt) do { __builtin_amdgcn_s_setprio(1); _Pragma("unroll") for (int m = 0; m < 4; ++m) _Pragma("unroll") for (int n = 0; n < 2; ++n) _Pragma("unroll") for (int k = 0; k < 2; ++k) \
        acc[ai][bj][m][n] = __builtin_amdgcn_mfma_f32_16x16x32_bf16(Bt[n][k], At[m][k], acc[ai][bj][m][n], 0, 0, 0); __builtin_amdgcn_s_setprio(0); } while (0)
#define PG8_WAIT_V(n) asm volatile("s_waitcnt vmcnt(" #n ")" ::: "memory")
#define PG8_WAIT_L(n) asm volatile("s_waitcnt lgkmcnt(" #n ")" ::: "memory")
#define PG8_BAR __builtin_amdgcn_s_barrier()
#define PG8_SCHED __builtin_amdgcn_sched_barrier(0)
    Unit cur, nxt; int ui = 0;
    if (!S.next(0, cur)) return;
    f32x4 acc[2][2][4][2];
#pragma unroll
    for (int a = 0; a < 2; ++a)
#pragma unroll
        for (int b = 0; b < 2; ++b)
#pragma unroll
            for (int m = 0; m < 4; ++m)
#pragma unroll
                for (int n = 0; n < 2; ++n) acc[a][b][m][n] = (f32x4){0.f, 0.f, 0.f, 0.f};
    bf16x8 At[4][2], B0[2][2], B1[2][2];
    const char* cA = (const char*)g.A + (size_t)cur.pm * tstep; const char* cB = (const char*)g.Bt + (size_t)cur.pn * tstep;
    S.a_ready(cur);
#define PG8_RSDMA(pm_, par_) __builtin_amdgcn_global_load_lds((const unsigned*)(E.RS + (pm_) * BM + wid * 64 + ((fq << 4) | fr)), (PG8_LAS unsigned*)(lds + 131072 + (par_) * 1024 + wid * 256), 4, 0, 0)
    if constexpr (Epi::RSLDS) { if (wid < 4) PG8_RSDMA(cur.pm, 0); }
    if constexpr (SP2) {
        PG8_STAGE(PG8_SB(0, 0), cB, voffB); PG8_STAGE(PG8_SB(0, 1), cB + hstep, voffB); PG8_STAGE(PG8_SA(0, 0), cA, voffA); PG8_STAGE(PG8_SA(0, 1), cA + hstep, voffA);
        if (wr == 1) PG8_BAR;
        PG8_WAIT_V(2); PG8_BAR;
        PG8_STAGE(PG8_SB(1, 0), cB + kstep, voffB); PG8_STAGE(PG8_SA(1, 0), cA + kstep, voffA); PG8_STAGE(PG8_SB(1, 1), cB + hstep + kstep, voffB);
        PG8_WAIT_V(6); PG8_BAR;
    } else {
        PG8_STAGE(PG8_SB(0, 0), cB, voffB); PG8_STAGE(PG8_SA(0, 0), cA, voffA); PG8_STAGE(PG8_SB(0, 1), cB + hstep, voffB); PG8_STAGE(PG8_SA(0, 1), cA + hstep, voffA);
        if (wr == 1) PG8_BAR;
        PG8_WAIT_V(4); PG8_BAR;
        PG8_STAGE(PG8_SB(1, 0), cB + kstep, voffB); PG8_STAGE(PG8_SA(1, 0), cA + kstep, voffA); PG8_STAGE(PG8_SB(1, 1), cB + hstep + kstep, voffB);
        PG8_WAIT_V(6); PG8_BAR;
    }
    for (;;) {
        const bool has_next = S.next(ui + 1, nxt);
        const char* nA = has_next ? (const char*)g.A + (size_t)nxt.pm * tstep : cA; const char* nB = has_next ? (const char*)g.Bt + (size_t)nxt.pn * tstep : cB;
        for (int t = 0; t < nt; t += 2) {
            const bool last = (t == nt - 2);
            const char* a1 = cA + (size_t)(t + 1) * kstep;
            const char* a2 = last ? nA : cA + (size_t)(t + 2) * kstep; const char* b2 = last ? nB : cB + (size_t)(t + 2) * kstep;
            const char* a3 = a2 + kstep; const char* b3 = b2 + kstep;
            if (last && has_next) S.a_ready(nxt);
            if constexpr (Epi::HOOK) { if (t == Epi::HOOK_T) E.hook(acc, cur, wr, wc, fr, fq); }
            if constexpr (SP2) {
            PG8_LDB(B0, 0, 0); PG8_LDB(B1, 0, 1); PG8_SCHED; PG8_LDA(At, 0, 0); PG8_STAGE(PG8_SA(1, 1), a1 + hstep, voffA);
            PG8_WAIT_V(8); PG8_WAIT_L(0); PG8_BAR; PG8_MMA(0, 0, At, B0); PG8_MMA(0, 1, At, B1); PG8_BAR; PG8_SCHED;
            PG8_LDA(At, 0, 1); PG8_STAGE(PG8_SB(0, 0), b2, voffB); PG8_STAGE(PG8_SB(0, 1), b2 + hstep, voffB); PG8_STAGE(PG8_SA(0, 0), a2, voffA);
            PG8_WAIT_V(8); PG8_WAIT_L(0); PG8_BAR; PG8_MMA(1, 0, At, B0); PG8_MMA(1, 1, At, B1); PG8_BAR; PG8_SCHED;
            PG8_LDB(B0, 1, 0); PG8_LDB(B1, 1, 1); PG8_SCHED; PG8_LDA(At, 1, 0); PG8_STAGE(PG8_SA(0, 1), a2 + hstep, voffA);
            PG8_WAIT_V(8); PG8_WAIT_L(0); PG8_BAR; PG8_MMA(0, 0, At, B0); PG8_MMA(0, 1, At, B1); PG8_BAR; PG8_SCHED;
            PG8_LDA(At, 1, 1); PG8_STAGE(PG8_SB(1, 0), b3, voffB); PG8_STAGE(PG8_SB(1, 1), b3 + hstep, voffB); PG8_STAGE(PG8_SA(1, 0), a3, voffA);
            PG8_WAIT_V(8); PG8_WAIT_L(0); PG8_BAR; PG8_MMA(1, 0, At, B0); PG8_MMA(1, 1, At, B1); PG8_BAR; PG8_SCHED;
            } else {
            PG8_LDB(B0, 0, 0); PG8_SCHED; PG8_LDA(At, 0, 0); PG8_STAGE(PG8_SA(1, 1), a1 + hstep, voffA);
            PG8_WAIT_L(8); PG8_BAR; PG8_WAIT_L(0); PG8_MMA(0, 0, At, B0); PG8_BAR; PG8_SCHED;
            PG8_LDB(B1, 0, 1); PG8_STAGE(PG8_SB(0, 0), b2, voffB);
            PG8_BAR; PG8_WAIT_L(0); PG8_MMA(0, 1, At, B1); PG8_BAR;
            PG8_LDA(At, 0, 1); PG8_STAGE(PG8_SA(0, 0), a2, voffA);
            PG8_BAR; PG8_WAIT_L(0); PG8_MMA(1, 0, At, B0); PG8_BAR; PG8_SCHED;
            PG8_STAGE(PG8_SB(0, 1), b2 + hstep, voffB);
            PG8_WAIT_V(6); PG8_BAR; PG8_MMA(1, 1, At, B1); PG8_BAR;
            PG8_LDB(B0, 1, 0); PG8_SCHED; PG8_LDA(At, 1, 0); PG8_STAGE(PG8_SA(0, 1), a2 + hstep, voffA);
            PG8_WAIT_L(8); PG8_BAR; PG8_WAIT_L(0); PG8_MMA(0, 0, At, B0); PG8_BAR; PG8_SCHED;
            PG8_LDB(B1, 1, 1); PG8_STAGE(PG8_SB(1, 0), b3, voffB);
            PG8_BAR; PG8_WAIT_L(0); PG8_MMA(0, 1, At, B1); PG8_BAR;
            PG8_LDA(At, 1, 1); PG8_STAGE(PG8_SA(1, 0), a3, voffA);
            PG8_BAR; PG8_WAIT_L(0); PG8_MMA(1, 0, At, B0); PG8_BAR; PG8_SCHED;
            PG8_STAGE(PG8_SB(1, 1), b3 + hstep, voffB);
            PG8_WAIT_V(6); PG8_BAR; PG8_MMA(1, 1, At, B1); PG8_BAR;
            }
        }
        if constexpr (ALIGN_EPI) { if (wr == 0) PG8_BAR; }
        if constexpr (!Epi::AFTER_DRAIN) {
            if constexpr (Epi::RSLDS) { float rsv[8]; const PG8_LAS float* rsl = (const PG8_LAS float*)(lds + 131072 + (ui & 1) * 1024) + wr * 64 + fr;
#pragma unroll
                for (int q = 0; q < 8; ++q) rsv[q] = rsl[(q >> 2) * HALF + (q & 3) * 16];
                asm volatile("s_waitcnt lgkmcnt(0)" : "+v"(rsv[0]), "+v"(rsv[1]), "+v"(rsv[2]), "+v"(rsv[3]), "+v"(rsv[4]), "+v"(rsv[5]), "+v"(rsv[6]), "+v"(rsv[7]) :: "memory");
                if (has_next && wid < 4) PG8_RSDMA(nxt.pm, (ui + 1) & 1);
                E(acc, cur, wr, wc, fr, fq, rsv);
            } else E(acc, cur, wr, wc, fr, fq);
            S.done(cur); }
        if (!has_next) break;
#pragma unroll
        for (int a = 0; a < 2; ++a)
#pragma unroll
            for (int b = 0; b < 2; ++b)
#pragma unroll
                for (int m = 0; m < 4; ++m)
#pragma unroll
                    for (int n = 0; n < 2; ++n) acc[a][b][m][n] = (f32x4){0.f, 0.f, 0.f, 0.f};
        cur = nxt; cA = nA; cB = nB; ++ui;
        if constexpr (ALIGN_EPI) { if (wr == 1) PG8_BAR; }
    }
    PG8_WAIT_V(0);
    if constexpr (!ALIGN_EPI) { if (wr == 0) PG8_BAR; }
    PG8_BAR;
    if constexpr (Epi::AFTER_DRAIN) { E.fused(acc, cur, wr, wc, fr, fq, lds, wid, lane); S.done(cur); }
#undef PG8_RSDMA
#undef PG8_SA
#undef PG8_SB
#undef PG8_STAGE
#undef PG8_LDA
#undef PG8_LDB
#undef PG8_MMA
#undef PG8_WAIT_V
#undef PG8_WAIT_L
#undef PG8_BAR
#undef PG8_SCHED
}
}
#define GAS __attribute__((address_space(1)))
#define LAS __attribute__((address_space(3)))
typedef unsigned short bf16;
typedef unsigned v4u __attribute__((ext_vector_type(4)));
typedef float f32x4 __attribute__((ext_vector_type(4)));
typedef short bf16x8 __attribute__((ext_vector_type(8)));
typedef GAS unsigned gu32;
typedef GAS unsigned long long gu64;
#define RLX_AGENT __ATOMIC_RELAXED, __HIP_MEMORY_SCOPE_AGENT
#define LDS_WAIT() asm volatile("s_waitcnt lgkmcnt(0)" ::: "memory")
#define VM_WAIT() asm volatile("s_waitcnt vmcnt(0)" ::: "memory")
__device__ __forceinline__ unsigned long long rt() { return __builtin_amdgcn_s_memrealtime(); }
__device__ __forceinline__ unsigned f2bf(float f) { unsigned u = __builtin_bit_cast(unsigned, f); return (u + 0x7fffu + ((u >> 16) & 1u)) >> 16; }
__device__ __forceinline__ unsigned pk2(float lo, float hi) { return f2bf(lo) | (f2bf(hi) << 16); }

#define XB_TMO      128
#define XB_XCNT(j)  (256  + 64 * (j))
#define XB_XSUB(j)  (1280 + 64 * (j))
#define XB_XGEN(j)  (2304 + 64 * (j))
#define XB_TOP      3328
#define XB_TOPGEN   3392
#define XCD_BAR_WORDS 3456
#define XB_SPIN_CAP (1u << 18)

__device__ __forceinline__ unsigned xb_ld(unsigned* p)              { return __hip_atomic_load(p, __ATOMIC_RELAXED, __HIP_MEMORY_SCOPE_AGENT); }
__device__ __forceinline__ unsigned xb_add(unsigned* p, unsigned v) { return __hip_atomic_fetch_add(p, v, __ATOMIC_RELAXED, __HIP_MEMORY_SCOPE_AGENT); }
__device__ __forceinline__ unsigned xb_xcc_id() { return (unsigned)__builtin_amdgcn_s_getreg((3 << 11) | 20) & 0xFu; }
#define XB_SPIN(cond, bar) do { unsigned _sp = 0; while (cond) { __builtin_amdgcn_s_sleep(1); \
    if ((++_sp & 255u) == 0u) { if (xb_ld(&(bar)[XB_TMO])) break; if (_sp > XB_SPIN_CAP) { atomicAdd(&(bar)[XB_TMO], 1u); break; } } } } while (0)

struct XcdBarrier {
    unsigned* bar; unsigned x;
    volatile LAS unsigned* st;
};

__device__ __forceinline__ XcdBarrier xcd_barrier_post(unsigned* bar, volatile LAS unsigned* st) {
    XcdBarrier b; b.bar = bar; b.x = xb_xcc_id(); b.st = st;
    if (threadIdx.x == 0) (void)xb_add(&bar[XB_XCNT(b.x)], 1u);
    return b;
}
__device__ __forceinline__ void xcd_barrier_complete(unsigned* bar, unsigned x, unsigned& nloc, unsigned& nx) {
    const unsigned G = gridDim.x * gridDim.y * gridDim.z;
    unsigned sum, cnt, mine, sp = 0u;
    for (;;) {
        sum = 0u; cnt = 0u; mine = 0u;
#pragma unroll
        for (unsigned j = 0; j < 16; ++j) { const unsigned c = xb_ld(&bar[XB_XCNT(j)]); sum += c; cnt += (c > 0u) ? 1u : 0u; mine = (j == x) ? c : mine; }
        if (sum == G) break;
        __builtin_amdgcn_s_sleep(1);
        if ((++sp & 255u) == 0u) { if (xb_ld(&bar[XB_TMO])) break; if (sp > XB_SPIN_CAP) { atomicAdd(&bar[XB_TMO], 1u); break; } }
    }
    nloc = mine > 0u ? mine : 1u; nx = cnt > 0u ? cnt : 1u;
}

__device__ __forceinline__ void xcd_barrier(const XcdBarrier& b) {
    asm volatile("s_waitcnt vmcnt(0)" ::: "memory");
    __syncthreads();
    if (threadIdx.x == 0) {
        unsigned* bar = b.bar;
        __builtin_amdgcn_s_waitcnt(0);
        unsigned nloc = b.st[0], nx = b.st[1];
        if (nloc == 0u) { xcd_barrier_complete(bar, b.x, nloc, nx); b.st[0] = nloc; b.st[1] = nx; }
        const unsigned old = xb_add(&bar[XB_XSUB(b.x)], 1u);
        const unsigned gen = old / nloc;
        if (old + 1u == (gen + 1u) * nloc) {
            __builtin_amdgcn_fence(__ATOMIC_RELEASE, "agent");
            asm volatile("s_waitcnt vmcnt(0)" ::: "memory");
            const unsigned og = xb_add(&bar[XB_TOP], 1u);
            const unsigned tg = og / nx;
            if (og + 1u == (tg + 1u) * nx) xb_add(&bar[XB_TOPGEN], 1u);
            else XB_SPIN(xb_ld(&bar[XB_TOPGEN]) == tg, bar);
            __builtin_amdgcn_fence(__ATOMIC_ACQUIRE, "agent");
            xb_add(&bar[XB_XGEN(b.x)], 1u);
            asm volatile("s_waitcnt vmcnt(0)" ::: "memory");
        } else {
            XB_SPIN(xb_ld(&bar[XB_XGEN(b.x)]) == gen, bar);
            __builtin_amdgcn_fence(__ATOMIC_ACQUIRE, "agent");
            asm volatile("s_waitcnt vmcnt(0)" ::: "memory");
        }
    }
    __syncthreads();
}
typedef float f32x16 __attribute__((ext_vector_type(16)));
typedef unsigned u32x2 __attribute__((ext_vector_type(2)));
__device__ __forceinline__ float bf2f(bf16 v) { return __uint_as_float(((unsigned)v) << 16); }
__device__ __forceinline__ float bflo(unsigned w) { return __uint_as_float(w << 16); }
__device__ __forceinline__ float bfhi(unsigned w) { return __uint_as_float(w & 0xffff0000u); }
__device__ __forceinline__ float wave_sum(float v) {
#pragma unroll
    for (int o = 1; o < 64; o <<= 1) v += __shfl_xor(v, o);
    return v;
}
__device__ __forceinline__ float wave_max(float v) {
#pragma unroll
    for (int o = 1; o < 64; o <<= 1) v = fmaxf(v, __shfl_xor(v, o));
    return v;
}
__device__ __forceinline__ float siluf_(float x) { return x * __builtin_amdgcn_rcpf(1.0f + __expf(-x)); }
__device__ __forceinline__ float softplusf_(float x) { return x > 20.0f ? x : log1pf(__expf(x)); }

struct Args { const float* in[23]; float* out; unsigned char* ws; int ph_lo, ph_hi, use_bar, pad; };
typedef const __attribute__((address_space(4))) Args* KArgs;
struct Ctx { LAS unsigned char* lds; int tid, lane, wave, G, bid; KArgs a; };

__device__ __forceinline__ int lane_now() { int t; asm volatile("v_mbcnt_lo_u32_b32 %0, -1, 0\n\tv_mbcnt_hi_u32_b32 %0, -1, %0" : "=v"(t)); return t; }
struct TItem { const float* sp; const float* gn; bf16* WT; int ldn, rowl, K, k0, R0; };
__device__ __forceinline__ void titem_load(const TItem& t, f32x4 (&v)[16], int) {
    const int kk = lane_now() >> 4;
    if (t.sp) {
#pragma unroll
        for (int i = 0; i < 16; ++i) v[i] = __builtin_nontemporal_load((const GAS f32x4*)(t.sp + (size_t)(t.k0 + 16 * kk + i) * t.ldn));
        if (t.gn) { const GAS f32x4* gp = (const GAS f32x4*)(t.gn + t.k0 + 16 * kk);
#pragma unroll
            for (int q = 0; q < 4; ++q) { const f32x4 g = gp[q]; v[4 * q] = v[4 * q] * g.x; v[4 * q + 1] = v[4 * q + 1] * g.y; v[4 * q + 2] = v[4 * q + 2] * g.z; v[4 * q + 3] = v[4 * q + 3] * g.w; } }
    } else {
#pragma unroll
        for (int i = 0; i < 16; ++i) { float z0 = 0.f; asm volatile("" : "+v"(z0)); v[i] = (f32x4){z0, z0, z0, z0}; }
    }
}
__device__ __forceinline__ void titem_store(const TItem& t, const f32x4 (&v)[16], LAS unsigned short* T, int) {
    const int lane = lane_now(), kk = lane >> 4;
    LAS unsigned char* Tb = (LAS unsigned char*)T;
#pragma unroll
    for (int j = 0; j < 4; ++j) { const int n = t.rowl + j, sw = (n >> 2) & 7; v4u lo, hi;
        lo.x = pg8::cvt_pk_bf16(v[0][j], v[1][j]); lo.y = pg8::cvt_pk_bf16(v[2][j], v[3][j]); lo.z = pg8::cvt_pk_bf16(v[4][j], v[5][j]); lo.w = pg8::cvt_pk_bf16(v[6][j], v[7][j]);
        hi.x = pg8::cvt_pk_bf16(v[8][j], v[9][j]); hi.y = pg8::cvt_pk_bf16(v[10][j], v[11][j]); hi.z = pg8::cvt_pk_bf16(v[12][j], v[13][j]); hi.w = pg8::cvt_pk_bf16(v[14][j], v[15][j]);
        *(LAS v4u*)(Tb + n * 128 + (((2 * kk) ^ sw) << 4)) = lo; *(LAS v4u*)(Tb + n * 128 + (((2 * kk + 1) ^ sw) << 4)) = hi; }
    LDS_WAIT(); asm volatile("" ::: "memory");
    const int ch = lane & 7, nr = lane >> 3;
#pragma unroll
    for (int it = 0; it < 8; ++it) { const int n = nr + 8 * it;
        const v4u o = *(const LAS v4u*)(Tb + n * 128 + ((ch ^ ((n >> 2) & 7)) << 4));
        *(GAS v4u*)(t.WT + (size_t)(t.R0 + n) * t.K + t.k0 + 8 * ch) = o; }
    LDS_WAIT(); asm volatile("" ::: "memory");
}
constexpr int IT_IN = (DM / 64) * (NU / 64), IT_CAT = (KCAT / 64) * (DM / 64), IT_OUT = (DM / 64) * (DM / 64), IT_GU = (DM / 64) * (NGU / 64), IT_DN = (FF / 64) * (DM / 64);
constexpr int IT_LAYER = IT_IN + IT_CAT + IT_OUT + IT_GU + IT_DN;
__device__ __forceinline__ TItem titem_decode(const Ctx& C, int it) {
    const int c4 = lane_now() & 15, l = it / IT_LAYER; int q = it % IT_LAYER; TItem t;
    if (q < IT_IN) { const int nblk = NU / 64, kb = q / nblk, nb = q % nblk, R = 64 * nb + 4 * c4;
        const int col = R < 10240 ? R : (R < 17408 ? R + 64 : (R < 17472 ? 10240 + (R - 17408) : -1));
        t.sp = col >= 0 ? (C.a->in[7]) + (size_t)l * DM * IN_DIM + col : nullptr; t.gn = (C.a->in[6]) + (size_t)l * DM; t.ldn = IN_DIM; t.rowl = 4 * c4; t.K = DM; t.WT = ((bf16*)(C.a->ws + WS_WIN)) + (size_t)l * NU * DM; t.k0 = 64 * kb; t.R0 = 64 * nb; return t; }
    q -= IT_IN;
    if (q < IT_CAT) { const int nblk = DM / 64, kb = q / nblk, nb = q % nblk, R = 64 * nb + 4 * c4, k0 = 64 * kb;
        t.sp = k0 < DI ? (C.a->in[14]) + (size_t)l * DI * DM + R : (C.a->in[15]) + (size_t)l * DM * DM + R - (size_t)DI * DM;
        t.gn = nullptr; t.ldn = DM; t.rowl = 4 * c4; t.K = KCAT; t.WT = ((bf16*)(C.a->ws + WS_WCAT)) + (size_t)l * DM * KCAT; t.k0 = k0; t.R0 = 64 * nb; return t; }
    q -= IT_CAT;
    if (q < IT_OUT) { const int nblk = DM / 64, kb = q / nblk, nb = q % nblk, R = 64 * nb + 4 * c4;
        t.sp = (C.a->in[17]) + (size_t)l * DM * DM + R; t.gn = nullptr; t.ldn = DM; t.rowl = 4 * c4; t.K = DM; t.WT = ((bf16*)(C.a->ws + WS_WOUT)) + (size_t)l * DM * DM; t.k0 = 64 * kb; t.R0 = 64 * nb; return t; }
    q -= IT_OUT;
    if (q < IT_GU) { const int nblk = NGU / 64, kb = q / nblk, nb = q % nblk;
        const int up = c4 >> 3, cg = c4 & 7;
        t.sp = (up ? (C.a->in[20]) : (C.a->in[19])) + (size_t)l * DM * FF + 32 * nb + 4 * cg; t.gn = (C.a->in[18]) + (size_t)l * DM; t.ldn = FF; t.rowl = 8 * cg + 4 * up; t.K = DM; t.WT = ((bf16*)(C.a->ws + WS_WGU)) + (size_t)l * NGU * DM; t.k0 = 64 * kb; t.R0 = 64 * nb; return t; }
    q -= IT_GU;
    { const int nblk = DM / 64, kb = q / nblk, nb = q % nblk, R = 64 * nb + 4 * c4;
        t.sp = (C.a->in[21]) + (size_t)l * FF * DM + R; t.gn = nullptr; t.ldn = DM; t.rowl = 4 * c4; t.K = FF; t.WT = ((bf16*)(C.a->ws + WS_WDN)) + (size_t)l * DM * FF; t.k0 = 64 * kb; t.R0 = 64 * nb; return t; }
}
__device__ __forceinline__ void p0_weights(const Ctx& C, int it_lo, int it_hi, int gw, int NGW) {
    LAS unsigned short* T = (LAS unsigned short*)(C.lds + RING_OFF + C.wave * 16384);
    int it = it_lo + gw; if (it >= it_hi) return;
    TItem cur = titem_decode(C, it); f32x4 va[16], vb[16];
    titem_load(cur, va, C.lane);
    for (;;) {
        int nit = it + NGW; TItem nxt = cur; const bool hn = nit < it_hi;
        if (hn) { nxt = titem_decode(C, nit); titem_load(nxt, vb, C.lane); }
        titem_store(cur, va, T, C.lane);
        if (!hn) break;
        it = nit + NGW; cur = nxt; const bool hn2 = it < it_hi;
        if (hn2) { cur = titem_decode(C, it); titem_load(cur, va, C.lane); }
        titem_store(nxt, vb, T, C.lane);
        if (!hn2) break;
    }
}
__device__ __forceinline__ void norm_row(const float* src, const float* gain, float* xcopy, bf16* xb, float* rs, float* fdst, int lane) {
    const GAS f32x4* xr = (const GAS f32x4*)src + lane;
    f32x4 v[8]; float s = 0.f;
#pragma unroll
    for (int j = 0; j < 8; ++j) { v[j] = xr[64 * j]; s += (v[j].x * v[j].x + v[j].y * v[j].y) + (v[j].z * v[j].z + v[j].w * v[j].w); }
    s = wave_sum(s);
    if (rs && lane == 0) *rs = s;
    if (xcopy) { GAS f32x4* xc = (GAS f32x4*)xcopy + lane;
#pragma unroll
        for (int j = 0; j < 8; ++j) xc[64 * j] = v[j]; }
    if (xb) {
#pragma unroll
        for (int j = 0; j < 8; ++j) { u32x2 w; w.x = pk2(v[j].x, v[j].y); w.y = pk2(v[j].z, v[j].w); *((GAS u32x2*)xb + lane + 64 * j) = w; } }
    if (fdst) { const float rstd = rsqrtf(s * (1.0f / DM) + EPS); const GAS f32x4* gr = (const GAS f32x4*)gain + lane;
#pragma unroll
        for (int j = 0; j < 8; ++j) { const f32x4 g = gr[64 * j]; f32x4 o = v[j] * rstd; o = o * g; *((GAS f32x4*)fdst + lane + 64 * j) = o; } }
}
__device__ __forceinline__ void p0_xinit(const Ctx& C) {
    const int gw = C.bid * NWAVES + C.wave, NGW = C.G * NWAVES;
    for (int m = gw; m < MV; m += NGW) { const float* src = m < SEQ ? (C.a->in[0]) + (size_t)m * DM : (C.a->in[1]) + (size_t)(m - SEQ) * DM;
        norm_row(src, nullptr, m < SEQ ? nullptr : ((float*)(C.a->ws + WS_X)) + (size_t)m * DM, ((bf16*)(C.a->ws + WS_XN)) + (size_t)m * DM, ((float*)(C.a->ws + WS_RSA)) + m, nullptr, C.lane); }
}
__device__ __forceinline__ void sample_rows_phase(const Ctx& C, float* RS) {
    const int gw = C.bid * NWAVES + C.wave, NGW = C.G * NWAVES;
    for (int m = SEQ + gw; m < MV; m += NGW) norm_row(((float*)(C.a->ws + WS_X)) + (size_t)m * DM, nullptr, nullptr, ((bf16*)(C.a->ws + WS_XN)) + (size_t)m * DM, RS + m, nullptr, C.lane);
}
__device__ __forceinline__ void final_norm_phase(const Ctx& C) {
    const int gw = C.bid * NWAVES + C.wave, NGW = C.G * NWAVES, lane = C.lane;
    f32x4 gv[8];
    { const GAS f32x4* gr = (const GAS f32x4*)(C.a->in[22]) + 2 * lane;
#pragma unroll
      for (int j = 0; j < 4; ++j) { gv[2 * j] = gr[128 * j]; gv[2 * j + 1] = gr[128 * j + 1]; } }
    for (int m = gw; m < MV; m += NGW) {
        if (m >= SEQ) { norm_row(((float*)(C.a->ws + WS_X)) + (size_t)m * DM, (C.a->in[22]), nullptr, nullptr, nullptr, (C.a->out) + O_YP + (size_t)m * DM, lane); continue; }
        const GAS v4u* xr = (const GAS v4u*)(((bf16*)(C.a->ws + WS_XN)) + (size_t)m * DM) + lane; v4u w[4]; float s = 0.f;
#pragma unroll
        for (int j = 0; j < 4; ++j) { w[j] = xr[64 * j]; const float a0 = bflo(w[j].x), a1 = bfhi(w[j].x), a2 = bflo(w[j].y), a3 = bfhi(w[j].y), a4 = bflo(w[j].z), a5 = bfhi(w[j].z), a6 = bflo(w[j].w), a7 = bfhi(w[j].w);
            s += ((a0 * a0 + a1 * a1) + (a2 * a2 + a3 * a3)) + ((a4 * a4 + a5 * a5) + (a6 * a6 + a7 * a7)); }
        const float rstd = rsqrtf(wave_sum(s) * (1.0f / DM) + EPS);
        GAS f32x4* op = (GAS f32x4*)((C.a->out) + O_YP + (size_t)m * DM) + 2 * lane;
#pragma unroll
        for (int j = 0; j < 4; ++j) { const f32x4 g0 = gv[2 * j], g1 = gv[2 * j + 1];
            op[128 * j] = (f32x4){bflo(w[j].x) * rstd * g0.x, bfhi(w[j].x) * rstd * g0.y, bflo(w[j].y) * rstd * g0.z, bfhi(w[j].y) * rstd * g0.w};
            op[128 * j + 1] = (f32x4){bflo(w[j].z) * rstd * g1.x, bfhi(w[j].z) * rstd * g1.y, bflo(w[j].w) * rstd * g1.z, bfhi(w[j].w) * rstd * g1.w}; }
    }
}
__device__ __forceinline__ void zero_f32(const Ctx& C, float* p, int n, int vb, int nvb) { float z0 = 0.f; asm volatile("" : "+v"(z0)); for (int i = vb * 512 + C.tid; i < n; i += nvb * 512) p[i] = z0; }

__device__ __forceinline__ void sample_ssd_wave_unit(const Ctx& C, int l, int b, int g, LAS float* wsc) {
    const int lane = lane_now();
    const int row = SEQ + b, n4 = lane & 31, prh = lane >> 5;
    LAS float* xs = wsc; LAS float* Bs = wsc + 512; LAS float* ys = wsc + 768;
    const float* cw = (C.a->in[8]) + (size_t)l * CW * CD; const float* cb = (C.a->in[9]) + (size_t)l * CD;
    const float* sc = (C.a->in[3]) + ((size_t)l * NB + b) * 3 * CD; const bf16* U = ((bf16*)(C.a->ws + WS_U));
    { const int ch = g * 512 + 8 * lane; const v4u un = *(const GAS v4u*)(U + UIDX(row, UXBC + ch)); const float nv[8] = {bflo(un.x), bfhi(un.x), bflo(un.y), bfhi(un.y), bflo(un.z), bfhi(un.z), bflo(un.w), bfhi(un.w)};
#pragma unroll
      for (int q = 0; q < 2; ++q) { const f32x4 bb = *(const GAS f32x4*)(cb + ch + 4 * q), w0 = *(const GAS f32x4*)(cw + ch + 4 * q), w1 = *(const GAS f32x4*)(cw + CD + ch + 4 * q), w2 = *(const GAS f32x4*)(cw + 2 * CD + ch + 4 * q), w3 = *(const GAS f32x4*)(cw + 3 * CD + ch + 4 * q);
          const f32x4 s0 = *(const GAS f32x4*)(sc + ch + 4 * q), s1 = *(const GAS f32x4*)(sc + CD + ch + 4 * q), s2 = *(const GAS f32x4*)(sc + 2 * CD + ch + 4 * q);
          f32x4 o;
#pragma unroll
          for (int e = 0; e < 4; ++e) o[e] = siluf_(bb[e] + w0[e] * s0[e] + w1[e] * s1[e] + w2[e] * s2[e] + w3[e] * nv[4 * q + e]);
          *(LAS f32x4*)(xs + 8 * lane + 4 * q) = o; } }
    { const int ch = (lane < 32 ? DI + g * 128 : DI + 1024 + g * 128 - 128) + 4 * lane;
      const u32x2 un = *(const GAS u32x2*)(U + UIDX(row, UXBC + ch)); const float nv[4] = {bflo(un.x), bfhi(un.x), bflo(un.y), bfhi(un.y)};
      const f32x4 bb = *(const GAS f32x4*)(cb + ch), w0 = *(const GAS f32x4*)(cw + ch), w1 = *(const GAS f32x4*)(cw + CD + ch), w2 = *(const GAS f32x4*)(cw + 2 * CD + ch), w3 = *(const GAS f32x4*)(cw + 3 * CD + ch);
      const f32x4 s0 = *(const GAS f32x4*)(sc + ch), s1 = *(const GAS f32x4*)(sc + CD + ch), s2 = *(const GAS f32x4*)(sc + 2 * CD + ch);
      f32x4 o;
#pragma unroll
      for (int e = 0; e < 4; ++e) o[e] = siluf_(bb[e] + w0[e] * s0[e] + w1[e] * s1[e] + w2[e] * s2[e] + w3[e] * nv[e]);
      *(LAS f32x4*)(Bs + 4 * lane) = o; }
    LDS_WAIT(); asm volatile("" ::: "memory");
    const f32x4 Bv = *((const LAS f32x4*)Bs + n4), Cv = *((const LAS f32x4*)(Bs + 128) + n4);
    const size_t sbase = (((size_t)l * NB + b) * NH + 8 * g) * HP * DS;
    for (int j = 0; j < 8; ++j) { const int h = 8 * g + j;
        const GAS f32x4* sp = (const GAS f32x4*)((C.a->in[2]) + sbase + (size_t)j * HP * DS + (size_t)prh * DS) + n4;
        GAS f32x4* op = (GAS f32x4*)((C.a->out) + O_SSSM + sbase + (size_t)j * HP * DS + (size_t)prh * DS) + n4;
        f32x4 hv[32];
#pragma unroll
        for (int i = 0; i < 32; ++i) hv[i] = __builtin_nontemporal_load(sp + (size_t)i * (2 * DS / 4));
        const float dt = ((float*)(C.a->ws + WS_DT))[(size_t)row * 64 + h], dA = __expf(-__expf((C.a->in[11])[l * NH + h]) * dt), Dh = (C.a->in[12])[l * NH + h];
#pragma unroll
        for (int i = 0; i < 32; ++i) { const int p = prh + 2 * i; const float xv = xs[j * 64 + p], dtx = dt * xv; const f32x4 h0 = hv[i];
            f32x4 hn; hn.x = dA * h0.x + dtx * Bv.x; hn.y = dA * h0.y + dtx * Bv.y; hn.z = dA * h0.z + dtx * Bv.z; hn.w = dA * h0.w + dtx * Bv.w;
            __builtin_nontemporal_store(hn, op + (size_t)i * (2 * DS / 4));
            float yp = (hn.x * Cv.x + hn.y * Cv.y) + (hn.z * Cv.z + hn.w * Cv.w);
#pragma unroll
            for (int o = 1; o < 32; o <<= 1) yp += __shfl_xor(yp, o);
            if (n4 == 0) ys[j * 64 + p] = yp + Dh * xv; }
    }
    LDS_WAIT(); asm volatile("" ::: "memory");
    { const int ch = g * 512 + 8 * lane; const v4u zw = *(const GAS v4u*)(U + UIDX(row, UZ + ch)); const f32x4 y0 = *(const LAS f32x4*)(ys + 8 * lane), y1 = *(const LAS f32x4*)(ys + 8 * lane + 4);
      float gv[8] = {y0.x * bflo(zw.x), y0.y * bfhi(zw.x), y0.z * bflo(zw.y), y0.w * bfhi(zw.y), y1.x * bflo(zw.z), y1.y * bfhi(zw.z), y1.z * bflo(zw.w), y1.w * bfhi(zw.w)};
      float ss = 0.f;
#pragma unroll
      for (int e = 0; e < 8; ++e) ss += gv[e] * gv[e];
      const float rstd = rsqrtf(wave_sum(ss) * (1.0f / 512.0f) + EPS);
      const f32x4 n0 = *(const GAS f32x4*)((C.a->in[13]) + (size_t)l * DI + ch), n1 = *(const GAS f32x4*)((C.a->in[13]) + (size_t)l * DI + ch + 4);
      v4u o; o.x = pk2(gv[0] * rstd * n0.x, gv[1] * rstd * n0.y); o.y = pk2(gv[2] * rstd * n0.z, gv[3] * rstd * n0.w); o.z = pk2(gv[4] * rstd * n1.x, gv[5] * rstd * n1.y); o.w = pk2(gv[6] * rstd * n1.z, gv[7] * rstd * n1.w);
      *(GAS v4u*)(((bf16*)(C.a->ws + WS_YO)) + (size_t)row * KCAT + ch) = o; }
    LDS_WAIT(); asm volatile("" ::: "memory");
}

__device__ __forceinline__ void sample_attn_phase(const Ctx& C, int l) {
    const int tid = C.tid;
    constexpr int KP = 68;
    LAS float* Ks = (LAS float*)(C.lds + RING_OFF); LAS float* Vs = Ks + 128 * KP; LAS float* qs = Vs + 128 * KP; LAS float* sc = qs + 256; LAS float* knew = sc + 4 * 132; LAS float* vnew = knew + 64;
    const bf16* U = ((bf16*)(C.a->ws + WS_U));
    f32x4 kv[4], vv[4]; float qx = 0.f;
#define SA_LOAD(u_) do { const int b_ = (u_) >> 3, kh_ = (u_) & 7, row_ = SEQ + b_; const size_t cb_ = ((size_t)l * NB + b_) * WIN * (KVH * AD) + (size_t)kh_ * AD; \
        _Pragma("unroll") for (int i = 0; i < 4; ++i) { const int idx = tid + 512 * i, w = idx >> 4, c4 = idx & 15; \
            kv[i] = __builtin_nontemporal_load((const GAS f32x4*)((C.a->in[4]) + cb_ + (size_t)w * (KVH * AD)) + c4); vv[i] = __builtin_nontemporal_load((const GAS f32x4*)((C.a->in[5]) + cb_ + (size_t)w * (KVH * AD)) + c4); } \
        if (tid < 256) qx = bf2f(U[UIDX(row_, UQ + kh_ * 256 + tid)]); else if (tid < 320) qx = bf2f(U[UIDX(row_, UK + kh_ * 64 + (tid - 256))]); else if (tid < 384) qx = bf2f(U[UIDX(row_, UV + kh_ * 64 + (tid - 320))]); } while (0)
    int u = C.bid; if (u >= NB * KVH) return;
    SA_LOAD(u);
    for (; u < NB * KVH; u += C.G) {
        const int b = u >> 3, kh = u & 7, row = SEQ + b;
        const size_t cbase = ((size_t)l * NB + b) * WIN * (KVH * AD) + (size_t)kh * AD;
        if (tid < 256) qs[tid] = qx; else if (tid < 320) knew[tid - 256] = qx; else if (tid < 384) vnew[tid - 320] = qx;
#pragma unroll
        for (int i = 0; i < 4; ++i) { const int idx = tid + 512 * i, w = idx >> 4, c4 = idx & 15; *((LAS f32x4*)(Ks + w * KP) + c4) = kv[i]; *((LAS f32x4*)(Vs + w * KP) + c4) = vv[i]; }
        __syncthreads();
        if (u + C.G < NB * KVH) SA_LOAD(u + C.G);
        if (tid < 16) { *((GAS f32x4*)((C.a->out) + O_SK + cbase + (size_t)(WIN - 1) * (KVH * AD)) + tid) = *((const LAS f32x4*)knew + tid); }
        else if (tid < 32) { *((GAS f32x4*)((C.a->out) + O_SV + cbase + (size_t)(WIN - 1) * (KVH * AD)) + (tid - 16)) = *((const LAS f32x4*)vnew + (tid - 16)); }
        { const int w = tid >> 2, hq = tid & 3; const LAS f32x4* kp = (const LAS f32x4*)(Ks + w * KP); const LAS f32x4* qp = (const LAS f32x4*)(qs + hq * 64);
          float s = 0.f;
    #pragma unroll
          for (int c = 0; c < 16; ++c) { const f32x4 kv = kp[c], qv = qp[c]; s += (kv.x * qv.x + kv.y * qv.y) + (kv.z * qv.z + kv.w * qv.w); }
          sc[hq * 132 + w] = s * 0.125f; }
        if (tid < 4) { float s = 0.f;
          for (int d = 0; d < 64; ++d) s += qs[tid * 64 + d] * knew[d];
          sc[tid * 132 + 128] = s * 0.125f; }
        __syncthreads();
        if (C.wave < 4) { const int hq = C.wave; const float sink = (C.a->in[16])[l * AH + 4 * kh + hq];
          const float v0 = sc[hq * 132 + C.lane], v1 = sc[hq * 132 + 64 + C.lane], v2 = C.lane == 0 ? sc[hq * 132 + 128] : -__builtin_inff();
          const float m = fmaxf(wave_max(fmaxf(fmaxf(v0, v1), v2)), sink);
          const float e0 = __expf(v0 - m), e1 = __expf(v1 - m), e2 = C.lane == 0 ? __expf(v2 - m) : 0.f;
          const float inv = 1.0f / (wave_sum(e0 + e1 + e2) + __expf(sink - m));
          sc[hq * 132 + C.lane] = e0 * inv; sc[hq * 132 + 64 + C.lane] = e1 * inv; if (C.lane == 0) sc[hq * 132 + 128] = e2 * inv; }
        __syncthreads();
        if (tid < 256) { const int hq = tid >> 6, d = tid & 63; float o = sc[hq * 132 + 128] * vnew[d];
    #pragma unroll 16
          for (int w = 0; w < WIN; ++w) o += sc[hq * 132 + w] * Vs[w * KP + d];
          ((bf16*)(C.a->ws + WS_YO))[(size_t)row * KCAT + DI + (4 * kh + hq) * 64 + d] = (bf16)f2bf(o); }
        __syncthreads();
    }
#undef SA_LOAD
}

__device__ __forceinline__ void cache_shift(const Ctx& C, int l, int vb, int nvb) {
    constexpr int ROWF4 = (WIN - 1) * KVH * AD / 4;
    for (int u = vb; u < NB * 2; u += nvb) { const int b = u >> 1, kv = u & 1;
        const GAS f32x4* src = (const GAS f32x4*)((kv ? (C.a->in[5]) : (C.a->in[4])) + ((size_t)l * NB + b) * WIN * (KVH * AD) + KVH * AD);
        GAS f32x4* dst = (GAS f32x4*)((C.a->out) + (kv ? O_SV : O_SK) + ((size_t)l * NB + b) * WIN * (KVH * AD));
        for (int i = C.tid; i < ROWF4; i += 512 * 8) { f32x4 v[8];
#pragma unroll
            for (int j = 0; j < 8; ++j) if (i + 512 * j < ROWF4) v[j] = __builtin_nontemporal_load(src + i + 512 * j);
#pragma unroll
            for (int j = 0; j < 8; ++j) if (i + 512 * j < ROWF4) __builtin_nontemporal_store(v[j], dst + i + 512 * j); } }
}

__device__ __forceinline__ void copy_outs(const Ctx& C, int l, int vb, int nvb) {
    const bf16* U = ((bf16*)(C.a->ws + WS_U)); const int gt = vb * 512 + C.tid, NT = nvb * 512;
    for (int i = gt; i < WIN * KVH * AD / 8; i += NT) { const int w = i >> 6, c = (i & 63) * 8, ur = SEQ - WIN + w;
        const v4u kw = *(const GAS v4u*)(U + UIDX(ur, UK + c)), vw = *(const GAS v4u*)(U + UIDX(ur, UV + c));
        GAS f32x4* pk = (GAS f32x4*)((C.a->out) + O_PK + (size_t)l * WIN * KVH * AD + (size_t)w * (KVH * AD) + c); GAS f32x4* pv = (GAS f32x4*)((C.a->out) + O_PV + (size_t)l * WIN * KVH * AD + (size_t)w * (KVH * AD) + c);
        pk[0] = (f32x4){bflo(kw.x), bfhi(kw.x), bflo(kw.y), bfhi(kw.y)}; pk[1] = (f32x4){bflo(kw.z), bfhi(kw.z), bflo(kw.w), bfhi(kw.w)};
        pv[0] = (f32x4){bflo(vw.x), bfhi(vw.x), bflo(vw.y), bfhi(vw.y)}; pv[1] = (f32x4){bflo(vw.z), bfhi(vw.z), bflo(vw.w), bfhi(vw.w)}; }
    constexpr int C8 = CD / 8;
    for (int i = gt; i < 3 * C8; i += NT) { const int j = i / C8, ch = (i - j * C8) * 8; const v4u w = *(const GAS v4u*)(U + UIDX(SEQ - 3 + j, UXBC + ch));
        GAS f32x4* po = (GAS f32x4*)((C.a->out) + O_PCONV + (size_t)l * 3 * CD + (size_t)j * CD + ch);
        po[0] = (f32x4){bflo(w.x), bfhi(w.x), bflo(w.y), bfhi(w.y)}; po[1] = (f32x4){bflo(w.z), bfhi(w.z), bflo(w.w), bfhi(w.w)}; }
    for (int i = gt; i < NB * C8; i += NT) { const int b = i / C8, ch = (i - b * C8) * 8;
        const GAS f32x4* si = (const GAS f32x4*)((C.a->in[3]) + ((size_t)l * NB + b) * 3 * CD + ch); GAS f32x4* so = (GAS f32x4*)((C.a->out) + O_SCONV + ((size_t)l * NB + b) * 3 * CD + ch);
        const f32x4 r10 = si[CD / 4], r11 = si[CD / 4 + 1], r20 = si[2 * CD / 4], r21 = si[2 * CD / 4 + 1]; const v4u w = *(const GAS v4u*)(U + UIDX(SEQ + b, UXBC + ch));
        so[0] = r10; so[1] = r11; so[CD / 4] = r20; so[CD / 4 + 1] = r21;
        so[2 * CD / 4] = (f32x4){bflo(w.x), bfhi(w.x), bflo(w.y), bfhi(w.y)}; so[2 * CD / 4 + 1] = (f32x4){bflo(w.z), bfhi(w.z), bflo(w.w), bfhi(w.w)}; }
}
typedef float f32x2_t __attribute__((ext_vector_type(2))); typedef __bf16 bf16x2_t __attribute__((ext_vector_type(2)));
__device__ __forceinline__ unsigned cvtpk(float lo, float hi) { f32x2_t v = {lo, hi}; bf16x2_t b = __builtin_convertvector(v, bf16x2_t); return __builtin_bit_cast(unsigned, b); }
__device__ __forceinline__ int crow(int reg, int hh) { return (reg & 3) + 8 * (reg >> 2) + 4 * hh; }
#define MFMA32(a, b, c) __builtin_amdgcn_mfma_f32_32x32x16_bf16((a), (b), (c), 0, 0, 0)
__device__ __forceinline__ bf16x8 ld16(const bf16* p) { return *(const GAS bf16x8*)p; }
__device__ __forceinline__ bf16x8 ld8x2(const bf16* p) {
    const u32x2 lo = *(const GAS u32x2*)p, hi = *(const GAS u32x2*)(p + 8); v4u w; w.x = lo.x; w.y = lo.y; w.z = hi.x; w.w = hi.y; return __builtin_bit_cast(bf16x8, w); }
#define PACK8(X, s) __builtin_bit_cast(bf16x8, (v4u){cvtpk((X)[8 * (s)], (X)[8 * (s) + 1]), cvtpk((X)[8 * (s) + 2], (X)[8 * (s) + 3]), cvtpk((X)[8 * (s) + 4], (X)[8 * (s) + 5]), cvtpk((X)[8 * (s) + 6], (X)[8 * (s) + 7])})

__device__ __forceinline__ void reformat_conv_item(const Ctx& C, int l, int c, int cblk) {
    const int co = C.lane & 7, rg = C.lane >> 3, ch0 = cblk * 64 + co * 8;
    const float* cw = (C.a->in[8]) + (size_t)l * CW * CD + ch0; const float* cb = (C.a->in[9]) + (size_t)l * CD + ch0;
    float w0[8], w1[8], w2[8], w3[8], bs[8];
#pragma unroll
    for (int j = 0; j < 8; ++j) { w0[j] = cw[j]; w1[j] = cw[CD + j]; w2[j] = cw[2 * CD + j]; w3[j] = cw[3 * CD + j]; bs[j] = cb[j]; }
    const bf16* U = ((bf16*)(C.a->ws + WS_U));
    const int row0 = 128 * c + 16 * rg;
    v4u raw[19];
    unsigned zu = 0u; asm volatile("" : "+v"(zu));
#pragma unroll
    for (int i = 0; i < 19; ++i) { const int rr = row0 - 3 + i; raw[i] = rr >= 0 ? *(const GAS v4u*)(U + UIDX(rr, UXBC + ch0)) : (v4u){zu, zu, zu, zu}; }
    unsigned tp[8][8];
    bf16* rm = nullptr; bf16* tr = nullptr;
    if (cblk < 64) tr = ((bf16*)(C.a->ws + WS_XT)) + (((size_t)c * 64 + cblk) * 64 + co * 8) * 128 + 16 * rg;
    else if (cblk < 80) { const int g = (cblk - 64) >> 1, hf = (cblk - 64) & 1;
        rm = ((bf16*)(C.a->ws + WS_BRM)) + (((size_t)c * 8 + g) * 128 + 16 * rg) * 128 + hf * 64 + co * 8;
        tr = ((bf16*)(C.a->ws + WS_BT)) + (((size_t)c * 8 + g) * 128 + hf * 64 + co * 8) * 128 + 16 * rg; }
    else { const int g = (cblk - 80) >> 1, hf = (cblk - 80) & 1;
        rm = ((bf16*)(C.a->ws + WS_CRM)) + (((size_t)c * 8 + g) * 128 + 16 * rg) * 128 + hf * 64 + co * 8; }
#define RAWF(i, j) (((j) & 1) ? bfhi(((j) >> 1) == 0 ? raw[i].x : (((j) >> 1) == 1 ? raw[i].y : (((j) >> 1) == 2 ? raw[i].z : raw[i].w))) : bflo(((j) >> 1) == 0 ? raw[i].x : (((j) >> 1) == 1 ? raw[i].y : (((j) >> 1) == 2 ? raw[i].z : raw[i].w))))
#pragma unroll
    for (int i2 = 0; i2 < 8; ++i2) {
        float oa[8], ob[8];
#pragma unroll
        for (int j = 0; j < 8; ++j) { oa[j] = siluf_(bs[j] + w0[j] * RAWF(2 * i2, j) + w1[j] * RAWF(2 * i2 + 1, j) + w2[j] * RAWF(2 * i2 + 2, j) + w3[j] * RAWF(2 * i2 + 3, j));
                                      ob[j] = siluf_(bs[j] + w0[j] * RAWF(2 * i2 + 1, j) + w1[j] * RAWF(2 * i2 + 2, j) + w2[j] * RAWF(2 * i2 + 3, j) + w3[j] * RAWF(2 * i2 + 4, j)); }
        if (rm) { v4u w; w.x = cvtpk(oa[0], oa[1]); w.y = cvtpk(oa[2], oa[3]); w.z = cvtpk(oa[4], oa[5]); w.w = cvtpk(oa[6], oa[7]); *(GAS v4u*)(rm + (size_t)(2 * i2) * 128) = w;
                  w.x = cvtpk(ob[0], ob[1]); w.y = cvtpk(ob[2], ob[3]); w.z = cvtpk(ob[4], ob[5]); w.w = cvtpk(ob[6], ob[7]); *(GAS v4u*)(rm + (size_t)(2 * i2 + 1) * 128) = w; }
#pragma unroll
        for (int j = 0; j < 8; ++j) tp[j][i2] = cvtpk(oa[j], ob[j]);
    }
#undef RAWF
    if (tr) {
#pragma unroll
        for (int j = 0; j < 8; ++j) { *(GAS v4u*)(tr + (size_t)j * 128) = (v4u){tp[j][0], tp[j][1], tp[j][2], tp[j][3]}; *(GAS v4u*)(tr + (size_t)j * 128 + 8) = (v4u){tp[j][4], tp[j][5], tp[j][6], tp[j][7]}; }
    }
}
__device__ __forceinline__ void reformat_dt_item(const Ctx& C, int l, int c) {
    const int h = C.lane; const float A = -__expf((C.a->in[11])[l * NH + h]);
    const float* D = ((float*)(C.a->ws + WS_DT)) + (size_t)(128 * c) * 64 + h;
    float* dto = ((float*)(C.a->ws + WS_DTT)) + ((size_t)c * 64 + h) * 128; float* aco = ((float*)(C.a->ws + WS_ACS)) + ((size_t)c * 64 + h) * 128;
    float cs = 0.f;
#pragma unroll
    for (int l0 = 0; l0 < 128; l0 += 64) { float dv[64];
#pragma unroll
        for (int i = 0; i < 64; ++i) dv[i] = D[(size_t)(l0 + i) * 64];
#pragma unroll
        for (int q = 0; q < 16; ++q) { f32x4 av;
#pragma unroll
            for (int e = 0; e < 4; ++e) { cs += dv[4 * q + e] * A; av[e] = cs; }
            *(GAS f32x4*)(dto + l0 + 4 * q) = (f32x4){dv[4 * q], dv[4 * q + 1], dv[4 * q + 2], dv[4 * q + 3]}; *(GAS f32x4*)(aco + l0 + 4 * q) = av; } }
}
__device__ __forceinline__ void reformat_vt_item(const Ctx& C, int tb, int kh) {
    const int co = C.lane & 7, rg = C.lane >> 3; const bf16* U = ((bf16*)(C.a->ws + WS_U)) + UIDX(128 * tb + 16 * rg, UV + kh * 64 + co * 8);
    unsigned tp[8][8];
#pragma unroll
    for (int i = 0; i < 16; ++i) { const v4u a = *(const GAS v4u*)(U + (size_t)i * 64); const unsigned w[4] = {a.x, a.y, a.z, a.w};
#pragma unroll
        for (int j = 0; j < 8; ++j) { const unsigned hb = (j & 1) ? (w[j >> 1] >> 16) : (w[j >> 1] & 0xffffu); if (i & 1) tp[j][i >> 1] |= hb << 16; else tp[j][i >> 1] = hb; } }
    bf16* tr = ((bf16*)(C.a->ws + WS_VT)) + ((size_t)kh * 64 + co * 8) * SEQ + 128 * tb + 16 * rg;
#pragma unroll
    for (int j = 0; j < 8; ++j) { *(GAS v4u*)(tr + (size_t)j * SEQ) = (v4u){tp[j][0], tp[j][1], tp[j][2], tp[j][3]}; *(GAS v4u*)(tr + (size_t)j * SEQ + 8) = (v4u){tp[j][4], tp[j][5], tp[j][6], tp[j][7]}; }
}
constexpr int RF_ITEMS = 64 * 96 + 64 + 64 * 8;
__device__ __forceinline__ void reformat_item(const Ctx& C, int l, int it) {
    constexpr int N1 = 64 * 96, N2 = 64;
    if (it < N1) reformat_conv_item(C, l, it / 96, it % 96);
    else if (it < N1 + N2) reformat_dt_item(C, l, it - N1);
    else reformat_vt_item(C, (it - N1 - N2) >> 3, (it - N1 - N2) & 7);
}

constexpr int AT_K = 0, AT_V = 36864, AT_KP = 144, AT_VP = 528;
__device__ __forceinline__ void attn_prompt_unit(const Ctx& C, int l, int qb, int kh) {
    const int lane_ = lane_now();
    const int r = lane_ & 31, hh = lane_ >> 5, hq = 4 * kh + (C.wave >> 1), rh = C.wave & 1, tid = C.wave * 64 + lane_;
    const bf16* U = ((bf16*)(C.a->ws + WS_U)); const bf16* VT = ((bf16*)(C.a->ws + WS_VT)) + (size_t)kh * 64 * SEQ; bf16* YO = ((bf16*)(C.a->ws + WS_YO));
    LAS unsigned char* Ks = C.lds + AT_K; LAS unsigned char* Vs = C.lds + AT_V;
    const int key0 = 128 * (qb - 1);
    { v4u tk[4], tv[4]; unsigned zu = 0u; asm volatile("" : "+v"(zu));
#pragma unroll
      for (int i = 0; i < 4; ++i) { const int idx = tid + 512 * i, kr = idx >> 3, ch = idx & 7, key = key0 + kr;
          tk[i] = key >= 0 ? *(const GAS v4u*)(U + UIDX(key, UK + kh * 64 + 8 * ch)) : (v4u){zu, zu, zu, zu};
          const int d = idx >> 5, c5 = idx & 31, kk = key0 + 8 * c5;
          tv[i] = kk >= 0 ? *(const GAS v4u*)(VT + (size_t)d * SEQ + kk) : (v4u){zu, zu, zu, zu}; }
#pragma unroll
      for (int i = 0; i < 4; ++i) { const int idx = tid + 512 * i; *(LAS v4u*)(Ks + (idx >> 3) * AT_KP + (idx & 7) * 16) = tk[i]; *(LAS v4u*)(Vs + (idx >> 5) * AT_VP + (idx & 31) * 16) = tv[i]; } }
    bf16x8 bq[2][4];
#pragma unroll
    for (int qt = 0; qt < 2; ++qt)
#pragma unroll
        for (int ks = 0; ks < 4; ++ks) bq[qt][ks] = ld16(U + UIDX(128 * qb + 32 * (2 * rh + qt) + r, UQ + hq * 64 + 16 * ks + 8 * hh));
    const float sink = (C.a->in[16])[l * AH + hq];
    __syncthreads();
#pragma unroll
    for (int qt = 0; qt < 2; ++qt) {
        const int ai = 2 * rh + qt, q0 = 128 * qb + 32 * ai, t = q0 + r;
        f32x16 S[5]; float mx = sink;
#pragma unroll
        for (int v = 0; v < 5; ++v) { const int kt = ai + v; const bool vis = qb > 0 || kt >= 4;
            if (vis) { const int kb = key0 + 32 * kt; f32x16 s;
#pragma unroll
                for (int e = 0; e < 16; ++e) s[e] = 0.f;
                const LAS unsigned char* kp = Ks + (32 * kt + r) * AT_KP + 16 * hh;
#pragma unroll
                for (int ks = 0; ks < 4; ++ks) { const bf16x8 a = *(const LAS bf16x8*)(kp + 32 * ks); s = MFMA32(a, bq[qt][ks], s); }
#pragma unroll
                for (int e = 0; e < 16; ++e) { const int j = kb + crow(e, hh); const bool ok = (j <= t) && (j >= t - WIN); const float x = ok ? s[e] * 0.125f : -__builtin_inff(); s[e] = x; mx = fmaxf(mx, x); }
                S[v] = s; }
        }
        mx = fmaxf(mx, __shfl_xor(mx, 32));
        float sum = 0.f;
#pragma unroll
        for (int v = 0; v < 5; ++v) { const int kt = ai + v; const bool vis = qb > 0 || kt >= 4;
            if (vis) {
#pragma unroll
                for (int e = 0; e < 16; ++e) { const float p = __expf(S[v][e] - mx); S[v][e] = p; sum += p; } } }
        sum += __shfl_xor(sum, 32); sum += __expf(sink - mx);
        f32x16 O[2];
#pragma unroll
        for (int e = 0; e < 16; ++e) { O[0][e] = 0.f; O[1][e] = 0.f; }
#pragma unroll
        for (int v = 0; v < 5; ++v) { const int kt = ai + v; const bool vis = qb > 0 || kt >= 4;
            if (vis) {
#pragma unroll
                for (int ss = 0; ss < 2; ++ss) { const bf16x8 pb = PACK8(S[v], ss);
#pragma unroll
                    for (int dt = 0; dt < 2; ++dt) { const LAS unsigned char* vp = Vs + (32 * dt + r) * AT_VP + (32 * kt + 16 * ss + 4 * hh) * 2;
                        const u32x2 lo = *(const LAS u32x2*)vp, hi = *(const LAS u32x2*)(vp + 16);
                        const bf16x8 va = __builtin_bit_cast(bf16x8, (v4u){lo.x, lo.y, hi.x, hi.y}); O[dt] = MFMA32(va, pb, O[dt]); } } } }
        const float inv = 1.0f / sum;
        bf16* op = YO + (size_t)t * KCAT + DI + hq * 64;
#pragma unroll
        for (int dt = 0; dt < 2; ++dt)
#pragma unroll
            for (int g4 = 0; g4 < 4; ++g4) { u32x2 w; w.x = cvtpk(O[dt][4 * g4] * inv, O[dt][4 * g4 + 1] * inv); w.y = cvtpk(O[dt][4 * g4 + 2] * inv, O[dt][4 * g4 + 3] * inv);
                *(GAS u32x2*)(op + 32 * dt + 8 * g4 + 4 * hh) = w; }
    }
    __syncthreads();
}

__device__ __forceinline__ void ssd_states_unit(const Ctx& C, int c, int g) {
    const int lane_ = lane_now();
    const int r = lane_ & 31, hh = lane_ >> 5, h = 8 * g + C.wave, tid = C.wave * 64 + lane_;
    const bf16* xT = ((bf16*)(C.a->ws + WS_XT)) + ((size_t)c * 64 + h) * 64 * 128; const bf16* bT = ((bf16*)(C.a->ws + WS_BT)) + ((size_t)c * 8 + g) * 128 * 128;
    const float* dtT = ((float*)(C.a->ws + WS_DTT)) + ((size_t)c * 64 + h) * 128; const float* acs = ((float*)(C.a->ws + WS_ACS)) + ((size_t)c * 64 + h) * 128;
    LAS unsigned char* Bs = C.lds + PC_B; LAS float* scs = (LAS float*)(C.lds + PC_C) + C.wave * 128;
    v4u tb[4], raw[2][8];
#pragma unroll
    for (int i = 0; i < 4; ++i) tb[i] = *(const GAS v4u*)(bT + (size_t)(tid + 512 * i) * 8);
    const float dl0 = dtT[lane_], dl1 = dtT[64 + lane_], al0 = acs[lane_], al1 = acs[64 + lane_], aend = acs[127];
#pragma unroll
    for (int ks = 0; ks < 8; ++ks)
#pragma unroll
        for (int pt = 0; pt < 2; ++pt) raw[pt][ks] = *(const GAS v4u*)(xT + (size_t)(32 * pt + r) * 128 + 16 * ks + 8 * hh);
    __builtin_amdgcn_sched_barrier(0);
#pragma unroll
    for (int i = 0; i < 4; ++i) { const int idx = tid + 512 * i; *(LAS v4u*)(Bs + (idx >> 4) * 272 + (idx & 15) * 16) = tb[i]; }
    scs[lane_] = dl0 * __expf(aend - al0); scs[64 + lane_] = dl1 * __expf(aend - al1);
    LDS_WAIT(); asm volatile("" ::: "memory");
    bf16x8 a[2][8];
#pragma unroll
    for (int ks = 0; ks < 8; ++ks) { const f32x4 s0 = *(const LAS f32x4*)(scs + 16 * ks + 8 * hh), s1 = *(const LAS f32x4*)(scs + 16 * ks + 8 * hh + 4);
#pragma unroll
        for (int pt = 0; pt < 2; ++pt) { const v4u w = raw[pt][ks];
            v4u o; o.x = cvtpk(bflo(w.x) * s0.x, bfhi(w.x) * s0.y); o.y = cvtpk(bflo(w.y) * s0.z, bfhi(w.y) * s0.w); o.z = cvtpk(bflo(w.z) * s1.x, bfhi(w.z) * s1.y); o.w = cvtpk(bflo(w.w) * s1.z, bfhi(w.w) * s1.w);
            a[pt][ks] = __builtin_bit_cast(bf16x8, o); } }
    __syncthreads();
    bf16* st = ((bf16*)(C.a->ws + WS_ST)) + ((size_t)c * 64 + h) * 64 * 128;
#pragma unroll
    for (int nt = 0; nt < 4; ++nt) {
        f32x16 acc[2];
#pragma unroll
        for (int e = 0; e < 16; ++e) { acc[0][e] = 0.f; acc[1][e] = 0.f; }
        const LAS unsigned char* bp = Bs + (32 * nt + r) * 272 + 16 * hh;
#pragma unroll
        for (int ks = 0; ks < 8; ++ks) { const bf16x8 b = *(const LAS bf16x8*)(bp + 32 * ks); acc[0] = MFMA32(b, a[0][ks], acc[0]); acc[1] = MFMA32(b, a[1][ks], acc[1]); }
#pragma unroll
        for (int pt = 0; pt < 2; ++pt)
#pragma unroll
            for (int q4 = 0; q4 < 4; ++q4) { u32x2 w; w.x = cvtpk(acc[pt][4 * q4], acc[pt][4 * q4 + 1]); w.y = cvtpk(acc[pt][4 * q4 + 2], acc[pt][4 * q4 + 3]);
                *(GAS u32x2*)(st + (size_t)(32 * pt + r) * 128 + 32 * nt + 8 * q4 + 4 * hh) = w; }
    }
    __syncthreads();
}

__device__ __forceinline__ void ssd_scan_phase(const Ctx& C, int l) {
    const bf16* ST = ((bf16*)(C.a->ws + WS_ST)); bf16* HS = ((bf16*)(C.a->ws + WS_HS)); const float* acs = ((float*)(C.a->ws + WS_ACS));
    for (int idx = C.bid * 512 + C.tid; idx < 64 * 64 * 128 / 4; idx += C.G * 512) { const int h = idx >> 11;
        f32x4 hc = (f32x4){0.f, 0.f, 0.f, 0.f};
        for (int c0 = 0; c0 < 64; c0 += 16) { u32x2 sw[16]; float av[16];
#pragma unroll
            for (int j = 0; j < 16; ++j) { sw[j] = *((const GAS u32x2*)(ST + (size_t)(c0 + j) * 64 * 64 * 128) + idx); av[j] = acs[((size_t)(c0 + j) * 64 + h) * 128 + 127]; }
#pragma unroll
            for (int j = 0; j < 16; ++j) {
                u32x2 w; w.x = cvtpk(hc.x, hc.y); w.y = cvtpk(hc.z, hc.w); *((GAS u32x2*)(HS + (size_t)(c0 + j) * 64 * 64 * 128) + idx) = w;
                const f32x4 s = (f32x4){bflo(sw[j].x), bfhi(sw[j].x), bflo(sw[j].y), bfhi(sw[j].y)}; const float dec = __expf(av[j]);
                hc = hc * dec + s; } }
        *((GAS f32x4*)((C.a->out) + O_PSSM + (size_t)l * NH * HP * DS) + idx) = hc; }
}

__device__ __forceinline__ void ssd_out_unit(const Ctx& C, int l, int c, int g) {
    const int lane_ = lane_now();
    const int r = lane_ & 31, hh = lane_ >> 5, h = 8 * g + C.wave, tid = C.wave * 64 + lane_;
    LAS unsigned char* Bs = C.lds + PC_B; LAS unsigned char* Cs = C.lds + PC_C; LAS float* Ysm = (LAS float*)(C.lds + PC_Y + C.wave * 8704);
    LAS float* ssq = (LAS float*)(C.lds + PC_SSQ); LAS float* acsS = (LAS float*)(C.lds + PC_AD + C.wave * 1024); LAS float* dtS = acsS + 128;
    const bf16* cR = ((bf16*)(C.a->ws + WS_CRM)) + ((size_t)c * 8 + g) * 128 * 128; const bf16* bR = ((bf16*)(C.a->ws + WS_BRM)) + ((size_t)c * 8 + g) * 128 * 128;
    const bf16* hS = ((bf16*)(C.a->ws + WS_HS)) + ((size_t)c * 64 + h) * 64 * 128; const bf16* xT = ((bf16*)(C.a->ws + WS_XT)) + ((size_t)c * 64 + h) * 64 * 128;
    LAS float* nws = (LAS float*)(C.lds + 152576) + C.wave * 64;
    bf16x8 hb[2][8], xb[4][2][2];
    { v4u tb[4], tc[4];
#pragma unroll
      for (int i = 0; i < 4; ++i) { const int idx = tid + 512 * i; tb[i] = *(const GAS v4u*)(bR + (size_t)idx * 8); tc[i] = *(const GAS v4u*)(cR + (size_t)idx * 8); }
      const float a0 = (((float*)(C.a->ws + WS_ACS)) + ((size_t)c * 64 + h) * 128)[lane_], a1 = (((float*)(C.a->ws + WS_ACS)) + ((size_t)c * 64 + h) * 128)[64 + lane_];
      const float d0 = (((float*)(C.a->ws + WS_DTT)) + ((size_t)c * 64 + h) * 128)[lane_], d1 = (((float*)(C.a->ws + WS_DTT)) + ((size_t)c * 64 + h) * 128)[64 + lane_];
      const float nwv = ((C.a->in[13]) + (size_t)l * DI + h * 64)[lane_];
#pragma unroll
      for (int pt = 0; pt < 2; ++pt)
#pragma unroll
          for (int ks = 0; ks < 8; ++ks) hb[pt][ks] = ld16(hS + (size_t)(32 * pt + r) * 128 + 16 * ks + 8 * hh);
#pragma unroll
      for (int st = 0; st < 4; ++st)
#pragma unroll
          for (int ss = 0; ss < 2; ++ss)
#pragma unroll
              for (int pt = 0; pt < 2; ++pt) xb[st][ss][pt] = ld8x2(xT + (size_t)(32 * pt + r) * 128 + 32 * st + 16 * ss + 4 * hh);
      __builtin_amdgcn_sched_barrier(0);
#pragma unroll
      for (int i = 0; i < 4; ++i) { const int idx = tid + 512 * i, row = idx >> 4, ch = idx & 15; *(LAS v4u*)(Bs + row * 272 + ch * 16) = tb[i]; *(LAS v4u*)(Cs + row * 272 + ch * 16) = tc[i]; }
      acsS[lane_] = a0; acsS[64 + lane_] = a1; dtS[lane_] = d0; dtS[64 + lane_] = d1; nws[lane_] = nwv; }
    const float Dh = (C.a->in[12])[l * NH + h];
    __syncthreads();
    const bf16* Uz = ((bf16*)(C.a->ws + WS_U)) + UIDX(128 * c + (lane_ >> 1), UZ + h * 64 + 32 * (lane_ & 1));
    bf16* YOw = ((bf16*)(C.a->ws + WS_YO)) + (size_t)(128 * c + (lane_ >> 1)) * KCAT + h * 64 + 32 * (lane_ & 1);
    const LAS float* nwp = nws + 32 * (lane_ & 1);
#pragma unroll
    for (int lt = 0; lt < 4; ++lt) {
        v4u zw[4];
        { const GAS v4u* zp = (const GAS v4u*)(Uz + (size_t)(32 * lt) * 64);
#pragma unroll
          for (int i = 0; i < 4; ++i) zw[i] = zp[i]; }
        f32x16 y[2];
#pragma unroll
        for (int e = 0; e < 16; ++e) { y[0][e] = 0.f; y[1][e] = 0.f; }
        const LAS unsigned char* crow_p = Cs + (32 * lt + r) * 272 + 16 * hh;
#pragma unroll
        for (int ks = 0; ks < 8; ++ks) { if ((ks & 3) == 0) asm volatile("" ::: "memory");
            const bf16x8 a = *(const LAS bf16x8*)(crow_p + 32 * ks); y[0] = MFMA32(a, hb[0][ks], y[0]); y[1] = MFMA32(a, hb[1][ks], y[1]); }
#pragma unroll
        for (int q4 = 0; q4 < 4; ++q4) { const f32x4 av = *(const LAS f32x4*)(acsS + 32 * lt + 8 * q4 + 4 * hh);
#pragma unroll
            for (int e = 0; e < 4; ++e) { const float f = __expf(av[e]); y[0][4 * q4 + e] *= f; y[1][4 * q4 + e] *= f; } }
        const float al = acsS[32 * lt + r];
#pragma unroll
        for (int st = 0; st < 4; ++st) { if (st > lt) continue;
            f32x16 X;
#pragma unroll
            for (int e = 0; e < 16; ++e) X[e] = 0.f;
            const LAS unsigned char* brow_p = Bs + (32 * st + r) * 272 + 16 * hh;
#pragma unroll
            for (int ks = 0; ks < 8; ++ks) { if ((ks & 1) == 0) asm volatile("" ::: "memory");
                const bf16x8 a = *(const LAS bf16x8*)(brow_p + 32 * ks), b = *(const LAS bf16x8*)(crow_p + 32 * ks); X = MFMA32(a, b, X); }
#pragma unroll
            for (int q4 = 0; q4 < 4; ++q4) { const f32x4 as = *(const LAS f32x4*)(acsS + 32 * st + 8 * q4 + 4 * hh), ds = *(const LAS f32x4*)(dtS + 32 * st + 8 * q4 + 4 * hh);
#pragma unroll
                for (int e = 0; e < 4; ++e) { const int s = 32 * st + 8 * q4 + 4 * hh + e, lrow = 32 * lt + r; const float wgt = (s <= lrow) ? ds[e] * __expf(al - as[e]) : 0.f; X[4 * q4 + e] *= wgt; } }
#pragma unroll
            for (int ss = 0; ss < 2; ++ss) { const bf16x8 xa = PACK8(X, ss); y[0] = MFMA32(xa, xb[st][ss][0], y[0]); y[1] = MFMA32(xa, xb[st][ss][1], y[1]); }
        }
#pragma unroll
        for (int pt = 0; pt < 2; ++pt)
#pragma unroll
            for (int e = 0; e < 16; ++e) { const int q4 = e >> 2; const v4u xw = __builtin_bit_cast(v4u, xb[lt][q4 >> 1][pt]); const unsigned w = (q4 & 1) ? ((e & 2) ? xw.w : xw.z) : ((e & 2) ? xw.y : xw.x);
                const float xv = (e & 1) ? bfhi(w) : bflo(w);
                Ysm[crow(e, hh) * 68 + 32 * pt + r] = y[pt][e] + Dh * xv; }
        { const LAS f32x4* yr = (const LAS f32x4*)(Ysm + (lane_ >> 1) * 68 + 32 * (lane_ & 1));
          float gq[32]; float sq = 0.f;
#pragma unroll
          for (int i = 0; i < 4; ++i) { const f32x4 ya = yr[2 * i], yb = yr[2 * i + 1];
              gq[8 * i + 0] = ya.x * bflo(zw[i].x); gq[8 * i + 1] = ya.y * bfhi(zw[i].x); gq[8 * i + 2] = ya.z * bflo(zw[i].y); gq[8 * i + 3] = ya.w * bfhi(zw[i].y);
              gq[8 * i + 4] = yb.x * bflo(zw[i].z); gq[8 * i + 5] = yb.y * bfhi(zw[i].z); gq[8 * i + 6] = yb.z * bflo(zw[i].w); gq[8 * i + 7] = yb.w * bfhi(zw[i].w);
#pragma unroll
              for (int e = 0; e < 8; ++e) sq += gq[8 * i + e] * gq[8 * i + e]; }
          sq += __shfl_xor(sq, 1);
          if ((lane_ & 1) == 0) ssq[(32 * lt + (lane_ >> 1)) * 8 + C.wave] = sq;
          __syncthreads();
          const LAS f32x4* sp = (const LAS f32x4*)(ssq + (32 * lt + (lane_ >> 1)) * 8); const f32x4 s0 = sp[0], s1 = sp[1];
          const float rstd = rsqrtf(((s0.x + s0.y) + (s0.z + s0.w) + (s1.x + s1.y) + (s1.z + s1.w)) * (1.0f / 512.0f) + EPS);
          GAS v4u* op = (GAS v4u*)(YOw + (size_t)(32 * lt) * KCAT);
#pragma unroll
          for (int i = 0; i < 4; ++i) { const f32x4 na = *(const LAS f32x4*)(nwp + 8 * i), nb = *(const LAS f32x4*)(nwp + 8 * i + 4);
              op[i] = (v4u){cvtpk(gq[8 * i] * rstd * na.x, gq[8 * i + 1] * rstd * na.y), cvtpk(gq[8 * i + 2] * rstd * na.z, gq[8 * i + 3] * rstd * na.w), cvtpk(gq[8 * i + 4] * rstd * nb.x, gq[8 * i + 5] * rstd * nb.y), cvtpk(gq[8 * i + 6] * rstd * nb.z, gq[8 * i + 7] * rstd * nb.w)}; } }
    }
    __syncthreads();
}

template <int MODE> __device__ __forceinline__ void mini_unit(const Ctx& C, int l, int mu) {
    constexpr int K = MODE == 0 ? KCAT : (MODE == 1 ? DM : FF), KS = MODE == 0 ? 1024 : (MODE == 1 ? 256 : 704);
    const int lane_ = lane_now();
    const int r = lane_ & 31, hh = lane_ >> 5, ct = mu & 31, sp = mu >> 5, rt = C.wave & 3, n0 = 64 * ct + 32 * (C.wave >> 2), k0 = KS * sp + 8 * hh;
    const bf16* Bt = (MODE == 0 ? ((bf16*)(C.a->ws + WS_WCAT)) + (size_t)l * DM * KCAT : (MODE == 1 ? ((bf16*)(C.a->ws + WS_WOUT)) + (size_t)l * DM * DM : ((bf16*)(C.a->ws + WS_WDN)) + (size_t)l * DM * FF)) + (size_t)(n0 + r) * K + k0;
    const bf16* Ab = (MODE == 0 ? ((bf16*)(C.a->ws + WS_YO)) + (size_t)(SEQ + 32 * rt + r) * KCAT : ((bf16*)(C.a->ws + WS_HB)) + (size_t)(SEQ + 32 * rt + r) * FF) + k0;
    const float* Af = ((float*)(C.a->ws + WS_MS)) + (size_t)(32 * rt + r) * DM + k0;
    f32x16 acc;
#pragma unroll
    for (int e = 0; e < 16; ++e) acc[e] = 0.f;
    constexpr int UB = MODE == 1 ? 8 : (MODE == 2 ? 11 : 16), NB_ = KS / 16 / UB;
    static_assert(NB_ * UB * 16 == KS, "mini-unit batches");
#pragma unroll 1
    for (int kb = 0; kb < NB_; ++kb) {
        bf16x8 bv[UB];
        if (MODE == 1) { f32x4 a0[UB], a1[UB];
#pragma unroll
            for (int j = 0; j < UB; ++j) { bv[j] = ld16(Bt + 16 * (kb * UB + j)); a0[j] = *(const GAS f32x4*)(Af + 16 * (kb * UB + j)); a1[j] = *(const GAS f32x4*)(Af + 16 * (kb * UB + j) + 4); }
            __builtin_amdgcn_sched_barrier(0);
#pragma unroll
            for (int j = 0; j < UB; ++j) { const bf16x8 a = __builtin_bit_cast(bf16x8, (v4u){cvtpk(a0[j].x, a0[j].y), cvtpk(a0[j].z, a0[j].w), cvtpk(a1[j].x, a1[j].y), cvtpk(a1[j].z, a1[j].w)}); acc = MFMA32(a, bv[j], acc); }
        } else { bf16x8 av[UB];
#pragma unroll
            for (int j = 0; j < UB; ++j) { bv[j] = ld16(Bt + 16 * (kb * UB + j)); av[j] = ld16(Ab + 16 * (kb * UB + j)); }
            __builtin_amdgcn_sched_barrier(0);
#pragma unroll
            for (int j = 0; j < UB; ++j) acc = MFMA32(av[j], bv[j], acc);
        }
        __builtin_amdgcn_sched_barrier(0);
    }
    float* dst = (MODE == 0 ? ((float*)(C.a->ws + WS_MS)) : ((float*)(C.a->ws + WS_X)) + (size_t)SEQ * DM) + n0 + r;
    if (MODE == 0) { const bf16* gp = ((bf16*)(C.a->ws + WS_U)) + UIDX(SEQ, (sp < 4 ? UGS : UGA) + n0 + r);
        bf16 gv[16];
#pragma unroll
        for (int e = 0; e < 16; ++e) gv[e] = gp[(size_t)(32 * rt + crow(e, hh)) * 64];
        __builtin_amdgcn_sched_barrier(0);
#pragma unroll
        for (int e = 0; e < 16; ++e) acc[e] *= bf2f(gv[e]); }
#pragma unroll
    for (int e = 0; e < 16; ++e) unsafeAtomicAdd(dst + (size_t)(32 * rt + crow(e, hh)) * DM, acc[e]);
}
template <int MODE> __device__ __forceinline__ void mini_phase(const Ctx& C, int l) {
    constexpr int NMU = 32 * (MODE == 0 ? 6 : 8);
    for (int mu = C.bid; mu < NMU; mu += C.G) mini_unit<MODE>(C, l, mu);
}
constexpr int NPL = 11;
constexpr int NPH = 1 + DEPTH * NPL;
#ifndef REP_P0
#define REP_P0 1
#endif
#ifndef REP_0
#define REP_0 1
#endif
#ifndef REP_1
#define REP_1 1
#endif
#ifndef REP_2
#define REP_2 1
#endif
#ifndef REP_3
#define REP_3 1
#endif
#ifndef REP_4
#define REP_4 1
#endif
#ifndef REP_5
#define REP_5 1
#endif
#ifndef REP_6
#define REP_6 1
#endif
#ifndef REP_7
#define REP_7 1
#endif
#ifndef REP_8
#define REP_8 1
#endif
#ifndef REP_9
#define REP_9 1
#endif
#ifndef REP_10
#define REP_10 1
#endif
#ifndef REP_RF
#define REP_RF 1
#endif
#ifndef REP_SSD
#define REP_SSD 1
#endif
#ifndef REP_SATT
#define REP_SATT 1
#endif
#ifndef GEMM_ALIGN
#define GEMM_ALIGN true
#endif
#ifndef GEMM_SP2
#define GEMM_SP2 true
#endif
#ifndef PROBE_LO
#define PROBE_LO -1
#define PROBE_HI -1
#endif
#ifndef PROBE_AMP
#define PROBE_AMP 2
#endif
#ifndef NW_SSD
#define NW_SSD 2
#endif
#ifndef PROBE_SUB
#define PROBE_SUB 0
#endif
#ifndef PROBE_CLK
#define PROBE_CLK 0
#endif
#ifndef REP_ATT
#define REP_ATT 1
#endif
#ifndef REP_PA
#define REP_PA 1
#endif
#ifndef NSP_G1
#define NSP_G1 49
#endif
#ifndef MK_SPLIT
#define MK_SPLIT 0
#endif
__global__ void __launch_bounds__(NWAVES * 64, 2) fwd(Args args) {
    extern __shared__ __attribute__((aligned(16))) unsigned char lds_raw[];
    LAS unsigned char* const lds = (LAS unsigned char*)lds_raw;
    const int wave_s = __builtin_amdgcn_readfirstlane(threadIdx.x >> 6);
    unsigned char* ws = args.ws;
#define FRESH_CTX() Ctx C; { int t_; asm volatile("v_mbcnt_lo_u32_b32 %0, -1, 0\n\tv_mbcnt_hi_u32_b32 %0, -1, %0" : "=v"(t_)); t_ += wave_s * 64; int b_ = blockIdx.x, g_ = gridDim.x; asm volatile("" : "+s"(b_), "+s"(g_)); \
        KArgs kp_ = (KArgs)__builtin_amdgcn_kernarg_segment_ptr(); asm volatile("" : "+s"(kp_)); \
        C.lds = lds; C.tid = t_; C.lane = t_ & 63; C.wave = __builtin_amdgcn_readfirstlane(t_ >> 6); C.G = g_; C.bid = b_; C.a = kp_; }
    for (int u = threadIdx.x; u < (LDS_BYTES - LDSCTL_OFF) / 4; u += NWAVES * 64) ((LAS unsigned*)(lds + LDSCTL_OFF))[u] = 0u;
    __syncthreads();
    volatile LAS unsigned* MISC = (volatile LAS unsigned*)(lds + MISC_OFF);
    unsigned* barw = (unsigned*)(ws + WS_CTL) + CW_BAR;
    XcdBarrier bar; bar.bar = barw; bar.x = 0; bar.st = nullptr;
    if (args.use_bar) bar = xcd_barrier_post(barw, MISC + 8);
    const int lo = args.ph_lo, hi = args.ph_hi;
#define IN(k) (lo <= (k) && (k) < hi)
#define SEAM(k) do { if (IN((k) + 1)) xcd_barrier(bar); } while (0)

#ifndef NO_P0
    if (IN(0)) { for (int rep_ = 0; rep_ < REP_P0; ++rep_) { FRESH_CTX(); p0_weights(C, 0, (C.G >= 64 && NSP_G1 > 0) ? IT_IN : DEPTH * IT_LAYER, C.bid * NWAVES + C.wave, C.G * NWAVES); p0_xinit(C); if (rep_ + 1 < REP_P0) xcd_barrier(bar); } SEAM(0); }
#endif

    unsigned long long probe_acc = 0ull, probe_t0 = 0ull;
    if (PROBE_CLK && threadIdx.x == 0) { const unsigned long long c0_ = __builtin_amdgcn_s_memtime(), r0_ = __builtin_amdgcn_s_memrealtime(); MISC[16] = (unsigned)c0_; MISC[17] = (unsigned)(c0_ >> 32); MISC[18] = (unsigned)r0_; MISC[19] = (unsigned)(r0_ >> 32); }
#define PROBE_BEGIN(j) do { if (PROBE_LO >= 0 && (j) == PROBE_LO) probe_t0 = __builtin_amdgcn_s_memrealtime(); } while (0)
#define PROBE_END(j) do { if (PROBE_LO >= 0 && (j) == PROBE_HI) probe_acc += __builtin_amdgcn_s_memrealtime() - probe_t0; } while (0)
#pragma nounroll
    for (int l = 0; l < DEPTH; ++l) {
        const int pb = 1 + l * NPL;
#ifndef NO_G1
        PROBE_BEGIN(0);
        if (IN(pb + 0)) { for (int rep_ = 0; rep_ < REP_0; ++rep_) {
            FRESH_CTX();
            const int nsp = (l == 0 && C.G >= 64) ? (C.G * NSP_G1) / 256 : 0, gG = C.G - nsp;
            if (C.bid < gG) {
            pg8::Gemm g{((bf16*)(C.a->ws + WS_XN)), ((bf16*)(C.a->ws + WS_WIN)) + (size_t)l * NU * DM, MP, NU, DM}; pg8::StaticOrder S; S.init(MP, NU, gG, C.bid);
            pg8::EpiU E{((bf16*)(C.a->ws + WS_U)), ((float*)(C.a->ws + WS_DT)), (C.a->in[10]) + l * NH, ((float*)(C.a->ws + WS_RSA))};
            pg8::gemm_phase<pg8::EpiU, pg8::StaticOrder, GEMM_ALIGN, GEMM_SP2>(C.lds + RING_OFF, g, S, E, C.tid);
            } else p0_weights(C, IT_IN, DEPTH * IT_LAYER, (C.bid - gG) * NWAVES + C.wave, nsp * NWAVES);
            if (rep_ + 1 < REP_0) xcd_barrier(bar); }
            SEAM(pb + 0);
        }
        PROBE_END(0);
#endif
        PROBE_BEGIN(1);
        if (IN(pb + 1)) { for (int rep_ = 0; rep_ < REP_1; ++rep_) {
            FRESH_CTX();
            { volatile LAS unsigned* qctr = (volatile LAS unsigned*)(C.lds + MISC_OFF) + 24;
              if (C.tid == 0) qctr[0] = 0u;
              __syncthreads();
              const int nS = (NB * NG - C.bid + C.G - 1) / C.G, nR = (RF_ITEMS - C.bid + C.G - 1) / C.G;
              LAS float* wsc = (LAS float*)(C.lds + RING_OFF + C.wave * 8192);
              for (;;) { unsigned idx = 0u; if (C.lane == 0) idx = __hip_atomic_fetch_add((LAS unsigned*)qctr, 1u, __ATOMIC_RELAXED, __HIP_MEMORY_SCOPE_WORKGROUP);
                  idx = (unsigned)__builtin_amdgcn_readfirstlane((int)idx);
                  if ((int)idx >= nS + nR) break;
                  if ((int)idx < nS) { const int u = C.bid + C.G * (int)idx; sample_ssd_wave_unit(C, l, u >> 3, u & 7, wsc); }
                  else reformat_item(C, l, C.bid + C.G * ((int)idx - nS)); } }
            __syncthreads();
            if (PROBE_SUB == 1) probe_acc += __builtin_amdgcn_s_memrealtime() - probe_t0;
            if (PROBE_SUB == 2) probe_t0 = __builtin_amdgcn_s_memrealtime();
            zero_f32(C, ((float*)(C.a->ws + WS_RSB)), SEQ, C.bid, C.G);
            { float z0 = 0.f; asm volatile("" : "+v"(z0));
              for (int i = C.bid * 512 + C.tid; i < NB * DM / 4; i += C.G * 512) ((GAS f32x4*)(C.a->ws + WS_MS))[i] = (f32x4){z0, z0, z0, z0}; }
            for (int rr_ = 0; rr_ < REP_SATT; ++rr_) sample_attn_phase(C, l);
            if (PROBE_SUB == 2) probe_acc += __builtin_amdgcn_s_memrealtime() - probe_t0;
            if (PROBE_SUB == 3) probe_t0 = __builtin_amdgcn_s_memrealtime();
            if (PROBE_SUB == 3) { __syncthreads(); probe_acc += __builtin_amdgcn_s_memrealtime() - probe_t0; }
            if (rep_ + 1 < REP_1) xcd_barrier(bar); }
            SEAM(pb + 1);
        }
        PROBE_END(1);
        PROBE_BEGIN(2);
        if (IN(pb + 2)) { for (int rep_ = 0; rep_ < REP_2; ++rep_) {
            FRESH_CTX();
#ifdef USE_NSSD
            if (C.bid < NG) naive_ssd_prompt(C, l, C.bid);
            else {
                const int vb = C.bid - NG, nvb = C.G - NG;
                for (int u = vb; u < 64 * KVH; u += nvb) attn_prompt_unit(C, l, u >> 3, u & 7);
                for (int u = vb; u < 64 * NG; u += nvb) ssd_states_unit(C, u >> 3, u & 7);
            }
#else
            for (int rr_ = 0; rr_ < REP_ATT; ++rr_) for (int u = C.bid; u < 64 * KVH; u += C.G) attn_prompt_unit(C, l, u >> 3, u & 7);
            for (int rr_ = 0; rr_ < REP_PA; ++rr_) for (int u = C.bid; u < 64 * NG; u += C.G) ssd_states_unit(C, u >> 3, u & 7);
#endif
            if (rep_ + 1 < REP_2) xcd_barrier(bar); }
            SEAM(pb + 2);
        }
        PROBE_END(2);
        PROBE_BEGIN(3);
        if (IN(pb + 3)) { for (int rep_ = 0; rep_ < REP_3; ++rep_) { FRESH_CTX(); ssd_scan_phase(C, l); if (rep_ + 1 < REP_3) xcd_barrier(bar); } SEAM(pb + 3); }
        PROBE_END(3);
        PROBE_BEGIN(4);
        if (IN(pb + 4)) { for (int rep_ = 0; rep_ < REP_4; ++rep_) {
            FRESH_CTX();
#ifndef USE_NSSD
            for (int u = C.bid; u < 64 * NG; u += C.G) ssd_out_unit(C, l, u >> 3, u & 7);
#endif
            if (rep_ + 1 < REP_4) xcd_barrier(bar); }
            SEAM(pb + 4);
        }
        PROBE_END(4);
#ifndef NO_G2
        PROBE_BEGIN(5);
        if (IN(pb + 5)) { for (int rep_ = 0; rep_ < REP_5; ++rep_) {
            FRESH_CTX();
            pg8::Gemm g{((bf16*)(C.a->ws + WS_YO)), ((bf16*)(C.a->ws + WS_WCAT)) + (size_t)l * DM * KCAT, SEQ, DM, KCAT}; pg8::StaticOrder S; S.init(SEQ, DM, C.G, C.bid);
            pg8::EpiMerge E{((bf16*)(C.a->ws + WS_U)), ((bf16*)(C.a->ws + WS_MRG))};
            pg8::gemm_phase<pg8::EpiMerge, pg8::StaticOrder, true, true>(C.lds + RING_OFF, g, S, E, C.tid);
            mini_phase<0>(C, l);
            if (rep_ + 1 < REP_5) xcd_barrier(bar); }
            SEAM(pb + 5);
        }
        PROBE_END(5);
#endif
#ifndef NO_G3
        PROBE_BEGIN(6);
        if (IN(pb + 6)) { for (int rep_ = 0; rep_ < REP_6; ++rep_) {
            FRESH_CTX();
            pg8::Gemm g{((bf16*)(C.a->ws + WS_MRG)), ((bf16*)(C.a->ws + WS_WOUT)) + (size_t)l * DM * DM, SEQ, DM, DM}; pg8::StaticOrder S; S.init(SEQ, DM, C.G, C.bid);
            pg8::EpiResid E{l == 0 ? (C.a->in[0]) : (const float*)nullptr, ((bf16*)(C.a->ws + WS_XN)), ((float*)(C.a->ws + WS_RSB))};
            pg8::gemm_phase<pg8::EpiResid, pg8::StaticOrder, true, true>(C.lds + RING_OFF, g, S, E, C.tid);
            mini_phase<1>(C, l);
            if (rep_ + 1 < REP_6) xcd_barrier(bar); }
            SEAM(pb + 6);
        }
        PROBE_END(6);
#endif
        PROBE_BEGIN(7);
        if (IN(pb + 7)) { for (int rep_ = 0; rep_ < REP_7; ++rep_) { FRESH_CTX(); sample_rows_phase(C, ((float*)(C.a->ws + WS_RSB))); if (rep_ + 1 < REP_7) xcd_barrier(bar); } SEAM(pb + 7); }
        PROBE_END(7);
#ifndef NO_G4
        PROBE_BEGIN(8);
        if (IN(pb + 8)) { for (int rep_ = 0; rep_ < REP_8; ++rep_) {
            FRESH_CTX();
            const int nsp = C.G >= 64 ? (C.G * 14) / 256 : 0, gG = C.G - nsp;
            if (C.bid < gG) {
            pg8::Gemm g{((bf16*)(C.a->ws + WS_XN)), ((bf16*)(C.a->ws + WS_WGU)) + (size_t)l * NGU * DM, MP, NGU, DM}; pg8::StaticOrder S; S.init(MP, NGU, gG, C.bid);
            pg8::EpiSwiGLU E{((bf16*)(C.a->ws + WS_HB)), ((float*)(C.a->ws + WS_RSB))};
            pg8::gemm_phase<pg8::EpiSwiGLU, pg8::StaticOrder, GEMM_ALIGN, GEMM_SP2>(C.lds + RING_OFF, g, S, E, C.tid);
            } else { zero_f32(C, ((float*)(C.a->ws + WS_RSA)), SEQ, C.bid - gG, nsp); copy_outs(C, l, C.bid - gG, nsp); cache_shift(C, l, C.bid - gG, nsp); }
            if (nsp == 0) { zero_f32(C, ((float*)(C.a->ws + WS_RSA)), SEQ, C.bid, C.G); copy_outs(C, l, C.bid, C.G); cache_shift(C, l, C.bid, C.G); }
            if (rep_ + 1 < REP_8) xcd_barrier(bar); }
            SEAM(pb + 8);
        }
        PROBE_END(8);
#endif
#ifndef NO_G5
        PROBE_BEGIN(9);
        if (IN(pb + 9)) { for (int rep_ = 0; rep_ < REP_9; ++rep_) {
            FRESH_CTX();
            pg8::Gemm g{((bf16*)(C.a->ws + WS_HB)), ((bf16*)(C.a->ws + WS_WDN)) + (size_t)l * DM * FF, SEQ, DM, FF}; pg8::StaticOrder S; S.init(SEQ, DM, C.G, C.bid);
            pg8::EpiResid E{(const float*)nullptr, ((bf16*)(C.a->ws + WS_XN)), ((float*)(C.a->ws + WS_RSA))};
            pg8::gemm_phase<pg8::EpiResid, pg8::StaticOrder, true, true>(C.lds + RING_OFF, g, S, E, C.tid);
            mini_phase<2>(C, l);
            if (rep_ + 1 < REP_9) xcd_barrier(bar); }
            SEAM(pb + 9);
        }
        PROBE_END(9);
#endif
        PROBE_BEGIN(10);
        if (IN(pb + 10)) { for (int rep_ = 0; rep_ < REP_10; ++rep_) {
            FRESH_CTX();
            if (l + 1 < DEPTH) sample_rows_phase(C, ((float*)(C.a->ws + WS_RSA))); else final_norm_phase(C);
            if (rep_ + 1 < REP_10) xcd_barrier(bar); }
            SEAM(pb + 10);
        }
        PROBE_END(10);
    }
    if (PROBE_CLK && blockIdx.x == 0 && wave_s == 0 && lane_now() == 0) { const unsigned long long c1 = __builtin_amdgcn_s_memtime(), r1 = __builtin_amdgcn_s_memrealtime(); const unsigned long long clk_c0 = ((unsigned long long)MISC[17] << 32) | MISC[16], clk_r0 = ((unsigned long long)MISC[19] << 32) | MISC[18]; const unsigned long long dc = (c1 - clk_c0) * 10000ull, dr = r1 - clk_r0;
        while ((__builtin_amdgcn_s_memrealtime() - r1) * dr < dc) __builtin_amdgcn_s_sleep(8); }
    if (PROBE_LO >= 0 && blockIdx.x == 0 && wave_s == 0 && lane_now() == 0) { const unsigned long long t1 = __builtin_amdgcn_s_memrealtime(); while (__builtin_amdgcn_s_memrealtime() - t1 < (unsigned long long)PROBE_AMP * probe_acc) __builtin_amdgcn_s_sleep(8); }
#undef IN
#undef SEAM
}

extern "C" void kernel_launch(void* const* d_in, const int* in_sizes, int n_in, void* d_out, int out_size, void* d_ws, size_t ws_size, hipStream_t stream) {
    static int grid = 0;
    if (grid == 0) {
        if (n_in != 23 || (size_t)out_size != O_END || ws_size < WS_END) { fprintf(stderr, "kernel_launch: unexpected problem (n_in %d, out %d, ws %zu; need ws >= %zu); nothing launched\n", n_in, out_size, ws_size, (size_t)WS_END); grid = -1; return; }
        int dev = 0, cus = 0, per_cu = 0;
        if (hipGetDevice(&dev) != hipSuccess || hipDeviceGetAttribute(&cus, hipDeviceAttributeMultiprocessorCount, dev) != hipSuccess) { grid = -1; return; }
        if (hipFuncSetAttribute((const void*)fwd, hipFuncAttributeMaxDynamicSharedMemorySize, LDS_BYTES) != hipSuccess) { fprintf(stderr, "kernel_launch: hipFuncSetAttribute failed\n"); grid = -1; return; }
        if (hipOccupancyMaxActiveBlocksPerMultiprocessor(&per_cu, (const void*)fwd, NWAVES * 64, LDS_BYTES) != hipSuccess || per_cu < 1) { fprintf(stderr, "kernel_launch: occupancy query says %d blocks per CU\n", per_cu); }
        (void)hipGetLastError();
        grid = cus;
    }
    if (grid < 0) return;
    if (hipMemsetAsync((char*)d_ws + WS_CTL, 0, CTL_ZERO_BYTES, stream) != hipSuccess) return;
    Args a{};
    for (int i = 0; i < 23; ++i) a.in[i] = (const float*)d_in[i];
    a.out = (float*)d_out; a.ws = (unsigned char*)d_ws; a.pad = 0;
#if MK_SPLIT
    for (int p = 0; p < NPH; ++p) { a.ph_lo = p; a.ph_hi = p + 1; a.use_bar = 0; hipLaunchKernelGGL(fwd, dim3(grid), dim3(NWAVES * 64), LDS_BYTES, stream, a); }
#else
    a.ph_lo = 0; a.ph_hi = NPH; a.use_bar = 1;
    hipLaunchKernelGGL(fwd, dim3(grid), dim3(NWAVES * 64), LDS_BYTES, stream, a);
#endif
    const hipError_t le = hipPeekAtLastError();
    if (le != hipSuccess) fprintf(stderr, "kernel_launch: launch failed: %s\n", hipGetErrorName(le));
}
```

```cpp
#include <hip/hip_runtime.h>
#include <cstdio>
#include <cstdint>

constexpr int DM = 2048, SEQ = 8192, NB = 128, DEPTH = 2;
constexpr int MV = SEQ + NB;
constexpr int MP = 8448;
constexpr int DI = 4096, NH = 64, HP = 64, DS = 128, NG = 8, CD = 6144, CW = 4;
constexpr int AH = 32, KVH = 8, AD = 64, WIN = 128;
constexpr int FF = 5632;
constexpr int IN_DIM = 17472;
constexpr float EPS = 1e-6f;
constexpr int UZ = 0, UXBC = 4096, UQ = 10240, UK = 12288, UV = 12800, UGS = 13312, UGA = 15360, LDU = 17408;
__host__ __device__ __forceinline__ constexpr size_t UIDX(int row, int col) { return ((size_t)(row >> 7) * (LDU / 64) + (size_t)(col >> 6)) * 8192 + (size_t)(((row & 127) << 6) + (col & 63)); }
constexpr int NU = 17664;
constexpr int KCAT = DI + DM;
constexpr int NGU = 2 * FF;

constexpr size_t O_YP = 0;
constexpr size_t O_YS = O_YP + (size_t)SEQ * DM;
constexpr size_t O_PSSM = O_YS + (size_t)NB * DM;
constexpr size_t O_PCONV = O_PSSM + (size_t)DEPTH * NH * HP * DS;
constexpr size_t O_PK = O_PCONV + (size_t)DEPTH * 3 * CD;
constexpr size_t O_PV = O_PK + (size_t)DEPTH * WIN * KVH * AD;
constexpr size_t O_SSSM = O_PV + (size_t)DEPTH * WIN * KVH * AD;
constexpr size_t O_SCONV = O_SSSM + (size_t)DEPTH * NB * NH * HP * DS;
constexpr size_t O_SK = O_SCONV + (size_t)DEPTH * NB * 3 * CD;
constexpr size_t O_SV = O_SK + (size_t)DEPTH * NB * WIN * KVH * AD;
constexpr size_t O_END = O_SV + (size_t)DEPTH * NB * WIN * KVH * AD;
static_assert(O_END == 190877696ull, "output size");

constexpr size_t al256(size_t x) { return (x + 255) & ~(size_t)255; }
constexpr size_t WS_CTL = 0, CTL_ZERO_BYTES = 1u << 20;
constexpr size_t SZ_WIN = (size_t)NU * DM * 2, SZ_WCAT = (size_t)DM * KCAT * 2, SZ_WOUT = (size_t)DM * DM * 2, SZ_WGU = (size_t)NGU * DM * 2, SZ_WDN = (size_t)DM * FF * 2;
constexpr size_t WS_WIN = 1u << 20;
constexpr size_t WS_WCAT = WS_WIN + DEPTH * SZ_WIN;
constexpr size_t WS_WOUT = WS_WCAT + DEPTH * SZ_WCAT;
constexpr size_t WS_WGU = WS_WOUT + DEPTH * SZ_WOUT;
constexpr size_t WS_WDN = WS_WGU + DEPTH * SZ_WGU;
constexpr size_t WS_X = WS_WDN + DEPTH * SZ_WDN;
constexpr size_t WS_XN = WS_X + (size_t)MP * DM * 4;
constexpr size_t WS_U = WS_XN + (size_t)MP * DM * 2;
constexpr size_t WS_DT = WS_U + (size_t)MP * LDU * 2;
constexpr size_t WS_YO = WS_DT + (size_t)MP * 64 * 4;
constexpr size_t WS_MRG = WS_YO + (size_t)MP * KCAT * 2;
constexpr size_t WS_HB = WS_MRG + (size_t)MP * DM * 2;
constexpr size_t WS_XT = WS_HB + (size_t)MP * FF * 2;
constexpr size_t WS_BRM = WS_XT + (size_t)64 * 64 * 64 * 128 * 2;
constexpr size_t WS_BT = WS_BRM + (size_t)64 * 8 * 128 * 128 * 2;
constexpr size_t WS_CRM = WS_BT + (size_t)64 * 8 * 128 * 128 * 2;
constexpr size_t WS_DTT = WS_CRM + (size_t)64 * 8 * 128 * 128 * 2;
constexpr size_t WS_ACS = WS_DTT + (size_t)64 * 64 * 128 * 4;
constexpr size_t WS_VT = WS_ACS + (size_t)64 * 64 * 128 * 4;
constexpr size_t WS_ST = WS_VT + (size_t)8 * 64 * 8192 * 2;
constexpr size_t WS_HS = WS_ST + (size_t)64 * 64 * 64 * 128 * 4;
constexpr size_t WS_MS = WS_HS + (size_t)64 * 64 * 64 * 128 * 2;
constexpr size_t WS_RSA = WS_MS + (size_t)NB * DM * 4;
constexpr size_t WS_RSB = WS_RSA + (size_t)MP * 4;
constexpr size_t WS_END = WS_RSB + (size_t)MP * 4;
static_assert(WS_WIN % 256 == 0 && WS_X % 256 == 0 && WS_U % 256 == 0 && WS_YO % 256 == 0 && WS_HB % 256 == 0 && WS_XT % 256 == 0 && WS_ST % 256 == 0, "ws alignment");
constexpr int CW_BAR = 4096;

constexpr int RING_OFF = 0, RING_BYTES = 131072;
constexpr int PC_B = 0, PC_C = 34816, PC_Y = 69632, PC_SSQ = 139264, PC_AD = 143360, PC_END = 151552;
constexpr int LDSCTL_OFF = PC_END, MISC_OFF = LDSCTL_OFF + 320;
constexpr int LDS_BYTES = 155648;
constexpr int NWAVES = 8;
#define MK_SPLIT 0
namespace pg8 {
#define PG8_LAS __attribute__((address_space(3)))
typedef unsigned short bf16_t;
typedef short bf16x8 __attribute__((ext_vector_type(8)));
typedef float f32x4 __attribute__((ext_vector_type(4)));
typedef unsigned u32x4 __attribute__((ext_vector_type(4)));
constexpr int BM = 256, BK = 64, HALF = 128, HTB = HALF * BK * 2  , STAGE_BYTES = 8 * HTB, NXCD = 8, WGM = 8;

__host__ __device__ __forceinline__ int lds_byte(int r, int c) { const int st = (r >> 4) * 2 + (c >> 5), rr = r & 15, cc = c & 31, ob = rr * 64 + cc * 2; return st * 1024 + (ob ^ (((ob >> 9) & 1) << 5)); }
__host__ __device__ __forceinline__ void stage_rc(int b, int& R, int& C) { const int st = b / 1024, sb = b % 1024, swz = sb ^ (((sb >> 9) & 1) << 5); R = (st >> 1) * 16 + swz / 64; C = (st & 1) * 32 + (swz % 64) / 2; }
__host__ __device__ __forceinline__ int perm32(int rho) { const int n = rho >> 4, i = rho & 15; return 8 * (i >> 2) + 4 * n + (i & 3); }

struct Unit { int pm, pn; };
struct Gemm { const bf16_t* A; const bf16_t* Bt; int M, N, K; };

struct StaticOrder {
    int nM, nN, nwg, G, c;
    __host__ __device__ void init(int M, int N, int G_, int c_) { nM = M / BM; nN = N / BM; nwg = nM * nN; G = G_; c = c_; }
    __host__ __device__ bool next(int i, Unit& u) const {
        const long L = (long)i * G + c; if (L >= nwg) return false;
        int wgid = (int)L; { const int q = nwg / NXCD, r = nwg % NXCD, xcd = wgid % NXCD, off = wgid / NXCD; wgid = (xcd < r ? xcd * (q + 1) : r * (q + 1) + (xcd - r) * q) + off; }
        const int nig = WGM * nN, gid = wgid / nig, fm = gid * WGM, gsz = (nM - fm) < WGM ? (nM - fm) : WGM;
        u.pm = fm + ((wgid % nig) % gsz); u.pn = (wgid % nig) / gsz; return true;
    }
    __device__ __forceinline__ void a_ready(const Unit&) const {}
    __device__ __forceinline__ void done(const Unit&) const {}
};
__device__ __forceinline__ unsigned cvt_pk_bf16(float lo, float hi) { unsigned r; asm volatile("v_cvt_pk_bf16_f32 %0, %1, %2" : "=v"(r) : "v"(lo), "v"(hi)); return r; }
__device__ __forceinline__ float bf_lo(unsigned w) { return __uint_as_float(w << 16); }
__device__ __forceinline__ float bf_hi(unsigned w) { return __uint_as_float(w & 0xffff0000u); }
__device__ __forceinline__ float sigmoidf_(float x) { return __builtin_amdgcn_rcpf(1.0f + __expf(-x)); }
constexpr int E_MV = 8320, E_LDU = 17408, E_UGS = 13312, E_UGA = 15360;
__device__ __forceinline__ size_t e_uidx(int row, int col) { return ((size_t)(row >> 7) * (E_LDU / 64) + (size_t)(col >> 6)) * 8192 + (size_t)(((row & 127) << 6) + (col & 63)); }
struct EpiU {
    static constexpr bool PERM = true, AFTER_DRAIN = false, HOOK = false, RSLDS = true; static constexpr int HOOK_T = -1;
    bf16_t* U; float* DT; const float* dtb; const float* RS;
    __device__ __forceinline__ void hook(f32x4 (&)[2][2][4][2], const Unit&, int, int, int, int) const {}
    __device__ __forceinline__ static float softplus_(float x) { return x > 20.0f ? x : log1pf(__expf(x)); }
    __device__ __forceinline__ void operator()(const f32x4 (&acc)[2][2][4][2], const Unit& u, int wr, int wc, int fr, int fq, const float (&rsv)[8]) const {
        const int row0 = u.pm * BM + wr * 64 + fr;
        auto rstd_ = [&](int q) { return rsqrtf(rsv[q] * (1.0f / 2048.0f) + 1e-6f); };
        if (u.pn == 68) {
            if (wc < 2) { const f32x4 b0 = *(const f32x4*)(dtb + wc * 32 + 8 * fq), b1 = *(const f32x4*)(dtb + wc * 32 + 8 * fq + 4);
#pragma unroll
                for (int ai = 0; ai < 2; ++ai) { if (u.pm * BM + ai * HALF >= E_MV) continue;
#pragma unroll
                    for (int m = 0; m < 4; ++m) { float* p = DT + (size_t)(row0 + ai * HALF + m * 16) * 64 + wc * 32 + 8 * fq; const float rs = rstd_(ai * 4 + m); f32x4 v0 = acc[ai][0][m][0] * rs + b0, v1 = acc[ai][0][m][1] * rs + b1;
#pragma unroll
                        for (int e = 0; e < 4; ++e) { v0[e] = softplus_(v0[e]); v1[e] = softplus_(v1[e]); }
                        *(f32x4*)p = v0; *(f32x4*)(p + 4) = v1; } }
            }
            return;
        }
        const bool sig = u.pn >= 52, zsilu = u.pn < 16;
        const int col0 = u.pn * BM + wc * 32 + 8 * fq;
#pragma unroll
        for (int ai = 0; ai < 2; ++ai) { if (u.pm * BM + ai * HALF >= E_MV) continue;
#pragma unroll
            for (int m = 0; m < 4; ++m) { const int rr = row0 + ai * HALF + m * 16; const float rs = rstd_(ai * 4 + m);
#pragma unroll
                for (int bj = 0; bj < 2; ++bj) { f32x4 v0 = acc[ai][bj][m][0] * rs, v1 = acc[ai][bj][m][1] * rs;
                    if (sig) {
#pragma unroll
                        for (int e = 0; e < 4; ++e) { v0[e] = sigmoidf_(v0[e]); v1[e] = sigmoidf_(v1[e]); } }
                    if (zsilu) {
#pragma unroll
                        for (int e = 0; e < 4; ++e) { v0[e] = v0[e] * sigmoidf_(v0[e]); v1[e] = v1[e] * sigmoidf_(v1[e]); } }
                    u32x4 w; w.x = cvt_pk_bf16(v0[0], v0[1]); w.y = cvt_pk_bf16(v0[2], v0[3]); w.z = cvt_pk_bf16(v1[0], v1[1]); w.w = cvt_pk_bf16(v1[2], v1[3]);
                    *(u32x4*)(U + e_uidx(rr, col0 + bj * HALF)) = w; } } }
    }
};
struct EpiMerge {
    static constexpr bool PERM = true, AFTER_DRAIN = false, HOOK = true, RSLDS = false; static constexpr int HOOK_T = 64;
    const bf16_t* U; bf16_t* O;
    __device__ __forceinline__ void hook(f32x4 (&acc)[2][2][4][2], const Unit& u, int wr, int wc, int fr, int fq) const {
        asm volatile("" : "+v"(fr), "+v"(fq));
        const int row0 = u.pm * BM + wr * 64 + fr, col0 = u.pn * BM + wc * 32 + 8 * fq;
        u32x4 gsA[2][2], gaA[2][2], gsB[2][2], gaB[2][2];
#define HK_LOAD(gs_, ga_, q_) do { _Pragma("unroll") for (int mm = 0; mm < 2; ++mm) { const int rr = row0 + ((q_) >> 1) * HALF + (2 * ((q_) & 1) + mm) * 16; \
            _Pragma("unroll") for (int bj = 0; bj < 2; ++bj) { gs_[mm][bj] = *(const u32x4*)(U + e_uidx(rr, E_UGS + col0 + bj * HALF)); ga_[mm][bj] = *(const u32x4*)(U + e_uidx(rr, E_UGA + col0 + bj * HALF)); } } } while (0)
#define HK_APPLY(gs_, ga_, q_) do { _Pragma("unroll") for (int mm = 0; mm < 2; ++mm) { const int ai = (q_) >> 1, m = 2 * ((q_) & 1) + mm; \
            _Pragma("unroll") for (int bj = 0; bj < 2; ++bj) { const u32x4 s = gs_[mm][bj], a = ga_[mm][bj]; f32x4 r0, r1; \
                r0[0] = bf_lo(s.x) * __builtin_amdgcn_rcpf(fmaxf(bf_lo(a.x), 1e-20f)); r0[1] = bf_hi(s.x) * __builtin_amdgcn_rcpf(fmaxf(bf_hi(a.x), 1e-20f)); r0[2] = bf_lo(s.y) * __builtin_amdgcn_rcpf(fmaxf(bf_lo(a.y), 1e-20f)); r0[3] = bf_hi(s.y) * __builtin_amdgcn_rcpf(fmaxf(bf_hi(a.y), 1e-20f)); \
                r1[0] = bf_lo(s.z) * __builtin_amdgcn_rcpf(fmaxf(bf_lo(a.z), 1e-20f)); r1[1] = bf_hi(s.z) * __builtin_amdgcn_rcpf(fmaxf(bf_hi(a.z), 1e-20f)); r1[2] = bf_lo(s.w) * __builtin_amdgcn_rcpf(fmaxf(bf_lo(a.w), 1e-20f)); r1[3] = bf_hi(s.w) * __builtin_amdgcn_rcpf(fmaxf(bf_hi(a.w), 1e-20f)); \
                acc[ai][bj][m][0] *= r0; acc[ai][bj][m][1] *= r1; } \
            asm volatile("" : "+v"(acc[ai][0][m][0]), "+v"(acc[ai][0][m][1]), "+v"(acc[ai][1][m][0]), "+v"(acc[ai][1][m][1]) :: "memory"); } } while (0)
        HK_LOAD(gsA, gaA, 0); HK_LOAD(gsB, gaB, 1); __builtin_amdgcn_sched_barrier(0);
        HK_APPLY(gsA, gaA, 0); HK_LOAD(gsA, gaA, 2); __builtin_amdgcn_sched_barrier(0);
        HK_APPLY(gsB, gaB, 1); HK_LOAD(gsB, gaB, 3); __builtin_amdgcn_sched_barrier(0);
        HK_APPLY(gsA, gaA, 2); __builtin_amdgcn_sched_barrier(0);
        HK_APPLY(gsB, gaB, 3);
#undef HK_LOAD
#undef HK_APPLY
    }
    __device__ __forceinline__ void operator()(const f32x4 (&acc)[2][2][4][2], const Unit& u, int wr, int wc, int fr, int fq) const {
        const int row0 = u.pm * BM + wr * 64 + fr, col0 = u.pn * BM + wc * 32 + 8 * fq;
        u32x4 gav[2][4][2];
#pragma unroll
        for (int ai = 0; ai < 2; ++ai)
#pragma unroll
            for (int m = 0; m < 4; ++m)
#pragma unroll
                for (int bj = 0; bj < 2; ++bj) gav[ai][m][bj] = *(const u32x4*)(U + e_uidx(row0 + ai * HALF + m * 16, E_UGA + col0 + bj * HALF));
#pragma unroll
        for (int ai = 0; ai < 2; ++ai)
#pragma unroll
            for (int m = 0; m < 4; ++m) { const size_t r = (size_t)(row0 + ai * HALF + m * 16);
#pragma unroll
                for (int bj = 0; bj < 2; ++bj) { const u32x4 ga = gav[ai][m][bj];
                    const f32x4 v0 = acc[ai][bj][m][0], v1 = acc[ai][bj][m][1];
                    u32x4 w; w.x = cvt_pk_bf16(v0[0] * bf_lo(ga.x), v0[1] * bf_hi(ga.x)); w.y = cvt_pk_bf16(v0[2] * bf_lo(ga.y), v0[3] * bf_hi(ga.y));
                    w.z = cvt_pk_bf16(v1[0] * bf_lo(ga.z), v1[1] * bf_hi(ga.z)); w.w = cvt_pk_bf16(v1[2] * bf_lo(ga.w), v1[3] * bf_hi(ga.w));
                    *(u32x4*)(O + r * 2048 + col0 + bj * HALF) = w; } }
    }
};
struct EpiResid {
    static constexpr bool PERM = true, AFTER_DRAIN = false, HOOK = false, RSLDS = false; static constexpr int HOOK_T = -1;
    const float* Xf; bf16_t* XB; float* RS;
    __device__ __forceinline__ void hook(f32x4 (&)[2][2][4][2], const Unit&, int, int, int, int) const {}
    __device__ __forceinline__ void tail_(f32x4 x0, f32x4 x1, float& ss, bf16_t* dst) const {
        ss += ((x0[0] * x0[0] + x0[1] * x0[1]) + (x0[2] * x0[2] + x0[3] * x0[3])) + ((x1[0] * x1[0] + x1[1] * x1[1]) + (x1[2] * x1[2] + x1[3] * x1[3]));
        u32x4 o; o.x = cvt_pk_bf16(x0[0], x0[1]); o.y = cvt_pk_bf16(x0[2], x0[3]); o.z = cvt_pk_bf16(x1[0], x1[1]); o.w = cvt_pk_bf16(x1[2], x1[3]);
        *(u32x4*)dst = o;
    }
    __device__ __forceinline__ void operator()(const f32x4 (&acc)[2][2][4][2], const Unit& u, int wr, int wc, int fr, int fq) const {
        const int row0 = u.pm * BM + wr * 64 + fr, col0 = u.pn * BM + wc * 32 + 8 * fq;
        if (Xf) {
#pragma unroll
            for (int ai = 0; ai < 2; ++ai) { f32x4 xo[4][2][2];
#pragma unroll
                for (int m = 0; m < 4; ++m)
#pragma unroll
                    for (int bj = 0; bj < 2; ++bj) { const float* p = Xf + (size_t)(row0 + ai * HALF + m * 16) * 2048 + col0 + bj * HALF; xo[m][bj][0] = *(const f32x4*)p; xo[m][bj][1] = *(const f32x4*)(p + 4); }
#pragma unroll
                for (int m = 0; m < 4; ++m) { const size_t ro = (size_t)(row0 + ai * HALF + m * 16) * 2048 + col0; float ss = 0.f;
#pragma unroll
                    for (int bj = 0; bj < 2; ++bj) tail_(xo[m][bj][0] + acc[ai][bj][m][0], xo[m][bj][1] + acc[ai][bj][m][1], ss, XB + ro + bj * HALF);
                    ss += __shfl_xor(ss, 16); ss += __shfl_xor(ss, 32);
                    if (fq == 0) unsafeAtomicAdd(RS + row0 + ai * HALF + m * 16, ss); } }
        } else {
            u32x4 xw[2][4][2];
#pragma unroll
            for (int ai = 0; ai < 2; ++ai)
#pragma unroll
                for (int m = 0; m < 4; ++m)
#pragma unroll
                    for (int bj = 0; bj < 2; ++bj) xw[ai][m][bj] = *(const u32x4*)(XB + (size_t)(row0 + ai * HALF + m * 16) * 2048 + col0 + bj * HALF);
#pragma unroll
            for (int ai = 0; ai < 2; ++ai)
#pragma unroll
                for (int m = 0; m < 4; ++m) { const size_t ro = (size_t)(row0 + ai * HALF + m * 16) * 2048 + col0; float ss = 0.f;
#pragma unroll
                    for (int bj = 0; bj < 2; ++bj) { const u32x4 w = xw[ai][m][bj];
                        tail_((f32x4){bf_lo(w.x), bf_hi(w.x), bf_lo(w.y), bf_hi(w.y)} + acc[ai][bj][m][0], (f32x4){bf_lo(w.z), bf_hi(w.z), bf_lo(w.w), bf_hi(w.w)} + acc[ai][bj][m][1], ss, XB + ro + bj * HALF); }
                    ss += __shfl_xor(ss, 16); ss += __shfl_xor(ss, 32);
                    if (fq == 0) unsafeAtomicAdd(RS + row0 + ai * HALF + m * 16, ss); }
        }
    }
};
struct EpiSwiGLU {
    static constexpr bool PERM = true, AFTER_DRAIN = false, HOOK = false, RSLDS = true; static constexpr int HOOK_T = -1;
    bf16_t* H; const float* RS;
    __device__ __forceinline__ void hook(f32x4 (&)[2][2][4][2], const Unit&, int, int, int, int) const {}
    __device__ __forceinline__ void operator()(const f32x4 (&acc)[2][2][4][2], const Unit& u, int wr, int wc, int fr, int fq, const float (&rsv)[8]) const {
        const int row0 = u.pm * BM + wr * 64 + fr, col0 = u.pn * 128 + wc * 16 + 4 * fq;
#pragma unroll
        for (int ai = 0; ai < 2; ++ai) { if (u.pm * BM + ai * HALF >= E_MV) continue;
#pragma unroll
            for (int m = 0; m < 4; ++m) { bf16_t* rowp = H + (size_t)(row0 + ai * HALF + m * 16) * 5632 + col0; const float rs = rsqrtf(rsv[ai * 4 + m] * (1.0f / 2048.0f) + 1e-6f);
#pragma unroll
                for (int bj = 0; bj < 2; ++bj) { const f32x4 g = acc[ai][bj][m][0] * rs, up = acc[ai][bj][m][1] * rs; float h[4];
#pragma unroll
                    for (int e = 0; e < 4; ++e) h[e] = g[e] * __builtin_amdgcn_rcpf(1.0f + __expf(-g[e])) * up[e];
                    typedef unsigned u32x2v __attribute__((ext_vector_type(2))); u32x2v w; w.x = cvt_pk_bf16(h[0], h[1]); w.y = cvt_pk_bf16(h[2], h[3]);
                    *(u32x2v*)(rowp + bj * 64) = w; } } }
    }
};
template <class Epi, class Sched, bool ALIGN_EPI = false, bool SP2 = false>
__device__ __forceinline__ void gemm_phase(PG8_LAS unsigned char* lds, const Gemm g, const Sched& S, const Epi& E, int tid_in) {
    int tid_l = tid_in; asm volatile("" : "+v"(tid_l));
    const int tid = tid_l, wid = __builtin_amdgcn_readfirstlane(tid >> 6), lane = tid & 63, wr = wid >> 2, wc = wid & 3, fr = lane & 15, fq = lane >> 4;
    const int K = g.K, nt = K / BK;
    unsigned voffA[2], voffB[2];
#pragma unroll
    for (int i = 0; i < 2; ++i) { int R, C; stage_rc(tid * 16 + i * 8192, R, C); const int Rb = Epi::PERM ? ((R & ~31) + perm32(R & 31)) : R;
        voffA[i] = (unsigned)(R * K + C) * 2u; voffB[i] = (unsigned)(Rb * K + C) * 2u; }
    const size_t kstep = (size_t)(BK * 2);
    const size_t hstep = (size_t)HALF * K * 2;
    const size_t tstep = 2 * hstep;
    const unsigned ldsw = (unsigned)wid * 1024u;
    const int aoff = lds_byte(wr * 64 + fr, fq * 8), boff = lds_byte(wc * 32 + fr, fq * 8);
#define PG8_SA(b, h) (((b) * 2 + (h)) * HTB)
#define PG8_SB(b, h) ((4 + (b) * 2 + (h)) * HTB)
#define PG8_STAGE(bufoff, gbase, voff) do { _Pragma("unroll") for (int _i = 0; _i < 2; ++_i) \
        __builtin_amdgcn_global_load_lds((const unsigned*)((const char*)(gbase) + (voff)[_i]), (PG8_LAS unsigned*)(lds + (bufoff) + ldsw + _i * 8192), 16, 0, 0); } while (0)
#define PG8_LDA(dst, b, h) do { _Pragma("unroll") for (int m = 0; m < 4; ++m) _Pragma("unroll") for (int k = 0; k < 2; ++k) dst[m][k] = *(const PG8_LAS bf16x8*)(lds + PG8_SA(b, h) + aoff + m * 2048 + k * 1024); } while (0)
#define PG8_LDB(dst, b, h) do { _Pragma("unroll") for (int n = 0; n < 2; ++n) _Pragma("unroll") for (int k = 0; k < 2; ++k) dst[n][k] = *(const PG8_LAS bf16x8*)(lds + PG8_SB(b, h) + boff + n * 2048 + k * 1024); } while (0)
#define PG8_MMA(ai, bj, At, Bt) do { __builtin_amdgcn_s_setprio(1); _Pragma("unroll") for (int m = 0; m < 4; ++m) _Pragma("unroll") for (int n = 0; n < 2; ++n) _Pragma("unroll") for (int k = 0; k < 2; ++k) \
        acc[ai][bj][m][n] = __builtin_amdgcn_mfma_f32_16x16x32_bf16(Bt[n][k], At[m][k], acc[ai][bj][m][n], 0, 0, 0); __builtin_amdgcn_s_setprio(0); } while (0)
#define PG8_WAIT_V(n) asm volatile("s_waitcnt vmcnt(" #n ")" ::: "memory")
#define PG8_WAIT_L(n) asm volatile("s_waitcnt lgkmcnt(" #n ")" ::: "memory")
#define PG8_BAR __builtin_amdgcn_s_barrier()
#define PG8_SCHED __builtin_amdgcn_sched_barrier(0)
    Unit cur, nxt; int ui = 0;
    if (!S.next(0, cur)) return;
    f32x4 acc[2][2][4][2];
#pragma unroll
    for (int a = 0; a < 2; ++a)
#pragma unroll
        for (int b = 0; b < 2; ++b)
#pragma unroll
            for (int m = 0; m < 4; ++m)
#pragma unroll
                for (int n = 0; n < 2; ++n) acc[a][b][m][n] = (f32x4){0.f, 0.f, 0.f, 0.f};
    bf16x8 At[4][2], B0[2][2], B1[2][2];
    const char* cA = (const char*)g.A + (size_t)cur.pm * tstep; const char* cB = (const char*)g.Bt + (size_t)cur.pn * tstep;
    S.a_ready(cur);
#define PG8_RSDMA(pm_, par_) __builtin_amdgcn_global_load_lds((const unsigned*)(E.RS + (pm_) * BM + wid * 64 + ((fq << 4) | fr)), (PG8_LAS unsigned*)(lds + 131072 + (par_) * 1024 + wid * 256), 4, 0, 0)
    if constexpr (Epi::RSLDS) { if (wid < 4) PG8_RSDMA(cur.pm, 0); }
    if constexpr (SP2) {
        PG8_STAGE(PG8_SB(0, 0), cB, voffB); PG8_STAGE(PG8_SB(0, 1), cB + hstep, voffB); PG8_STAGE(PG8_SA(0, 0), cA, voffA); PG8_STAGE(PG8_SA(0, 1), cA + hstep, voffA);
        if (wr == 1) PG8_BAR;
        PG8_WAIT_V(2); PG8_BAR;
        PG8_STAGE(PG8_SB(1, 0), cB + kstep, voffB); PG8_STAGE(PG8_SA(1, 0), cA + kstep, voffA); PG8_STAGE(PG8_SB(1, 1), cB + hstep + kstep, voffB);
        PG8_WAIT_V(6); PG8_BAR;
    } else {
        PG8_STAGE(PG8_SB(0, 0), cB, voffB); PG8_STAGE(PG8_SA(0, 0), cA, voffA); PG8_STAGE(PG8_SB(0, 1), cB + hstep, voffB); PG8_STAGE(PG8_SA(0, 1), cA + hstep, voffA);
        if (wr == 1) PG8_BAR;
        PG8_WAIT_V(4); PG8_BAR;
        PG8_STAGE(PG8_SB(1, 0), cB + kstep, voffB); PG8_STAGE(PG8_SA(1, 0), cA + kstep, voffA); PG8_STAGE(PG8_SB(1, 1), cB + hstep + kstep, voffB);
        PG8_WAIT_V(6); PG8_BAR;
    }
    for (;;) {
        const bool has_next = S.next(ui + 1, nxt);
        const char* nA = has_next ? (const char*)g.A + (size_t)nxt.pm * tstep : cA; const char* nB = has_next ? (const char*)g.Bt + (size_t)nxt.pn * tstep : cB;
        for (int t = 0; t < nt; t += 2) {
            const bool last = (t == nt - 2);
            const char* a1 = cA + (size_t)(t + 1) * kstep;
            const char* a2 = last ? nA : cA + (size_t)(t + 2) * kstep; const char* b2 = last ? nB : cB + (size_t)(t + 2) * kstep;
            const char* a3 = a2 + kstep; const char* b3 = b2 + kstep;
            if (last && has_next) S.a_ready(nxt);
            if constexpr (Epi::HOOK) { if (t == Epi::HOOK_T) E.hook(acc, cur, wr, wc, fr, fq); }
            if constexpr (SP2) {
            PG8_LDB(B0, 0, 0); PG8_LDB(B1, 0, 1); PG8_SCHED; PG8_LDA(At, 0, 0); PG8_STAGE(PG8_SA(1, 1), a1 + hstep, voffA);
            PG8_WAIT_V(8); PG8_WAIT_L(0); PG8_BAR; PG8_MMA(0, 0, At, B0); PG8_MMA(0, 1, At, B1); PG8_BAR; PG8_SCHED;
            PG8_LDA(At, 0, 1); PG8_STAGE(PG8_SB(0, 0), b2, voffB); PG8_STAGE(PG8_SB(0, 1), b2 + hstep, voffB); PG8_STAGE(PG8_SA(0, 0), a2, voffA);
            PG8_WAIT_V(8); PG8_WAIT_L(0); PG8_BAR; PG8_MMA(1, 0, At, B0); PG8_MMA(1, 1, At, B1); PG8_BAR; PG8_SCHED;
            PG8_LDB(B0, 1, 0); PG8_LDB(B1, 1, 1); PG8_SCHED; PG8_LDA(At, 1, 0); PG8_STAGE(PG8_SA(0, 1), a2 + hstep, voffA);
            PG8_WAIT_V(8); PG8_WAIT_L(0); PG8_BAR; PG8_MMA(0, 0, At, B0); PG8_MMA(0, 1, At, B1); PG8_BAR; PG8_SCHED;
            PG8_LDA(At, 1, 1); PG8_STAGE(PG8_SB(1, 0), b3, voffB); PG8_STAGE(PG8_SB(1, 1), b3 + hstep, voffB); PG8_STAGE(PG8_SA(1, 0), a3, voffA);
            PG8_WAIT_V(8); PG8_WAIT_L(0); PG8_BAR; PG8_MMA(1, 0, At, B0); PG8_MMA(1, 1, At, B1); PG8_BAR; PG8_SCHED;
            } else {
            PG8_LDB(B0, 0, 0); PG8_SCHED; PG8_LDA(At, 0, 0); PG8_STAGE(PG8_SA(1, 1), a1 + hstep, voffA);
            PG8_WAIT_L(8); PG8_BAR; PG8_WAIT_L(0); PG8_MMA(0, 0, At, B0); PG8_BAR; PG8_SCHED;
            PG8_LDB(B1, 0, 1); PG8_STAGE(PG8_SB(0, 0), b2, voffB);
            PG8_BAR; PG8_WAIT_L(0); PG8_MMA(0, 1, At, B1); PG8_BAR;
            PG8_LDA(At, 0, 1); PG8_STAGE(PG8_SA(0, 0), a2, voffA);
            PG8_BAR; PG8_WAIT_L(0); PG8_MMA(1, 0, At, B0); PG8_BAR; PG8_SCHED;
            PG8_STAGE(PG8_SB(0, 1), b2 + hstep, voffB);
            PG8_WAIT_V(6); PG8_BAR; PG8_MMA(1, 1, At, B1); PG8_BAR;
            PG8_LDB(B0, 1, 0); PG8_SCHED; PG8_LDA(At, 1, 0); PG8_STAGE(PG8_SA(0, 1), a2 + hstep, voffA);
            PG8_WAIT_L(8); PG8_BAR; PG8_WAIT_L(0); PG8_MMA(0, 0, At, B0); PG8_BAR; PG8_SCHED;
            PG8_LDB(B1, 1, 1); PG8_STAGE(PG8_SB(1, 0), b3, voffB);
            PG8_BAR; PG8_WAIT_L(0); PG8_MMA(0, 1, At, B1); PG8_BAR;
            PG8_LDA(At, 1, 1); PG8_STAGE(PG8_SA(1, 0), a3, voffA);
            PG8_BAR; PG8_WAIT_L(0); PG8_MMA(1, 0, At, B0); PG8_BAR; PG8_SCHED;
            PG8_STAGE(PG8_SB(1, 1), b3 + hstep, voffB);
            PG8_WAIT_V(6); PG8_BAR; PG8_MMA(1, 1, At, B1); PG8_BAR;
            }
        }
        if constexpr (ALIGN_EPI) { if (wr == 0) PG8_BAR; }
        if constexpr (!Epi::AFTER_DRAIN) {
            if constexpr (Epi::RSLDS) { float rsv[8]; const PG8_LAS float* rsl = (const PG8_LAS float*)(lds + 131072 + (ui & 1) * 1024) + wr * 64 + fr;
#pragma unroll
                for (int q = 0; q < 8; ++q) rsv[q] = rsl[(q >> 2) * HALF + (q & 3) * 16];
                asm volatile("s_waitcnt lgkmcnt(0)" : "+v"(rsv[0]), "+v"(rsv[1]), "+v"(rsv[2]), "+v"(rsv[3]), "+v"(rsv[4]), "+v"(rsv[5]), "+v"(rsv[6]), "+v"(rsv[7]) :: "memory");
                if (has_next && wid < 4) PG8_RSDMA(nxt.pm, (ui + 1) & 1);
                E(acc, cur, wr, wc, fr, fq, rsv);
            } else E(acc, cur, wr, wc, fr, fq);
            S.done(cur); }
        if (!has_next) break;
#pragma unroll
        for (int a = 0; a < 2; ++a)
#pragma unroll
            for (int b = 0; b < 2; ++b)
#pragma unroll
                for (int m = 0; m < 4; ++m)
#pragma unroll
                    for (int n = 0; n < 2; ++n) acc[a][b][m][n] = (f32x4){0.f, 0.f, 0.f, 0.f};
        cur = nxt; cA = nA; cB = nB; ++ui;
        if constexpr (ALIGN_EPI) { if (wr == 1) PG8_BAR; }
    }
    PG8_WAIT_V(0);
    if constexpr (!ALIGN_EPI) { if (wr == 0) PG8_BAR; }
    PG8_BAR;
    if constexpr (Epi::AFTER_DRAIN) { E.fused(acc, cur, wr, wc, fr, fq, lds, wid, lane); S.done(cur); }
#undef PG8_RSDMA
#undef PG8_SA
#undef PG8_SB
#undef PG8_STAGE
#undef PG8_LDA
#undef PG8_LDB
#undef PG8_MMA
#undef PG8_WAIT_V
#undef PG8_WAIT_L
#undef PG8_BAR
#undef PG8_SCHED
}
}
#define GAS __attribute__((address_space(1)))
#define LAS __attribute__((address_space(3)))
typedef unsigned short bf16;
typedef unsigned v4u __attribute__((ext_vector_type(4)));
typedef float f32x4 __attribute__((ext_vector_type(4)));
typedef short bf16x8 __attribute__((ext_vector_type(8)));
typedef GAS unsigned gu32;
typedef GAS unsigned long long gu64;
#define RLX_AGENT __ATOMIC_RELAXED, __HIP_MEMORY_SCOPE_AGENT
#define LDS_WAIT() asm volatile("s_waitcnt lgkmcnt(0)" ::: "memory")
#define VM_WAIT() asm volatile("s_waitcnt vmcnt(0)" ::: "memory")
__device__ __forceinline__ unsigned long long rt() { return __builtin_amdgcn_s_memrealtime(); }
__device__ __forceinline__ unsigned f2bf(float f) { unsigned u = __builtin_bit_cast(unsigned, f); return (u + 0x7fffu + ((u >> 16) & 1u)) >> 16; }
__device__ __forceinline__ unsigned pk2(float lo, float hi) { return f2bf(lo) | (f2bf(hi) << 16); }

#define XB_TMO      128
#define XB_XCNT(j)  (256  + 64 * (j))
#define XB_XSUB(j)  (1280 + 64 * (j))
#define XB_XGEN(j)  (2304 + 64 * (j))
#define XB_TOP      3328
#define XB_TOPGEN   3392
#define XCD_BAR_WORDS 3456
#define XB_SPIN_CAP (1u << 18)

__device__ __forceinline__ unsigned xb_ld(unsigned* p)              { return __hip_atomic_load(p, __ATOMIC_RELAXED, __HIP_MEMORY_SCOPE_AGENT); }
__device__ __forceinline__ unsigned xb_add(unsigned* p, unsigned v) { return __hip_atomic_fetch_add(p, v, __ATOMIC_RELAXED, __HIP_MEMORY_SCOPE_AGENT); }
__device__ __forceinline__ unsigned xb_xcc_id() { return (unsigned)__builtin_amdgcn_s_getreg((3 << 11) | 20) & 0xFu; }
#define XB_SPIN(cond, bar) do { unsigned _sp = 0; while (cond) { __builtin_amdgcn_s_sleep(1); \
    if ((++_sp & 255u) == 0u) { if (xb_ld(&(bar)[XB_TMO])) break; if (_sp > XB_SPIN_CAP) { atomicAdd(&(bar)[XB_TMO], 1u); break; } } } } while (0)

struct XcdBarrier {
    unsigned* bar; unsigned x;
    volatile LAS unsigned* st;
};

__device__ __forceinline__ XcdBarrier xcd_barrier_post(unsigned* bar, volatile LAS unsigned* st) {
    XcdBarrier b; b.bar = bar; b.x = xb_xcc_id(); b.st = st;
    if (threadIdx.x == 0) (void)xb_add(&bar[XB_XCNT(b.x)], 1u);
    return b;
}
__device__ __forceinline__ void xcd_barrier_complete(unsigned* bar, unsigned x, unsigned& nloc, unsigned& nx) {
    const unsigned G = gridDim.x * gridDim.y * gridDim.z;
    unsigned sum, cnt, mine, sp = 0u;
    for (;;) {
        sum = 0u; cnt = 0u; mine = 0u;
#pragma unroll
        for (unsigned j = 0; j < 16; ++j) { const unsigned c = xb_ld(&bar[XB_XCNT(j)]); sum += c; cnt += (c > 0u) ? 1u : 0u; mine = (j == x) ? c : mine; }
        if (sum == G) break;
        __builtin_amdgcn_s_sleep(1);
        if ((++sp & 255u) == 0u) { if (xb_ld(&bar[XB_TMO])) break; if (sp > XB_SPIN_CAP) { atomicAdd(&bar[XB_TMO], 1u); break; } }
    }
    nloc = mine > 0u ? mine : 1u; nx = cnt > 0u ? cnt : 1u;
}

__device__ __forceinline__ void xcd_barrier(const XcdBarrier& b) {
    asm volatile("s_waitcnt vmcnt(0)" ::: "memory");
    __syncthreads();
    if (threadIdx.x == 0) {
        unsigned* bar = b.bar;
        __builtin_amdgcn_s_waitcnt(0);
        unsigned nloc = b.st[0], nx = b.st[1];
        if (nloc == 0u) { xcd_barrier_complete(bar, b.x, nloc, nx); b.st[0] = nloc; b.st[1] = nx; }
        const unsigned old = xb_add(&bar[XB_XSUB(b.x)], 1u);
        const unsigned gen = old / nloc;
        if (old + 1u == (gen + 1u) * nloc) {
            __builtin_amdgcn_fence(__ATOMIC_RELEASE, "agent");
            asm volatile("s_waitcnt vmcnt(0)" ::: "memory");
            const unsigned og = xb_add(&bar[XB_TOP], 1u);
            const unsigned tg = og / nx;
            if (og + 1u == (tg + 1u) * nx) xb_add(&bar[XB_TOPGEN], 1u);
            else XB_SPIN(xb_ld(&bar[XB_TOPGEN]) == tg, bar);
            __builtin_amdgcn_fence(__ATOMIC_ACQUIRE, "agent");
            xb_add(&bar[XB_XGEN(b.x)], 1u);
            asm volatile("s_waitcnt vmcnt(0)" ::: "memory");
        } else {
            XB_SPIN(xb_ld(&bar[XB_XGEN(b.x)]) == gen, bar);
            __builtin_amdgcn_fence(__ATOMIC_ACQUIRE, "agent");
            asm volatile("s_waitcnt vmcnt(0)" ::: "memory");
        }
    }
    __syncthreads();
}
typedef float f32x16 __attribute__((ext_vector_type(16)));
typedef unsigned u32x2 __attribute__((ext_vector_type(2)));
__device__ __forceinline__ float bf2f(bf16 v) { return __uint_as_float(((unsigned)v) << 16); }
__device__ __forceinline__ float bflo(unsigned w) { return __uint_as_float(w << 16); }
__device__ __forceinline__ float bfhi(unsigned w) { return __uint_as_float(w & 0xffff0000u); }
__device__ __forceinline__ float wave_sum(float v) {
#pragma unroll
    for (int o = 1; o < 64; o <<= 1) v += __shfl_xor(v, o);
    return v;
}
__device__ __forceinline__ float wave_max(float v) {
#pragma unroll
    for (int o = 1; o < 64; o <<= 1) v = fmaxf(v, __shfl_xor(v, o));
    return v;
}
__device__ __forceinline__ float siluf_(float x) { return x * __builtin_amdgcn_rcpf(1.0f + __expf(-x)); }
__device__ __forceinline__ float softplusf_(float x) { return x > 20.0f ? x : log1pf(__expf(x)); }

struct Args { const float* in[23]; float* out; unsigned char* ws; int ph_lo, ph_hi, use_bar, pad; };
typedef const __attribute__((address_space(4))) Args* KArgs;
struct Ctx { LAS unsigned char* lds; int tid, lane, wave, G, bid; KArgs a; };

__device__ __forceinline__ int lane_now() { int t; asm volatile("v_mbcnt_lo_u32_b32 %0, -1, 0\n\tv_mbcnt_hi_u32_b32 %0, -1, %0" : "=v"(t)); return t; }
struct TItem { const float* sp; const float* gn; bf16* WT; int ldn, rowl, K, k0, R0; };
__device__ __forceinline__ void titem_load(const TItem& t, f32x4 (&v)[16], int) {
    const int kk = lane_now() >> 4;
    if (t.sp) {
#pragma unroll
        for (int i = 0; i < 16; ++i) v[i] = __builtin_nontemporal_load((const GAS f32x4*)(t.sp + (size_t)(t.k0 + 16 * kk + i) * t.ldn));
        if (t.gn) { const GAS f32x4* gp = (const GAS f32x4*)(t.gn + t.k0 + 16 * kk);
#pragma unroll
            for (int q = 0; q < 4; ++q) { const f32x4 g = gp[q]; v[4 * q] = v[4 * q] * g.x; v[4 * q + 1] = v[4 * q + 1] * g.y; v[4 * q + 2] = v[4 * q + 2] * g.z; v[4 * q + 3] = v[4 * q + 3] * g.w; } }
    } else {
#pragma unroll
        for (int i = 0; i < 16; ++i) { float z0 = 0.f; asm volatile("" : "+v"(z0)); v[i] = (f32x4){z0, z0, z0, z0}; }
    }
}
__device__ __forceinline__ void titem_store(const TItem& t, const f32x4 (&v)[16], LAS unsigned short* T, int) {
    const int lane = lane_now(), kk = lane >> 4;
    LAS unsigned char* Tb = (LAS unsigned char*)T;
#pragma unroll
    for (int j = 0; j < 4; ++j) { const int n = t.rowl + j, sw = (n >> 2) & 7; v4u lo, hi;
        lo.x = pg8::cvt_pk_bf16(v[0][j], v[1][j]); lo.y = pg8::cvt_pk_bf16(v[2][j], v[3][j]); lo.z = pg8::cvt_pk_bf16(v[4][j], v[5][j]); lo.w = pg8::cvt_pk_bf16(v[6][j], v[7][j]);
        hi.x = pg8::cvt_pk_bf16(v[8][j], v[9][j]); hi.y = pg8::cvt_pk_bf16(v[10][j], v[11][j]); hi.z = pg8::cvt_pk_bf16(v[12][j], v[13][j]); hi.w = pg8::cvt_pk_bf16(v[14][j], v[15][j]);
        *(LAS v4u*)(Tb + n * 128 + (((2 * kk) ^ sw) << 4)) = lo; *(LAS v4u*)(Tb + n * 128 + (((2 * kk + 1) ^ sw) << 4)) = hi; }
    LDS_WAIT(); asm volatile("" ::: "memory");
    const int ch = lane & 7, nr = lane >> 3;
#pragma unroll
    for (int it = 0; it < 8; ++it) { const int n = nr + 8 * it;
        const v4u o = *(const LAS v4u*)(Tb + n * 128 + ((ch ^ ((n >> 2) & 7)) << 4));
        *(GAS v4u*)(t.WT + (size_t)(t.R0 + n) * t.K + t.k0 + 8 * ch) = o; }
    LDS_WAIT(); asm volatile("" ::: "memory");
}
constexpr int IT_IN = (DM / 64) * (NU / 64), IT_CAT = (KCAT / 64) * (DM / 64), IT_OUT = (DM / 64) * (DM / 64), IT_GU = (DM / 64) * (NGU / 64), IT_DN = (FF / 64) * (DM / 64);
constexpr int IT_LAYER = IT_IN + IT_CAT + IT_OUT + IT_GU + IT_DN;
__device__ __forceinline__ TItem titem_decode(const Ctx& C, int it) {
    const int c4 = lane_now() & 15, l = it / IT_LAYER; int q = it % IT_LAYER; TItem t;
    if (q < IT_IN) { const int nblk = NU / 64, kb = q / nblk, nb = q % nblk, R = 64 * nb + 4 * c4;
        const int col = R < 10240 ? R : (R < 17408 ? R + 64 : (R < 17472 ? 10240 + (R - 17408) : -1));
        t.sp = col >= 0 ? (C.a->in[7]) + (size_t)l * DM * IN_DIM + col : nullptr; t.gn = (C.a->in[6]) + (size_t)l * DM; t.ldn = IN_DIM; t.rowl = 4 * c4; t.K = DM; t.WT = ((bf16*)(C.a->ws + WS_WIN)) + (size_t)l * NU * DM; t.k0 = 64 * kb; t.R0 = 64 * nb; return t; }
    q -= IT_IN;
    if (q < IT_CAT) { const int nblk = DM / 64, kb = q / nblk, nb = q % nblk, R = 64 * nb + 4 * c4, k0 = 64 * kb;
        t.sp = k0 < DI ? (C.a->in[14]) + (size_t)l * DI * DM + R : (C.a->in[15]) + (size_t)l * DM * DM + R - (size_t)DI * DM;
        t.gn = nullptr; t.ldn = DM; t.rowl = 4 * c4; t.K = KCAT; t.WT = ((bf16*)(C.a->ws + WS_WCAT)) + (size_t)l * DM * KCAT; t.k0 = k0; t.R0 = 64 * nb; return t; }
    q -= IT_CAT;
    if (q < IT_OUT) { const int nblk = DM / 64, kb = q / nblk, nb = q % nblk, R = 64 * nb + 4 * c4;
        t.sp = (C.a->in[17]) + (size_t)l * DM * DM + R; t.gn = nullptr; t.ldn = DM; t.rowl = 4 * c4; t.K = DM; t.WT = ((bf16*)(C.a->ws + WS_WOUT)) + (size_t)l * DM * DM; t.k0 = 64 * kb; t.R0 = 64 * nb; return t; }
    q -= IT_OUT;
    if (q < IT_GU) { const int nblk = NGU / 64, kb = q / nblk, nb = q % nblk;
        const int up = c4 >> 3, cg = c4 & 7;
        t.sp = (up ? (C.a->in[20]) : (C.a->in[19])) + (size_t)l * DM * FF + 32 * nb + 4 * cg; t.gn = (C.a->in[18]) + (size_t)l * DM; t.ldn = FF; t.rowl = 8 * cg + 4 * up; t.K = DM; t.WT = ((bf16*)(C.a->ws + WS_WGU)) + (size_t)l * NGU * DM; t.k0 = 64 * kb; t.R0 = 64 * nb; return t; }
    q -= IT_GU;
    { const int nblk = DM / 64, kb = q / nblk, nb = q % nblk, R = 64 * nb + 4 * c4;
        t.sp = (C.a->in[21]) + (size_t)l * FF * DM + R; t.gn = nullptr; t.ldn = DM; t.rowl = 4 * c4; t.K = FF; t.WT = ((bf16*)(C.a->ws + WS_WDN)) + (size_t)l * DM * FF; t.k0 = 64 * kb; t.R0 = 64 * nb; return t; }
}
__device__ __forceinline__ void p0_weights(const Ctx& C, int it_lo, int it_hi, int gw, int NGW) {
    LAS unsigned short* T = (LAS unsigned short*)(C.lds + RING_OFF + C.wave * 16384);
    int it = it_lo + gw; if (it >= it_hi) return;
    TItem cur = titem_decode(C, it); f32x4 va[16], vb[16];
    titem_load(cur, va, C.lane);
    for (;;) {
        int nit = it + NGW; TItem nxt = cur; const bool hn = nit < it_hi;
        if (hn) { nxt = titem_decode(C, nit); titem_load(nxt, vb, C.lane); }
        titem_store(cur, va, T, C.lane);
        if (!hn) break;
        it = nit + NGW; cur = nxt; const bool hn2 = it < it_hi;
        if (hn2) { cur = titem_decode(C, it); titem_load(cur, va, C.lane); }
        titem_store(nxt, vb, T, C.lane);
        if (!hn2) break;
    }
}
__device__ __forceinline__ void norm_row(const float* src, const float* gain, float* xcopy, bf16* xb, float* rs, float* fdst, int lane) {
    const GAS f32x4* xr = (const GAS f32x4*)src + lane;
    f32x4 v[8]; float s = 0.f;
#pragma unroll
    for (int j = 0; j < 8; ++j) { v[j] = xr[64 * j]; s += (v[j].x * v[j].x + v[j].y * v[j].y) + (v[j].z * v[j].z + v[j].w * v[j].w); }
    s = wave_sum(s);
    if (rs && lane == 0) *rs = s;
    if (xcopy) { GAS f32x4* xc = (GAS f32x4*)xcopy + lane;
#pragma unroll
        for (int j = 0; j < 8; ++j) xc[64 * j] = v[j]; }
    if (xb) {
#pragma unroll
        for (int j = 0; j < 8; ++j) { u32x2 w; w.x = pk2(v[j].x, v[j].y); w.y = pk2(v[j].z, v[j].w); *((GAS u32x2*)xb + lane + 64 * j) = w; } }
    if (fdst) { const float rstd = rsqrtf(s * (1.0f / DM) + EPS); const GAS f32x4* gr = (const GAS f32x4*)gain + lane;
#pragma unroll
        for (int j = 0; j < 8; ++j) { const f32x4 g = gr[64 * j]; f32x4 o = v[j] * rstd; o = o * g; *((GAS f32x4*)fdst + lane + 64 * j) = o; } }
}
__device__ __forceinline__ void p0_xinit(const Ctx& C) {
    const int gw = C.bid * NWAVES + C.wave, NGW = C.G * NWAVES;
    for (int m = gw; m < MV; m += NGW) { const float* src = m < SEQ ? (C.a->in[0]) + (size_t)m * DM : (C.a->in[1]) + (size_t)(m - SEQ) * DM;
        norm_row(src, nullptr, m < SEQ ? nullptr : ((float*)(C.a->ws + WS_X)) + (size_t)m * DM, ((bf16*)(C.a->ws + WS_XN)) + (size_t)m * DM, ((float*)(C.a->ws + WS_RSA)) + m, nullptr, C.lane); }
}
__device__ __forceinline__ void sample_rows_phase(const Ctx& C, float* RS) {
    const int gw = C.bid * NWAVES + C.wave, NGW = C.G * NWAVES;
    for (int m = SEQ + gw; m < MV; m += NGW) norm_row(((float*)(C.a->ws + WS_X)) + (size_t)m * DM, nullptr, nullptr, ((bf16*)(C.a->ws + WS_XN)) + (size_t)m * DM, RS + m, nullptr, C.lane);
}
__device__ __forceinline__ void final_norm_phase(const Ctx& C) {
    const int gw = C.bid * NWAVES + C.wave, NGW = C.G * NWAVES, lane = C.lane;
    f32x4 gv[8];
    { const GAS f32x4* gr = (const GAS f32x4*)(C.a->in[22]) + 2 * lane;
#pragma unroll
      for (int j = 0; j < 4; ++j) { gv[2 * j] = gr[128 * j]; gv[2 * j + 1] = gr[128 * j + 1]; } }
    for (int m = gw; m < MV; m += NGW) {
        if (m >= SEQ) { norm_row(((float*)(C.a->ws + WS_X)) + (size_t)m * DM, (C.a->in[22]), nullptr, nullptr, nullptr, (C.a->out) + O_YP + (size_t)m * DM, lane); continue; }
        const GAS v4u* xr = (const GAS v4u*)(((bf16*)(C.a->ws + WS_XN)) + (size_t)m * DM) + lane; v4u w[4]; float s = 0.f;
#pragma unroll
        for (int j = 0; j < 4; ++j) { w[j] = xr[64 * j]; const float a0 = bflo(w[j].x), a1 = bfhi(w[j].x), a2 = bflo(w[j].y), a3 = bfhi(w[j].y), a4 = bflo(w[j].z), a5 = bfhi(w[j].z), a6 = bflo(w[j].w), a7 = bfhi(w[j].w);
            s += ((a0 * a0 + a1 * a1) + (a2 * a2 + a3 * a3)) + ((a4 * a4 + a5 * a5) + (a6 * a6 + a7 * a7)); }
        const float rstd = rsqrtf(wave_sum(s) * (1.0f / DM) + EPS);
        GAS f32x4* op = (GAS f32x4*)((C.a->out) + O_YP + (size_t)m * DM) + 2 * lane;
#pragma unroll
        for (int j = 0; j < 4; ++j) { const f32x4 g0 = gv[2 * j], g1 = gv[2 * j + 1];
            op[128 * j] = (f32x4){bflo(w[j].x) * rstd * g0.x, bfhi(w[j].x) * rstd * g0.y, bflo(w[j].y) * rstd * g0.z, bfhi(w[j].y) * rstd * g0.w};
            op[128 * j + 1] = (f32x4){bflo(w[j].z) * rstd * g1.x, bfhi(w[j].z) * rstd * g1.y, bflo(w[j].w) * rstd * g1.z, bfhi(w[j].w) * rstd * g1.w}; }
    }
}
__device__ __forceinline__ void zero_f32(const Ctx& C, float* p, int n, int vb, int nvb) { float z0 = 0.f; asm volatile("" : "+v"(z0)); for (int i = vb * 512 + C.tid; i < n; i += nvb * 512) p[i] = z0; }

__device__ __forceinline__ void sample_ssd_wave_unit(const Ctx& C, int l, int b, int g, LAS float* wsc) {
    const int lane = lane_now();
    const int row = SEQ + b, n4 = lane & 31, prh = lane >> 5;
    LAS float* xs = wsc; LAS float* Bs = wsc + 512; LAS float* ys = wsc + 768;
    const float* cw = (C.a->in[8]) + (size_t)l * CW * CD; const float* cb = (C.a->in[9]) + (size_t)l * CD;
    const float* sc = (C.a->in[3]) + ((size_t)l * NB + b) * 3 * CD; const bf16* U = ((bf16*)(C.a->ws + WS_U));
    { const int ch = g * 512 + 8 * lane; const v4u un = *(const GAS v4u*)(U + UIDX(row, UXBC + ch)); const float nv[8] = {bflo(un.x), bfhi(un.x), bflo(un.y), bfhi(un.y), bflo(un.z), bfhi(un.z), bflo(un.w), bfhi(un.w)};
#pragma unroll
      for (int q = 0; q < 2; ++q) { const f32x4 bb = *(const GAS f32x4*)(cb + ch + 4 * q), w0 = *(const GAS f32x4*)(cw + ch + 4 * q), w1 = *(const GAS f32x4*)(cw + CD + ch + 4 * q), w2 = *(const GAS f32x4*)(cw + 2 * CD + ch + 4 * q), w3 = *(const GAS f32x4*)(cw + 3 * CD + ch + 4 * q);
          const f32x4 s0 = *(const GAS f32x4*)(sc + ch + 4 * q), s1 = *(const GAS f32x4*)(sc + CD + ch + 4 * q), s2 = *(const GAS f32x4*)(sc + 2 * CD + ch + 4 * q);
          f32x4 o;
#pragma unroll
          for (int e = 0; e < 4; ++e) o[e] = siluf_(bb[e] + w0[e] * s0[e] + w1[e] * s1[e] + w2[e] * s2[e] + w3[e] * nv[4 * q + e]);
          *(LAS f32x4*)(xs + 8 * lane + 4 * q) = o; } }
    { const int ch = (lane < 32 ? DI + g * 128 : DI + 1024 + g * 128 - 128) + 4 * lane;
      const u32x2 un = *(const GAS u32x2*)(U + UIDX(row, UXBC + ch)); const float nv[4] = {bflo(un.x), bfhi(un.x), bflo(un.y), bfhi(un.y)};
      const f32x4 bb = *(const GAS f32x4*)(cb + ch), w0 = *(const GAS f32x4*)(cw + ch), w1 = *(const GAS f32x4*)(cw + CD + ch), w2 = *(const GAS f32x4*)(cw + 2 * CD + ch), w3 = *(const GAS f32x4*)(cw + 3 * CD + ch);
      const f32x4 s0 = *(const GAS f32x4*)(sc + ch), s1 = *(const GAS f32x4*)(sc + CD + ch), s2 = *(const GAS f32x4*)(sc + 2 * CD + ch);
      f32x4 o;
#pragma unroll
      for (int e = 0; e < 4; ++e) o[e] = siluf_(bb[e] + w0[e] * s0[e] + w1[e] * s1[e] + w2[e] * s2[e] + w3[e] * nv[e]);
      *(LAS f32x4*)(Bs + 4 * lane) = o; }
    LDS_WAIT(); asm volatile("" ::: "memory");
    const f32x4 Bv = *((const LAS f32x4*)Bs + n4), Cv = *((const LAS f32x4*)(Bs + 128) + n4);
    const size_t sbase = (((size_t)l * NB + b) * NH + 8 * g) * HP * DS;
    for (int j = 0; j < 8; ++j) { const int h = 8 * g + j;
        const GAS f32x4* sp = (const GAS f32x4*)((C.a->in[2]) + sbase + (size_t)j * HP * DS + (size_t)prh * DS) + n4;
        GAS f32x4* op = (GAS f32x4*)((C.a->out) + O_SSSM + sbase + (size_t)j * HP * DS + (size_t)prh * DS) + n4;
        f32x4 hv[32];
#pragma unroll
        for (int i = 0; i < 32; ++i) hv[i] = __builtin_nontemporal_load(sp + (size_t)i * (2 * DS / 4));
        const float dt = ((float*)(C.a->ws + WS_DT))[(size_t)row * 64 + h], dA = __expf(-__expf((C.a->in[11])[l * NH + h]) * dt), Dh = (C.a->in[12])[l * NH + h];
#pragma unroll
        for (int i = 0; i < 32; ++i) { const int p = prh + 2 * i; const float xv = xs[j * 64 + p], dtx = dt * xv; const f32x4 h0 = hv[i];
            f32x4 hn; hn.x = dA * h0.x + dtx * Bv.x; hn.y = dA * h0.y + dtx * Bv.y; hn.z = dA * h0.z + dtx * Bv.z; hn.w = dA * h0.w + dtx * Bv.w;
            __builtin_nontemporal_store(hn, op + (size_t)i * (2 * DS / 4));
            float yp = (hn.x * Cv.x + hn.y * Cv.y) + (hn.z * Cv.z + hn.w * Cv.w);
#pragma unroll
            for (int o = 1; o < 32; o <<= 1) yp += __shfl_xor(yp, o);
            if (n4 == 0) ys[j * 64 + p] = yp + Dh * xv; }
    }
    LDS_WAIT(); asm volatile("" ::: "memory");
    { const int ch = g * 512 + 8 * lane; const v4u zw = *(const GAS v4u*)(U + UIDX(row, UZ + ch)); const f32x4 y0 = *(const LAS f32x4*)(ys + 8 * lane), y1 = *(const LAS f32x4*)(ys + 8 * lane + 4);
      float gv[8] = {y0.x * bflo(zw.x), y0.y * bfhi(zw.x), y0.z * bflo(zw.y), y0.w * bfhi(zw.y), y1.x * bflo(zw.z), y1.y * bfhi(zw.z), y1.z * bflo(zw.w), y1.w * bfhi(zw.w)};
      float ss = 0.f;
#pragma unroll
      for (int e = 0; e < 8; ++e) ss += gv[e] * gv[e];
      const float rstd = rsqrtf(wave_sum(ss) * (1.0f / 512.0f) + EPS);
      const f32x4 n0 = *(const GAS f32x4*)((C.a->in[13]) + (size_t)l * DI + ch), n1 = *(const GAS f32x4*)((C.a->in[13]) + (size_t)l * DI + ch + 4);
      v4u o; o.x = pk2(gv[0] * rstd * n0.x, gv[1] * rstd * n0.y); o.y = pk2(gv[2] * rstd * n0.z, gv[3] * rstd * n0.w); o.z = pk2(gv[4] * rstd * n1.x, gv[5] * rstd * n1.y); o.w = pk2(gv[6] * rstd * n1.z, gv[7] * rstd * n1.w);
      *(GAS v4u*)(((bf16*)(C.a->ws + WS_YO)) + (size_t)row * KCAT + ch) = o; }
    LDS_WAIT(); asm volatile("" ::: "memory");
}

__device__ __forceinline__ void sample_attn_phase(const Ctx& C, int l) {
    const int tid = C.tid;
    constexpr int KP = 68;
    LAS float* Ks = (LAS float*)(C.lds + RING_OFF); LAS float* Vs = Ks + 128 * KP; LAS float* qs = Vs + 128 * KP; LAS float* sc = qs + 256; LAS float* knew = sc + 4 * 132; LAS float* vnew = knew + 64;
    const bf16* U = ((bf16*)(C.a->ws + WS_U));
    f32x4 kv[4], vv[4]; float qx = 0.f;
#define SA_LOAD(u_) do { const int b_ = (u_) >> 3, kh_ = (u_) & 7, row_ = SEQ + b_; const size_t cb_ = ((size_t)l * NB + b_) * WIN * (KVH * AD) + (size_t)kh_ * AD; \
        _Pragma("unroll") for (int i = 0; i < 4; ++i) { const int idx = tid + 512 * i, w = idx >> 4, c4 = idx & 15; \
            kv[i] = __builtin_nontemporal_load((const GAS f32x4*)((C.a->in[4]) + cb_ + (size_t)w * (KVH * AD)) + c4); vv[i] = __builtin_nontemporal_load((const GAS f32x4*)((C.a->in[5]) + cb_ + (size_t)w * (KVH * AD)) + c4); } \
        if (tid < 256) qx = bf2f(U[UIDX(row_, UQ + kh_ * 256 + tid)]); else if (tid < 320) qx = bf2f(U[UIDX(row_, UK + kh_ * 64 + (tid - 256))]); else if (tid < 384) qx = bf2f(U[UIDX(row_, UV + kh_ * 64 + (tid - 320))]); } while (0)
    int u = C.bid; if (u >= NB * KVH) return;
    SA_LOAD(u);
    for (; u < NB * KVH; u += C.G) {
        const int b = u >> 3, kh = u & 7, row = SEQ + b;
        const size_t cbase = ((size_t)l * NB + b) * WIN * (KVH * AD) + (size_t)kh * AD;
        if (tid < 256) qs[tid] = qx; else if (tid < 320) knew[tid - 256] = qx; else if (tid < 384) vnew[tid - 320] = qx;
#pragma unroll
        for (int i = 0; i < 4; ++i) { const int idx = tid + 512 * i, w = idx >> 4, c4 = idx & 15; *((LAS f32x4*)(Ks + w * KP) + c4) = kv[i]; *((LAS f32x4*)(Vs + w * KP) + c4) = vv[i]; }
        __syncthreads();
        if (u + C.G < NB * KVH) SA_LOAD(u + C.G);
        if (tid < 16) { *((GAS f32x4*)((C.a->out) + O_SK + cbase + (size_t)(WIN - 1) * (KVH * AD)) + tid) = *((const LAS f32x4*)knew + tid); }
        else if (tid < 32) { *((GAS f32x4*)((C.a->out) + O_SV + cbase + (size_t)(WIN - 1) * (KVH * AD)) + (tid - 16)) = *((const LAS f32x4*)vnew + (tid - 16)); }
        { const int w = tid >> 2, hq = tid & 3; const LAS f32x4* kp = (const LAS f32x4*)(Ks + w * KP); const LAS f32x4* qp = (const LAS f32x4*)(qs + hq * 64);
          float s = 0.f;
    #pragma unroll
          for (int c = 0; c < 16; ++c) { const f32x4 kv = kp[c], qv = qp[c]; s += (kv.x * qv.x + kv.y * qv.y) + (kv.z * qv.z + kv.w * qv.w); }
          sc[hq * 132 + w] = s * 0.125f; }
        if (tid < 4) { float s = 0.f;
          for (int d = 0; d < 64; ++d) s += qs[tid * 64 + d] * knew[d];
          sc[tid * 132 + 128] = s * 0.125f; }
        __syncthreads();
        if (C.wave < 4) { const int hq = C.wave; const float sink = (C.a->in[16])[l * AH + 4 * kh + hq];
          const float v0 = sc[hq * 132 + C.lane], v1 = sc[hq * 132 + 64 + C.lane], v2 = C.lane == 0 ? sc[hq * 132 + 128] : -__builtin_inff();
          const float m = fmaxf(wave_max(fmaxf(fmaxf(v0, v1), v2)), sink);
          const float e0 = __expf(v0 - m), e1 = __expf(v1 - m), e2 = C.lane == 0 ? __expf(v2 - m) : 0.f;
          const float inv = 1.0f / (wave_sum(e0 + e1 + e2) + __expf(sink - m));
          sc[hq * 132 + C.lane] = e0 * inv; sc[hq * 132 + 64 + C.lane] = e1 * inv; if (C.lane == 0) sc[hq * 132 + 128] = e2 * inv; }
        __syncthreads();
        if (tid < 256) { const int hq = tid >> 6, d = tid & 63; float o = sc[hq * 132 + 128] * vnew[d];
    #pragma unroll 16
          for (int w = 0; w < WIN; ++w) o += sc[hq * 132 + w] * Vs[w * KP + d];
          ((bf16*)(C.a->ws + WS_YO))[(size_t)row * KCAT + DI + (4 * kh + hq) * 64 + d] = (bf16)f2bf(o); }
        __syncthreads();
    }
#undef SA_LOAD
}

__device__ __forceinline__ void cache_shift(const Ctx& C, int l, int vb, int nvb) {
    constexpr int ROWF4 = (WIN - 1) * KVH * AD / 4;
    for (int u = vb; u < NB * 2; u += nvb) { const int b = u >> 1, kv = u & 1;
        const GAS f32x4* src = (const GAS f32x4*)((kv ? (C.a->in[5]) : (C.a->in[4])) + ((size_t)l * NB + b) * WIN * (KVH * AD) + KVH * AD);
        GAS f32x4* dst = (GAS f32x4*)((C.a->out) + (kv ? O_SV : O_SK) + ((size_t)l * NB + b) * WIN * (KVH * AD));
        for (int i = C.tid; i < ROWF4; i += 512 * 8) { f32x4 v[8];
#pragma unroll
            for (int j = 0; j < 8; ++j) if (i + 512 * j < ROWF4) v[j] = __builtin_nontemporal_load(src + i + 512 * j);
#pragma unroll
            for (int j = 0; j < 8; ++j) if (i + 512 * j < ROWF4) __builtin_nontemporal_store(v[j], dst + i + 512 * j); } }
}

__device__ __forceinline__ void copy_outs(const Ctx& C, int l, int vb, int nvb) {
    const bf16* U = ((bf16*)(C.a->ws + WS_U)); const int gt = vb * 512 + C.tid, NT = nvb * 512;
    for (int i = gt; i < WIN * KVH * AD / 8; i += NT) { const int w = i >> 6, c = (i & 63) * 8, ur = SEQ - WIN + w;
        const v4u kw = *(const GAS v4u*)(U + UIDX(ur, UK + c)), vw = *(const GAS v4u*)(U + UIDX(ur, UV + c));
        GAS f32x4* pk = (GAS f32x4*)((C.a->out) + O_PK + (size_t)l * WIN * KVH * AD + (size_t)w * (KVH * AD) + c); GAS f32x4* pv = (GAS f32x4*)((C.a->out) + O_PV + (size_t)l * WIN * KVH * AD + (size_t)w * (KVH * AD) + c);
        pk[0] = (f32x4){bflo(kw.x), bfhi(kw.x), bflo(kw.y), bfhi(kw.y)}; pk[1] = (f32x4){bflo(kw.z), bfhi(kw.z), bflo(kw.w), bfhi(kw.w)};
        pv[0] = (f32x4){bflo(vw.x), bfhi(vw.x), bflo(vw.y), bfhi(vw.y)}; pv[1] = (f32x4){bflo(vw.z), bfhi(vw.z), bflo(vw.w), bfhi(vw.w)}; }
    constexpr int C8 = CD / 8;
    for (int i = gt; i < 3 * C8; i += NT) { const int j = i / C8, ch = (i - j * C8) * 8; const v4u w = *(const GAS v4u*)(U + UIDX(SEQ - 3 + j, UXBC + ch));
        GAS f32x4* po = (GAS f32x4*)((C.a->out) + O_PCONV + (size_t)l * 3 * CD + (size_t)j * CD + ch);
        po[0] = (f32x4){bflo(w.x), bfhi(w.x), bflo(w.y), bfhi(w.y)}; po[1] = (f32x4){bflo(w.z), bfhi(w.z), bflo(w.w), bfhi(w.w)}; }
    for (int i = gt; i < NB * C8; i += NT) { const int b = i / C8, ch = (i - b * C8) * 8;
        const GAS f32x4* si = (const GAS f32x4*)((C.a->in[3]) + ((size_t)l * NB + b) * 3 * CD + ch); GAS f32x4* so = (GAS f32x4*)((C.a->out) + O_SCONV + ((size_t)l * NB + b) * 3 * CD + ch);
        const f32x4 r10 = si[CD / 4], r11 = si[CD / 4 + 1], r20 = si[2 * CD / 4], r21 = si[2 * CD / 4 + 1]; const v4u w = *(const GAS v4u*)(U + UIDX(SEQ + b, UXBC + ch));
        so[0] = r10; so[1] = r11; so[CD / 4] = r20; so[CD / 4 + 1] = r21;
        so[2 * CD / 4] = (f32x4){bflo(w.x), bfhi(w.x), bflo(w.y), bfhi(w.y)}; so[2 * CD / 4 + 1] = (f32x4){bflo(w.z), bfhi(w.z), bflo(w.w), bfhi(w.w)}; }
}
typedef float f32x2_t __attribute__((ext_vector_type(2))); typedef __bf16 bf16x2_t __attribute__((ext_vector_type(2)));
__device__ __forceinline__ unsigned cvtpk(float lo, float hi) { f32x2_t v = {lo, hi}; bf16x2_t b = __builtin_convertvector(v, bf16x2_t); return __builtin_bit_cast(unsigned, b); }
__device__ __forceinline__ int crow(int reg, int hh) { return (reg & 3) + 8 * (reg >> 2) + 4 * hh; }
#define MFMA32(a, b, c) __builtin_amdgcn_mfma_f32_32x32x16_bf16((a), (b), (c), 0, 0, 0)
__device__ __forceinline__ bf16x8 ld16(const bf16* p) { return *(const GAS bf16x8*)p; }
__device__ __forceinline__ bf16x8 ld8x2(const bf16* p) {
    const u32x2 lo = *(const GAS u32x2*)p, hi = *(const GAS u32x2*)(p + 8); v4u w; w.x = lo.x; w.y = lo.y; w.z = hi.x; w.w = hi.y; return __builtin_bit_cast(bf16x8, w); }
#define PACK8(X, s) __builtin_bit_cast(bf16x8, (v4u){cvtpk((X)[8 * (s)], (X)[8 * (s) + 1]), cvtpk((X)[8 * (s) + 2], (X)[8 * (s) + 3]), cvtpk((X)[8 * (s) + 4], (X)[8 * (s) + 5]), cvtpk((X)[8 * (s) + 6], (X)[8 * (s) + 7])})

__device__ __forceinline__ void reformat_conv_item(const Ctx& C, int l, int c, int cblk) {
    const int co = C.lane & 7, rg = C.lane >> 3, ch0 = cblk * 64 + co * 8;
    const float* cw = (C.a->in[8]) + (size_t)l * CW * CD + ch0; const float* cb = (C.a->in[9]) + (size_t)l * CD + ch0;
    float w0[8], w1[8], w2[8], w3[8], bs[8];
#pragma unroll
    for (int j = 0; j < 8; ++j) { w0[j] = cw[j]; w1[j] = cw[CD + j]; w2[j] = cw[2 * CD + j]; w3[j] = cw[3 * CD + j]; bs[j] = cb[j]; }
    const bf16* U = ((bf16*)(C.a->ws + WS_U));
    const int row0 = 128 * c + 16 * rg;
    v4u raw[19];
    unsigned zu = 0u; asm volatile("" : "+v"(zu));
#pragma unroll
    for (int i = 0; i < 19; ++i) { const int rr = row0 - 3 + i; raw[i] = *(const GAS v4u*)(U + UIDX(rr < 0 ? 0 : rr, UXBC + ch0)); }
    __builtin_amdgcn_sched_barrier(0);
#pragma unroll
    for (int i = 0; i < 3; ++i) { if (row0 - 3 + i < 0) raw[i] = (v4u){zu, zu, zu, zu}; }
    unsigned tp[8][8];
    bf16* rm = nullptr; bf16* tr = nullptr;
    if (cblk < 64) tr = ((bf16*)(C.a->ws + WS_XT)) + (((size_t)c * 64 + cblk) * 64 + co * 8) * 128 + 16 * rg;
    else if (cblk < 80) { const int g = (cblk - 64) >> 1, hf = (cblk - 64) & 1;
        rm = ((bf16*)(C.a->ws + WS_BRM)) + (((size_t)c * 8 + g) * 128 + 16 * rg) * 128 + hf * 64 + co * 8;
        tr = ((bf16*)(C.a->ws + WS_BT)) + (((size_t)c * 8 + g) * 128 + hf * 64 + co * 8) * 128 + 16 * rg; }
    else { const int g = (cblk - 80) >> 1, hf = (cblk - 80) & 1;
        rm = ((bf16*)(C.a->ws + WS_CRM)) + (((size_t)c * 8 + g) * 128 + 16 * rg) * 128 + hf * 64 + co * 8; }
#define RAWF(i, j) (((j) & 1) ? bfhi(((j) >> 1) == 0 ? raw[i].x : (((j) >> 1) == 1 ? raw[i].y : (((j) >> 1) == 2 ? raw[i].z : raw[i].w))) : bflo(((j) >> 1) == 0 ? raw[i].x : (((j) >> 1) == 1 ? raw[i].y : (((j) >> 1) == 2 ? raw[i].z : raw[i].w))))
#pragma unroll
    for (int i2 = 0; i2 < 8; ++i2) {
        float oa[8], ob[8];
#pragma unroll
        for (int j = 0; j < 8; ++j) { oa[j] = siluf_(bs[j] + w0[j] * RAWF(2 * i2, j) + w1[j] * RAWF(2 * i2 + 1, j) + w2[j] * RAWF(2 * i2 + 2, j) + w3[j] * RAWF(2 * i2 + 3, j));
                                      ob[j] = siluf_(bs[j] + w0[j] * RAWF(2 * i2 + 1, j) + w1[j] * RAWF(2 * i2 + 2, j) + w2[j] * RAWF(2 * i2 + 3, j) + w3[j] * RAWF(2 * i2 + 4, j)); }
        if (rm) { v4u w; w.x = cvtpk(oa[0], oa[1]); w.y = cvtpk(oa[2], oa[3]); w.z = cvtpk(oa[4], oa[5]); w.w = cvtpk(oa[6], oa[7]); *(GAS v4u*)(rm + (size_t)(2 * i2) * 128) = w;
                  w.x = cvtpk(ob[0], ob[1]); w.y = cvtpk(ob[2], ob[3]); w.z = cvtpk(ob[4], ob[5]); w.w = cvtpk(ob[6], ob[7]); *(GAS v4u*)(rm + (size_t)(2 * i2 + 1) * 128) = w; }
#pragma unroll
        for (int j = 0; j < 8; ++j) tp[j][i2] = cvtpk(oa[j], ob[j]);
    }
#undef RAWF
    if (tr) {
#pragma unroll
        for (int j = 0; j < 8; ++j) { *(GAS v4u*)(tr + (size_t)j * 128) = (v4u){tp[j][0], tp[j][1], tp[j][2], tp[j][3]}; *(GAS v4u*)(tr + (size_t)j * 128 + 8) = (v4u){tp[j][4], tp[j][5], tp[j][6], tp[j][7]}; }
    }
}
__device__ __forceinline__ void reformat_dt_item(const Ctx& C, int l, int c) {
    const int h = C.lane; const float A = -__expf((C.a->in[11])[l * NH + h]);
    const float* D = ((float*)(C.a->ws + WS_DT)) + (size_t)(128 * c) * 64 + h;
    float* dto = ((float*)(C.a->ws + WS_DTT)) + ((size_t)c * 64 + h) * 128; float* aco = ((float*)(C.a->ws + WS_ACS)) + ((size_t)c * 64 + h) * 128;
    float cs = 0.f;
#pragma unroll
    for (int l0 = 0; l0 < 128; l0 += 64) { float dv[64];
#pragma unroll
        for (int i = 0; i < 64; ++i) dv[i] = D[(size_t)(l0 + i) * 64];
        __builtin_amdgcn_sched_barrier(0);
#pragma unroll
        for (int q = 0; q < 16; ++q) { f32x4 av;
#pragma unroll
            for (int e = 0; e < 4; ++e) { cs += dv[4 * q + e] * A; av[e] = cs; }
            *(GAS f32x4*)(dto + l0 + 4 * q) = (f32x4){dv[4 * q], dv[4 * q + 1], dv[4 * q + 2], dv[4 * q + 3]}; *(GAS f32x4*)(aco + l0 + 4 * q) = av; } }
}
__device__ __forceinline__ void reformat_vt_item(const Ctx& C, int tb, int kh) {
    const int co = C.lane & 7, rg = C.lane >> 3; const bf16* U = ((bf16*)(C.a->ws + WS_U)) + UIDX(128 * tb + 16 * rg, UV + kh * 64 + co * 8);
    unsigned tp[8][8]; v4u rv[16];
#pragma unroll
    for (int i = 0; i < 16; ++i) rv[i] = *(const GAS v4u*)(U + (size_t)i * 64);
    __builtin_amdgcn_sched_barrier(0);
#pragma unroll
    for (int i = 0; i < 16; ++i) { const v4u a = rv[i]; const unsigned w[4] = {a.x, a.y, a.z, a.w};
#pragma unroll
        for (int j = 0; j < 8; ++j) { const unsigned hb = (j & 1) ? (w[j >> 1] >> 16) : (w[j >> 1] & 0xffffu); if (i & 1) tp[j][i >> 1] |= hb << 16; else tp[j][i >> 1] = hb; } }
    bf16* tr = ((bf16*)(C.a->ws + WS_VT)) + ((size_t)kh * 64 + co * 8) * SEQ + 128 * tb + 16 * rg;
#pragma unroll
    for (int j = 0; j < 8; ++j) { *(GAS v4u*)(tr + (size_t)j * SEQ) = (v4u){tp[j][0], tp[j][1], tp[j][2], tp[j][3]}; *(GAS v4u*)(tr + (size_t)j * SEQ + 8) = (v4u){tp[j][4], tp[j][5], tp[j][6], tp[j][7]}; }
}
constexpr int RF_ITEMS = 64 * 96 + 64 + 64 * 8;
__device__ __forceinline__ void reformat_item(const Ctx& C, int l, int it) {
    constexpr int N1 = 64 * 96, N2 = 64;
    if (it < N1) reformat_conv_item(C, l, it / 96, it % 96);
    else if (it < N1 + N2) reformat_dt_item(C, l, it - N1);
    else reformat_vt_item(C, (it - N1 - N2) >> 3, (it - N1 - N2) & 7);
}

constexpr int AT_K = 0, AT_V = 36864, AT_KP = 144, AT_VP = 528;
__device__ __forceinline__ void attn_prompt_unit(const Ctx& C, int l, int qb, int kh) {
    const int lane_ = lane_now();
    const int r = lane_ & 31, hh = lane_ >> 5, hq = 4 * kh + (C.wave >> 1), rh = C.wave & 1, tid = C.wave * 64 + lane_;
    const bf16* U = ((bf16*)(C.a->ws + WS_U)); const bf16* VT = ((bf16*)(C.a->ws + WS_VT)) + (size_t)kh * 64 * SEQ; bf16* YO = ((bf16*)(C.a->ws + WS_YO));
    LAS unsigned char* Ks = C.lds + AT_K; LAS unsigned char* Vs = C.lds + AT_V;
    const int key0 = 128 * (qb - 1);
    bf16x8 bq[2][4];
    { v4u tk[4], tv[4]; unsigned zu = 0u; asm volatile("" : "+v"(zu));
#pragma unroll
      for (int i = 0; i < 4; ++i) { const int idx = tid + 512 * i, kr = idx >> 3, ch = idx & 7, key = key0 + kr;
          tk[i] = *(const GAS v4u*)(U + UIDX(key < 0 ? 0 : key, UK + kh * 64 + 8 * ch));
          const int d = idx >> 5, c5 = idx & 31, kk = key0 + 8 * c5;
          tv[i] = *(const GAS v4u*)(VT + (size_t)d * SEQ + (kk < 0 ? 0 : kk)); }
#pragma unroll
      for (int qt = 0; qt < 2; ++qt)
#pragma unroll
          for (int ks = 0; ks < 4; ++ks) bq[qt][ks] = ld16(U + UIDX(128 * qb + 32 * (2 * rh + qt) + r, UQ + hq * 64 + 16 * ks + 8 * hh));
      __builtin_amdgcn_sched_barrier(0);
#pragma unroll
      for (int i = 0; i < 4; ++i) { const int idx = tid + 512 * i; if (key0 + (idx >> 3) < 0) tk[i] = (v4u){zu, zu, zu, zu}; if (key0 + 8 * (idx & 31) < 0) tv[i] = (v4u){zu, zu, zu, zu}; }
#pragma unroll
      for (int i = 0; i < 4; ++i) { const int idx = tid + 512 * i; *(LAS v4u*)(Ks + (idx >> 3) * AT_KP + (idx & 7) * 16) = tk[i]; *(LAS v4u*)(Vs + (idx >> 5) * AT_VP + (idx & 31) * 16) = tv[i]; } }
    const float sink = (C.a->in[16])[l * AH + hq];
    __syncthreads();
#pragma unroll
    for (int qt = 0; qt < 2; ++qt) {
        const int ai = 2 * rh + qt, q0 = 128 * qb + 32 * ai, t = q0 + r;
        f32x16 S[5]; float mx = sink;
#pragma unroll
        for (int v = 0; v < 5; ++v) { const int kt = ai + v; const bool vis = qb > 0 || kt >= 4;
            if (vis) { const int kb = key0 + 32 * kt; f32x16 s;
#pragma unroll
                for (int e = 0; e < 16; ++e) s[e] = 0.f;
                const LAS unsigned char* kp = Ks + (32 * kt + r) * AT_KP + 16 * hh;
#pragma unroll
                for (int ks = 0; ks < 4; ++ks) { const bf16x8 a = *(const LAS bf16x8*)(kp + 32 * ks); s = MFMA32(a, bq[qt][ks], s); }
#pragma unroll
                for (int e = 0; e < 16; ++e) { const int j = kb + crow(e, hh); const bool ok = (j <= t) && (j >= t - WIN); const float x = ok ? s[e] * 0.125f : -__builtin_inff(); s[e] = x; mx = fmaxf(mx, x); }
                S[v] = s; }
        }
        mx = fmaxf(mx, __shfl_xor(mx, 32));
        float sum = 0.f;
#pragma unroll
        for (int v = 0; v < 5; ++v) { const int kt = ai + v; const bool vis = qb > 0 || kt >= 4;
            if (vis) {
#pragma unroll
                for (int e = 0; e < 16; ++e) { const float p = __expf(S[v][e] - mx); S[v][e] = p; sum += p; } } }
        sum += __shfl_xor(sum, 32); sum += __expf(sink - mx);
        f32x16 O[2];
#pragma unroll
        for (int e = 0; e < 16; ++e) { O[0][e] = 0.f; O[1][e] = 0.f; }
#pragma unroll
        for (int v = 0; v < 5; ++v) { const int kt = ai + v; const bool vis = qb > 0 || kt >= 4;
            if (vis) {
#pragma unroll
                for (int ss = 0; ss < 2; ++ss) { const bf16x8 pb = PACK8(S[v], ss);
#pragma unroll
                    for (int dt = 0; dt < 2; ++dt) { const LAS unsigned char* vp = Vs + (32 * dt + r) * AT_VP + (32 * kt + 16 * ss + 4 * hh) * 2;
                        const u32x2 lo = *(const LAS u32x2*)vp, hi = *(const LAS u32x2*)(vp + 16);
                        const bf16x8 va = __builtin_bit_cast(bf16x8, (v4u){lo.x, lo.y, hi.x, hi.y}); O[dt] = MFMA32(va, pb, O[dt]); } } } }
        const float inv = 1.0f / sum;
        bf16* op = YO + (size_t)t * KCAT + DI + hq * 64;
#pragma unroll
        for (int dt = 0; dt < 2; ++dt)
#pragma unroll
            for (int g4 = 0; g4 < 4; ++g4) { u32x2 w; w.x = cvtpk(O[dt][4 * g4] * inv, O[dt][4 * g4 + 1] * inv); w.y = cvtpk(O[dt][4 * g4 + 2] * inv, O[dt][4 * g4 + 3] * inv);
                *(GAS u32x2*)(op + 32 * dt + 8 * g4 + 4 * hh) = w; }
    }
    __syncthreads();
}

__device__ __forceinline__ void ssd_states_unit(const Ctx& C, int c, int g) {
    const int lane_ = lane_now();
    const int r = lane_ & 31, hh = lane_ >> 5, h = 8 * g + C.wave, tid = C.wave * 64 + lane_;
    const bf16* xT = ((bf16*)(C.a->ws + WS_XT)) + ((size_t)c * 64 + h) * 64 * 128; const bf16* bT = ((bf16*)(C.a->ws + WS_BT)) + ((size_t)c * 8 + g) * 128 * 128;
    const float* dtT = ((float*)(C.a->ws + WS_DTT)) + ((size_t)c * 64 + h) * 128; const float* acs = ((float*)(C.a->ws + WS_ACS)) + ((size_t)c * 64 + h) * 128;
    LAS unsigned char* Bs = C.lds + PC_B; LAS float* scs = (LAS float*)(C.lds + PC_C) + C.wave * 128;
    v4u tb[4], raw[2][8];
#pragma unroll
    for (int i = 0; i < 4; ++i) tb[i] = *(const GAS v4u*)(bT + (size_t)(tid + 512 * i) * 8);
    const float dl0 = dtT[lane_], dl1 = dtT[64 + lane_], al0 = acs[lane_], al1 = acs[64 + lane_], aend = acs[127];
#pragma unroll
    for (int ks = 0; ks < 8; ++ks)
#pragma unroll
        for (int pt = 0; pt < 2; ++pt) raw[pt][ks] = *(const GAS v4u*)(xT + (size_t)(32 * pt + r) * 128 + 16 * ks + 8 * hh);
    __builtin_amdgcn_sched_barrier(0);
#pragma unroll
    for (int i = 0; i < 4; ++i) { const int idx = tid + 512 * i; *(LAS v4u*)(Bs + (idx >> 4) * 272 + (idx & 15) * 16) = tb[i]; }
    scs[lane_] = dl0 * __expf(aend - al0); scs[64 + lane_] = dl1 * __expf(aend - al1);
    LDS_WAIT(); asm volatile("" ::: "memory");
    bf16x8 a[2][8];
#pragma unroll
    for (int ks = 0; ks < 8; ++ks) { const f32x4 s0 = *(const LAS f32x4*)(scs + 16 * ks + 8 * hh), s1 = *(const LAS f32x4*)(scs + 16 * ks + 8 * hh + 4);
#pragma unroll
        for (int pt = 0; pt < 2; ++pt) { const v4u w = raw[pt][ks];
            v4u o; o.x = cvtpk(bflo(w.x) * s0.x, bfhi(w.x) * s0.y); o.y = cvtpk(bflo(w.y) * s0.z, bfhi(w.y) * s0.w); o.z = cvtpk(bflo(w.z) * s1.x, bfhi(w.z) * s1.y); o.w = cvtpk(bflo(w.w) * s1.z, bfhi(w.w) * s1.w);
            a[pt][ks] = __builtin_bit_cast(bf16x8, o); } }
    __syncthreads();
    bf16* st = ((bf16*)(C.a->ws + WS_ST)) + ((size_t)c * 64 + h) * 64 * 128;
#pragma unroll
    for (int nt = 0; nt < 4; ++nt) {
        f32x16 acc[2];
#pragma unroll
        for (int e = 0; e < 16; ++e) { acc[0][e] = 0.f; acc[1][e] = 0.f; }
        const LAS unsigned char* bp = Bs + (32 * nt + r) * 272 + 16 * hh;
#pragma unroll
        for (int ks = 0; ks < 8; ++ks) { const bf16x8 b = *(const LAS bf16x8*)(bp + 32 * ks); acc[0] = MFMA32(b, a[0][ks], acc[0]); acc[1] = MFMA32(b, a[1][ks], acc[1]); }
#pragma unroll
        for (int pt = 0; pt < 2; ++pt)
#pragma unroll
            for (int q4 = 0; q4 < 4; ++q4) { u32x2 w; w.x = cvtpk(acc[pt][4 * q4], acc[pt][4 * q4 + 1]); w.y = cvtpk(acc[pt][4 * q4 + 2], acc[pt][4 * q4 + 3]);
                *(GAS u32x2*)(st + (size_t)(32 * pt + r) * 128 + 32 * nt + 8 * q4 + 4 * hh) = w; }
    }
    __syncthreads();
}

__device__ __forceinline__ void ssd_scan_phase(const Ctx& C, int l) {
    const bf16* ST = ((bf16*)(C.a->ws + WS_ST)); bf16* HS = ((bf16*)(C.a->ws + WS_HS)); const float* acs = ((float*)(C.a->ws + WS_ACS));
    for (int idx = C.bid * 512 + C.tid; idx < 64 * 64 * 128 / 4; idx += C.G * 512) { const int h = idx >> 11;
        f32x4 hc = (f32x4){0.f, 0.f, 0.f, 0.f};
        for (int c0 = 0; c0 < 64; c0 += 16) { u32x2 sw[16]; float av[16];
#pragma unroll
            for (int j = 0; j < 16; ++j) { sw[j] = *((const GAS u32x2*)(ST + (size_t)(c0 + j) * 64 * 64 * 128) + idx); av[j] = acs[((size_t)(c0 + j) * 64 + h) * 128 + 127]; }
#pragma unroll
            for (int j = 0; j < 16; ++j) {
                u32x2 w; w.x = cvtpk(hc.x, hc.y); w.y = cvtpk(hc.z, hc.w); *((GAS u32x2*)(HS + (size_t)(c0 + j) * 64 * 64 * 128) + idx) = w;
                const f32x4 s = (f32x4){bflo(sw[j].x), bfhi(sw[j].x), bflo(sw[j].y), bfhi(sw[j].y)}; const float dec = __expf(av[j]);
                hc = hc * dec + s; } }
        *((GAS f32x4*)((C.a->out) + O_PSSM + (size_t)l * NH * HP * DS) + idx) = hc; }
}

__device__ __forceinline__ void ssd_out_unit(const Ctx& C, int l, int c, int g) {
    const int lane_ = lane_now();
    const int r = lane_ & 31, hh = lane_ >> 5, h = 8 * g + C.wave, tid = C.wave * 64 + lane_;
    LAS unsigned char* Bs = C.lds + PC_B; LAS unsigned char* Cs = C.lds + PC_C; LAS float* Ysm = (LAS float*)(C.lds + PC_Y + C.wave * 8704);
    LAS float* ssq = (LAS float*)(C.lds + PC_SSQ); LAS float* acsS = (LAS float*)(C.lds + PC_AD + C.wave * 1024); LAS float* dtS = acsS + 128;
    const bf16* cR = ((bf16*)(C.a->ws + WS_CRM)) + ((size_t)c * 8 + g) * 128 * 128; const bf16* bR = ((bf16*)(C.a->ws + WS_BRM)) + ((size_t)c * 8 + g) * 128 * 128;
    const bf16* hS = ((bf16*)(C.a->ws + WS_HS)) + ((size_t)c * 64 + h) * 64 * 128; const bf16* xT = ((bf16*)(C.a->ws + WS_XT)) + ((size_t)c * 64 + h) * 64 * 128;
    LAS float* nws = (LAS float*)(C.lds + 152576) + C.wave * 64;
    bf16x8 hb[2][8], xb[4][2][2];
    { v4u tb[4], tc[4];
#pragma unroll
      for (int i = 0; i < 4; ++i) { const int idx = tid + 512 * i; tb[i] = *(const GAS v4u*)(bR + (size_t)idx * 8); tc[i] = *(const GAS v4u*)(cR + (size_t)idx * 8); }
      const float a0 = (((float*)(C.a->ws + WS_ACS)) + ((size_t)c * 64 + h) * 128)[lane_], a1 = (((float*)(C.a->ws + WS_ACS)) + ((size_t)c * 64 + h) * 128)[64 + lane_];
      const float d0 = (((float*)(C.a->ws + WS_DTT)) + ((size_t)c * 64 + h) * 128)[lane_], d1 = (((float*)(C.a->ws + WS_DTT)) + ((size_t)c * 64 + h) * 128)[64 + lane_];
      const float nwv = ((C.a->in[13]) + (size_t)l * DI + h * 64)[lane_];
#pragma unroll
      for (int pt = 0; pt < 2; ++pt)
#pragma unroll
          for (int ks = 0; ks < 8; ++ks) hb[pt][ks] = ld16(hS + (size_t)(32 * pt + r) * 128 + 16 * ks + 8 * hh);
#pragma unroll
      for (int st = 0; st < 4; ++st)
#pragma unroll
          for (int ss = 0; ss < 2; ++ss)
#pragma unroll
              for (int pt = 0; pt < 2; ++pt) xb[st][ss][pt] = ld8x2(xT + (size_t)(32 * pt + r) * 128 + 32 * st + 16 * ss + 4 * hh);
      __builtin_amdgcn_sched_barrier(0);
#pragma unroll
      for (int i = 0; i < 4; ++i) { const int idx = tid + 512 * i, row = idx >> 4, ch = idx & 15; *(LAS v4u*)(Bs + row * 272 + ch * 16) = tb[i]; *(LAS v4u*)(Cs + row * 272 + ch * 16) = tc[i]; }
      acsS[lane_] = a0; acsS[64 + lane_] = a1; dtS[lane_] = d0; dtS[64 + lane_] = d1; nws[lane_] = nwv; }
    const float Dh = (C.a->in[12])[l * NH + h];
    __syncthreads();
    const bf16* Uz = ((bf16*)(C.a->ws + WS_U)) + UIDX(128 * c + (lane_ >> 1), UZ + h * 64 + 32 * (lane_ & 1));
    bf16* YOw = ((bf16*)(C.a->ws + WS_YO)) + (size_t)(128 * c + (lane_ >> 1)) * KCAT + h * 64 + 32 * (lane_ & 1);
    const LAS float* nwp = nws + 32 * (lane_ & 1);
#pragma unroll
    for (int lt = 0; lt < 4; ++lt) {
        v4u zw[4];
        { const GAS v4u* zp = (const GAS v4u*)(Uz + (size_t)(32 * lt) * 64);
#pragma unroll
          for (int i = 0; i < 4; ++i) zw[i] = zp[i]; }
        f32x16 y[2];
#pragma unroll
        for (int e = 0; e < 16; ++e) { y[0][e] = 0.f; y[1][e] = 0.f; }
        const LAS unsigned char* crow_p = Cs + (32 * lt + r) * 272 + 16 * hh;
#pragma unroll
        for (int ks = 0; ks < 8; ++ks) { if ((ks & 3) == 0) asm volatile("" ::: "memory");
            const bf16x8 a = *(const LAS bf16x8*)(crow_p + 32 * ks); y[0] = MFMA32(a, hb[0][ks], y[0]); y[1] = MFMA32(a, hb[1][ks], y[1]); }
#pragma unroll
        for (int q4 = 0; q4 < 4; ++q4) { const f32x4 av = *(const LAS f32x4*)(acsS + 32 * lt + 8 * q4 + 4 * hh);
#pragma unroll
            for (int e = 0; e < 4; ++e) { const float f = __expf(av[e]); y[0][4 * q4 + e] *= f; y[1][4 * q4 + e] *= f; } }
        const float al = acsS[32 * lt + r];
#pragma unroll
        for (int st = 0; st < 4; ++st) { if (st > lt) continue;
            f32x16 X;
#pragma unroll
            for (int e = 0; e < 16; ++e) X[e] = 0.f;
            const LAS unsigned char* brow_p = Bs + (32 * st + r) * 272 + 16 * hh;
#pragma unroll
            for (int ks = 0; ks < 8; ++ks) { if ((ks & 1) == 0) asm volatile("" ::: "memory");
                const bf16x8 a = *(const LAS bf16x8*)(brow_p + 32 * ks), b = *(const LAS bf16x8*)(crow_p + 32 * ks); X = MFMA32(a, b, X); }
#pragma unroll
            for (int q4 = 0; q4 < 4; ++q4) { const f32x4 as = *(const LAS f32x4*)(acsS + 32 * st + 8 * q4 + 4 * hh), ds = *(const LAS f32x4*)(dtS + 32 * st + 8 * q4 + 4 * hh);
#pragma unroll
                for (int e = 0; e < 4; ++e) { const int s = 32 * st + 8 * q4 + 4 * hh + e, lrow = 32 * lt + r; const float wgt = (s <= lrow) ? ds[e] * __expf(al - as[e]) : 0.f; X[4 * q4 + e] *= wgt; } }
#pragma unroll
            for (int ss = 0; ss < 2; ++ss) { const bf16x8 xa = PACK8(X, ss); y[0] = MFMA32(xa, xb[st][ss][0], y[0]); y[1] = MFMA32(xa, xb[st][ss][1], y[1]); }
        }
#pragma unroll
        for (int pt = 0; pt < 2; ++pt)
#pragma unroll
            for (int e = 0; e < 16; ++e) { const int q4 = e >> 2; const v4u xw = __builtin_bit_cast(v4u, xb[lt][q4 >> 1][pt]); const unsigned w = (q4 & 1) ? ((e & 2) ? xw.w : xw.z) : ((e & 2) ? xw.y : xw.x);
                const float xv = (e & 1) ? bfhi(w) : bflo(w);
                Ysm[crow(e, hh) * 68 + 32 * pt + r] = y[pt][e] + Dh * xv; }
        { const LAS f32x4* yr = (const LAS f32x4*)(Ysm + (lane_ >> 1) * 68 + 32 * (lane_ & 1));
          float gq[32]; float sq = 0.f;
#pragma unroll
          for (int i = 0; i < 4; ++i) { const f32x4 ya = yr[2 * i], yb = yr[2 * i + 1];
              gq[8 * i + 0] = ya.x * bflo(zw[i].x); gq[8 * i + 1] = ya.y * bfhi(zw[i].x); gq[8 * i + 2] = ya.z * bflo(zw[i].y); gq[8 * i + 3] = ya.w * bfhi(zw[i].y);
              gq[8 * i + 4] = yb.x * bflo(zw[i].z); gq[8 * i + 5] = yb.y * bfhi(zw[i].z); gq[8 * i + 6] = yb.z * bflo(zw[i].w); gq[8 * i + 7] = yb.w * bfhi(zw[i].w);
#pragma unroll
              for (int e = 0; e < 8; ++e) sq += gq[8 * i + e] * gq[8 * i + e]; }
          sq += __shfl_xor(sq, 1);
          if ((lane_ & 1) == 0) ssq[(32 * lt + (lane_ >> 1)) * 8 + C.wave] = sq;
          __syncthreads();
          const LAS f32x4* sp = (const LAS f32x4*)(ssq + (32 * lt + (lane_ >> 1)) * 8); const f32x4 s0 = sp[0], s1 = sp[1];
          const float rstd = rsqrtf(((s0.x + s0.y) + (s0.z + s0.w) + (s1.x + s1.y) + (s1.z + s1.w)) * (1.0f / 512.0f) + EPS);
          GAS v4u* op = (GAS v4u*)(YOw + (size_t)(32 * lt) * KCAT);
#pragma unroll
          for (int i = 0; i < 4; ++i) { const f32x4 na = *(const LAS f32x4*)(nwp + 8 * i), nb = *(const LAS f32x4*)(nwp + 8 * i + 4);
              op[i] = (v4u){cvtpk(gq[8 * i] * rstd * na.x, gq[8 * i + 1] * rstd * na.y), cvtpk(gq[8 * i + 2] * rstd * na.z, gq[8 * i + 3] * rstd * na.w), cvtpk(gq[8 * i + 4] * rstd * nb.x, gq[8 * i + 5] * rstd * nb.y), cvtpk(gq[8 * i + 6] * rstd * nb.z, gq[8 * i + 7] * rstd * nb.w)}; } }
    }
    __syncthreads();
}

template <int MODE> __device__ __forceinline__ void mini_unit(const Ctx& C, int l, int mu) {
    constexpr int K = MODE == 0 ? KCAT : (MODE == 1 ? DM : FF), KS = MODE == 0 ? 1024 : (MODE == 1 ? 256 : 704);
    const int lane_ = lane_now();
    const int r = lane_ & 31, hh = lane_ >> 5, ct = mu & 31, sp = mu >> 5, rt = C.wave & 3, n0 = 64 * ct + 32 * (C.wave >> 2), k0 = KS * sp + 8 * hh;
    const bf16* Bt = (MODE == 0 ? ((bf16*)(C.a->ws + WS_WCAT)) + (size_t)l * DM * KCAT : (MODE == 1 ? ((bf16*)(C.a->ws + WS_WOUT)) + (size_t)l * DM * DM : ((bf16*)(C.a->ws + WS_WDN)) + (size_t)l * DM * FF)) + (size_t)(n0 + r) * K + k0;
    const bf16* Ab = (MODE == 0 ? ((bf16*)(C.a->ws + WS_YO)) + (size_t)(SEQ + 32 * rt + r) * KCAT : ((bf16*)(C.a->ws + WS_HB)) + (size_t)(SEQ + 32 * rt + r) * FF) + k0;
    const float* Af = ((float*)(C.a->ws + WS_MS)) + (size_t)(32 * rt + r) * DM + k0;
    f32x16 acc;
#pragma unroll
    for (int e = 0; e < 16; ++e) acc[e] = 0.f;
    constexpr int UB = MODE == 1 ? 8 : (MODE == 2 ? 11 : 16), NB_ = KS / 16 / UB;
    static_assert(NB_ * UB * 16 == KS, "mini-unit batches");
#pragma unroll 1
    for (int kb = 0; kb < NB_; ++kb) {
        bf16x8 bv[UB];
        if (MODE == 1) { f32x4 a0[UB], a1[UB];
#pragma unroll
            for (int j = 0; j < UB; ++j) { bv[j] = ld16(Bt + 16 * (kb * UB + j)); a0[j] = *(const GAS f32x4*)(Af + 16 * (kb * UB + j)); a1[j] = *(const GAS f32x4*)(Af + 16 * (kb * UB + j) + 4); }
            __builtin_amdgcn_sched_barrier(0);
#pragma unroll
            for (int j = 0; j < UB; ++j) { const bf16x8 a = __builtin_bit_cast(bf16x8, (v4u){cvtpk(a0[j].x, a0[j].y), cvtpk(a0[j].z, a0[j].w), cvtpk(a1[j].x, a1[j].y), cvtpk(a1[j].z, a1[j].w)}); acc = MFMA32(a, bv[j], acc); }
        } else { bf16x8 av[UB];
#pragma unroll
            for (int j = 0; j < UB; ++j) { bv[j] = ld16(Bt + 16 * (kb * UB + j)); av[j] = ld16(Ab + 16 * (kb * UB + j)); }
            __builtin_amdgcn_sched_barrier(0);
#pragma unroll
            for (int j = 0; j < UB; ++j) acc = MFMA32(av[j], bv[j], acc);
        }
        __builtin_amdgcn_sched_barrier(0);
    }
    float* dst = (MODE == 0 ? ((float*)(C.a->ws + WS_MS)) : ((float*)(C.a->ws + WS_X)) + (size_t)SEQ * DM) + n0 + r;
    if (MODE == 0) { const bf16* gp = ((bf16*)(C.a->ws + WS_U)) + UIDX(SEQ, (sp < 4 ? UGS : UGA) + n0 + r);
        bf16 gv[16];
#pragma unroll
        for (int e = 0; e < 16; ++e) gv[e] = gp[(size_t)(32 * rt + crow(e, hh)) * 64];
        __builtin_amdgcn_sched_barrier(0);
#pragma unroll
        for (int e = 0; e < 16; ++e) acc[e] *= bf2f(gv[e]); }
#pragma unroll
    for (int e = 0; e < 16; ++e) unsafeAtomicAdd(dst + (size_t)(32 * rt + crow(e, hh)) * DM, acc[e]);
}
template <int MODE> __device__ __forceinline__ void mini_phase(const Ctx& C, int l) {
    constexpr int NMU = 32 * (MODE == 0 ? 6 : 8);
    for (int mu = C.bid; mu < NMU; mu += C.G) mini_unit<MODE>(C, l, mu);
}
constexpr int NPL = 11;
constexpr int NPH = 1 + DEPTH * NPL;
#ifndef REP_P0
#define REP_P0 1
#endif
#ifndef REP_0
#define REP_0 1
#endif
#ifndef REP_1
#define REP_1 1
#endif
#ifndef REP_2
#define REP_2 1
#endif
#ifndef REP_3
#define REP_3 1
#endif
#ifndef REP_4
#define REP_4 1
#endif
#ifndef REP_5
#define REP_5 1
#endif
#ifndef REP_6
#define REP_6 1
#endif
#ifndef REP_7
#define REP_7 1
#endif
#ifndef REP_8
#define REP_8 1
#endif
#ifndef REP_9
#define REP_9 1
#endif
#ifndef REP_10
#define REP_10 1
#endif
#ifndef REP_RF
#define REP_RF 1
#endif
#ifndef REP_SSD
#define REP_SSD 1
#endif
#ifndef REP_SATT
#define REP_SATT 1
#endif
#ifndef GEMM_ALIGN
#define GEMM_ALIGN true
#endif
#ifndef GEMM_SP2
#define GEMM_SP2 true
#endif
#ifndef PROBE_LO
#define PROBE_LO -1
#define PROBE_HI -1
#endif
#ifndef PROBE_AMP
#define PROBE_AMP 2
#endif
#ifndef NW_SSD
#define NW_SSD 2
#endif
#ifndef PROBE_SUB
#define PROBE_SUB 0
#endif
#ifndef PROBE_CLK
#define PROBE_CLK 0
#endif
#ifndef REP_ATT
#define REP_ATT 1
#endif
#ifndef REP_PA
#define REP_PA 1
#endif
#ifndef NSP_G1
#define NSP_G1 49
#endif
#ifndef MK_SPLIT
#define MK_SPLIT 0
#endif
__global__ void __launch_bounds__(NWAVES * 64, 2) fwd(Args args) {
    extern __shared__ __attribute__((aligned(16))) unsigned char lds_raw[];
    LAS unsigned char* const lds = (LAS unsigned char*)lds_raw;
    const int wave_s = __builtin_amdgcn_readfirstlane(threadIdx.x >> 6);
    unsigned char* ws = args.ws;
#define FRESH_CTX() Ctx C; { int t_; asm volatile("v_mbcnt_lo_u32_b32 %0, -1, 0\n\tv_mbcnt_hi_u32_b32 %0, -1, %0" : "=v"(t_)); t_ += wave_s * 64; int b_ = blockIdx.x, g_ = gridDim.x; asm volatile("" : "+s"(b_), "+s"(g_)); \
        KArgs kp_ = (KArgs)__builtin_amdgcn_kernarg_segment_ptr(); asm volatile("" : "+s"(kp_)); \
        C.lds = lds; C.tid = t_; C.lane = t_ & 63; C.wave = __builtin_amdgcn_readfirstlane(t_ >> 6); C.G = g_; C.bid = b_; C.a = kp_; }
    for (int u = threadIdx.x; u < (LDS_BYTES - LDSCTL_OFF) / 4; u += NWAVES * 64) ((LAS unsigned*)(lds + LDSCTL_OFF))[u] = 0u;
    __syncthreads();
    volatile LAS unsigned* MISC = (volatile LAS unsigned*)(lds + MISC_OFF);
    unsigned* barw = (unsigned*)(ws + WS_CTL) + CW_BAR;
    XcdBarrier bar; bar.bar = barw; bar.x = 0; bar.st = nullptr;
    if (args.use_bar) bar = xcd_barrier_post(barw, MISC + 8);
    const int lo = args.ph_lo, hi = args.ph_hi;
#define IN(k) (lo <= (k) && (k) < hi)
#define SEAM(k) do { if (IN((k) + 1)) xcd_barrier(bar); } while (0)

#ifndef NO_P0
    if (IN(0)) { for (int rep_ = 0; rep_ < REP_P0; ++rep_) { FRESH_CTX(); p0_weights(C, 0, (C.G >= 64 && NSP_G1 > 0) ? IT_IN : DEPTH * IT_LAYER, C.bid * NWAVES + C.wave, C.G * NWAVES); p0_xinit(C); if (rep_ + 1 < REP_P0) xcd_barrier(bar); } SEAM(0); }
#endif

    unsigned long long probe_acc = 0ull, probe_t0 = 0ull;
    if (PROBE_CLK && threadIdx.x == 0) { const unsigned long long c0_ = __builtin_amdgcn_s_memtime(), r0_ = __builtin_amdgcn_s_memrealtime(); MISC[16] = (unsigned)c0_; MISC[17] = (unsigned)(c0_ >> 32); MISC[18] = (unsigned)r0_; MISC[19] = (unsigned)(r0_ >> 32); }
#define PROBE_BEGIN(j) do { if (PROBE_LO >= 0 && (j) == PROBE_LO) probe_t0 = __builtin_amdgcn_s_memrealtime(); } while (0)
#define PROBE_END(j) do { if (PROBE_LO >= 0 && (j) == PROBE_HI) probe_acc += __builtin_amdgcn_s_memrealtime() - probe_t0; } while (0)
#pragma nounroll
    for (int l = 0; l < DEPTH; ++l) {
        const int pb = 1 + l * NPL;
#ifndef NO_G1
        PROBE_BEGIN(0);
        if (IN(pb + 0)) { for (int rep_ = 0; rep_ < REP_0; ++rep_) {
            FRESH_CTX();
            const int nsp = (l == 0 && C.G >= 64) ? (C.G * NSP_G1) / 256 : 0, gG = C.G - nsp;
            if (C.bid < gG) {
            pg8::Gemm g{((bf16*)(C.a->ws + WS_XN)), ((bf16*)(C.a->ws + WS_WIN)) + (size_t)l * NU * DM, MP, NU, DM}; pg8::StaticOrder S; S.init(MP, NU, gG, C.bid);
            pg8::EpiU E{((bf16*)(C.a->ws + WS_U)), ((float*)(C.a->ws + WS_DT)), (C.a->in[10]) + l * NH, ((float*)(C.a->ws + WS_RSA))};
            pg8::gemm_phase<pg8::EpiU, pg8::StaticOrder, GEMM_ALIGN, GEMM_SP2>(C.lds + RING_OFF, g, S, E, C.tid);
            } else p0_weights(C, IT_IN, DEPTH * IT_LAYER, (C.bid - gG) * NWAVES + C.wave, nsp * NWAVES);
            if (rep_ + 1 < REP_0) xcd_barrier(bar); }
            SEAM(pb + 0);
        }
        PROBE_END(0);
#endif
        PROBE_BEGIN(1);
        if (IN(pb + 1)) { for (int rep_ = 0; rep_ < REP_1; ++rep_) {
            FRESH_CTX();
            { volatile LAS unsigned* qctr = (volatile LAS unsigned*)(C.lds + MISC_OFF) + 24;
              if (C.tid == 0) qctr[0] = 0u;
              __syncthreads();
              const int nS = (NB * NG - C.bid + C.G - 1) / C.G, nR = (RF_ITEMS - C.bid + C.G - 1) / C.G;
              LAS float* wsc = (LAS float*)(C.lds + RING_OFF + C.wave * 8192);
              for (;;) { unsigned idx = 0u; if (C.lane == 0) idx = __hip_atomic_fetch_add((LAS unsigned*)qctr, 1u, __ATOMIC_RELAXED, __HIP_MEMORY_SCOPE_WORKGROUP);
                  idx = (unsigned)__builtin_amdgcn_readfirstlane((int)idx);
                  if ((int)idx >= nS + nR) break;
                  if ((int)idx < nS) { const int u = C.bid + C.G * (int)idx; sample_ssd_wave_unit(C, l, u >> 3, u & 7, wsc); }
                  else reformat_item(C, l, C.bid + C.G * ((int)idx - nS)); } }
            __syncthreads();
            if (PROBE_SUB == 1) probe_acc += __builtin_amdgcn_s_memrealtime() - probe_t0;
            if (PROBE_SUB == 2) probe_t0 = __builtin_amdgcn_s_memrealtime();
            zero_f32(C, ((float*)(C.a->ws + WS_RSB)), SEQ, C.bid, C.G);
            { float z0 = 0.f; asm volatile("" : "+v"(z0));
              for (int i = C.bid * 512 + C.tid; i < NB * DM / 4; i += C.G * 512) ((GAS f32x4*)(C.a->ws + WS_MS))[i] = (f32x4){z0, z0, z0, z0}; }
            for (int rr_ = 0; rr_ < REP_SATT; ++rr_) sample_attn_phase(C, l);
            if (PROBE_SUB == 2) probe_acc += __builtin_amdgcn_s_memrealtime() - probe_t0;
            if (PROBE_SUB == 3) probe_t0 = __builtin_amdgcn_s_memrealtime();
            if (PROBE_SUB == 3) { __syncthreads(); probe_acc += __builtin_amdgcn_s_memrealtime() - probe_t0; }
            if (rep_ + 1 < REP_1) xcd_barrier(bar); }
            SEAM(pb + 1);
        }
        PROBE_END(1);
        PROBE_BEGIN(2);
        if (IN(pb + 2)) { for (int rep_ = 0; rep_ < REP_2; ++rep_) {
            FRESH_CTX();
#ifdef USE_NSSD
            if (C.bid < NG) naive_ssd_prompt(C, l, C.bid);
            else {
                const int vb = C.bid - NG, nvb = C.G - NG;
                for (int u = vb; u < 64 * KVH; u += nvb) attn_prompt_unit(C, l, u >> 3, u & 7);
                for (int u = vb; u < 64 * NG; u += nvb) ssd_states_unit(C, u >> 3, u & 7);
            }
#else
            for (int rr_ = 0; rr_ < REP_ATT; ++rr_) for (int u = C.bid; u < 64 * KVH; u += C.G) attn_prompt_unit(C, l, u >> 3, u & 7);
            for (int rr_ = 0; rr_ < REP_PA; ++rr_) for (int u = C.bid; u < 64 * NG; u += C.G) ssd_states_unit(C, u >> 3, u & 7);
#endif
            if (rep_ + 1 < REP_2) xcd_barrier(bar); }
            SEAM(pb + 2);
        }
        PROBE_END(2);
        PROBE_BEGIN(3);
        if (IN(pb + 3)) { for (int rep_ = 0; rep_ < REP_3; ++rep_) { FRESH_CTX(); ssd_scan_phase(C, l); if (rep_ + 1 < REP_3) xcd_barrier(bar); } SEAM(pb + 3); }
        PROBE_END(3);
        PROBE_BEGIN(4);
        if (IN(pb + 4)) { for (int rep_ = 0; rep_ < REP_4; ++rep_) {
            FRESH_CTX();
#ifndef USE_NSSD
            for (int u = C.bid; u < 64 * NG; u += C.G) ssd_out_unit(C, l, u >> 3, u & 7);
#endif
            if (rep_ + 1 < REP_4) xcd_barrier(bar); }
            SEAM(pb + 4);
        }
        PROBE_END(4);
#ifndef NO_G2
        PROBE_BEGIN(5);
        if (IN(pb + 5)) { for (int rep_ = 0; rep_ < REP_5; ++rep_) {
            FRESH_CTX();
            pg8::Gemm g{((bf16*)(C.a->ws + WS_YO)), ((bf16*)(C.a->ws + WS_WCAT)) + (size_t)l * DM * KCAT, SEQ, DM, KCAT}; pg8::StaticOrder S; S.init(SEQ, DM, C.G, C.bid);
            pg8::EpiMerge E{((bf16*)(C.a->ws + WS_U)), ((bf16*)(C.a->ws + WS_MRG))};
            pg8::gemm_phase<pg8::EpiMerge, pg8::StaticOrder, true, true>(C.lds + RING_OFF, g, S, E, C.tid);
            mini_phase<0>(C, l);
            if (rep_ + 1 < REP_5) xcd_barrier(bar); }
            SEAM(pb + 5);
        }
        PROBE_END(5);
#endif
#ifndef NO_G3
        PROBE_BEGIN(6);
        if (IN(pb + 6)) { for (int rep_ = 0; rep_ < REP_6; ++rep_) {
            FRESH_CTX();
            pg8::Gemm g{((bf16*)(C.a->ws + WS_MRG)), ((bf16*)(C.a->ws + WS_WOUT)) + (size_t)l * DM * DM, SEQ, DM, DM}; pg8::StaticOrder S; S.init(SEQ, DM, C.G, C.bid);
            pg8::EpiResid E{l == 0 ? (C.a->in[0]) : (const float*)nullptr, ((bf16*)(C.a->ws + WS_XN)), ((float*)(C.a->ws + WS_RSB))};
            pg8::gemm_phase<pg8::EpiResid, pg8::StaticOrder, true, true>(C.lds + RING_OFF, g, S, E, C.tid);
            mini_phase<1>(C, l);
            if (rep_ + 1 < REP_6) xcd_barrier(bar); }
            SEAM(pb + 6);
        }
        PROBE_END(6);
#endif
        PROBE_BEGIN(7);
        if (IN(pb + 7)) { for (int rep_ = 0; rep_ < REP_7; ++rep_) { FRESH_CTX(); sample_rows_phase(C, ((float*)(C.a->ws + WS_RSB))); if (rep_ + 1 < REP_7) xcd_barrier(bar); } SEAM(pb + 7); }
        PROBE_END(7);
#ifndef NO_G4
        PROBE_BEGIN(8);
        if (IN(pb + 8)) { for (int rep_ = 0; rep_ < REP_8; ++rep_) {
            FRESH_CTX();
            const int nsp = C.G >= 64 ? (C.G * 14) / 256 : 0, gG = C.G - nsp;
            if (C.bid < gG) {
            pg8::Gemm g{((bf16*)(C.a->ws + WS_XN)), ((bf16*)(C.a->ws + WS_WGU)) + (size_t)l * NGU * DM, MP, NGU, DM}; pg8::StaticOrder S; S.init(MP, NGU, gG, C.bid);
            pg8::EpiSwiGLU E{((bf16*)(C.a->ws + WS_HB)), ((float*)(C.a->ws + WS_RSB))};
            pg8::gemm_phase<pg8::EpiSwiGLU, pg8::StaticOrder, GEMM_ALIGN, GEMM_SP2>(C.lds + RING_OFF, g, S, E, C.tid);
            } else { zero_f32(C, ((float*)(C.a->ws + WS_RSA)), SEQ, C.bid - gG, nsp); copy_outs(C, l, C.bid - gG, nsp); cache_shift(C, l, C.bid - gG, nsp); }
            if (nsp == 0) { zero_f32(C, ((float*)(C.a->ws + WS_RSA)), SEQ, C.bid, C.G); copy_outs(C, l, C.bid, C.G); cache_shift(C, l, C.bid, C.G); }
            if (rep_ + 1 < REP_8) xcd_barrier(bar); }
            SEAM(pb + 8);
        }
        PROBE_END(8);
#endif
#ifndef NO_G5
        PROBE_BEGIN(9);
        if (IN(pb + 9)) { for (int rep_ = 0; rep_ < REP_9; ++rep_) {
            FRESH_CTX();
            pg8::Gemm g{((bf16*)(C.a->ws + WS_HB)), ((bf16*)(C.a->ws + WS_WDN)) + (size_t)l * DM * FF, SEQ, DM, FF}; pg8::StaticOrder S; S.init(SEQ, DM, C.G, C.bid);
            pg8::EpiResid E{(const float*)nullptr, ((bf16*)(C.a->ws + WS_XN)), ((float*)(C.a->ws + WS_RSA))};
            pg8::gemm_phase<pg8::EpiResid, pg8::StaticOrder, true, true>(C.lds + RING_OFF, g, S, E, C.tid);
            mini_phase<2>(C, l);
            if (rep_ + 1 < REP_9) xcd_barrier(bar); }
            SEAM(pb + 9);
        }
        PROBE_END(9);
#endif
        PROBE_BEGIN(10);
        if (IN(pb + 10)) { for (int rep_ = 0; rep_ < REP_10; ++rep_) {
            FRESH_CTX();
            if (l + 1 < DEPTH) sample_rows_phase(C, ((float*)(C.a->ws + WS_RSA))); else final_norm_phase(C);
            if (rep_ + 1 < REP_10) xcd_barrier(bar); }
            SEAM(pb + 10);
        }
        PROBE_END(10);
    }
    if (PROBE_CLK && blockIdx.x == 0 && wave_s == 0 && lane_now() == 0) { const unsigned long long c1 = __builtin_amdgcn_s_memtime(), r1 = __builtin_amdgcn_s_memrealtime(); const unsigned long long clk_c0 = ((unsigned long long)MISC[17] << 32) | MISC[16], clk_r0 = ((unsigned long long)MISC[19] << 32) | MISC[18]; const unsigned long long dc = (c1 - clk_c0) * 10000ull, dr = r1 - clk_r0;
        while ((__builtin_amdgcn_s_memrealtime() - r1) * dr < dc) __builtin_amdgcn_s_sleep(8); }
    if (PROBE_LO >= 0 && blockIdx.x == 0 && wave_s == 0 && lane_now() == 0) { const unsigned long long t1 = __builtin_amdgcn_s_memrealtime(); while (__builtin_amdgcn_s_memrealtime() - t1 < (unsigned long long)PROBE_AMP * probe_acc) __builtin_amdgcn_s_sleep(8); }
#undef IN
#undef SEAM
}

extern "C" void kernel_launch(void* const* d_in, const int* in_sizes, int n_in, void* d_out, int out_size, void* d_ws, size_t ws_size, hipStream_t stream) {
    static int grid = 0;
    if (grid == 0) {
        if (n_in != 23 || (size_t)out_size != O_END || ws_size < WS_END) { fprintf(stderr, "kernel_launch: unexpected problem (n_in %d, out %d, ws %zu; need ws >= %zu); nothing launched\n", n_in, out_size, ws_size, (size_t)WS_END); grid = -1; return; }
        int dev = 0, cus = 0, per_cu = 0;
        if (hipGetDevice(&dev) != hipSuccess || hipDeviceGetAttribute(&cus, hipDeviceAttributeMultiprocessorCount, dev) != hipSuccess) { grid = -1; return; }
        if (hipFuncSetAttribute((const void*)fwd, hipFuncAttributeMaxDynamicSharedMemorySize, LDS_BYTES) != hipSuccess) { fprintf(stderr, "kernel_launch: hipFuncSetAttribute failed\n"); grid = -1; return; }
        if (hipOccupancyMaxActiveBlocksPerMultiprocessor(&per_cu, (const void*)fwd, NWAVES * 64, LDS_BYTES) != hipSuccess || per_cu < 1) { fprintf(stderr, "kernel_launch: occupancy query says %d blocks per CU\n", per_cu); }
        (void)hipGetLastError();
        grid = cus;
    }
    if (grid < 0) return;
    if (hipMemsetAsync((char*)d_ws + WS_CTL, 0, CTL_ZERO_BYTES, stream) != hipSuccess) return;
    Args a{};
    for (int i = 0; i < 23; ++i) a.in[i] = (const float*)d_in[i];
    a.out = (float*)d_out; a.ws = (unsigned char*)d_ws; a.pad = 0;
#if MK_SPLIT
    for (int p = 0; p < NPH; ++p) { a.ph_lo = p; a.ph_hi = p + 1; a.use_bar = 0; hipLaunchKernelGGL(fwd, dim3(grid), dim3(NWAVES * 64), LDS_BYTES, stream, a); }
#else
    a.ph_lo = 0; a.ph_hi = NPH; a.use_bar = 1;
    hipLaunchKernelGGL(fwd, dim3(grid), dim3(NWAVES * 64), LDS_BYTES, stream, a);
#endif
    const hipError_t le = hipPeekAtLastError();
    if (le != hipSuccess) fprintf(stderr, "kernel_launch: launch failed: %s\n", hipGetErrorName(le));
}
```

```cpp
#include <hip/hip_runtime.h>
#include <cstdio>
#include <cstdint>

constexpr int DM = 2048, SEQ = 8192, NB = 128, DEPTH = 2;
constexpr int MV = SEQ + NB;
constexpr int MP = 8448;
constexpr int DI = 4096, NH = 64, HP = 64, DS = 128, NG = 8, CD = 6144, CW = 4;
constexpr int AH = 32, KVH = 8, AD = 64, WIN = 128;
constexpr int FF = 5632;
constexpr int IN_DIM = 17472;
constexpr float EPS = 1e-6f;
constexpr int UZ = 0, UXBC = 4096, UQ = 10240, UK = 12288, UV = 12800, UGS = 13312, UGA = 15360, LDU = 17408;
__host__ __device__ __forceinline__ constexpr size_t UIDX(int row, int col) { return ((size_t)(row >> 7) * (LDU / 64) + (size_t)(col >> 6)) * 8192 + (size_t)(((row & 127) << 6) + (col & 63)); }
constexpr int NU = 17664;
constexpr int KCAT = DI + DM;
constexpr int NGU = 2 * FF;

constexpr size_t O_YP = 0;
constexpr size_t O_YS = O_YP + (size_t)SEQ * DM;
constexpr size_t O_PSSM = O_YS + (size_t)NB * DM;
constexpr size_t O_PCONV = O_PSSM + (size_t)DEPTH * NH * HP * DS;
constexpr size_t O_PK = O_PCONV + (size_t)DEPTH * 3 * CD;
constexpr size_t O_PV = O_PK + (size_t)DEPTH * WIN * KVH * AD;
constexpr size_t O_SSSM = O_PV + (size_t)DEPTH * WIN * KVH * AD;
constexpr size_t O_SCONV = O_SSSM + (size_t)DEPTH * NB * NH * HP * DS;
constexpr size_t O_SK = O_SCONV + (size_t)DEPTH * NB * 3 * CD;
constexpr size_t O_SV = O_SK + (size_t)DEPTH * NB * WIN * KVH * AD;
constexpr size_t O_END = O_SV + (size_t)DEPTH * NB * WIN * KVH * AD;
static_assert(O_END == 190877696ull, "output size");

constexpr size_t al256(size_t x) { return (x + 255) & ~(size_t)255; }
constexpr size_t WS_CTL = 0, CTL_ZERO_BYTES = 1u << 20;
constexpr size_t SZ_WIN = (size_t)NU * DM * 2, SZ_WCAT = (size_t)DM * KCAT * 2, SZ_WOUT = (size_t)DM * DM * 2, SZ_WGU = (size_t)NGU * DM * 2, SZ_WDN = (size_t)DM * FF * 2;
constexpr size_t WS_WIN = 1u << 20;
constexpr size_t WS_WCAT = WS_WIN + DEPTH * SZ_WIN;
constexpr size_t WS_WOUT = WS_WCAT + DEPTH * SZ_WCAT;
constexpr size_t WS_WGU = WS_WOUT + DEPTH * SZ_WOUT;
constexpr size_t WS_WDN = WS_WGU + DEPTH * SZ_WGU;
constexpr size_t WS_X = WS_WDN + DEPTH * SZ_WDN;
constexpr size_t WS_XN = WS_X + (size_t)MP * DM * 4;
constexpr size_t WS_U = WS_XN + (size_t)MP * DM * 2;
constexpr size_t WS_DT = WS_U + (size_t)MP * LDU * 2;
constexpr size_t WS_YO = WS_DT + (size_t)MP * 64 * 4;
constexpr size_t WS_MRG = WS_YO + (size_t)MP * KCAT * 2;
constexpr size_t WS_HB = WS_MRG + (size_t)MP * DM * 2;
constexpr size_t WS_XT = WS_HB + (size_t)MP * FF * 2;
constexpr size_t WS_BRM = WS_XT + (size_t)64 * 64 * 64 * 128 * 2;
constexpr size_t WS_BT = WS_BRM + (size_t)64 * 8 * 128 * 128 * 2;
constexpr size_t WS_CRM = WS_BT + (size_t)64 * 8 * 128 * 128 * 2;
constexpr size_t WS_DTT = WS_CRM + (size_t)64 * 8 * 128 * 128 * 2;
constexpr size_t WS_ACS = WS_DTT + (size_t)64 * 64 * 128 * 4;
constexpr size_t WS_VT = WS_ACS + (size_t)64 * 64 * 128 * 4;
constexpr size_t WS_ST = WS_VT + (size_t)8 * 64 * 8192 * 2;
constexpr size_t WS_HS = WS_ST + (size_t)64 * 64 * 64 * 128 * 4;
constexpr size_t WS_MS = WS_HS + (size_t)64 * 64 * 64 * 128 * 2;
constexpr size_t WS_RSA = WS_MS + (size_t)NB * DM * 4;
constexpr size_t WS_RSB = WS_RSA + (size_t)MP * 4;
constexpr size_t WS_END = WS_RSB + (size_t)MP * 4;
static_assert(WS_WIN % 256 == 0 && WS_X % 256 == 0 && WS_U % 256 == 0 && WS_YO % 256 == 0 && WS_HB % 256 == 0 && WS_XT % 256 == 0 && WS_ST % 256 == 0, "ws alignment");
constexpr int CW_BAR = 4096;

constexpr int RING_OFF = 0, RING_BYTES = 131072;
constexpr int PC_B = 0, PC_C = 34816, PC_Y = 69632, PC_SSQ = 139264, PC_AD = 143360, PC_END = 151552;
constexpr int LDSCTL_OFF = PC_END, MISC_OFF = LDSCTL_OFF + 320;
constexpr int LDS_BYTES = 155648;
constexpr int NWAVES = 8;
#define MK_SPLIT 0
namespace pg8 {
#define PG8_LAS __attribute__((address_space(3)))
typedef unsigned short bf16_t;
typedef short bf16x8 __attribute__((ext_vector_type(8)));
typedef float f32x4 __attribute__((ext_vector_type(4)));
typedef unsigned u32x4 __attribute__((ext_vector_type(4)));
constexpr int BM = 256, BK = 64, HALF = 128, HTB = HALF * BK * 2  , STAGE_BYTES = 8 * HTB, NXCD = 8, WGM = 8;

__host__ __device__ __forceinline__ int lds_byte(int r, int c) { const int st = (r >> 4) * 2 + (c >> 5), rr = r & 15, cc = c & 31, ob = rr * 64 + cc * 2; return st * 1024 + (ob ^ (((ob >> 9) & 1) << 5)); }
__host__ __device__ __forceinline__ void stage_rc(int b, int& R, int& C) { const int st = b / 1024, sb = b % 1024, swz = sb ^ (((sb >> 9) & 1) << 5); R = (st >> 1) * 16 + swz / 64; C = (st & 1) * 32 + (swz % 64) / 2; }
__host__ __device__ __forceinline__ int perm32(int rho) { const int n = rho >> 4, i = rho & 15; return 8 * (i >> 2) + 4 * n + (i & 3); }

struct Unit { int pm, pn; };
struct Gemm { const bf16_t* A; const bf16_t* Bt; int M, N, K; };

struct StaticOrder {
    int nM, nN, nwg, G, c;
    __host__ __device__ void init(int M, int N, int G_, int c_) { nM = M / BM; nN = N / BM; nwg = nM * nN; G = G_; c = c_; }
    __host__ __device__ bool next(int i, Unit& u) const {
        const long L = (long)i * G + c; if (L >= nwg) return false;
        int wgid = (int)L; { const int q = nwg / NXCD, r = nwg % NXCD, xcd = wgid % NXCD, off = wgid / NXCD; wgid = (xcd < r ? xcd * (q + 1) : r * (q + 1) + (xcd - r) * q) + off; }
        const int nig = WGM * nN, gid = wgid / nig, fm = gid * WGM, gsz = (nM - fm) < WGM ? (nM - fm) : WGM;
        u.pm = fm + ((wgid % nig) % gsz); u.pn = (wgid % nig) / gsz; return true;
    }
    __device__ __forceinline__ void a_ready(const Unit&) const {}
    __device__ __forceinline__ void done(const Unit&) const {}
};
__device__ __forceinline__ unsigned cvt_pk_bf16(float lo, float hi) { unsigned r; asm volatile("v_cvt_pk_bf16_f32 %0, %1, %2" : "=v"(r) : "v"(lo), "v"(hi)); return r; }
__device__ __forceinline__ float bf_lo(unsigned w) { return __uint_as_float(w << 16); }
__device__ __forceinline__ float bf_hi(unsigned w) { return __uint_as_float(w & 0xffff0000u); }
__device__ __forceinline__ float sigmoidf_(float x) { return __builtin_amdgcn_rcpf(1.0f + __expf(-x)); }
constexpr int E_MV = 8320, E_LDU = 17408, E_UGS = 13312, E_UGA = 15360;
__device__ __forceinline__ size_t e_uidx(int row, int col) { return ((size_t)(row >> 7) * (E_LDU / 64) + (size_t)(col >> 6)) * 8192 + (size_t)(((row & 127) << 6) + (col & 63)); }
struct EpiU {
    static constexpr bool PERM = true, AFTER_DRAIN = false, HOOK = false, RSLDS = true; static constexpr int HOOK_T = -1;
    bf16_t* U; float* DT; const float* dtb; const float* RS;
    __device__ __forceinline__ void hook(f32x4 (&)[2][2][4][2], const Unit&, int, int, int, int) const {}
    __device__ __forceinline__ static float softplus_(float x) { return x > 20.0f ? x : log1pf(__expf(x)); }
    __device__ __forceinline__ void operator()(const f32x4 (&acc)[2][2][4][2], const Unit& u, int wr, int wc, int fr, int fq, const float (&rsv)[8]) const {
        const int row0 = u.pm * BM + wr * 64 + fr;
        auto rstd_ = [&](int q) { return rsqrtf(rsv[q] * (1.0f / 2048.0f) + 1e-6f); };
        if (u.pn == 68) {
            if (wc < 2) { const f32x4 b0 = *(const f32x4*)(dtb + wc * 32 + 8 * fq), b1 = *(const f32x4*)(dtb + wc * 32 + 8 * fq + 4);
#pragma unroll
                for (int ai = 0; ai < 2; ++ai) { if (u.pm * BM + ai * HALF >= E_MV) continue;
#pragma unroll
                    for (int m = 0; m < 4; ++m) { float* p = DT + (size_t)(row0 + ai * HALF + m * 16) * 64 + wc * 32 + 8 * fq; const float rs = rstd_(ai * 4 + m); f32x4 v0 = acc[ai][0][m][0] * rs + b0, v1 = acc[ai][0][m][1] * rs + b1;
#pragma unroll
                        for (int e = 0; e < 4; ++e) { v0[e] = softplus_(v0[e]); v1[e] = softplus_(v1[e]); }
                        *(f32x4*)p = v0; *(f32x4*)(p + 4) = v1; } }
            }
            return;
        }
        const bool sig = u.pn >= 52, zsilu = u.pn < 16;
        const int col0 = u.pn * BM + wc * 32 + 8 * fq;
#pragma unroll
        for (int ai = 0; ai < 2; ++ai) { if (u.pm * BM + ai * HALF >= E_MV) continue;
#pragma unroll
            for (int m = 0; m < 4; ++m) { const int rr = row0 + ai * HALF + m * 16; const float rs = rstd_(ai * 4 + m);
#pragma unroll
                for (int bj = 0; bj < 2; ++bj) { f32x4 v0 = acc[ai][bj][m][0] * rs, v1 = acc[ai][bj][m][1] * rs;
                    if (sig) {
#pragma unroll
                        for (int e = 0; e < 4; ++e) { v0[e] = sigmoidf_(v0[e]); v1[e] = sigmoidf_(v1[e]); } }
                    if (zsilu) {
#pragma unroll
                        for (int e = 0; e < 4; ++e) { v0[e] = v0[e] * sigmoidf_(v0[e]); v1[e] = v1[e] * sigmoidf_(v1[e]); } }
                    u32x4 w; w.x = cvt_pk_bf16(v0[0], v0[1]); w.y = cvt_pk_bf16(v0[2], v0[3]); w.z = cvt_pk_bf16(v1[0], v1[1]); w.w = cvt_pk_bf16(v1[2], v1[3]);
                    *(u32x4*)(U + e_uidx(rr, col0 + bj * HALF)) = w; } } }
    }
};
struct EpiMerge {
    static constexpr bool PERM = true, AFTER_DRAIN = false, HOOK = true, RSLDS = false; static constexpr int HOOK_T = 64;
    const bf16_t* U; bf16_t* O;
    __device__ __forceinline__ void hook(f32x4 (&acc)[2][2][4][2], const Unit& u, int wr, int wc, int fr, int fq) const {
        asm volatile("" : "+v"(fr), "+v"(fq));
        const int row0 = u.pm * BM + wr * 64 + fr, col0 = u.pn * BM + wc * 32 + 8 * fq;
        u32x4 gsA[2][2], gaA[2][2], gsB[2][2], gaB[2][2];
#define HK_LOAD(gs_, ga_, q_) do { _Pragma("unroll") for (int mm = 0; mm < 2; ++mm) { const int rr = row0 + ((q_) >> 1) * HALF + (2 * ((q_) & 1) + mm) * 16; \
            _Pragma("unroll") for (int bj = 0; bj < 2; ++bj) { gs_[mm][bj] = *(const u32x4*)(U + e_uidx(rr, E_UGS + col0 + bj * HALF)); ga_[mm][bj] = *(const u32x4*)(U + e_uidx(rr, E_UGA + col0 + bj * HALF)); } } } while (0)
#define HK_APPLY(gs_, ga_, q_) do { _Pragma("unroll") for (int mm = 0; mm < 2; ++mm) { const int ai = (q_) >> 1, m = 2 * ((q_) & 1) + mm; \
            _Pragma("unroll") for (int bj = 0; bj < 2; ++bj) { const u32x4 s = gs_[mm][bj], a = ga_[mm][bj]; f32x4 r0, r1; \
                r0[0] = bf_lo(s.x) * __builtin_amdgcn_rcpf(fmaxf(bf_lo(a.x), 1e-20f)); r0[1] = bf_hi(s.x) * __builtin_amdgcn_rcpf(fmaxf(bf_hi(a.x), 1e-20f)); r0[2] = bf_lo(s.y) * __builtin_amdgcn_rcpf(fmaxf(bf_lo(a.y), 1e-20f)); r0[3] = bf_hi(s.y) * __builtin_amdgcn_rcpf(fmaxf(bf_hi(a.y), 1e-20f)); \
                r1[0] = bf_lo(s.z) * __builtin_amdgcn_rcpf(fmaxf(bf_lo(a.z), 1e-20f)); r1[1] = bf_hi(s.z) * __builtin_amdgcn_rcpf(fmaxf(bf_hi(a.z), 1e-20f)); r1[2] = bf_lo(s.w) * __builtin_amdgcn_rcpf(fmaxf(bf_lo(a.w), 1e-20f)); r1[3] = bf_hi(s.w) * __builtin_amdgcn_rcpf(fmaxf(bf_hi(a.w), 1e-20f)); \
                acc[ai][bj][m][0] *= r0; acc[ai][bj][m][1] *= r1; } \
            asm volatile("" : "+v"(acc[ai][0][m][0]), "+v"(acc[ai][0][m][1]), "+v"(acc[ai][1][m][0]), "+v"(acc[ai][1][m][1]) :: "memory"); } } while (0)
        HK_LOAD(gsA, gaA, 0); HK_LOAD(gsB, gaB, 1); __builtin_amdgcn_sched_barrier(0);
        HK_APPLY(gsA, gaA, 0); HK_LOAD(gsA, gaA, 2); __builtin_amdgcn_sched_barrier(0);
        HK_APPLY(gsB, gaB, 1); HK_LOAD(gsB, gaB, 3); __builtin_amdgcn_sched_barrier(0);
        HK_APPLY(gsA, gaA, 2); __builtin_amdgcn_sched_barrier(0);
        HK_APPLY(gsB, gaB, 3);
#undef HK_LOAD
#undef HK_APPLY
    }
    __device__ __forceinline__ void operator()(const f32x4 (&acc)[2][2][4][2], const Unit& u, int wr, int wc, int fr, int fq) const {
        const int row0 = u.pm * BM + wr * 64 + fr, col0 = u.pn * BM + wc * 32 + 8 * fq;
        u32x4 gav[2][4][2];
#pragma unroll
        for (int ai = 0; ai < 2; ++ai)
#pragma unroll
            for (int m = 0; m < 4; ++m)
#pragma unroll
                for (int bj = 0; bj < 2; ++bj) gav[ai][m][bj] = *(const u32x4*)(U + e_uidx(row0 + ai * HALF + m * 16, E_UGA + col0 + bj * HALF));
#pragma unroll
        for (int ai = 0; ai < 2; ++ai)
#pragma unroll
            for (int m = 0; m < 4; ++m) { const size_t r = (size_t)(row0 + ai * HALF + m * 16);
#pragma unroll
                for (int bj = 0; bj < 2; ++bj) { const u32x4 ga = gav[ai][m][bj];
                    const f32x4 v0 = acc[ai][bj][m][0], v1 = acc[ai][bj][m][1];
                    u32x4 w; w.x = cvt_pk_bf16(v0[0] * bf_lo(ga.x), v0[1] * bf_hi(ga.x)); w.y = cvt_pk_bf16(v0[2] * bf_lo(ga.y), v0[3] * bf_hi(ga.y));
                    w.z = cvt_pk_bf16(v1[0] * bf_lo(ga.z), v1[1] * bf_hi(ga.z)); w.w = cvt_pk_bf16(v1[2] * bf_lo(ga.w), v1[3] * bf_hi(ga.w));
                    *(u32x4*)(O + r * 2048 + col0 + bj * HALF) = w; } }
    }
};
struct EpiResid {
    static constexpr bool PERM = true, AFTER_DRAIN = false, HOOK = false, RSLDS = false; static constexpr int HOOK_T = -1;
    const float* Xf; bf16_t* XB; float* RS;
    __device__ __forceinline__ void hook(f32x4 (&)[2][2][4][2], const Unit&, int, int, int, int) const {}
    __device__ __forceinline__ void tail_(f32x4 x0, f32x4 x1, float& ss, bf16_t* dst) const {
        ss += ((x0[0] * x0[0] + x0[1] * x0[1]) + (x0[2] * x0[2] + x0[3] * x0[3])) + ((x1[0] * x1[0] + x1[1] * x1[1]) + (x1[2] * x1[2] + x1[3] * x1[3]));
        u32x4 o; o.x = cvt_pk_bf16(x0[0], x0[1]); o.y = cvt_pk_bf16(x0[2], x0[3]); o.z = cvt_pk_bf16(x1[0], x1[1]); o.w = cvt_pk_bf16(x1[2], x1[3]);
        *(u32x4*)dst = o;
    }
    __device__ __forceinline__ void operator()(const f32x4 (&acc)[2][2][4][2], const Unit& u, int wr, int wc, int fr, int fq) const {
        const int row0 = u.pm * BM + wr * 64 + fr, col0 = u.pn * BM + wc * 32 + 8 * fq;
        if (Xf) {
#pragma unroll
            for (int ai = 0; ai < 2; ++ai) { f32x4 xo[4][2][2];
#pragma unroll
                for (int m = 0; m < 4; ++m)
#pragma unroll
                    for (int bj = 0; bj < 2; ++bj) { const float* p = Xf + (size_t)(row0 + ai * HALF + m * 16) * 2048 + col0 + bj * HALF; xo[m][bj][0] = *(const f32x4*)p; xo[m][bj][1] = *(const f32x4*)(p + 4); }
#pragma unroll
                for (int m = 0; m < 4; ++m) { const size_t ro = (size_t)(row0 + ai * HALF + m * 16) * 2048 + col0; float ss = 0.f;
#pragma unroll
                    for (int bj = 0; bj < 2; ++bj) tail_(xo[m][bj][0] + acc[ai][bj][m][0], xo[m][bj][1] + acc[ai][bj][m][1], ss, XB + ro + bj * HALF);
                    ss += __shfl_xor(ss, 16); ss += __shfl_xor(ss, 32);
                    if (fq == 0) unsafeAtomicAdd(RS + row0 + ai * HALF + m * 16, ss); } }
        } else {
            u32x4 xw[2][4][2];
#pragma unroll
            for (int ai = 0; ai < 2; ++ai)
#pragma unroll
                for (int m = 0; m < 4; ++m)
#pragma unroll
                    for (int bj = 0; bj < 2; ++bj) xw[ai][m][bj] = *(const u32x4*)(XB + (size_t)(row0 + ai * HALF + m * 16) * 2048 + col0 + bj * HALF);
#pragma unroll
            for (int ai = 0; ai < 2; ++ai)
#pragma unroll
                for (int m = 0; m < 4; ++m) { const size_t ro = (size_t)(row0 + ai * HALF + m * 16) * 2048 + col0; float ss = 0.f;
#pragma unroll
                    for (int bj = 0; bj < 2; ++bj) { const u32x4 w = xw[ai][m][bj];
                        tail_((f32x4){bf_lo(w.x), bf_hi(w.x), bf_lo(w.y), bf_hi(w.y)} + acc[ai][bj][m][0], (f32x4){bf_lo(w.z), bf_hi(w.z), bf_lo(w.w), bf_hi(w.w)} + acc[ai][bj][m][1], ss, XB + ro + bj * HALF); }
                    ss += __shfl_xor(ss, 16); ss += __shfl_xor(ss, 32);
                    if (fq == 0) unsafeAtomicAdd(RS + row0 + ai * HALF + m * 16, ss); }
        }
    }
};
struct EpiSwiGLU {
    static constexpr bool PERM = true, AFTER_DRAIN = false, HOOK = false, RSLDS = true; static constexpr int HOOK_T = -1;
    bf16_t* H; const float* RS;
    __device__ __forceinline__ void hook(f32x4 (&)[2][2][4][2], const Unit&, int, int, int, int) const {}
    __device__ __forceinline__ void operator()(const f32x4 (&acc)[2][2][4][2], const Unit& u, int wr, int wc, int fr, int fq, const float (&rsv)[8]) const {
        const int row0 = u.pm * BM + wr * 64 + fr, col0 = u.pn * 128 + wc * 16 + 4 * fq;
#pragma unroll
        for (int ai = 0; ai < 2; ++ai) { if (u.pm * BM + ai * HALF >= E_MV) continue;
#pragma unroll
            for (int m = 0; m < 4; ++m) { bf16_t* rowp = H + (size_t)(row0 + ai * HALF + m * 16) * 5632 + col0; const float rs = rsqrtf(rsv[ai * 4 + m] * (1.0f / 2048.0f) + 1e-6f);
#pragma unroll
                for (int bj = 0; bj < 2; ++bj) { const f32x4 g = acc[ai][bj][m][0] * rs, up = acc[ai][bj][m][1] * rs; float h[4];
#pragma unroll
                    for (int e = 0; e < 4; ++e) h[e] = g[e] * __builtin_amdgcn_rcpf(1.0f + __expf(-g[e])) * up[e];
                    typedef unsigned u32x2v __attribute__((ext_vector_type(2))); u32x2v w; w.x = cvt_pk_bf16(h[0], h[1]); w.y = cvt_pk_bf16(h[2], h[3]);
                    *(u32x2v*)(rowp + bj * 64) = w; } } }
    }
};
template <class Epi, class Sched, bool ALIGN_EPI = false, bool SP2 = false>
__device__ __forceinline__ void gemm_phase(PG8_LAS unsigned char* lds, const Gemm g, const Sched& S, const Epi& E, int tid_in) {
    int tid_l = tid_in; asm volatile("" : "+v"(tid_l));
    const int tid = tid_l, wid = __builtin_amdgcn_readfirstlane(tid >> 6), lane = tid & 63, wr = wid >> 2, wc = wid & 3, fr = lane & 15, fq = lane >> 4;
    const int K = g.K, nt = K / BK;
    unsigned voffA[2], voffB[2];
#pragma unroll
    for (int i = 0; i < 2; ++i) { int R, C; stage_rc(tid * 16 + i * 8192, R, C); const int Rb = Epi::PERM ? ((R & ~31) + perm32(R & 31)) : R;
        voffA[i] = (unsigned)(R * K + C) * 2u; voffB[i] = (unsigned)(Rb * K + C) * 2u; }
    const size_t kstep = (size_t)(BK * 2);
    const size_t hstep = (size_t)HALF * K * 2;
    const size_t tstep = 2 * hstep;
    const unsigned ldsw = (unsigned)wid * 1024u;
    const int aoff = lds_byte(wr * 64 + fr, fq * 8), boff = lds_byte(wc * 32 + fr, fq * 8);
#define PG8_SA(b, h) (((b) * 2 + (h)) * HTB)
#define PG8_SB(b, h) ((4 + (b) * 2 + (h)) * HTB)
#define PG8_STAGE(bufoff, gbase, voff) do { _Pragma("unroll") for (int _i = 0; _i < 2; ++_i) \
        __builtin_amdgcn_global_load_lds((const unsigned*)((const char*)(gbase) + (voff)[_i]), (PG8_LAS unsigned*)(lds + (bufoff) + ldsw + _i * 8192), 16, 0, 0); } while (0)
#define PG8_LDA(dst, b, h) do { _Pragma("unroll") for (int m = 0; m < 4; ++m) _Pragma("unroll") for (int k = 0; k < 2; ++k) dst[m][k] = *(const PG8_LAS bf16x8*)(lds + PG8_SA(b, h) + aoff + m * 2048 + k * 1024); } while (0)
#define PG8_LDB(dst, b, h) do { _Pragma("unroll") for (int n = 0; n < 2; ++n) _Pragma("unroll") for (int k = 0; k < 2; ++k) dst[n][k] = *(const PG8_LAS bf16x8*)(lds + PG8_SB(b, h) + boff + n * 2048 + k * 1024); } while (0)
#define PG8_MMA(ai, bj, At, Bt) do { __builtin_amdgcn_s_setprio(1); _Pragma("unroll") for (int m = 0; m < 4; ++m) _Pragma("unroll") for (int n = 0; n < 2; ++n) _Pragma("unroll") for (int k = 0; k < 2; ++k) \
        acc[ai][bj][m][n] = __builtin_amdgcn_mfma_f32_16x16x32_bf16(Bt[n][k], At[m][k], acc[ai][bj][m][n], 0, 0, 0); __builtin_amdgcn_s_setprio(0); } while (0)
#define PG8_WAIT_V(n) asm volatile("s_waitcnt vmcnt(" #n ")" ::: "memory")
#define PG8_WAIT_L(n) asm volatile("s_waitcnt lgkmcnt(" #n ")" ::: "memory")
#define PG8_BAR __builtin_amdgcn_s_barrier()
#define PG8_SCHED __builtin_amdgcn_sched_barrier(0)
    Unit cur, nxt; int ui = 0;
    if (!S.next(0, cur)) return;
    f32x4 acc[2][2][4][2];
#pragma unroll
    for (int a = 0; a < 2; ++a)
#pragma unroll
        for (int b = 0; b < 2; ++b)
#pragma unroll
            for (int m = 0; m < 4; ++m)
#pragma unroll
                for (int n = 0; n < 2; ++n) acc[a][b][m][n] = (f32x4){0.f, 0.f, 0.f, 0.f};
    bf16x8 At[4][2], B0[2][2], B1[2][2];
    const char* cA = (const char*)g.A + (size_t)cur.pm * tstep; const char* cB = (const char*)g.Bt + (size_t)cur.pn * tstep;
    S.a_ready(cur);
#define PG8_RSDMA(pm_, par_) __builtin_amdgcn_global_load_lds((const unsigned*)(E.RS + (pm_) * BM + wid * 64 + ((fq << 4) | fr)), (PG8_LAS unsigned*)(lds + 131072 + (par_) * 1024 + wid * 256), 4, 0, 0)
    if constexpr (Epi::RSLDS) { if (wid < 4) PG8_RSDMA(cur.pm, 0); }
    if constexpr (SP2) {
        PG8_STAGE(PG8_SB(0, 0), cB, voffB); PG8_STAGE(PG8_SB(0, 1), cB + hstep, voffB); PG8_STAGE(PG8_SA(0, 0), cA, voffA); PG8_STAGE(PG8_SA(0, 1), cA + hstep, voffA);
        if (wr == 1) PG8_BAR;
        PG8_WAIT_V(2); PG8_BAR;
        PG8_STAGE(PG8_SB(1, 0), cB + kstep, voffB); PG8_STAGE(PG8_SA(1, 0), cA + kstep, voffA); PG8_STAGE(PG8_SB(1, 1), cB + hstep + kstep, voffB);
        PG8_WAIT_V(6); PG8_BAR;
    } else {
        PG8_STAGE(PG8_SB(0, 0), cB, voffB); PG8_STAGE(PG8_SA(0, 0), cA, voffA); PG8_STAGE(PG8_SB(0, 1), cB + hstep, voffB); PG8_STAGE(PG8_SA(0, 1), cA + hstep, voffA);
        if (wr == 1) PG8_BAR;
        PG8_WAIT_V(4); PG8_BAR;
        PG8_STAGE(PG8_SB(1, 0), cB + kstep, voffB); PG8_STAGE(PG8_SA(1, 0), cA + kstep, voffA); PG8_STAGE(PG8_SB(1, 1), cB + hstep + kstep, voffB);
        PG8_WAIT_V(6); PG8_BAR;
    }
    for (;;) {
        const bool has_next = S.next(ui + 1, nxt);
        const char* nA = has_next ? (const char*)g.A + (size_t)nxt.pm * tstep : cA; const char* nB = has_next ? (const char*)g.Bt + (size_t)nxt.pn * tstep : cB;
        for (int t = 0; t < nt; t += 2) {
            const bool last = (t == nt - 2);
            const char* a1 = cA + (size_t)(t + 1) * kstep;
            const char* a2 = last ? nA : cA + (size_t)(t + 2) * kstep; const char* b2 = last ? nB : cB + (size_t)(t + 2) * kstep;
            const char* a3 = a2 + kstep; const char* b3 = b2 + kstep;
            if (last && has_next) S.a_ready(nxt);
            if constexpr (Epi::HOOK) { if (t == Epi::HOOK_T) E.hook(acc, cur, wr, wc, fr, fq); }
            if constexpr (SP2) {
            PG8_LDB(B0, 0, 0); PG8_LDB(B1, 0, 1); PG8_SCHED; PG8_LDA(At, 0, 0); PG8_STAGE(PG8_SA(1, 1), a1 + hstep, voffA);
            PG8_WAIT_V(8); PG8_WAIT_L(0); PG8_BAR; PG8_MMA(0, 0, At, B0); PG8_MMA(0, 1, At, B1); PG8_BAR; PG8_SCHED;
            PG8_LDA(At, 0, 1); PG8_STAGE(PG8_SB(0, 0), b2, voffB); PG8_STAGE(PG8_SB(0, 1), b2 + hstep, voffB); PG8_STAGE(PG8_SA(0, 0), a2, voffA);
            PG8_WAIT_V(8); PG8_WAIT_L(0); PG8_BAR; PG8_MMA(1, 0, At, B0); PG8_MMA(1, 1, At, B1); PG8_BAR; PG8_SCHED;
            PG8_LDB(B0, 1, 0); PG8_LDB(B1, 1, 1); PG8_SCHED; PG8_LDA(At, 1, 0); PG8_STAGE(PG8_SA(0, 1), a2 + hstep, voffA);
            PG8_WAIT_V(8); PG8_WAIT_L(0); PG8_BAR; PG8_MMA(0, 0, At, B0); PG8_MMA(0, 1, At, B1); PG8_BAR; PG8_SCHED;
            PG8_LDA(At, 1, 1); PG8_STAGE(PG8_SB(1, 0), b3, voffB); PG8_STAGE(PG8_SB(1, 1), b3 + hstep, voffB); PG8_STAGE(PG8_SA(1, 0), a3, voffA);
            PG8_WAIT_V(8); PG8_WAIT_L(0); PG8_BAR; PG8_MMA(1, 0, At, B0); PG8_MMA(1, 1, At, B1); PG8_BAR; PG8_SCHED;
            } else {
            PG8_LDB(B0, 0, 0); PG8_SCHED; PG8_LDA(At, 0, 0); PG8_STAGE(PG8_SA(1, 1), a1 + hstep, voffA);
            PG8_WAIT_L(8); PG8_BAR; PG8_WAIT_L(0); PG8_MMA(0, 0, At, B0); PG8_BAR; PG8_SCHED;
            PG8_LDB(B1, 0, 1); PG8_STAGE(PG8_SB(0, 0), b2, voffB);
            PG8_BAR; PG8_WAIT_L(0); PG8_MMA(0, 1, At, B1); PG8_BAR;
            PG8_LDA(At, 0, 1); PG8_STAGE(PG8_SA(0, 0), a2, voffA);
            PG8_BAR; PG8_WAIT_L(0); PG8_MMA(1, 0, At, B0); PG8_BAR; PG8_SCHED;
            PG8_STAGE(PG8_SB(0, 1), b2 + hstep, voffB);
            PG8_WAIT_V(6); PG8_BAR; PG8_MMA(1, 1, At, B1); PG8_BAR;
            PG8_LDB(B0, 1, 0); PG8_SCHED; PG8_LDA(At, 1, 0); PG8_STAGE(PG8_SA(0, 1), a2 + hstep, voffA);
            PG8_WAIT_L(8); PG8_BAR; PG8_WAIT_L(0); PG8_MMA(0, 0, At, B0); PG8_BAR; PG8_SCHED;
            PG8_LDB(B1, 1, 1); PG8_STAGE(PG8_SB(1, 0), b3, voffB);
            PG8_BAR; PG8_WAIT_L(0); PG8_MMA(0, 1, At, B1); PG8_BAR;
            PG8_LDA(At, 1, 1); PG8_STAGE(PG8_SA(1, 0), a3, voffA);
            PG8_BAR; PG8_WAIT_L(0); PG8_MMA(1, 0, At, B0); PG8_BAR; PG8_SCHED;
            PG8_STAGE(PG8_SB(1, 1), b3 + hstep, voffB);
            PG8_WAIT_V(6); PG8_BAR; PG8_MMA(1, 1, At, B1); PG8_BAR;
            }
        }
        if constexpr (ALIGN_EPI) { if (wr == 0) PG8_BAR; }
        if constexpr (!Epi::AFTER_DRAIN) {
            if constexpr (Epi::RSLDS) { float rsv[8]; const PG8_LAS float* rsl = (const PG8_LAS float*)(lds + 131072 + (ui & 1) * 1024) + wr * 64 + fr;
#pragma unroll
                for (int q = 0; q < 8; ++q) rsv[q] = rsl[(q >> 2) * HALF + (q & 3) * 16];
                asm volatile("s_waitcnt lgkmcnt(0)" : "+v"(rsv[0]), "+v"(rsv[1]), "+v"(rsv[2]), "+v"(rsv[3]), "+v"(rsv[4]), "+v"(rsv[5]), "+v"(rsv[6]), "+v"(rsv[7]) :: "memory");
                if (has_next && wid < 4) PG8_RSDMA(nxt.pm, (ui + 1) & 1);
                E(acc, cur, wr, wc, fr, fq, rsv);
            } else E(acc, cur, wr, wc, fr, fq);
            S.done(cur); }
        if (!has_next) break;
#pragma unroll
        for (int a = 0; a < 2; ++a)
#pragma unroll
            for (int b = 0; b < 2; ++b)
#pragma unroll
                for (int m = 0; m < 4; ++m)
#pragma unroll
                    for (int n = 0; n < 2; ++n) acc[a][b][m][n] = (f32x4){0.f, 0.f, 0.f, 0.f};
        cur = nxt; cA = nA; cB = nB; ++ui;
        if constexpr (ALIGN_EPI) { if (wr == 1) PG8_BAR; }
    }
    PG8_WAIT_V(0);
    if constexpr (!ALIGN_EPI) { if (wr == 0) PG8_BAR; }
    PG8_BAR;
    if constexpr (Epi::AFTER_DRAIN) { E.fused(acc, cur, wr, wc, fr, fq, lds, wid, lane); S.done(cur); }
#undef PG8_RSDMA
#undef PG8_SA
#undef PG8_SB
#undef PG8_STAGE
#undef PG8_LDA
#undef PG8_LDB
#undef PG8_MMA
#undef PG8_WAIT_V
#undef PG8_WAIT_L
#undef PG8_BAR
#undef PG8_SCHED
}
}
#define GAS __attribute__((address_space(1)))
#define LAS __attribute__((address_space(3)))
typedef unsigned short bf16;
typedef unsigned v4u __attribute__((ext_vector_type(4)));
typedef float f32x4 __attribute__((ext_vector_type(4)));
typedef short bf16x8 __attribute__((ext_vector_type(8)));
typedef GAS unsigned gu32;
typedef GAS unsigned long long gu64;
#define RLX_AGENT __ATOMIC_RELAXED, __HIP_MEMORY_SCOPE_AGENT
#define LDS_WAIT() asm volatile("s_waitcnt lgkmcnt(0)" ::: "memory")
#define VM_WAIT() asm volatile("s_waitcnt vmcnt(0)" ::: "memory")
__device__ __forceinline__ unsigned long long rt() { return __builtin_amdgcn_s_memrealtime(); }
__device__ __forceinline__ unsigned f2bf(float f) { unsigned u = __builtin_bit_cast(unsigned, f); return (u + 0x7fffu + ((u >> 16) & 1u)) >> 16; }
__device__ __forceinline__ unsigned pk2(float lo, float hi) { return f2bf(lo) | (f2bf(hi) << 16); }

#define XB_TMO      128
#define XB_XCNT(j)  (256  + 64 * (j))
#define XB_XSUB(j)  (1280 + 64 * (j))
#define XB_XGEN(j)  (2304 + 64 * (j))
#define XB_TOP      3328
#define XB_TOPGEN   3392
#define XCD_BAR_WORDS 3456
#define XB_SPIN_CAP (1u << 18)

__device__ __forceinline__ unsigned xb_ld(unsigned* p)              { return __hip_atomic_load(p, __ATOMIC_RELAXED, __HIP_MEMORY_SCOPE_AGENT); }
__device__ __forceinline__ unsigned xb_add(unsigned* p, unsigned v) { return __hip_atomic_fetch_add(p, v, __ATOMIC_RELAXED, __HIP_MEMORY_SCOPE_AGENT); }
__device__ __forceinline__ unsigned xb_xcc_id() { return (unsigned)__builtin_amdgcn_s_getreg((3 << 11) | 20) & 0xFu; }
#define XB_SPIN(cond, bar) do { unsigned _sp = 0; while (cond) { __builtin_amdgcn_s_sleep(1); \
    if ((++_sp & 255u) == 0u) { if (xb_ld(&(bar)[XB_TMO])) break; if (_sp > XB_SPIN_CAP) { atomicAdd(&(bar)[XB_TMO], 1u); break; } } } } while (0)

struct XcdBarrier {
    unsigned* bar; unsigned x;
    volatile LAS unsigned* st;
};

__device__ __forceinline__ XcdBarrier xcd_barrier_post(unsigned* bar, volatile LAS unsigned* st) {
    XcdBarrier b; b.bar = bar; b.x = xb_xcc_id(); b.st = st;
    if (threadIdx.x == 0) (void)xb_add(&bar[XB_XCNT(b.x)], 1u);
    return b;
}
__device__ __forceinline__ void xcd_barrier_complete(unsigned* bar, unsigned x, unsigned& nloc, unsigned& nx) {
    const unsigned G = gridDim.x * gridDim.y * gridDim.z;
    unsigned sum, cnt, mine, sp = 0u;
    for (;;) {
        sum = 0u; cnt = 0u; mine = 0u;
#pragma unroll
        for (unsigned j = 0; j < 16; ++j) { const unsigned c = xb_ld(&bar[XB_XCNT(j)]); sum += c; cnt += (c > 0u) ? 1u : 0u; mine = (j == x) ? c : mine; }
        if (sum == G) break;
        __builtin_amdgcn_s_sleep(1);
        if ((++sp & 255u) == 0u) { if (xb_ld(&bar[XB_TMO])) break; if (sp > XB_SPIN_CAP) { atomicAdd(&bar[XB_TMO], 1u); break; } }
    }
    nloc = mine > 0u ? mine : 1u; nx = cnt > 0u ? cnt : 1u;
}

__device__ __forceinline__ void xcd_barrier(const XcdBarrier& b) {
    asm volatile("s_waitcnt vmcnt(0)" ::: "memory");
    __syncthreads();
    if (threadIdx.x == 0) {
        unsigned* bar = b.bar;
        __builtin_amdgcn_s_waitcnt(0);
        unsigned nloc = b.st[0], nx = b.st[1];
        if (nloc == 0u) { xcd_barrier_complete(bar, b.x, nloc, nx); b.st[0] = nloc; b.st[1] = nx; }
        const unsigned old = xb_add(&bar[XB_XSUB(b.x)], 1u);
        const unsigned gen = old / nloc;
        if (old + 1u == (gen + 1u) * nloc) {
            __builtin_amdgcn_fence(__ATOMIC_RELEASE, "agent");
            asm volatile("s_waitcnt vmcnt(0)" ::: "memory");
            const unsigned og = xb_add(&bar[XB_TOP], 1u);
            const unsigned tg = og / nx;
            if (og + 1u == (tg + 1u) * nx) xb_add(&bar[XB_TOPGEN], 1u);
            else XB_SPIN(xb_ld(&bar[XB_TOPGEN]) == tg, bar);
            __builtin_amdgcn_fence(__ATOMIC_ACQUIRE, "agent");
            xb_add(&bar[XB_XGEN(b.x)], 1u);
            asm volatile("s_waitcnt vmcnt(0)" ::: "memory");
        } else {
            XB_SPIN(xb_ld(&bar[XB_XGEN(b.x)]) == gen, bar);
            __builtin_amdgcn_fence(__ATOMIC_ACQUIRE, "agent");
            asm volatile("s_waitcnt vmcnt(0)" ::: "memory");
        }
    }
    __syncthreads();
}
typedef float f32x16 __attribute__((ext_vector_type(16)));
typedef unsigned u32x2 __attribute__((ext_vector_type(2)));
__device__ __forceinline__ float bf2f(bf16 v) { return __uint_as_float(((unsigned)v) << 16); }
__device__ __forceinline__ float bflo(unsigned w) { return __uint_as_float(w << 16); }
__device__ __forceinline__ float bfhi(unsigned w) { return __uint_as_float(w & 0xffff0000u); }
__device__ __forceinline__ float wave_sum(float v) {
#pragma unroll
    for (int o = 1; o < 64; o <<= 1) v += __shfl_xor(v, o);
    return v;
}
__device__ __forceinline__ float wave_max(float v) {
#pragma unroll
    for (int o = 1; o < 64; o <<= 1) v = fmaxf(v, __shfl_xor(v, o));
    return v;
}
__device__ __forceinline__ float siluf_(float x) { return x * __builtin_amdgcn_rcpf(1.0f + __expf(-x)); }
__device__ __forceinline__ float softplusf_(float x) { return x > 20.0f ? x : log1pf(__expf(x)); }

struct Args { const float* in[23]; float* out; unsigned char* ws; int ph_lo, ph_hi, use_bar, pad; };
typedef const __attribute__((address_space(4))) Args* KArgs;
struct Ctx { LAS unsigned char* lds; int tid, lane, wave, G, bid; KArgs a; };

__device__ __forceinline__ int lane_now() { int t; asm volatile("v_mbcnt_lo_u32_b32 %0, -1, 0\n\tv_mbcnt_hi_u32_b32 %0, -1, %0" : "=v"(t)); return t; }
struct TItem { const float* sp; const float* gn; bf16* WT; int ldn, rowl, K, k0, R0; };
__device__ __forceinline__ void titem_load(const TItem& t, f32x4 (&v)[16], f32x4 (&gv)[4], int) {
    const int kk = lane_now() >> 4;
    if (t.sp) {
#pragma unroll
        for (int i = 0; i < 16; ++i) v[i] = __builtin_nontemporal_load((const GAS f32x4*)(t.sp + (size_t)(t.k0 + 16 * kk + i) * t.ldn));
        if (t.gn) { const GAS f32x4* gp = (const GAS f32x4*)(t.gn + t.k0 + 16 * kk);
#pragma unroll
            for (int q = 0; q < 4; ++q) gv[q] = gp[q]; }
    } else {
#pragma unroll
        for (int i = 0; i < 16; ++i) { float z0 = 0.f; asm volatile("" : "+v"(z0)); v[i] = (f32x4){z0, z0, z0, z0}; }
    }
}
__device__ __forceinline__ void titem_store(const TItem& t, const f32x4 (&vin)[16], const f32x4 (&gv)[4], LAS unsigned short* T, int) {
    const int lane = lane_now(), kk = lane >> 4;
    LAS unsigned char* Tb = (LAS unsigned char*)T;
#pragma unroll
    for (int j = 0; j < 4; ++j) { const int n = t.rowl + j, sw = (n >> 2) & 7; v4u lo, hi;
#define TI_PK(a_) pg8::cvt_pk_bf16(vin[a_][j] * gv[(a_) >> 2].x, vin[(a_) + 1][j] * gv[(a_) >> 2].y)
#define TI_PK2(a_) pg8::cvt_pk_bf16(vin[a_][j] * gv[(a_) >> 2].z, vin[(a_) + 1][j] * gv[(a_) >> 2].w)
#define TI_PN(a_) pg8::cvt_pk_bf16(vin[a_][j], vin[(a_) + 1][j])
        if (t.gn && t.sp) { lo.x = TI_PK(0); lo.y = TI_PK2(2); lo.z = TI_PK(4); lo.w = TI_PK2(6); hi.x = TI_PK(8); hi.y = TI_PK2(10); hi.z = TI_PK(12); hi.w = TI_PK2(14); }
        else { lo.x = TI_PN(0); lo.y = TI_PN(2); lo.z = TI_PN(4); lo.w = TI_PN(6); hi.x = TI_PN(8); hi.y = TI_PN(10); hi.z = TI_PN(12); hi.w = TI_PN(14); }
#undef TI_PK
#undef TI_PK2
#undef TI_PN
        *(LAS v4u*)(Tb + n * 128 + (((2 * kk) ^ sw) << 4)) = lo; *(LAS v4u*)(Tb + n * 128 + (((2 * kk + 1) ^ sw) << 4)) = hi; }
    LDS_WAIT(); asm volatile("" ::: "memory");
    const int ch = lane & 7, nr = lane >> 3;
#pragma unroll
    for (int it = 0; it < 8; ++it) { const int n = nr + 8 * it;
        const v4u o = *(const LAS v4u*)(Tb + n * 128 + ((ch ^ ((n >> 2) & 7)) << 4));
        *(GAS v4u*)(t.WT + (size_t)(t.R0 + n) * t.K + t.k0 + 8 * ch) = o; }
    LDS_WAIT(); asm volatile("" ::: "memory");
}
constexpr int IT_IN = (DM / 64) * (NU / 64), IT_CAT = (KCAT / 64) * (DM / 64), IT_OUT = (DM / 64) * (DM / 64), IT_GU = (DM / 64) * (NGU / 64), IT_DN = (FF / 64) * (DM / 64);
constexpr int IT_LAYER = IT_IN + IT_CAT + IT_OUT + IT_GU + IT_DN;
__device__ __forceinline__ TItem titem_decode(const Ctx& C, int it) {
    const int c4 = lane_now() & 15, l = it / IT_LAYER; int q = it % IT_LAYER; TItem t;
    if (q < IT_IN) { const int nblk = NU / 64, kb = q / nblk, nb = q % nblk, R = 64 * nb + 4 * c4;
        const int col = R < 10240 ? R : (R < 17408 ? R + 64 : (R < 17472 ? 10240 + (R - 17408) : -1));
        t.sp = col >= 0 ? (C.a->in[7]) + (size_t)l * DM * IN_DIM + col : nullptr; t.gn = (C.a->in[6]) + (size_t)l * DM; t.ldn = IN_DIM; t.rowl = 4 * c4; t.K = DM; t.WT = ((bf16*)(C.a->ws + WS_WIN)) + (size_t)l * NU * DM; t.k0 = 64 * kb; t.R0 = 64 * nb; return t; }
    q -= IT_IN;
    if (q < IT_CAT) { const int nblk = DM / 64, kb = q / nblk, nb = q % nblk, R = 64 * nb + 4 * c4, k0 = 64 * kb;
        t.sp = k0 < DI ? (C.a->in[14]) + (size_t)l * DI * DM + R : (C.a->in[15]) + (size_t)l * DM * DM + R - (size_t)DI * DM;
        t.gn = nullptr; t.ldn = DM; t.rowl = 4 * c4; t.K = KCAT; t.WT = ((bf16*)(C.a->ws + WS_WCAT)) + (size_t)l * DM * KCAT; t.k0 = k0; t.R0 = 64 * nb; return t; }
    q -= IT_CAT;
    if (q < IT_OUT) { const int nblk = DM / 64, kb = q / nblk, nb = q % nblk, R = 64 * nb + 4 * c4;
        t.sp = (C.a->in[17]) + (size_t)l * DM * DM + R; t.gn = nullptr; t.ldn = DM; t.rowl = 4 * c4; t.K = DM; t.WT = ((bf16*)(C.a->ws + WS_WOUT)) + (size_t)l * DM * DM; t.k0 = 64 * kb; t.R0 = 64 * nb; return t; }
    q -= IT_OUT;
    if (q < IT_GU) { const int nblk = NGU / 64, kb = q / nblk, nb = q % nblk;
        const int up = c4 >> 3, cg = c4 & 7;
        t.sp = (up ? (C.a->in[20]) : (C.a->in[19])) + (size_t)l * DM * FF + 32 * nb + 4 * cg; t.gn = (C.a->in[18]) + (size_t)l * DM; t.ldn = FF; t.rowl = 8 * cg + 4 * up; t.K = DM; t.WT = ((bf16*)(C.a->ws + WS_WGU)) + (size_t)l * NGU * DM; t.k0 = 64 * kb; t.R0 = 64 * nb; return t; }
    q -= IT_GU;
    { const int nblk = DM / 64, kb = q / nblk, nb = q % nblk, R = 64 * nb + 4 * c4;
        t.sp = (C.a->in[21]) + (size_t)l * FF * DM + R; t.gn = nullptr; t.ldn = DM; t.rowl = 4 * c4; t.K = FF; t.WT = ((bf16*)(C.a->ws + WS_WDN)) + (size_t)l * DM * FF; t.k0 = 64 * kb; t.R0 = 64 * nb; return t; }
}
__device__ __forceinline__ void p0_weights(const Ctx& C, int it_lo, int it_hi, int gw, int NGW) {
    LAS unsigned short* T = (LAS unsigned short*)(C.lds + RING_OFF + C.wave * 16384);
    int it = it_lo + gw; if (it >= it_hi) return;
    TItem cur = titem_decode(C, it); f32x4 va[16], vb[16], ga[4], gb[4];
    titem_load(cur, va, ga, C.lane);
    for (;;) {
        int nit = it + NGW; TItem nxt = cur; const bool hn = nit < it_hi;
        if (hn) { nxt = titem_decode(C, nit); titem_load(nxt, vb, gb, C.lane); }
        titem_store(cur, va, ga, T, C.lane);
        if (!hn) break;
        it = nit + NGW; cur = nxt; const bool hn2 = it < it_hi;
        if (hn2) { cur = titem_decode(C, it); titem_load(cur, va, ga, C.lane); }
        titem_store(nxt, vb, gb, T, C.lane);
        if (!hn2) break;
    }
}
__device__ __forceinline__ void norm_row(const float* src, const float* gain, float* xcopy, bf16* xb, float* rs, float* fdst, int lane) {
    const GAS f32x4* xr = (const GAS f32x4*)src + lane;
    f32x4 v[8]; float s = 0.f;
#pragma unroll
    for (int j = 0; j < 8; ++j) { v[j] = xr[64 * j]; s += (v[j].x * v[j].x + v[j].y * v[j].y) + (v[j].z * v[j].z + v[j].w * v[j].w); }
    s = wave_sum(s);
    if (rs && lane == 0) *rs = s;
    if (xcopy) { GAS f32x4* xc = (GAS f32x4*)xcopy + lane;
#pragma unroll
        for (int j = 0; j < 8; ++j) xc[64 * j] = v[j]; }
    if (xb) {
#pragma unroll
        for (int j = 0; j < 8; ++j) { u32x2 w; w.x = pk2(v[j].x, v[j].y); w.y = pk2(v[j].z, v[j].w); *((GAS u32x2*)xb + lane + 64 * j) = w; } }
    if (fdst) { const float rstd = rsqrtf(s * (1.0f / DM) + EPS); const GAS f32x4* gr = (const GAS f32x4*)gain + lane;
#pragma unroll
        for (int j = 0; j < 8; ++j) { const f32x4 g = gr[64 * j]; f32x4 o = v[j] * rstd; o = o * g; *((GAS f32x4*)fdst + lane + 64 * j) = o; } }
}
__device__ __forceinline__ void p0_xinit(const Ctx& C) {
    const int gw = C.bid * NWAVES + C.wave, NGW = C.G * NWAVES;
    for (int m = gw; m < MV; m += NGW) { const float* src = m < SEQ ? (C.a->in[0]) + (size_t)m * DM : (C.a->in[1]) + (size_t)(m - SEQ) * DM;
        norm_row(src, nullptr, m < SEQ ? nullptr : ((float*)(C.a->ws + WS_X)) + (size_t)m * DM, ((bf16*)(C.a->ws + WS_XN)) + (size_t)m * DM, ((float*)(C.a->ws + WS_RSA)) + m, nullptr, C.lane); }
}
__device__ __forceinline__ void sample_rows_phase(const Ctx& C, float* RS) {
    const int gw = C.bid * NWAVES + C.wave, NGW = C.G * NWAVES;
    for (int m = SEQ + gw; m < MV; m += NGW) norm_row(((float*)(C.a->ws + WS_X)) + (size_t)m * DM, nullptr, nullptr, ((bf16*)(C.a->ws + WS_XN)) + (size_t)m * DM, RS + m, nullptr, C.lane);
}
__device__ __forceinline__ void final_norm_phase(const Ctx& C) {
    const int gw = C.bid * NWAVES + C.wave, NGW = C.G * NWAVES, lane = C.lane;
    f32x4 gv[8];
    { const GAS f32x4* gr = (const GAS f32x4*)(C.a->in[22]) + 2 * lane;
#pragma unroll
      for (int j = 0; j < 4; ++j) { gv[2 * j] = gr[128 * j]; gv[2 * j + 1] = gr[128 * j + 1]; } }
    for (int m = gw; m < MV; m += NGW) {
        if (m >= SEQ) { norm_row(((float*)(C.a->ws + WS_X)) + (size_t)m * DM, (C.a->in[22]), nullptr, nullptr, nullptr, (C.a->out) + O_YP + (size_t)m * DM, lane); continue; }
        const GAS v4u* xr = (const GAS v4u*)(((bf16*)(C.a->ws + WS_XN)) + (size_t)m * DM) + lane; v4u w[4]; float s = 0.f;
#pragma unroll
        for (int j = 0; j < 4; ++j) { w[j] = xr[64 * j]; const float a0 = bflo(w[j].x), a1 = bfhi(w[j].x), a2 = bflo(w[j].y), a3 = bfhi(w[j].y), a4 = bflo(w[j].z), a5 = bfhi(w[j].z), a6 = bflo(w[j].w), a7 = bfhi(w[j].w);
            s += ((a0 * a0 + a1 * a1) + (a2 * a2 + a3 * a3)) + ((a4 * a4 + a5 * a5) + (a6 * a6 + a7 * a7)); }
        const float rstd = rsqrtf(wave_sum(s) * (1.0f / DM) + EPS);
        GAS f32x4* op = (GAS f32x4*)((C.a->out) + O_YP + (size_t)m * DM) + 2 * lane;
#pragma unroll
        for (int j = 0; j < 4; ++j) { const f32x4 g0 = gv[2 * j], g1 = gv[2 * j + 1];
            op[128 * j] = (f32x4){bflo(w[j].x) * rstd * g0.x, bfhi(w[j].x) * rstd * g0.y, bflo(w[j].y) * rstd * g0.z, bfhi(w[j].y) * rstd * g0.w};
            op[128 * j + 1] = (f32x4){bflo(w[j].z) * rstd * g1.x, bfhi(w[j].z) * rstd * g1.y, bflo(w[j].w) * rstd * g1.z, bfhi(w[j].w) * rstd * g1.w}; }
    }
}
__device__ __forceinline__ void zero_f32(const Ctx& C, float* p, int n, int vb, int nvb) { float z0 = 0.f; asm volatile("" : "+v"(z0)); for (int i = vb * 512 + C.tid; i < n; i += nvb * 512) p[i] = z0; }

__device__ __forceinline__ void sample_ssd_wave_unit(const Ctx& C, int l, int b, int g, LAS float* wsc) {
    const int lane = lane_now();
    const int row = SEQ + b, n4 = lane & 31, prh = lane >> 5;
    LAS float* xs = wsc; LAS float* Bs = wsc + 512; LAS float* ys = wsc + 768;
    const float* cw = (C.a->in[8]) + (size_t)l * CW * CD; const float* cb = (C.a->in[9]) + (size_t)l * CD;
    const float* sc = (C.a->in[3]) + ((size_t)l * NB + b) * 3 * CD; const bf16* U = ((bf16*)(C.a->ws + WS_U));
    { const int ch = g * 512 + 8 * lane; const v4u un = *(const GAS v4u*)(U + UIDX(row, UXBC + ch)); const float nv[8] = {bflo(un.x), bfhi(un.x), bflo(un.y), bfhi(un.y), bflo(un.z), bfhi(un.z), bflo(un.w), bfhi(un.w)};
#pragma unroll
      for (int q = 0; q < 2; ++q) { const f32x4 bb = *(const GAS f32x4*)(cb + ch + 4 * q), w0 = *(const GAS f32x4*)(cw + ch + 4 * q), w1 = *(const GAS f32x4*)(cw + CD + ch + 4 * q), w2 = *(const GAS f32x4*)(cw + 2 * CD + ch + 4 * q), w3 = *(const GAS f32x4*)(cw + 3 * CD + ch + 4 * q);
          const f32x4 s0 = *(const GAS f32x4*)(sc + ch + 4 * q), s1 = *(const GAS f32x4*)(sc + CD + ch + 4 * q), s2 = *(const GAS f32x4*)(sc + 2 * CD + ch + 4 * q);
          f32x4 o;
#pragma unroll
          for (int e = 0; e < 4; ++e) o[e] = siluf_(bb[e] + w0[e] * s0[e] + w1[e] * s1[e] + w2[e] * s2[e] + w3[e] * nv[4 * q + e]);
          *(LAS f32x4*)(xs + 8 * lane + 4 * q) = o; } }
    { const int ch = (lane < 32 ? DI + g * 128 : DI + 1024 + g * 128 - 128) + 4 * lane;
      const u32x2 un = *(const GAS u32x2*)(U + UIDX(row, UXBC + ch)); const float nv[4] = {bflo(un.x), bfhi(un.x), bflo(un.y), bfhi(un.y)};
      const f32x4 bb = *(const GAS f32x4*)(cb + ch), w0 = *(const GAS f32x4*)(cw + ch), w1 = *(const GAS f32x4*)(cw + CD + ch), w2 = *(const GAS f32x4*)(cw + 2 * CD + ch), w3 = *(const GAS f32x4*)(cw + 3 * CD + ch);
      const f32x4 s0 = *(const GAS f32x4*)(sc + ch), s1 = *(const GAS f32x4*)(sc + CD + ch), s2 = *(const GAS f32x4*)(sc + 2 * CD + ch);
      f32x4 o;
#pragma unroll
      for (int e = 0; e < 4; ++e) o[e] = siluf_(bb[e] + w0[e] * s0[e] + w1[e] * s1[e] + w2[e] * s2[e] + w3[e] * nv[e]);
      *(LAS f32x4*)(Bs + 4 * lane) = o; }
    LDS_WAIT(); asm volatile("" ::: "memory");
    const f32x4 Bv = *((const LAS f32x4*)Bs + n4), Cv = *((const LAS f32x4*)(Bs + 128) + n4);
    const size_t sbase = (((size_t)l * NB + b) * NH + 8 * g) * HP * DS;
    for (int j = 0; j < 8; ++j) { const int h = 8 * g + j;
        const GAS f32x4* sp = (const GAS f32x4*)((C.a->in[2]) + sbase + (size_t)j * HP * DS + (size_t)prh * DS) + n4;
        GAS f32x4* op = (GAS f32x4*)((C.a->out) + O_SSSM + sbase + (size_t)j * HP * DS + (size_t)prh * DS) + n4;
        f32x4 hv[32];
#pragma unroll
        for (int i = 0; i < 32; ++i) hv[i] = __builtin_nontemporal_load(sp + (size_t)i * (2 * DS / 4));
        const float dt = ((float*)(C.a->ws + WS_DT))[(size_t)row * 64 + h], dA = __expf(-__expf((C.a->in[11])[l * NH + h]) * dt), Dh = (C.a->in[12])[l * NH + h];
#pragma unroll
        for (int i = 0; i < 32; ++i) { const int p = prh + 2 * i; const float xv = xs[j * 64 + p], dtx = dt * xv; const f32x4 h0 = hv[i];
            f32x4 hn; hn.x = dA * h0.x + dtx * Bv.x; hn.y = dA * h0.y + dtx * Bv.y; hn.z = dA * h0.z + dtx * Bv.z; hn.w = dA * h0.w + dtx * Bv.w;
            __builtin_nontemporal_store(hn, op + (size_t)i * (2 * DS / 4));
            float yp = (hn.x * Cv.x + hn.y * Cv.y) + (hn.z * Cv.z + hn.w * Cv.w);
#pragma unroll
            for (int o = 1; o < 32; o <<= 1) yp += __shfl_xor(yp, o);
            if (n4 == 0) ys[j * 64 + p] = yp + Dh * xv; }
    }
    LDS_WAIT(); asm volatile("" ::: "memory");
    { const int ch = g * 512 + 8 * lane; const v4u zw = *(const GAS v4u*)(U + UIDX(row, UZ + ch)); const f32x4 y0 = *(const LAS f32x4*)(ys + 8 * lane), y1 = *(const LAS f32x4*)(ys + 8 * lane + 4);
      float gv[8] = {y0.x * bflo(zw.x), y0.y * bfhi(zw.x), y0.z * bflo(zw.y), y0.w * bfhi(zw.y), y1.x * bflo(zw.z), y1.y * bfhi(zw.z), y1.z * bflo(zw.w), y1.w * bfhi(zw.w)};
      float ss = 0.f;
#pragma unroll
      for (int e = 0; e < 8; ++e) ss += gv[e] * gv[e];
      const float rstd = rsqrtf(wave_sum(ss) * (1.0f / 512.0f) + EPS);
      const f32x4 n0 = *(const GAS f32x4*)((C.a->in[13]) + (size_t)l * DI + ch), n1 = *(const GAS f32x4*)((C.a->in[13]) + (size_t)l * DI + ch + 4);
      v4u o; o.x = pk2(gv[0] * rstd * n0.x, gv[1] * rstd * n0.y); o.y = pk2(gv[2] * rstd * n0.z, gv[3] * rstd * n0.w); o.z = pk2(gv[4] * rstd * n1.x, gv[5] * rstd * n1.y); o.w = pk2(gv[6] * rstd * n1.z, gv[7] * rstd * n1.w);
      *(GAS v4u*)(((bf16*)(C.a->ws + WS_YO)) + (size_t)row * KCAT + ch) = o; }
    LDS_WAIT(); asm volatile("" ::: "memory");
}

__device__ __forceinline__ void sample_attn_phase(const Ctx& C, int l) {
    const int tid = C.tid;
    constexpr int KP = 68;
    LAS float* Ks = (LAS float*)(C.lds + RING_OFF); LAS float* Vs = Ks + 128 * KP; LAS float* qs = Vs + 128 * KP; LAS float* sc = qs + 256; LAS float* knew = sc + 4 * 132; LAS float* vnew = knew + 64;
    const bf16* U = ((bf16*)(C.a->ws + WS_U));
    f32x4 kv[4], vv[4]; float qx = 0.f;
#define SA_LOAD(u_) do { const int b_ = (u_) >> 3, kh_ = (u_) & 7, row_ = SEQ + b_; const size_t cb_ = ((size_t)l * NB + b_) * WIN * (KVH * AD) + (size_t)kh_ * AD; \
        _Pragma("unroll") for (int i = 0; i < 4; ++i) { const int idx = tid + 512 * i, w = idx >> 4, c4 = idx & 15; \
            kv[i] = __builtin_nontemporal_load((const GAS f32x4*)((C.a->in[4]) + cb_ + (size_t)w * (KVH * AD)) + c4); vv[i] = __builtin_nontemporal_load((const GAS f32x4*)((C.a->in[5]) + cb_ + (size_t)w * (KVH * AD)) + c4); } \
        if (tid < 256) qx = bf2f(U[UIDX(row_, UQ + kh_ * 256 + tid)]); else if (tid < 320) qx = bf2f(U[UIDX(row_, UK + kh_ * 64 + (tid - 256))]); else if (tid < 384) qx = bf2f(U[UIDX(row_, UV + kh_ * 64 + (tid - 320))]); } while (0)
    int u = C.bid; if (u >= NB * KVH) return;
    SA_LOAD(u);
    for (; u < NB * KVH; u += C.G) {
        const int b = u >> 3, kh = u & 7, row = SEQ + b;
        const size_t cbase = ((size_t)l * NB + b) * WIN * (KVH * AD) + (size_t)kh * AD;
        if (tid < 256) qs[tid] = qx; else if (tid < 320) knew[tid - 256] = qx; else if (tid < 384) vnew[tid - 320] = qx;
#pragma unroll
        for (int i = 0; i < 4; ++i) { const int idx = tid + 512 * i, w = idx >> 4, c4 = idx & 15; *((LAS f32x4*)(Ks + w * KP) + c4) = kv[i]; *((LAS f32x4*)(Vs + w * KP) + c4) = vv[i]; }
        __syncthreads();
        if (u + C.G < NB * KVH) SA_LOAD(u + C.G);
        if (tid < 16) { *((GAS f32x4*)((C.a->out) + O_SK + cbase + (size_t)(WIN - 1) * (KVH * AD)) + tid) = *((const LAS f32x4*)knew + tid); }
        else if (tid < 32) { *((GAS f32x4*)((C.a->out) + O_SV + cbase + (size_t)(WIN - 1) * (KVH * AD)) + (tid - 16)) = *((const LAS f32x4*)vnew + (tid - 16)); }
        { const int w = tid >> 2, hq = tid & 3; const LAS f32x4* kp = (const LAS f32x4*)(Ks + w * KP); const LAS f32x4* qp = (const LAS f32x4*)(qs + hq * 64);
          float s = 0.f;
    #pragma unroll
          for (int c = 0; c < 16; ++c) { const f32x4 kv = kp[c], qv = qp[c]; s += (kv.x * qv.x + kv.y * qv.y) + (kv.z * qv.z + kv.w * qv.w); }
          sc[hq * 132 + w] = s * 0.125f; }
        if (tid < 4) { float s = 0.f;
          for (int d = 0; d < 64; ++d) s += qs[tid * 64 + d] * knew[d];
          sc[tid * 132 + 128] = s * 0.125f; }
        __syncthreads();
        if (C.wave < 4) { const int hq = C.wave; const float sink = (C.a->in[16])[l * AH + 4 * kh + hq];
          const float v0 = sc[hq * 132 + C.lane], v1 = sc[hq * 132 + 64 + C.lane], v2 = C.lane == 0 ? sc[hq * 132 + 128] : -__builtin_inff();
          const float m = fmaxf(wave_max(fmaxf(fmaxf(v0, v1), v2)), sink);
          const float e0 = __expf(v0 - m), e1 = __expf(v1 - m), e2 = C.lane == 0 ? __expf(v2 - m) : 0.f;
          const float inv = 1.0f / (wave_sum(e0 + e1 + e2) + __expf(sink - m));
          sc[hq * 132 + C.lane] = e0 * inv; sc[hq * 132 + 64 + C.lane] = e1 * inv; if (C.lane == 0) sc[hq * 132 + 128] = e2 * inv; }
        __syncthreads();
        if (tid < 256) { const int hq = tid >> 6, d = tid & 63; float o = sc[hq * 132 + 128] * vnew[d];
    #pragma unroll 16
          for (int w = 0; w < WIN; ++w) o += sc[hq * 132 + w] * Vs[w * KP + d];
          ((bf16*)(C.a->ws + WS_YO))[(size_t)row * KCAT + DI + (4 * kh + hq) * 64 + d] = (bf16)f2bf(o); }
        __syncthreads();
    }
#undef SA_LOAD
}

__device__ __forceinline__ void cache_shift(const Ctx& C, int l, int vb, int nvb) {
    constexpr int ROWF4 = (WIN - 1) * KVH * AD / 4;
    for (int u = vb; u < NB * 2; u += nvb) { const int b = u >> 1, kv = u & 1;
        const GAS f32x4* src = (const GAS f32x4*)((kv ? (C.a->in[5]) : (C.a->in[4])) + ((size_t)l * NB + b) * WIN * (KVH * AD) + KVH * AD);
        GAS f32x4* dst = (GAS f32x4*)((C.a->out) + (kv ? O_SV : O_SK) + ((size_t)l * NB + b) * WIN * (KVH * AD));
        for (int i = C.tid; i < ROWF4; i += 512 * 8) { f32x4 v[8];
#pragma unroll
            for (int j = 0; j < 8; ++j) if (i + 512 * j < ROWF4) v[j] = __builtin_nontemporal_load(src + i + 512 * j);
#pragma unroll
            for (int j = 0; j < 8; ++j) if (i + 512 * j < ROWF4) __builtin_nontemporal_store(v[j], dst + i + 512 * j); } }
}

__device__ __forceinline__ void copy_outs(const Ctx& C, int l, int vb, int nvb) {
    const bf16* U = ((bf16*)(C.a->ws + WS_U)); const int gt = vb * 512 + C.tid, NT = nvb * 512;
    for (int i = gt; i < WIN * KVH * AD / 8; i += NT) { const int w = i >> 6, c = (i & 63) * 8, ur = SEQ - WIN + w;
        const v4u kw = *(const GAS v4u*)(U + UIDX(ur, UK + c)), vw = *(const GAS v4u*)(U + UIDX(ur, UV + c));
        GAS f32x4* pk = (GAS f32x4*)((C.a->out) + O_PK + (size_t)l * WIN * KVH * AD + (size_t)w * (KVH * AD) + c); GAS f32x4* pv = (GAS f32x4*)((C.a->out) + O_PV + (size_t)l * WIN * KVH * AD + (size_t)w * (KVH * AD) + c);
        pk[0] = (f32x4){bflo(kw.x), bfhi(kw.x), bflo(kw.y), bfhi(kw.y)}; pk[1] = (f32x4){bflo(kw.z), bfhi(kw.z), bflo(kw.w), bfhi(kw.w)};
        pv[0] = (f32x4){bflo(vw.x), bfhi(vw.x), bflo(vw.y), bfhi(vw.y)}; pv[1] = (f32x4){bflo(vw.z), bfhi(vw.z), bflo(vw.w), bfhi(vw.w)}; }
    constexpr int C8 = CD / 8;
    for (int i = gt; i < 3 * C8; i += NT) { const int j = i / C8, ch = (i - j * C8) * 8; const v4u w = *(const GAS v4u*)(U + UIDX(SEQ - 3 + j, UXBC + ch));
        GAS f32x4* po = (GAS f32x4*)((C.a->out) + O_PCONV + (size_t)l * 3 * CD + (size_t)j * CD + ch);
        po[0] = (f32x4){bflo(w.x), bfhi(w.x), bflo(w.y), bfhi(w.y)}; po[1] = (f32x4){bflo(w.z), bfhi(w.z), bflo(w.w), bfhi(w.w)}; }
    for (int i = gt; i < NB * C8; i += NT) { const int b = i / C8, ch = (i - b * C8) * 8;
        const GAS f32x4* si = (const GAS f32x4*)((C.a->in[3]) + ((size_t)l * NB + b) * 3 * CD + ch); GAS f32x4* so = (GAS f32x4*)((C.a->out) + O_SCONV + ((size_t)l * NB + b) * 3 * CD + ch);
        const f32x4 r10 = si[CD / 4], r11 = si[CD / 4 + 1], r20 = si[2 * CD / 4], r21 = si[2 * CD / 4 + 1]; const v4u w = *(const GAS v4u*)(U + UIDX(SEQ + b, UXBC + ch));
        so[0] = r10; so[1] = r11; so[CD / 4] = r20; so[CD / 4 + 1] = r21;
        so[2 * CD / 4] = (f32x4){bflo(w.x), bfhi(w.x), bflo(w.y), bfhi(w.y)}; so[2 * CD / 4 + 1] = (f32x4){bflo(w.z), bfhi(w.z), bflo(w.w), bfhi(w.w)}; }
}
typedef float f32x2_t __attribute__((ext_vector_type(2))); typedef __bf16 bf16x2_t __attribute__((ext_vector_type(2)));
__device__ __forceinline__ unsigned cvtpk(float lo, float hi) { f32x2_t v = {lo, hi}; bf16x2_t b = __builtin_convertvector(v, bf16x2_t); return __builtin_bit_cast(unsigned, b); }
__device__ __forceinline__ int crow(int reg, int hh) { return (reg & 3) + 8 * (reg >> 2) + 4 * hh; }
#define MFMA32(a, b, c) __builtin_amdgcn_mfma_f32_32x32x16_bf16((a), (b), (c), 0, 0, 0)
__device__ __forceinline__ bf16x8 ld16(const bf16* p) { return *(const GAS bf16x8*)p; }
__device__ __forceinline__ bf16x8 ld8x2(const bf16* p) {
    const u32x2 lo = *(const GAS u32x2*)p, hi = *(const GAS u32x2*)(p + 8); v4u w; w.x = lo.x; w.y = lo.y; w.z = hi.x; w.w = hi.y; return __builtin_bit_cast(bf16x8, w); }
#define PACK8(X, s) __builtin_bit_cast(bf16x8, (v4u){cvtpk((X)[8 * (s)], (X)[8 * (s) + 1]), cvtpk((X)[8 * (s) + 2], (X)[8 * (s) + 3]), cvtpk((X)[8 * (s) + 4], (X)[8 * (s) + 5]), cvtpk((X)[8 * (s) + 6], (X)[8 * (s) + 7])})

__device__ __forceinline__ void reformat_conv_item(const Ctx& C, int l, int c, int cblk) {
    const int co = C.lane & 7, rg = C.lane >> 3, ch0 = cblk * 64 + co * 8;
    const float* cw = (C.a->in[8]) + (size_t)l * CW * CD + ch0; const float* cb = (C.a->in[9]) + (size_t)l * CD + ch0;
    float w0[8], w1[8], w2[8], w3[8], bs[8];
#pragma unroll
    for (int j = 0; j < 8; ++j) { w0[j] = cw[j]; w1[j] = cw[CD + j]; w2[j] = cw[2 * CD + j]; w3[j] = cw[3 * CD + j]; bs[j] = cb[j]; }
    const bf16* U = ((bf16*)(C.a->ws + WS_U));
    const int row0 = 128 * c + 16 * rg;
    v4u raw[19];
    unsigned zu = 0u; asm volatile("" : "+v"(zu));
#pragma unroll
    for (int i = 0; i < 19; ++i) { const int rr = row0 - 3 + i; raw[i] = *(const GAS v4u*)(U + UIDX(rr < 0 ? 0 : rr, UXBC + ch0)); }
    __builtin_amdgcn_sched_barrier(0);
#pragma unroll
    for (int i = 0; i < 3; ++i) { if (row0 - 3 + i < 0) raw[i] = (v4u){zu, zu, zu, zu}; }
    unsigned tp[8][8];
    bf16* rm = nullptr; bf16* tr = nullptr;
    if (cblk < 64) tr = ((bf16*)(C.a->ws + WS_XT)) + (((size_t)c * 64 + cblk) * 64 + co * 8) * 128 + 16 * rg;
    else if (cblk < 80) { const int g = (cblk - 64) >> 1, hf = (cblk - 64) & 1;
        rm = ((bf16*)(C.a->ws + WS_BRM)) + (((size_t)c * 8 + g) * 128 + 16 * rg) * 128 + hf * 64 + co * 8;
        tr = ((bf16*)(C.a->ws + WS_BT)) + (((size_t)c * 8 + g) * 128 + hf * 64 + co * 8) * 128 + 16 * rg; }
    else { const int g = (cblk - 80) >> 1, hf = (cblk - 80) & 1;
        rm = ((bf16*)(C.a->ws + WS_CRM)) + (((size_t)c * 8 + g) * 128 + 16 * rg) * 128 + hf * 64 + co * 8; }
#define RAWF(i, j) (((j) & 1) ? bfhi(((j) >> 1) == 0 ? raw[i].x : (((j) >> 1) == 1 ? raw[i].y : (((j) >> 1) == 2 ? raw[i].z : raw[i].w))) : bflo(((j) >> 1) == 0 ? raw[i].x : (((j) >> 1) == 1 ? raw[i].y : (((j) >> 1) == 2 ? raw[i].z : raw[i].w))))
#pragma unroll
    for (int i2 = 0; i2 < 8; ++i2) {
        float oa[8], ob[8];
#pragma unroll
        for (int j = 0; j < 8; ++j) { oa[j] = siluf_(bs[j] + w0[j] * RAWF(2 * i2, j) + w1[j] * RAWF(2 * i2 + 1, j) + w2[j] * RAWF(2 * i2 + 2, j) + w3[j] * RAWF(2 * i2 + 3, j));
                                      ob[j] = siluf_(bs[j] + w0[j] * RAWF(2 * i2 + 1, j) + w1[j] * RAWF(2 * i2 + 2, j) + w2[j] * RAWF(2 * i2 + 3, j) + w3[j] * RAWF(2 * i2 + 4, j)); }
        if (rm) { v4u w; w.x = cvtpk(oa[0], oa[1]); w.y = cvtpk(oa[2], oa[3]); w.z = cvtpk(oa[4], oa[5]); w.w = cvtpk(oa[6], oa[7]); *(GAS v4u*)(rm + (size_t)(2 * i2) * 128) = w;
                  w.x = cvtpk(ob[0], ob[1]); w.y = cvtpk(ob[2], ob[3]); w.z = cvtpk(ob[4], ob[5]); w.w = cvtpk(ob[6], ob[7]); *(GAS v4u*)(rm + (size_t)(2 * i2 + 1) * 128) = w; }
#pragma unroll
        for (int j = 0; j < 8; ++j) tp[j][i2] = cvtpk(oa[j], ob[j]);
    }
#undef RAWF
    if (tr) {
#pragma unroll
        for (int j = 0; j < 8; ++j) { *(GAS v4u*)(tr + (size_t)j * 128) = (v4u){tp[j][0], tp[j][1], tp[j][2], tp[j][3]}; *(GAS v4u*)(tr + (size_t)j * 128 + 8) = (v4u){tp[j][4], tp[j][5], tp[j][6], tp[j][7]}; }
    }
}
__device__ __forceinline__ void reformat_dt_item(const Ctx& C, int l, int c) {
    const int h = C.lane; const float A = -__expf((C.a->in[11])[l * NH + h]);
    const float* D = ((float*)(C.a->ws + WS_DT)) + (size_t)(128 * c) * 64 + h;
    float* dto = ((float*)(C.a->ws + WS_DTT)) + ((size_t)c * 64 + h) * 128; float* aco = ((float*)(C.a->ws + WS_ACS)) + ((size_t)c * 64 + h) * 128;
    float cs = 0.f;
#pragma unroll
    for (int l0 = 0; l0 < 128; l0 += 64) { float dv[64];
#pragma unroll
        for (int i = 0; i < 64; ++i) dv[i] = D[(size_t)(l0 + i) * 64];
        __builtin_amdgcn_sched_barrier(0);
#pragma unroll
        for (int q = 0; q < 16; ++q) { f32x4 av;
#pragma unroll
            for (int e = 0; e < 4; ++e) { cs += dv[4 * q + e] * A; av[e] = cs; }
            *(GAS f32x4*)(dto + l0 + 4 * q) = (f32x4){dv[4 * q], dv[4 * q + 1], dv[4 * q + 2], dv[4 * q + 3]}; *(GAS f32x4*)(aco + l0 + 4 * q) = av; } }
}
__device__ __forceinline__ void reformat_vt_item(const Ctx& C, int tb, int kh) {
    const int co = C.lane & 7, rg = C.lane >> 3; const bf16* U = ((bf16*)(C.a->ws + WS_U)) + UIDX(128 * tb + 16 * rg, UV + kh * 64 + co * 8);
    unsigned tp[8][8]; v4u rv[16];
#pragma unroll
    for (int i = 0; i < 16; ++i) rv[i] = *(const GAS v4u*)(U + (size_t)i * 64);
    __builtin_amdgcn_sched_barrier(0);
#pragma unroll
    for (int i = 0; i < 16; ++i) { const v4u a = rv[i]; const unsigned w[4] = {a.x, a.y, a.z, a.w};
#pragma unroll
        for (int j = 0; j < 8; ++j) { const unsigned hb = (j & 1) ? (w[j >> 1] >> 16) : (w[j >> 1] & 0xffffu); if (i & 1) tp[j][i >> 1] |= hb << 16; else tp[j][i >> 1] = hb; } }
    bf16* tr = ((bf16*)(C.a->ws + WS_VT)) + ((size_t)kh * 64 + co * 8) * SEQ + 128 * tb + 16 * rg;
#pragma unroll
    for (int j = 0; j < 8; ++j) { *(GAS v4u*)(tr + (size_t)j * SEQ) = (v4u){tp[j][0], tp[j][1], tp[j][2], tp[j][3]}; *(GAS v4u*)(tr + (size_t)j * SEQ + 8) = (v4u){tp[j][4], tp[j][5], tp[j][6], tp[j][7]}; }
}
constexpr int RF_ITEMS = 64 * 96 + 64 + 64 * 8;
__device__ __forceinline__ void reformat_item(const Ctx& C, int l, int it) {
    constexpr int N1 = 64 * 96, N2 = 64;
    if (it < N1) reformat_conv_item(C, l, it / 96, it % 96);
    else if (it < N1 + N2) reformat_dt_item(C, l, it - N1);
    else reformat_vt_item(C, (it - N1 - N2) >> 3, (it - N1 - N2) & 7);
}

constexpr int AT_K = 0, AT_V = 36864, AT_KP = 144, AT_VP = 528;
__device__ __forceinline__ void attn_prompt_unit(const Ctx& C, int l, int qb, int kh) {
    const int lane_ = lane_now();
    const int r = lane_ & 31, hh = lane_ >> 5, hq = 4 * kh + (C.wave >> 1), rh = C.wave & 1, tid = C.wave * 64 + lane_;
    const bf16* U = ((bf16*)(C.a->ws + WS_U)); const bf16* VT = ((bf16*)(C.a->ws + WS_VT)) + (size_t)kh * 64 * SEQ; bf16* YO = ((bf16*)(C.a->ws + WS_YO));
    LAS unsigned char* Ks = C.lds + AT_K; LAS unsigned char* Vs = C.lds + AT_V;
    const int key0 = 128 * (qb - 1);
    bf16x8 bq[2][4];
    { v4u tk[4], tv[4]; unsigned zu = 0u; asm volatile("" : "+v"(zu));
#pragma unroll
      for (int i = 0; i < 4; ++i) { const int idx = tid + 512 * i, kr = idx >> 3, ch = idx & 7, key = key0 + kr;
          tk[i] = *(const GAS v4u*)(U + UIDX(key < 0 ? 0 : key, UK + kh * 64 + 8 * ch));
          const int d = idx >> 5, c5 = idx & 31, kk = key0 + 8 * c5;
          tv[i] = *(const GAS v4u*)(VT + (size_t)d * SEQ + (kk < 0 ? 0 : kk)); }
#pragma unroll
      for (int qt = 0; qt < 2; ++qt)
#pragma unroll
          for (int ks = 0; ks < 4; ++ks) bq[qt][ks] = ld16(U + UIDX(128 * qb + 32 * (2 * rh + qt) + r, UQ + hq * 64 + 16 * ks + 8 * hh));
      __builtin_amdgcn_sched_barrier(0);
#pragma unroll
      for (int i = 0; i < 4; ++i) { const int idx = tid + 512 * i; if (key0 + (idx >> 3) < 0) tk[i] = (v4u){zu, zu, zu, zu}; if (key0 + 8 * (idx & 31) < 0) tv[i] = (v4u){zu, zu, zu, zu}; }
#pragma unroll
      for (int i = 0; i < 4; ++i) { const int idx = tid + 512 * i; *(LAS v4u*)(Ks + (idx >> 3) * AT_KP + (idx & 7) * 16) = tk[i]; *(LAS v4u*)(Vs + (idx >> 5) * AT_VP + (idx & 31) * 16) = tv[i]; } }
    const float sink = (C.a->in[16])[l * AH + hq];
    __syncthreads();
#pragma unroll
    for (int qt = 0; qt < 2; ++qt) {
        const int ai = 2 * rh + qt, q0 = 128 * qb + 32 * ai, t = q0 + r;
        f32x16 S[5]; float mx = sink;
#pragma unroll
        for (int v = 0; v < 5; ++v) { const int kt = ai + v; const bool vis = qb > 0 || kt >= 4;
            if (vis) { const int kb = key0 + 32 * kt; f32x16 s;
#pragma unroll
                for (int e = 0; e < 16; ++e) s[e] = 0.f;
                const LAS unsigned char* kp = Ks + (32 * kt + r) * AT_KP + 16 * hh;
#pragma unroll
                for (int ks = 0; ks < 4; ++ks) { const bf16x8 a = *(const LAS bf16x8*)(kp + 32 * ks); s = MFMA32(a, bq[qt][ks], s); }
#pragma unroll
                for (int e = 0; e < 16; ++e) { const int j = kb + crow(e, hh); const bool ok = (j <= t) && (j >= t - WIN); const float x = ok ? s[e] * 0.125f : -__builtin_inff(); s[e] = x; mx = fmaxf(mx, x); }
                S[v] = s; }
        }
        mx = fmaxf(mx, __shfl_xor(mx, 32));
        float sum = 0.f;
#pragma unroll
        for (int v = 0; v < 5; ++v) { const int kt = ai + v; const bool vis = qb > 0 || kt >= 4;
            if (vis) {
#pragma unroll
                for (int e = 0; e < 16; ++e) { const float p = __expf(S[v][e] - mx); S[v][e] = p; sum += p; } } }
        sum += __shfl_xor(sum, 32); sum += __expf(sink - mx);
        f32x16 O[2];
#pragma unroll
        for (int e = 0; e < 16; ++e) { O[0][e] = 0.f; O[1][e] = 0.f; }
#pragma unroll
        for (int v = 0; v < 5; ++v) { const int kt = ai + v; const bool vis = qb > 0 || kt >= 4;
            if (vis) {
#pragma unroll
                for (int ss = 0; ss < 2; ++ss) { const bf16x8 pb = PACK8(S[v], ss);
#pragma unroll
                    for (int dt = 0; dt < 2; ++dt) { const LAS unsigned char* vp = Vs + (32 * dt + r) * AT_VP + (32 * kt + 16 * ss + 4 * hh) * 2;
                        const u32x2 lo = *(const LAS u32x2*)vp, hi = *(const LAS u32x2*)(vp + 16);
                        const bf16x8 va = __builtin_bit_cast(bf16x8, (v4u){lo.x, lo.y, hi.x, hi.y}); O[dt] = MFMA32(va, pb, O[dt]); } } } }
        const float inv = 1.0f / sum;
        bf16* op = YO + (size_t)t * KCAT + DI + hq * 64;
#pragma unroll
        for (int dt = 0; dt < 2; ++dt)
#pragma unroll
            for (int g4 = 0; g4 < 4; ++g4) { u32x2 w; w.x = cvtpk(O[dt][4 * g4] * inv, O[dt][4 * g4 + 1] * inv); w.y = cvtpk(O[dt][4 * g4 + 2] * inv, O[dt][4 * g4 + 3] * inv);
                *(GAS u32x2*)(op + 32 * dt + 8 * g4 + 4 * hh) = w; }
    }
    __syncthreads();
}

__device__ __forceinline__ void ssd_states_unit(const Ctx& C, int c, int g) {
    const int lane_ = lane_now();
    const int r = lane_ & 31, hh = lane_ >> 5, h = 8 * g + C.wave, tid = C.wave * 64 + lane_;
    const bf16* xT = ((bf16*)(C.a->ws + WS_XT)) + ((size_t)c * 64 + h) * 64 * 128; const bf16* bT = ((bf16*)(C.a->ws + WS_BT)) + ((size_t)c * 8 + g) * 128 * 128;
    const float* dtT = ((float*)(C.a->ws + WS_DTT)) + ((size_t)c * 64 + h) * 128; const float* acs = ((float*)(C.a->ws + WS_ACS)) + ((size_t)c * 64 + h) * 128;
    LAS unsigned char* Bs = C.lds + PC_B; LAS float* scs = (LAS float*)(C.lds + PC_C) + C.wave * 128;
    v4u tb[4], raw[2][8];
#pragma unroll
    for (int i = 0; i < 4; ++i) tb[i] = *(const GAS v4u*)(bT + (size_t)(tid + 512 * i) * 8);
    const float dl0 = dtT[lane_], dl1 = dtT[64 + lane_], al0 = acs[lane_], al1 = acs[64 + lane_], aend = acs[127];
#pragma unroll
    for (int ks = 0; ks < 8; ++ks)
#pragma unroll
        for (int pt = 0; pt < 2; ++pt) raw[pt][ks] = *(const GAS v4u*)(xT + (size_t)(32 * pt + r) * 128 + 16 * ks + 8 * hh);
    __builtin_amdgcn_sched_barrier(0);
#pragma unroll
    for (int i = 0; i < 4; ++i) { const int idx = tid + 512 * i; *(LAS v4u*)(Bs + (idx >> 4) * 272 + (idx & 15) * 16) = tb[i]; }
    scs[lane_] = dl0 * __expf(aend - al0); scs[64 + lane_] = dl1 * __expf(aend - al1);
    LDS_WAIT(); asm volatile("" ::: "memory");
    bf16x8 a[2][8];
#pragma unroll
    for (int ks = 0; ks < 8; ++ks) { const f32x4 s0 = *(const LAS f32x4*)(scs + 16 * ks + 8 * hh), s1 = *(const LAS f32x4*)(scs + 16 * ks + 8 * hh + 4);
#pragma unroll
        for (int pt = 0; pt < 2; ++pt) { const v4u w = raw[pt][ks];
            v4u o; o.x = cvtpk(bflo(w.x) * s0.x, bfhi(w.x) * s0.y); o.y = cvtpk(bflo(w.y) * s0.z, bfhi(w.y) * s0.w); o.z = cvtpk(bflo(w.z) * s1.x, bfhi(w.z) * s1.y); o.w = cvtpk(bflo(w.w) * s1.z, bfhi(w.w) * s1.w);
            a[pt][ks] = __builtin_bit_cast(bf16x8, o); } }
    __syncthreads();
    bf16* st = ((bf16*)(C.a->ws + WS_ST)) + ((size_t)c * 64 + h) * 64 * 128;
#pragma unroll
    for (int nt = 0; nt < 4; ++nt) {
        f32x16 acc[2];
#pragma unroll
        for (int e = 0; e < 16; ++e) { acc[0][e] = 0.f; acc[1][e] = 0.f; }
        const LAS unsigned char* bp = Bs + (32 * nt + r) * 272 + 16 * hh;
#pragma unroll
        for (int ks = 0; ks < 8; ++ks) { const bf16x8 b = *(const LAS bf16x8*)(bp + 32 * ks); acc[0] = MFMA32(b, a[0][ks], acc[0]); acc[1] = MFMA32(b, a[1][ks], acc[1]); }
#pragma unroll
        for (int pt = 0; pt < 2; ++pt)
#pragma unroll
            for (int q4 = 0; q4 < 4; ++q4) { u32x2 w; w.x = cvtpk(acc[pt][4 * q4], acc[pt][4 * q4 + 1]); w.y = cvtpk(acc[pt][4 * q4 + 2], acc[pt][4 * q4 + 3]);
                *(GAS u32x2*)(st + (size_t)(32 * pt + r) * 128 + 32 * nt + 8 * q4 + 4 * hh) = w; }
    }
    __syncthreads();
}

__device__ __forceinline__ void ssd_scan_phase(const Ctx& C, int l) {
    const bf16* ST = ((bf16*)(C.a->ws + WS_ST)); bf16* HS = ((bf16*)(C.a->ws + WS_HS)); const float* acs = ((float*)(C.a->ws + WS_ACS));
    for (int idx = C.bid * 512 + C.tid; idx < 64 * 64 * 128 / 4; idx += C.G * 512) { const int h = idx >> 11;
        f32x4 hc = (f32x4){0.f, 0.f, 0.f, 0.f};
        for (int c0 = 0; c0 < 64; c0 += 16) { u32x2 sw[16]; float av[16];
#pragma unroll
            for (int j = 0; j < 16; ++j) { sw[j] = *((const GAS u32x2*)(ST + (size_t)(c0 + j) * 64 * 64 * 128) + idx); av[j] = acs[((size_t)(c0 + j) * 64 + h) * 128 + 127]; }
#pragma unroll
            for (int j = 0; j < 16; ++j) {
                u32x2 w; w.x = cvtpk(hc.x, hc.y); w.y = cvtpk(hc.z, hc.w); *((GAS u32x2*)(HS + (size_t)(c0 + j) * 64 * 64 * 128) + idx) = w;
                const f32x4 s = (f32x4){bflo(sw[j].x), bfhi(sw[j].x), bflo(sw[j].y), bfhi(sw[j].y)}; const float dec = __expf(av[j]);
                hc = hc * dec + s; } }
        *((GAS f32x4*)((C.a->out) + O_PSSM + (size_t)l * NH * HP * DS) + idx) = hc; }
}

__device__ __forceinline__ void ssd_out_unit(const Ctx& C, int l, int c, int g) {
    const int lane_ = lane_now();
    const int r = lane_ & 31, hh = lane_ >> 5, h = 8 * g + C.wave, tid = C.wave * 64 + lane_;
    LAS unsigned char* Bs = C.lds + PC_B; LAS unsigned char* Cs = C.lds + PC_C; LAS float* Ysm = (LAS float*)(C.lds + PC_Y + C.wave * 8704);
    LAS float* ssq = (LAS float*)(C.lds + PC_SSQ); LAS float* acsS = (LAS float*)(C.lds + PC_AD + C.wave * 1024); LAS float* dtS = acsS + 128;
    const bf16* cR = ((bf16*)(C.a->ws + WS_CRM)) + ((size_t)c * 8 + g) * 128 * 128; const bf16* bR = ((bf16*)(C.a->ws + WS_BRM)) + ((size_t)c * 8 + g) * 128 * 128;
    const bf16* hS = ((bf16*)(C.a->ws + WS_HS)) + ((size_t)c * 64 + h) * 64 * 128; const bf16* xT = ((bf16*)(C.a->ws + WS_XT)) + ((size_t)c * 64 + h) * 64 * 128;
    LAS float* nws = (LAS float*)(C.lds + 152576) + C.wave * 64;
    bf16x8 hb[2][8], xb[4][2][2];
    { v4u tb[4], tc[4];
#pragma unroll
      for (int i = 0; i < 4; ++i) { const int idx = tid + 512 * i; tb[i] = *(const GAS v4u*)(bR + (size_t)idx * 8); tc[i] = *(const GAS v4u*)(cR + (size_t)idx * 8); }
      const float a0 = (((float*)(C.a->ws + WS_ACS)) + ((size_t)c * 64 + h) * 128)[lane_], a1 = (((float*)(C.a->ws + WS_ACS)) + ((size_t)c * 64 + h) * 128)[64 + lane_];
      const float d0 = (((float*)(C.a->ws + WS_DTT)) + ((size_t)c * 64 + h) * 128)[lane_], d1 = (((float*)(C.a->ws + WS_DTT)) + ((size_t)c * 64 + h) * 128)[64 + lane_];
      const float nwv = ((C.a->in[13]) + (size_t)l * DI + h * 64)[lane_];
#pragma unroll
      for (int pt = 0; pt < 2; ++pt)
#pragma unroll
          for (int ks = 0; ks < 8; ++ks) hb[pt][ks] = ld16(hS + (size_t)(32 * pt + r) * 128 + 16 * ks + 8 * hh);
#pragma unroll
      for (int st = 0; st < 4; ++st)
#pragma unroll
          for (int ss = 0; ss < 2; ++ss)
#pragma unroll
              for (int pt = 0; pt < 2; ++pt) xb[st][ss][pt] = ld8x2(xT + (size_t)(32 * pt + r) * 128 + 32 * st + 16 * ss + 4 * hh);
      __builtin_amdgcn_sched_barrier(0);
#pragma unroll
      for (int i = 0; i < 4; ++i) { const int idx = tid + 512 * i, row = idx >> 4, ch = idx & 15; *(LAS v4u*)(Bs + row * 272 + ch * 16) = tb[i]; *(LAS v4u*)(Cs + row * 272 + ch * 16) = tc[i]; }
      acsS[lane_] = a0; acsS[64 + lane_] = a1; dtS[lane_] = d0; dtS[64 + lane_] = d1; nws[lane_] = nwv; }
    const float Dh = (C.a->in[12])[l * NH + h];
    __syncthreads();
    const bf16* Uz = ((bf16*)(C.a->ws + WS_U)) + UIDX(128 * c + (lane_ >> 1), UZ + h * 64 + 32 * (lane_ & 1));
    bf16* YOw = ((bf16*)(C.a->ws + WS_YO)) + (size_t)(128 * c + (lane_ >> 1)) * KCAT + h * 64 + 32 * (lane_ & 1);
    const LAS float* nwp = nws + 32 * (lane_ & 1);
#pragma unroll
    for (int lt = 0; lt < 4; ++lt) {
        v4u zw[4];
        { const GAS v4u* zp = (const GAS v4u*)(Uz + (size_t)(32 * lt) * 64);
#pragma unroll
          for (int i = 0; i < 4; ++i) zw[i] = zp[i]; }
        f32x16 y[2];
#pragma unroll
        for (int e = 0; e < 16; ++e) { y[0][e] = 0.f; y[1][e] = 0.f; }
        const LAS unsigned char* crow_p = Cs + (32 * lt + r) * 272 + 16 * hh;
#pragma unroll
        for (int ks = 0; ks < 8; ++ks) { if ((ks & 3) == 0) asm volatile("" ::: "memory");
            const bf16x8 a = *(const LAS bf16x8*)(crow_p + 32 * ks); y[0] = MFMA32(a, hb[0][ks], y[0]); y[1] = MFMA32(a, hb[1][ks], y[1]); }
#pragma unroll
        for (int q4 = 0; q4 < 4; ++q4) { const f32x4 av = *(const LAS f32x4*)(acsS + 32 * lt + 8 * q4 + 4 * hh);
#pragma unroll
            for (int e = 0; e < 4; ++e) { const float f = __expf(av[e]); y[0][4 * q4 + e] *= f; y[1][4 * q4 + e] *= f; } }
        const float al = acsS[32 * lt + r];
#pragma unroll
        for (int st = 0; st < 4; ++st) { if (st > lt) continue;
            f32x16 X;
#pragma unroll
            for (int e = 0; e < 16; ++e) X[e] = 0.f;
            const LAS unsigned char* brow_p = Bs + (32 * st + r) * 272 + 16 * hh;
#pragma unroll
            for (int ks = 0; ks < 8; ++ks) { if ((ks & 1) == 0) asm volatile("" ::: "memory");
                const bf16x8 a = *(const LAS bf16x8*)(brow_p + 32 * ks), b = *(const LAS bf16x8*)(crow_p + 32 * ks); X = MFMA32(a, b, X); }
#pragma unroll
            for (int q4 = 0; q4 < 4; ++q4) { const f32x4 as = *(const LAS f32x4*)(acsS + 32 * st + 8 * q4 + 4 * hh), ds = *(const LAS f32x4*)(dtS + 32 * st + 8 * q4 + 4 * hh);
#pragma unroll
                for (int e = 0; e < 4; ++e) { const int s = 32 * st + 8 * q4 + 4 * hh + e, lrow = 32 * lt + r; const float wgt = (s <= lrow) ? ds[e] * __expf(al - as[e]) : 0.f; X[4 * q4 + e] *= wgt; } }
#pragma unroll
            for (int ss = 0; ss < 2; ++ss) { const bf16x8 xa = PACK8(X, ss); y[0] = MFMA32(xa, xb[st][ss][0], y[0]); y[1] = MFMA32(xa, xb[st][ss][1], y[1]); }
        }
#pragma unroll
        for (int pt = 0; pt < 2; ++pt)
#pragma unroll
            for (int e = 0; e < 16; ++e) { const int q4 = e >> 2; const v4u xw = __builtin_bit_cast(v4u, xb[lt][q4 >> 1][pt]); const unsigned w = (q4 & 1) ? ((e & 2) ? xw.w : xw.z) : ((e & 2) ? xw.y : xw.x);
                const float xv = (e & 1) ? bfhi(w) : bflo(w);
                Ysm[crow(e, hh) * 68 + 32 * pt + r] = y[pt][e] + Dh * xv; }
        { const LAS f32x4* yr = (const LAS f32x4*)(Ysm + (lane_ >> 1) * 68 + 32 * (lane_ & 1));
          float gq[32]; float sq = 0.f;
#pragma unroll
          for (int i = 0; i < 4; ++i) { const f32x4 ya = yr[2 * i], yb = yr[2 * i + 1];
              gq[8 * i + 0] = ya.x * bflo(zw[i].x); gq[8 * i + 1] = ya.y * bfhi(zw[i].x); gq[8 * i + 2] = ya.z * bflo(zw[i].y); gq[8 * i + 3] = ya.w * bfhi(zw[i].y);
              gq[8 * i + 4] = yb.x * bflo(zw[i].z); gq[8 * i + 5] = yb.y * bfhi(zw[i].z); gq[8 * i + 6] = yb.z * bflo(zw[i].w); gq[8 * i + 7] = yb.w * bfhi(zw[i].w);
#pragma unroll
              for (int e = 0; e < 8; ++e) sq += gq[8 * i + e] * gq[8 * i + e]; }
          sq += __shfl_xor(sq, 1);
          if ((lane_ & 1) == 0) ssq[(32 * lt + (lane_ >> 1)) * 8 + C.wave] = sq;
          __syncthreads();
          const LAS f32x4* sp = (const LAS f32x4*)(ssq + (32 * lt + (lane_ >> 1)) * 8); const f32x4 s0 = sp[0], s1 = sp[1];
          const float rstd = rsqrtf(((s0.x + s0.y) + (s0.z + s0.w) + (s1.x + s1.y) + (s1.z + s1.w)) * (1.0f / 512.0f) + EPS);
          GAS v4u* op = (GAS v4u*)(YOw + (size_t)(32 * lt) * KCAT);
#pragma unroll
          for (int i = 0; i < 4; ++i) { const f32x4 na = *(const LAS f32x4*)(nwp + 8 * i), nb = *(const LAS f32x4*)(nwp + 8 * i + 4);
              op[i] = (v4u){cvtpk(gq[8 * i] * rstd * na.x, gq[8 * i + 1] * rstd * na.y), cvtpk(gq[8 * i + 2] * rstd * na.z, gq[8 * i + 3] * rstd * na.w), cvtpk(gq[8 * i + 4] * rstd * nb.x, gq[8 * i + 5] * rstd * nb.y), cvtpk(gq[8 * i + 6] * rstd * nb.z, gq[8 * i + 7] * rstd * nb.w)}; } }
    }
    __syncthreads();
}

template <int MODE> __device__ __forceinline__ void mini_unit(const Ctx& C, int l, int mu) {
    constexpr int K = MODE == 0 ? KCAT : (MODE == 1 ? DM : FF), KS = MODE == 0 ? 1024 : (MODE == 1 ? 256 : 704);
    const int lane_ = lane_now();
    const int r = lane_ & 31, hh = lane_ >> 5, ct = mu & 31, sp = mu >> 5, rt = C.wave & 3, n0 = 64 * ct + 32 * (C.wave >> 2), k0 = KS * sp + 8 * hh;
    const bf16* Bt = (MODE == 0 ? ((bf16*)(C.a->ws + WS_WCAT)) + (size_t)l * DM * KCAT : (MODE == 1 ? ((bf16*)(C.a->ws + WS_WOUT)) + (size_t)l * DM * DM : ((bf16*)(C.a->ws + WS_WDN)) + (size_t)l * DM * FF)) + (size_t)(n0 + r) * K + k0;
    const bf16* Ab = (MODE == 0 ? ((bf16*)(C.a->ws + WS_YO)) + (size_t)(SEQ + 32 * rt + r) * KCAT : ((bf16*)(C.a->ws + WS_HB)) + (size_t)(SEQ + 32 * rt + r) * FF) + k0;
    const float* Af = ((float*)(C.a->ws + WS_MS)) + (size_t)(32 * rt + r) * DM + k0;
    f32x16 acc;
#pragma unroll
    for (int e = 0; e < 16; ++e) acc[e] = 0.f;
    constexpr int UB = MODE == 1 ? 8 : (MODE == 2 ? 11 : 16), NB_ = KS / 16 / UB;
    static_assert(NB_ * UB * 16 == KS, "mini-unit batches");
#pragma unroll 1
    for (int kb = 0; kb < NB_; ++kb) {
        bf16x8 bv[UB];
        if (MODE == 1) { f32x4 a0[UB], a1[UB];
#pragma unroll
            for (int j = 0; j < UB; ++j) { bv[j] = ld16(Bt + 16 * (kb * UB + j)); a0[j] = *(const GAS f32x4*)(Af + 16 * (kb * UB + j)); a1[j] = *(const GAS f32x4*)(Af + 16 * (kb * UB + j) + 4); }
            __builtin_amdgcn_sched_barrier(0);
#pragma unroll
            for (int j = 0; j < UB; ++j) { const bf16x8 a = __builtin_bit_cast(bf16x8, (v4u){cvtpk(a0[j].x, a0[j].y), cvtpk(a0[j].z, a0[j].w), cvtpk(a1[j].x, a1[j].y), cvtpk(a1[j].z, a1[j].w)}); acc = MFMA32(a, bv[j], acc); }
        } else { bf16x8 av[UB];
#pragma unroll
            for (int j = 0; j < UB; ++j) { bv[j] = ld16(Bt + 16 * (kb * UB + j)); av[j] = ld16(Ab + 16 * (kb * UB + j)); }
            __builtin_amdgcn_sched_barrier(0);
#pragma unroll
            for (int j = 0; j < UB; ++j) acc = MFMA32(av[j], bv[j], acc);
        }
        __builtin_amdgcn_sched_barrier(0);
    }
    float* dst = (MODE == 0 ? ((float*)(C.a->ws + WS_MS)) : ((float*)(C.a->ws + WS_X)) + (size_t)SEQ * DM) + n0 + r;
    if (MODE == 0) { const bf16* gp = ((bf16*)(C.a->ws + WS_U)) + UIDX(SEQ, (sp < 4 ? UGS : UGA) + n0 + r);
        bf16 gv[16];
#pragma unroll
        for (int e = 0; e < 16; ++e) gv[e] = gp[(size_t)(32 * rt + crow(e, hh)) * 64];
        __builtin_amdgcn_sched_barrier(0);
#pragma unroll
        for (int e = 0; e < 16; ++e) acc[e] *= bf2f(gv[e]); }
#pragma unroll
    for (int e = 0; e < 16; ++e) unsafeAtomicAdd(dst + (size_t)(32 * rt + crow(e, hh)) * DM, acc[e]);
}
template <int MODE> __device__ __forceinline__ void mini_phase(const Ctx& C, int l) {
    constexpr int NMU = 32 * (MODE == 0 ? 6 : 8);
    for (int mu = C.bid; mu < NMU; mu += C.G) mini_unit<MODE>(C, l, mu);
}
constexpr int NPL = 11;
constexpr int NPH = 1 + DEPTH * NPL;
#ifndef REP_P0
#define REP_P0 1
#endif
#ifndef REP_0
#define REP_0 1
#endif
#ifndef REP_1
#define REP_1 1
#endif
#ifndef REP_2
#define REP_2 1
#endif
#ifndef REP_3
#define REP_3 1
#endif
#ifndef REP_4
#define REP_4 1
#endif
#ifndef REP_5
#define REP_5 1
#endif
#ifndef REP_6
#define REP_6 1
#endif
#ifndef REP_7
#define REP_7 1
#endif
#ifndef REP_8
#define REP_8 1
#endif
#ifndef REP_9
#define REP_9 1
#endif
#ifndef REP_10
#define REP_10 1
#endif
#ifndef REP_RF
#define REP_RF 1
#endif
#ifndef REP_SSD
#define REP_SSD 1
#endif
#ifndef REP_SATT
#define REP_SATT 1
#endif
#ifndef GEMM_ALIGN
#define GEMM_ALIGN true
#endif
#ifndef GEMM_SP2
#define GEMM_SP2 true
#endif
#ifndef PROBE_LO
#define PROBE_LO -1
#define PROBE_HI -1
#endif
#ifndef PROBE_AMP
#define PROBE_AMP 2
#endif
#ifndef NW_SSD
#define NW_SSD 2
#endif
#ifndef PROBE_SUB
#define PROBE_SUB 0
#endif
#ifndef PROBE_CLK
#define PROBE_CLK 0
#endif
#ifndef REP_ATT
#define REP_ATT 1
#endif
#ifndef REP_PA
#define REP_PA 1
#endif
#ifndef NSP_G1
#define NSP_G1 49
#endif
#ifndef MK_SPLIT
#define MK_SPLIT 0
#endif
__global__ void __launch_bounds__(NWAVES * 64, 2) fwd(Args args) {
    extern __shared__ __attribute__((aligned(16))) unsigned char lds_raw[];
    LAS unsigned char* const lds = (LAS unsigned char*)lds_raw;
    const int wave_s = __builtin_amdgcn_readfirstlane(threadIdx.x >> 6);
    unsigned char* ws = args.ws;
#define FRESH_CTX() Ctx C; { int t_; asm volatile("v_mbcnt_lo_u32_b32 %0, -1, 0\n\tv_mbcnt_hi_u32_b32 %0, -1, %0" : "=v"(t_)); t_ += wave_s * 64; int b_ = blockIdx.x, g_ = gridDim.x; asm volatile("" : "+s"(b_), "+s"(g_)); \
        KArgs kp_ = (KArgs)__builtin_amdgcn_kernarg_segment_ptr(); asm volatile("" : "+s"(kp_)); \
        C.lds = lds; C.tid = t_; C.lane = t_ & 63; C.wave = __builtin_amdgcn_readfirstlane(t_ >> 6); C.G = g_; C.bid = b_; C.a = kp_; }
    for (int u = threadIdx.x; u < (LDS_BYTES - LDSCTL_OFF) / 4; u += NWAVES * 64) ((LAS unsigned*)(lds + LDSCTL_OFF))[u] = 0u;
    __syncthreads();
    volatile LAS unsigned* MISC = (volatile LAS unsigned*)(lds + MISC_OFF);
    unsigned* barw = (unsigned*)(ws + WS_CTL) + CW_BAR;
    XcdBarrier bar; bar.bar = barw; bar.x = 0; bar.st = nullptr;
    if (args.use_bar) bar = xcd_barrier_post(barw, MISC + 8);
    const int lo = args.ph_lo, hi = args.ph_hi;
#define IN(k) (lo <= (k) && (k) < hi)
#define SEAM(k) do { if (IN((k) + 1)) xcd_barrier(bar); } while (0)

#ifndef NO_P0
    if (IN(0)) { for (int rep_ = 0; rep_ < REP_P0; ++rep_) { FRESH_CTX(); p0_weights(C, 0, (C.G >= 64 && NSP_G1 > 0) ? IT_IN : DEPTH * IT_LAYER, C.bid * NWAVES + C.wave, C.G * NWAVES); p0_xinit(C); if (rep_ + 1 < REP_P0) xcd_barrier(bar); } SEAM(0); }
#endif

    unsigned long long probe_acc = 0ull, probe_t0 = 0ull;
    if (PROBE_CLK && threadIdx.x == 0) { const unsigned long long c0_ = __builtin_amdgcn_s_memtime(), r0_ = __builtin_amdgcn_s_memrealtime(); MISC[16] = (unsigned)c0_; MISC[17] = (unsigned)(c0_ >> 32); MISC[18] = (unsigned)r0_; MISC[19] = (unsigned)(r0_ >> 32); }
#define PROBE_BEGIN(j) do { if (PROBE_LO >= 0 && (j) == PROBE_LO) probe_t0 = __builtin_amdgcn_s_memrealtime(); } while (0)
#define PROBE_END(j) do { if (PROBE_LO >= 0 && (j) == PROBE_HI) probe_acc += __builtin_amdgcn_s_memrealtime() - probe_t0; } while (0)
#pragma nounroll
    for (int l = 0; l < DEPTH; ++l) {
        const int pb = 1 + l * NPL;
#ifndef NO_G1
        PROBE_BEGIN(0);
        if (IN(pb + 0)) { for (int rep_ = 0; rep_ < REP_0; ++rep_) {
            FRESH_CTX();
            const int nsp = (l == 0 && C.G >= 64) ? (C.G * NSP_G1) / 256 : 0, gG = C.G - nsp;
            if (C.bid < gG) {
            pg8::Gemm g{((bf16*)(C.a->ws + WS_XN)), ((bf16*)(C.a->ws + WS_WIN)) + (size_t)l * NU * DM, MP, NU, DM}; pg8::StaticOrder S; S.init(MP, NU, gG, C.bid);
            pg8::EpiU E{((bf16*)(C.a->ws + WS_U)), ((float*)(C.a->ws + WS_DT)), (C.a->in[10]) + l * NH, ((float*)(C.a->ws + WS_RSA))};
            pg8::gemm_phase<pg8::EpiU, pg8::StaticOrder, GEMM_ALIGN, GEMM_SP2>(C.lds + RING_OFF, g, S, E, C.tid);
            } else p0_weights(C, IT_IN, DEPTH * IT_LAYER, (C.bid - gG) * NWAVES + C.wave, nsp * NWAVES);
            if (rep_ + 1 < REP_0) xcd_barrier(bar); }
            SEAM(pb + 0);
        }
        PROBE_END(0);
#endif
        PROBE_BEGIN(1);
        if (IN(pb + 1)) { for (int rep_ = 0; rep_ < REP_1; ++rep_) {
            FRESH_CTX();
            { volatile LAS unsigned* qctr = (volatile LAS unsigned*)(C.lds + MISC_OFF) + 24;
              if (C.tid == 0) qctr[0] = 0u;
              __syncthreads();
              const int nS = (NB * NG - C.bid + C.G - 1) / C.G, nR = (RF_ITEMS - C.bid + C.G - 1) / C.G;
              LAS float* wsc = (LAS float*)(C.lds + RING_OFF + C.wave * 8192);
              for (;;) { unsigned idx = 0u; if (C.lane == 0) idx = __hip_atomic_fetch_add((LAS unsigned*)qctr, 1u, __ATOMIC_RELAXED, __HIP_MEMORY_SCOPE_WORKGROUP);
                  idx = (unsigned)__builtin_amdgcn_readfirstlane((int)idx);
                  if ((int)idx >= nS + nR) break;
                  if ((int)idx < nS) { const int u = C.bid + C.G * (int)idx; sample_ssd_wave_unit(C, l, u >> 3, u & 7, wsc); }
                  else reformat_item(C, l, C.bid + C.G * ((int)idx - nS)); } }
            __syncthreads();
            if (PROBE_SUB == 1) probe_acc += __builtin_amdgcn_s_memrealtime() - probe_t0;
            if (PROBE_SUB == 2) probe_t0 = __builtin_amdgcn_s_memrealtime();
            zero_f32(C, ((float*)(C.a->ws + WS_RSB)), SEQ, C.bid, C.G);
            { float z0 = 0.f; asm volatile("" : "+v"(z0));
              for (int i = C.bid * 512 + C.tid; i < NB * DM / 4; i += C.G * 512) ((GAS f32x4*)(C.a->ws + WS_MS))[i] = (f32x4){z0, z0, z0, z0}; }
            for (int rr_ = 0; rr_ < REP_SATT; ++rr_) sample_attn_phase(C, l);
            if (PROBE_SUB == 2) probe_acc += __builtin_amdgcn_s_memrealtime() - probe_t0;
            if (PROBE_SUB == 3) probe_t0 = __builtin_amdgcn_s_memrealtime();
            if (PROBE_SUB == 3) { __syncthreads(); probe_acc += __builtin_amdgcn_s_memrealtime() - probe_t0; }
            if (rep_ + 1 < REP_1) xcd_barrier(bar); }
            SEAM(pb + 1);
        }
        PROBE_END(1);
        PROBE_BEGIN(2);
        if (IN(pb + 2)) { for (int rep_ = 0; rep_ < REP_2; ++rep_) {
            FRESH_CTX();
#ifdef USE_NSSD
            if (C.bid < NG) naive_ssd_prompt(C, l, C.bid);
            else {
                const int vb = C.bid - NG, nvb = C.G - NG;
                for (int u = vb; u < 64 * KVH; u += nvb) attn_prompt_unit(C, l, u >> 3, u & 7);
                for (int u = vb; u < 64 * NG; u += nvb) ssd_states_unit(C, u >> 3, u & 7);
            }
#else
            for (int rr_ = 0; rr_ < REP_ATT; ++rr_) for (int u = C.bid; u < 64 * KVH; u += C.G) attn_prompt_unit(C, l, u >> 3, u & 7);
            for (int rr_ = 0; rr_ < REP_PA; ++rr_) for (int u = C.bid; u < 64 * NG; u += C.G) ssd_states_unit(C, u >> 3, u & 7);
#endif
            if (rep_ + 1 < REP_2) xcd_barrier(bar); }
            SEAM(pb + 2);
        }
        PROBE_END(2);
        PROBE_BEGIN(3);
        if (IN(pb + 3)) { for (int rep_ = 0; rep_ < REP_3; ++rep_) { FRESH_CTX(); ssd_scan_phase(C, l); if (rep_ + 1 < REP_3) xcd_barrier(bar); } SEAM(pb + 3); }
        PROBE_END(3);
        PROBE_BEGIN(4);
        if (IN(pb + 4)) { for (int rep_ = 0; rep_ < REP_4; ++rep_) {
            FRESH_CTX();
#ifndef USE_NSSD
            for (int u = C.bid; u < 64 * NG; u += C.G) ssd_out_unit(C, l, u >> 3, u & 7);
#endif
            if (rep_ + 1 < REP_4) xcd_barrier(bar); }
            SEAM(pb + 4);
        }
        PROBE_END(4);
#ifndef NO_G2
        PROBE_BEGIN(5);
        if (IN(pb + 5)) { for (int rep_ = 0; rep_ < REP_5; ++rep_) {
            FRESH_CTX();
            pg8::Gemm g{((bf16*)(C.a->ws + WS_YO)), ((bf16*)(C.a->ws + WS_WCAT)) + (size_t)l * DM * KCAT, SEQ, DM, KCAT}; pg8::StaticOrder S; S.init(SEQ, DM, C.G, C.bid);
            pg8::EpiMerge E{((bf16*)(C.a->ws + WS_U)), ((bf16*)(C.a->ws + WS_MRG))};
            pg8::gemm_phase<pg8::EpiMerge, pg8::StaticOrder, true, true>(C.lds + RING_OFF, g, S, E, C.tid);
            mini_phase<0>(C, l);
            if (rep_ + 1 < REP_5) xcd_barrier(bar); }
            SEAM(pb + 5);
        }
        PROBE_END(5);
#endif
#ifndef NO_G3
        PROBE_BEGIN(6);
        if (IN(pb + 6)) { for (int rep_ = 0; rep_ < REP_6; ++rep_) {
            FRESH_CTX();
            pg8::Gemm g{((bf16*)(C.a->ws + WS_MRG)), ((bf16*)(C.a->ws + WS_WOUT)) + (size_t)l * DM * DM, SEQ, DM, DM}; pg8::StaticOrder S; S.init(SEQ, DM, C.G, C.bid);
            pg8::EpiResid E{l == 0 ? (C.a->in[0]) : (const float*)nullptr, ((bf16*)(C.a->ws + WS_XN)), ((float*)(C.a->ws + WS_RSB))};
            pg8::gemm_phase<pg8::EpiResid, pg8::StaticOrder, true, true>(C.lds + RING_OFF, g, S, E, C.tid);
            mini_phase<1>(C, l);
            if (rep_ + 1 < REP_6) xcd_barrier(bar); }
            SEAM(pb + 6);
        }
        PROBE_END(6);
#endif
        PROBE_BEGIN(7);
        if (IN(pb + 7)) { for (int rep_ = 0; rep_ < REP_7; ++rep_) { FRESH_CTX(); sample_rows_phase(C, ((float*)(C.a->ws + WS_RSB))); if (rep_ + 1 < REP_7) xcd_barrier(bar); } SEAM(pb + 7); }
        PROBE_END(7);
#ifndef NO_G4
        PROBE_BEGIN(8);
        if (IN(pb + 8)) { for (int rep_ = 0; rep_ < REP_8; ++rep_) {
            FRESH_CTX();
            const int nsp = C.G >= 64 ? (C.G * 14) / 256 : 0, gG = C.G - nsp;
            if (C.bid < gG) {
            pg8::Gemm g{((bf16*)(C.a->ws + WS_XN)), ((bf16*)(C.a->ws + WS_WGU)) + (size_t)l * NGU * DM, MP, NGU, DM}; pg8::StaticOrder S; S.init(MP, NGU, gG, C.bid);
            pg8::EpiSwiGLU E{((bf16*)(C.a->ws + WS_HB)), ((float*)(C.a->ws + WS_RSB))};
            pg8::gemm_phase<pg8::EpiSwiGLU, pg8::StaticOrder, GEMM_ALIGN, GEMM_SP2>(C.lds + RING_OFF, g, S, E, C.tid);
            } else { zero_f32(C, ((float*)(C.a->ws + WS_RSA)), SEQ, C.bid - gG, nsp); copy_outs(C, l, C.bid - gG, nsp); cache_shift(C, l, C.bid - gG, nsp); }
            if (nsp == 0) { zero_f32(C, ((float*)(C.a->ws + WS_RSA)), SEQ, C.bid, C.G); copy_outs(C, l, C.bid, C.G); cache_shift(C, l, C.bid, C.G); }
            if (rep_ + 1 < REP_8) xcd_barrier(bar); }
            SEAM(pb + 8);
        }
        PROBE_END(8);
#endif
#ifndef NO_G5
        PROBE_BEGIN(9);
        if (IN(pb + 9)) { for (int rep_ = 0; rep_ < REP_9; ++rep_) {
            FRESH_CTX();
            pg8::Gemm g{((bf16*)(C.a->ws + WS_HB)), ((bf16*)(C.a->ws + WS_WDN)) + (size_t)l * DM * FF, SEQ, DM, FF}; pg8::StaticOrder S; S.init(SEQ, DM, C.G, C.bid);
            pg8::EpiResid E{(const float*)nullptr, ((bf16*)(C.a->ws + WS_XN)), ((float*)(C.a->ws + WS_RSA))};
            pg8::gemm_phase<pg8::EpiResid, pg8::StaticOrder, true, true>(C.lds + RING_OFF, g, S, E, C.tid);
            mini_phase<2>(C, l);
            if (rep_ + 1 < REP_9) xcd_barrier(bar); }
            SEAM(pb + 9);
        }
        PROBE_END(9);
#endif
        PROBE_BEGIN(10);
        if (IN(pb + 10)) { for (int rep_ = 0; rep_ < REP_10; ++rep_) {
            FRESH_CTX();
            if (l + 1 < DEPTH) sample_rows_phase(C, ((float*)(C.a->ws + WS_RSA))); else final_norm_phase(C);
            if (rep_ + 1 < REP_10) xcd_barrier(bar); }
            SEAM(pb + 10);
        }
        PROBE_END(10);
    }
    if (PROBE_CLK && blockIdx.x == 0 && wave_s == 0 && lane_now() == 0) { const unsigned long long c1 = __builtin_amdgcn_s_memtime(), r1 = __builtin_amdgcn_s_memrealtime(); const unsigned long long clk_c0 = ((unsigned long long)MISC[17] << 32) | MISC[16], clk_r0 = ((unsigned long long)MISC[19] << 32) | MISC[18]; const unsigned long long dc = (c1 - clk_c0) * 10000ull, dr = r1 - clk_r0;
        while ((__builtin_amdgcn_s_memrealtime() - r1) * dr < dc) __builtin_amdgcn_s_sleep(8); }
    if (PROBE_LO >= 0 && blockIdx.x == 0 && wave_s == 0 && lane_now() == 0) { const unsigned long long t1 = __builtin_amdgcn_s_memrealtime(); while (__builtin_amdgcn_s_memrealtime() - t1 < (unsigned long long)PROBE_AMP * probe_acc) __builtin_amdgcn_s_sleep(8); }
#undef IN
#undef SEAM
}

extern "C" void kernel_launch(void* const* d_in, const int* in_sizes, int n_in, void* d_out, int out_size, void* d_ws, size_t ws_size, hipStream_t stream) {
    static int grid = 0;
    if (grid == 0) {
        if (n_in != 23 || (size_t)out_size != O_END || ws_size < WS_END) { fprintf(stderr, "kernel_launch: unexpected problem (n_in %d, out %d, ws %zu; need ws >= %zu); nothing launched\n", n_in, out_size, ws_size, (size_t)WS_END); grid = -1; return; }
        int dev = 0, cus = 0, per_cu = 0;
        if (hipGetDevice(&dev) != hipSuccess || hipDeviceGetAttribute(&cus, hipDeviceAttributeMultiprocessorCount, dev) != hipSuccess) { grid = -1; return; }
        if (hipFuncSetAttribute((const void*)fwd, hipFuncAttributeMaxDynamicSharedMemorySize, LDS_BYTES) != hipSuccess) { fprintf(stderr, "kernel_launch: hipFuncSetAttribute failed\n"); grid = -1; return; }
        if (hipOccupancyMaxActiveBlocksPerMultiprocessor(&per_cu, (const void*)fwd, NWAVES * 64, LDS_BYTES) != hipSuccess || per_cu < 1) { fprintf(stderr, "kernel_launch: occupancy query says %d blocks per CU\n", per_cu); }
        (void)hipGetLastError();
        grid = cus;
    }
    if (grid < 0) return;
    if (hipMemsetAsync((char*)d_ws + WS_CTL, 0, CTL_ZERO_BYTES, stream) != hipSuccess) return;
    Args a{};
    for (int i = 0; i < 23; ++i) a.in[i] = (const float*)d_in[i];
    a.out = (float*)d_out; a.ws = (unsigned char*)d_ws; a.pad = 0;
#if MK_SPLIT
    for (int p = 0; p < NPH; ++p) { a.ph_lo = p; a.ph_hi = p + 1; a.use_bar = 0; hipLaunchKernelGGL(fwd, dim3(grid), dim3(NWAVES * 64), LDS_BYTES, stream, a); }
#else
    a.ph_lo = 0; a.ph_hi = NPH; a.use_bar = 1;
    hipLaunchKernelGGL(fwd, dim3(grid), dim3(NWAVES * 64), LDS_BYTES, stream, a);
#endif
    const hipError_t le = hipPeekAtLastError();
    if (le != hipSuccess) fprintf(stderr, "kernel_launch: launch failed: %s\n", hipGetErrorName(le));
}
```

```cpp
#include <hip/hip_runtime.h>
#include <cstdio>
#include <cstdint>

constexpr int DM = 2048, SEQ = 8192, NB = 128, DEPTH = 2;
constexpr int MV = SEQ + NB;
constexpr int MP = 8448;
constexpr int DI = 4096, NH = 64, HP = 64, DS = 128, NG = 8, CD = 6144, CW = 4;
constexpr int AH = 32, KVH = 8, AD = 64, WIN = 128;
constexpr int FF = 5632;
constexpr int IN_DIM = 17472;
constexpr float EPS = 1e-6f;
constexpr int UZ = 0, UXBC = 4096, UQ = 10240, UK = 12288, UV = 12800, UGS = 13312, UGA = 15360, LDU = 17408;
__host__ __device__ __forceinline__ constexpr size_t UIDX(int row, int col) { return ((size_t)(row >> 7) * (LDU / 64) + (size_t)(col >> 6)) * 8192 + (size_t)(((row & 127) << 6) + (col & 63)); }
constexpr int NU = 17664;
constexpr int KCAT = DI + DM;
constexpr int NGU = 2 * FF;

constexpr size_t O_YP = 0;
constexpr size_t O_YS = O_YP + (size_t)SEQ * DM;
constexpr size_t O_PSSM = O_YS + (size_t)NB * DM;
constexpr size_t O_PCONV = O_PSSM + (size_t)DEPTH * NH * HP * DS;
constexpr size_t O_PK = O_PCONV + (size_t)DEPTH * 3 * CD;
constexpr size_t O_PV = O_PK + (size_t)DEPTH * WIN * KVH * AD;
constexpr size_t O_SSSM = O_PV + (size_t)DEPTH * WIN * KVH * AD;
constexpr size_t O_SCONV = O_SSSM + (size_t)DEPTH * NB * NH * HP * DS;
constexpr size_t O_SK = O_SCONV + (size_t)DEPTH * NB * 3 * CD;
constexpr size_t O_SV = O_SK + (size_t)DEPTH * NB * WIN * KVH * AD;
constexpr size_t O_END = O_SV + (size_t)DEPTH * NB * WIN * KVH * AD;
static_assert(O_END == 190877696ull, "output size");

constexpr size_t al256(size_t x) { return (x + 255) & ~(size_t)255; }
constexpr size_t WS_CTL = 0, CTL_ZERO_BYTES = 1u << 20;
constexpr size_t SZ_WIN = (size_t)NU * DM * 2, SZ_WCAT = (size_t)DM * KCAT * 2, SZ_WOUT = (size_t)DM * DM * 2, SZ_WGU = (size_t)NGU * DM * 2, SZ_WDN = (size_t)DM * FF * 2;
constexpr size_t WS_WIN = 1u << 20;
constexpr size_t WS_WCAT = WS_WIN + DEPTH * SZ_WIN;
constexpr size_t WS_WOUT = WS_WCAT + DEPTH * SZ_WCAT;
constexpr size_t WS_WGU = WS_WOUT + DEPTH * SZ_WOUT;
constexpr size_t WS_WDN = WS_WGU + DEPTH * SZ_WGU;
constexpr size_t WS_X = WS_WDN + DEPTH * SZ_WDN;
constexpr size_t WS_XN = WS_X + (size_t)MP * DM * 4;
constexpr size_t WS_U = WS_XN + (size_t)MP * DM * 2;
constexpr size_t WS_DT = WS_U + (size_t)MP * LDU * 2;
constexpr size_t WS_YO = WS_DT + (size_t)MP * 64 * 4;
constexpr size_t WS_MRG = WS_YO + (size_t)MP * KCAT * 2;
constexpr size_t WS_HB = WS_MRG + (size_t)MP * DM * 2;
constexpr size_t WS_XT = WS_HB + (size_t)MP * FF * 2;
constexpr size_t WS_BRM = WS_XT + (size_t)64 * 64 * 64 * 128 * 2;
constexpr size_t WS_BT = WS_BRM + (size_t)64 * 8 * 128 * 128 * 2;
constexpr size_t WS_CRM = WS_BT + (size_t)64 * 8 * 128 * 128 * 2;
constexpr size_t WS_DTT = WS_CRM + (size_t)64 * 8 * 128 * 128 * 2;
constexpr size_t WS_ACS = WS_DTT + (size_t)64 * 64 * 128 * 4;
constexpr size_t WS_VT = WS_ACS + (size_t)64 * 64 * 128 * 4;
constexpr size_t WS_ST = WS_VT + (size_t)8 * 64 * 8192 * 2;
constexpr size_t WS_HS = WS_ST + (size_t)64 * 64 * 64 * 128 * 4;
constexpr size_t WS_MS = WS_HS + (size_t)64 * 64 * 64 * 128 * 2;
constexpr size_t WS_RSA = WS_MS + (size_t)NB * DM * 4;
constexpr size_t WS_RSB = WS_RSA + (size_t)MP * 4;
constexpr size_t WS_END = WS_RSB + (size_t)MP * 4;
static_assert(WS_WIN % 256 == 0 && WS_X % 256 == 0 && WS_U % 256 == 0 && WS_YO % 256 == 0 && WS_HB % 256 == 0 && WS_XT % 256 == 0 && WS_ST % 256 == 0, "ws alignment");
constexpr int CW_BAR = 4096;

constexpr int RING_OFF = 0, RING_BYTES = 131072;
constexpr int PC_B = 0, PC_C = 34816, PC_Y = 69632, PC_SSQ = 139264, PC_AD = 143360, PC_END = 151552;
constexpr int LDSCTL_OFF = PC_END, MISC_OFF = LDSCTL_OFF + 320;
constexpr int LDS_BYTES = 155648;
constexpr int NWAVES = 8;
#define MK_SPLIT 0
namespace pg8 {
#define PG8_LAS __attribute__((address_space(3)))
typedef unsigned short bf16_t;
typedef short bf16x8 __attribute__((ext_vector_type(8)));
typedef float f32x4 __attribute__((ext_vector_type(4)));
typedef unsigned u32x4 __attribute__((ext_vector_type(4)));
constexpr int BM = 256, BK = 64, HALF = 128, HTB = HALF * BK * 2  , STAGE_BYTES = 8 * HTB, NXCD = 8, WGM = 8;

__host__ __device__ __forceinline__ int lds_byte(int r, int c) { const int st = (r >> 4) * 2 + (c >> 5), rr = r & 15, cc = c & 31, ob = rr * 64 + cc * 2; return st * 1024 + (ob ^ (((ob >> 9) & 1) << 5)); }
__host__ __device__ __forceinline__ void stage_rc(int b, int& R, int& C) { const int st = b / 1024, sb = b % 1024, swz = sb ^ (((sb >> 9) & 1) << 5); R = (st >> 1) * 16 + swz / 64; C = (st & 1) * 32 + (swz % 64) / 2; }
__host__ __device__ __forceinline__ int perm32(int rho) { const int n = rho >> 4, i = rho & 15; return 8 * (i >> 2) + 4 * n + (i & 3); }

struct Unit { int pm, pn; };
struct Gemm { const bf16_t* A; const bf16_t* Bt; int M, N, K; };

struct StaticOrder {
    int nM, nN, nwg, G, c;
    __host__ __device__ void init(int M, int N, int G_, int c_) { nM = M / BM; nN = N / BM; nwg = nM * nN; G = G_; c = c_; }
    __host__ __device__ bool next(int i, Unit& u) const {
        const long L = (long)i * G + c; if (L >= nwg) return false;
        int wgid = (int)L; { const int q = nwg / NXCD, r = nwg % NXCD, xcd = wgid % NXCD, off = wgid / NXCD; wgid = (xcd < r ? xcd * (q + 1) : r * (q + 1) + (xcd - r) * q) + off; }
        const int nig = WGM * nN, gid = wgid / nig, fm = gid * WGM, gsz = (nM - fm) < WGM ? (nM - fm) : WGM;
        u.pm = fm + ((wgid % nig) % gsz); u.pn = (wgid % nig) / gsz; return true;
    }
    __device__ __forceinline__ void a_ready(const Unit&) const {}
    __device__ __forceinline__ void done(const Unit&) const {}
};
__device__ __forceinline__ unsigned cvt_pk_bf16(float lo, float hi) { unsigned r; asm volatile("v_cvt_pk_bf16_f32 %0, %1, %2" : "=v"(r) : "v"(lo), "v"(hi)); return r; }
__device__ __forceinline__ float bf_lo(unsigned w) { return __uint_as_float(w << 16); }
__device__ __forceinline__ float bf_hi(unsigned w) { return __uint_as_float(w & 0xffff0000u); }
__device__ __forceinline__ float sigmoidf_(float x) { return __builtin_amdgcn_rcpf(1.0f + __expf(-x)); }
constexpr int E_MV = 8320, E_LDU = 17408, E_UGS = 13312, E_UGA = 15360;
__device__ __forceinline__ size_t e_uidx(int row, int col) { return ((size_t)(row >> 7) * (E_LDU / 64) + (size_t)(col >> 6)) * 8192 + (size_t)(((row & 127) << 6) + (col & 63)); }
struct EpiU {
    static constexpr bool PERM = true, AFTER_DRAIN = false, HOOK = false, RSLDS = true; static constexpr int HOOK_T = -1;
    bf16_t* U; float* DT; const float* dtb; const float* RS;
    __device__ __forceinline__ void hook(f32x4 (&)[2][2][4][2], const Unit&, int, int, int, int) const {}
    __device__ __forceinline__ static float softplus_(float x) { return x > 20.0f ? x : log1pf(__expf(x)); }
    __device__ __forceinline__ void operator()(const f32x4 (&acc)[2][2][4][2], const Unit& u, int wr, int wc, int fr, int fq, const float (&rsv)[8]) const {
        const int row0 = u.pm * BM + wr * 64 + fr;
        auto rstd_ = [&](int q) { return rsqrtf(rsv[q] * (1.0f / 2048.0f) + 1e-6f); };
        if (u.pn == 68) {
            if (wc < 2) { const f32x4 b0 = *(const f32x4*)(dtb + wc * 32 + 8 * fq), b1 = *(const f32x4*)(dtb + wc * 32 + 8 * fq + 4);
#pragma unroll
                for (int ai = 0; ai < 2; ++ai) { if (u.pm * BM + ai * HALF >= E_MV) continue;
#pragma unroll
                    for (int m = 0; m < 4; ++m) { float* p = DT + (size_t)(row0 + ai * HALF + m * 16) * 64 + wc * 32 + 8 * fq; const float rs = rstd_(ai * 4 + m); f32x4 v0 = acc[ai][0][m][0] * rs + b0, v1 = acc[ai][0][m][1] * rs + b1;
#pragma unroll
                        for (int e = 0; e < 4; ++e) { v0[e] = softplus_(v0[e]); v1[e] = softplus_(v1[e]); }
                        *(f32x4*)p = v0; *(f32x4*)(p + 4) = v1; } }
            }
            return;
        }
        const bool sig = u.pn >= 52, zsilu = u.pn < 16;
        const int col0 = u.pn * BM + wc * 32 + 8 * fq;
#pragma unroll
        for (int ai = 0; ai < 2; ++ai) { if (u.pm * BM + ai * HALF >= E_MV) continue;
#pragma unroll
            for (int m = 0; m < 4; ++m) { const int rr = row0 + ai * HALF + m * 16; const float rs = rstd_(ai * 4 + m);
#pragma unroll
                for (int bj = 0; bj < 2; ++bj) { f32x4 v0 = acc[ai][bj][m][0] * rs, v1 = acc[ai][bj][m][1] * rs;
                    if (sig) {
#pragma unroll
                        for (int e = 0; e < 4; ++e) { v0[e] = sigmoidf_(v0[e]); v1[e] = sigmoidf_(v1[e]); } }
                    if (zsilu) {
#pragma unroll
                        for (int e = 0; e < 4; ++e) { v0[e] = v0[e] * sigmoidf_(v0[e]); v1[e] = v1[e] * sigmoidf_(v1[e]); } }
                    u32x4 w; w.x = cvt_pk_bf16(v0[0], v0[1]); w.y = cvt_pk_bf16(v0[2], v0[3]); w.z = cvt_pk_bf16(v1[0], v1[1]); w.w = cvt_pk_bf16(v1[2], v1[3]);
                    *(u32x4*)(U + e_uidx(rr, col0 + bj * HALF)) = w; } } }
    }
};
struct EpiMerge {
    static constexpr bool PERM = true, AFTER_DRAIN = false, HOOK = true, RSLDS = false; static constexpr int HOOK_T = 64;
    const bf16_t* U; bf16_t* O;
    __device__ __forceinline__ void hook(f32x4 (&acc)[2][2][4][2], const Unit& u, int wr, int wc, int fr, int fq) const {
        asm volatile("" : "+v"(fr), "+v"(fq));
        const int row0 = u.pm * BM + wr * 64 + fr, col0 = u.pn * BM + wc * 32 + 8 * fq;
        u32x4 gsA[2][2], gaA[2][2], gsB[2][2], gaB[2][2];
#define HK_LOAD(gs_, ga_, q_) do { _Pragma("unroll") for (int mm = 0; mm < 2; ++mm) { const int rr = row0 + ((q_) >> 1) * HALF + (2 * ((q_) & 1) + mm) * 16; \
            _Pragma("unroll") for (int bj = 0; bj < 2; ++bj) { gs_[mm][bj] = *(const u32x4*)(U + e_uidx(rr, E_UGS + col0 + bj * HALF)); ga_[mm][bj] = *(const u32x4*)(U + e_uidx(rr, E_UGA + col0 + bj * HALF)); } } } while (0)
#define HK_APPLY(gs_, ga_, q_) do { _Pragma("unroll") for (int mm = 0; mm < 2; ++mm) { const int ai = (q_) >> 1, m = 2 * ((q_) & 1) + mm; \
            _Pragma("unroll") for (int bj = 0; bj < 2; ++bj) { const u32x4 s = gs_[mm][bj], a = ga_[mm][bj]; f32x4 r0, r1; \
                r0[0] = bf_lo(s.x) * __builtin_amdgcn_rcpf(fmaxf(bf_lo(a.x), 1e-20f)); r0[1] = bf_hi(s.x) * __builtin_amdgcn_rcpf(fmaxf(bf_hi(a.x), 1e-20f)); r0[2] = bf_lo(s.y) * __builtin_amdgcn_rcpf(fmaxf(bf_lo(a.y), 1e-20f)); r0[3] = bf_hi(s.y) * __builtin_amdgcn_rcpf(fmaxf(bf_hi(a.y), 1e-20f)); \
                r1[0] = bf_lo(s.z) * __builtin_amdgcn_rcpf(fmaxf(bf_lo(a.z), 1e-20f)); r1[1] = bf_hi(s.z) * __builtin_amdgcn_rcpf(fmaxf(bf_hi(a.z), 1e-20f)); r1[2] = bf_lo(s.w) * __builtin_amdgcn_rcpf(fmaxf(bf_lo(a.w), 1e-20f)); r1[3] = bf_hi(s.w) * __builtin_amdgcn_rcpf(fmaxf(bf_hi(a.w), 1e-20f)); \
                acc[ai][bj][m][0] *= r0; acc[ai][bj][m][1] *= r1; } \
            asm volatile("" : "+v"(acc[ai][0][m][0]), "+v"(acc[ai][0][m][1]), "+v"(acc[ai][1][m][0]), "+v"(acc[ai][1][m][1]) :: "memory"); } } while (0)
        HK_LOAD(gsA, gaA, 0); HK_LOAD(gsB, gaB, 1); __builtin_amdgcn_sched_barrier(0);
        HK_APPLY(gsA, gaA, 0); HK_LOAD(gsA, gaA, 2); __builtin_amdgcn_sched_barrier(0);
        HK_APPLY(gsB, gaB, 1); HK_LOAD(gsB, gaB, 3); __builtin_amdgcn_sched_barrier(0);
        HK_APPLY(gsA, gaA, 2); __builtin_amdgcn_sched_barrier(0);
        HK_APPLY(gsB, gaB, 3);
#undef HK_LOAD
#undef HK_APPLY
    }
    __device__ __forceinline__ void operator()(const f32x4 (&acc)[2][2][4][2], const Unit& u, int wr, int wc, int fr, int fq) const {
        const int row0 = u.pm * BM + wr * 64 + fr, col0 = u.pn * BM + wc * 32 + 8 * fq;
        u32x4 gav[2][4][2];
#pragma unroll
        for (int ai = 0; ai < 2; ++ai)
#pragma unroll
            for (int m = 0; m < 4; ++m)
#pragma unroll
                for (int bj = 0; bj < 2; ++bj) gav[ai][m][bj] = *(const u32x4*)(U + e_uidx(row0 + ai * HALF + m * 16, E_UGA + col0 + bj * HALF));
#pragma unroll
        for (int ai = 0; ai < 2; ++ai)
#pragma unroll
            for (int m = 0; m < 4; ++m) { const size_t r = (size_t)(row0 + ai * HALF + m * 16);
#pragma unroll
                for (int bj = 0; bj < 2; ++bj) { const u32x4 ga = gav[ai][m][bj];
                    const f32x4 v0 = acc[ai][bj][m][0], v1 = acc[ai][bj][m][1];
                    u32x4 w; w.x = cvt_pk_bf16(v0[0] * bf_lo(ga.x), v0[1] * bf_hi(ga.x)); w.y = cvt_pk_bf16(v0[2] * bf_lo(ga.y), v0[3] * bf_hi(ga.y));
                    w.z = cvt_pk_bf16(v1[0] * bf_lo(ga.z), v1[1] * bf_hi(ga.z)); w.w = cvt_pk_bf16(v1[2] * bf_lo(ga.w), v1[3] * bf_hi(ga.w));
                    *(u32x4*)(O + r * 2048 + col0 + bj * HALF) = w; } }
    }
};
struct EpiResid {
    static constexpr bool PERM = true, AFTER_DRAIN = false, HOOK = false, RSLDS = false; static constexpr int HOOK_T = -1;
    const float* Xf; bf16_t* XB; float* RS;
    __device__ __forceinline__ void hook(f32x4 (&)[2][2][4][2], const Unit&, int, int, int, int) const {}
    __device__ __forceinline__ void tail_(f32x4 x0, f32x4 x1, float& ss, bf16_t* dst) const {
        ss += ((x0[0] * x0[0] + x0[1] * x0[1]) + (x0[2] * x0[2] + x0[3] * x0[3])) + ((x1[0] * x1[0] + x1[1] * x1[1]) + (x1[2] * x1[2] + x1[3] * x1[3]));
        u32x4 o; o.x = cvt_pk_bf16(x0[0], x0[1]); o.y = cvt_pk_bf16(x0[2], x0[3]); o.z = cvt_pk_bf16(x1[0], x1[1]); o.w = cvt_pk_bf16(x1[2], x1[3]);
        *(u32x4*)dst = o;
    }
    __device__ __forceinline__ void operator()(const f32x4 (&acc)[2][2][4][2], const Unit& u, int wr, int wc, int fr, int fq) const {
        const int row0 = u.pm * BM + wr * 64 + fr, col0 = u.pn * BM + wc * 32 + 8 * fq;
        if (Xf) {
#pragma unroll
            for (int ai = 0; ai < 2; ++ai) { f32x4 xo[4][2][2];
#pragma unroll
                for (int m = 0; m < 4; ++m)
#pragma unroll
                    for (int bj = 0; bj < 2; ++bj) { const float* p = Xf + (size_t)(row0 + ai * HALF + m * 16) * 2048 + col0 + bj * HALF; xo[m][bj][0] = *(const f32x4*)p; xo[m][bj][1] = *(const f32x4*)(p + 4); }
#pragma unroll
                for (int m = 0; m < 4; ++m) { const size_t ro = (size_t)(row0 + ai * HALF + m * 16) * 2048 + col0; float ss = 0.f;
#pragma unroll
                    for (int bj = 0; bj < 2; ++bj) tail_(xo[m][bj][0] + acc[ai][bj][m][0], xo[m][bj][1] + acc[ai][bj][m][1], ss, XB + ro + bj * HALF);
                    ss += __shfl_xor(ss, 16); ss += __shfl_xor(ss, 32);
                    if (fq == 0) unsafeAtomicAdd(RS + row0 + ai * HALF + m * 16, ss); } }
        } else {
            u32x4 xw[2][4][2];
#pragma unroll
            for (int ai = 0; ai < 2; ++ai)
#pragma unroll
                for (int m = 0; m < 4; ++m)
#pragma unroll
                    for (int bj = 0; bj < 2; ++bj) xw[ai][m][bj] = *(const u32x4*)(XB + (size_t)(row0 + ai * HALF + m * 16) * 2048 + col0 + bj * HALF);
#pragma unroll
            for (int ai = 0; ai < 2; ++ai)
#pragma unroll
                for (int m = 0; m < 4; ++m) { const size_t ro = (size_t)(row0 + ai * HALF + m * 16) * 2048 + col0; float ss = 0.f;
#pragma unroll
                    for (int bj = 0; bj < 2; ++bj) { const u32x4 w = xw[ai][m][bj];
                        tail_((f32x4){bf_lo(w.x), bf_hi(w.x), bf_lo(w.y), bf_hi(w.y)} + acc[ai][bj][m][0], (f32x4){bf_lo(w.z), bf_hi(w.z), bf_lo(w.w), bf_hi(w.w)} + acc[ai][bj][m][1], ss, XB + ro + bj * HALF); }
                    ss += __shfl_xor(ss, 16); ss += __shfl_xor(ss, 32);
                    if (fq == 0) unsafeAtomicAdd(RS + row0 + ai * HALF + m * 16, ss); }
        }
    }
};
struct EpiSwiGLU {
    static constexpr bool PERM = true, AFTER_DRAIN = false, HOOK = false, RSLDS = true; static constexpr int HOOK_T = -1;
    bf16_t* H; const float* RS;
    __device__ __forceinline__ void hook(f32x4 (&)[2][2][4][2], const Unit&, int, int, int, int) const {}
    __device__ __forceinline__ void operator()(const f32x4 (&acc)[2][2][4][2], const Unit& u, int wr, int wc, int fr, int fq, const float (&rsv)[8]) const {
        const int row0 = u.pm * BM + wr * 64 + fr, col0 = u.pn * 128 + wc * 16 + 4 * fq;
#pragma unroll
        for (int ai = 0; ai < 2; ++ai) { if (u.pm * BM + ai * HALF >= E_MV) continue;
#pragma unroll
            for (int m = 0; m < 4; ++m) { bf16_t* rowp = H + (size_t)(row0 + ai * HALF + m * 16) * 5632 + col0; const float rs = rsqrtf(rsv[ai * 4 + m] * (1.0f / 2048.0f) + 1e-6f);
#pragma unroll
                for (int bj = 0; bj < 2; ++bj) { const f32x4 g = acc[ai][bj][m][0] * rs, up = acc[ai][bj][m][1] * rs; float h[4];
#pragma unroll
                    for (int e = 0; e < 4; ++e) h[e] = g[e] * __builtin_amdgcn_rcpf(1.0f + __expf(-g[e])) * up[e];
                    typedef unsigned u32x2v __attribute__((ext_vector_type(2))); u32x2v w; w.x = cvt_pk_bf16(h[0], h[1]); w.y = cvt_pk_bf16(h[2], h[3]);
                    *(u32x2v*)(rowp + bj * 64) = w; } } }
    }
};
template <class Epi, class Sched, bool ALIGN_EPI = false, bool SP2 = false>
__device__ __forceinline__ void gemm_phase(PG8_LAS unsigned char* lds, const Gemm g, const Sched& S, const Epi& E, int tid_in) {
    int tid_l = tid_in; asm volatile("" : "+v"(tid_l));
    const int tid = tid_l, wid = __builtin_amdgcn_readfirstlane(tid >> 6), lane = tid & 63, wr = wid >> 2, wc = wid & 3, fr = lane & 15, fq = lane >> 4;
    const int K = g.K, nt = K / BK;
    unsigned voffA[2], voffB[2];
#pragma unroll
    for (int i = 0; i < 2; ++i) { int R, C; stage_rc(tid * 16 + i * 8192, R, C); const int Rb = Epi::PERM ? ((R & ~31) + perm32(R & 31)) : R;
        voffA[i] = (unsigned)(R * K + C) * 2u; voffB[i] = (unsigned)(Rb * K + C) * 2u; }
    const size_t kstep = (size_t)(BK * 2);
    const size_t hstep = (size_t)HALF * K * 2;
    const size_t tstep = 2 * hstep;
    const unsigned ldsw = (unsigned)wid * 1024u;
    const int aoff = lds_byte(wr * 64 + fr, fq * 8), boff = lds_byte(wc * 32 + fr, fq * 8);
#define PG8_SA(b, h) (((b) * 2 + (h)) * HTB)
#define PG8_SB(b, h) ((4 + (b) * 2 + (h)) * HTB)
#define PG8_STAGE(bufoff, gbase, voff) do { _Pragma("unroll") for (int _i = 0; _i < 2; ++_i) \
        __builtin_amdgcn_global_load_lds((const unsigned*)((const char*)(gbase) + (voff)[_i]), (PG8_LAS unsigned*)(lds + (bufoff) + ldsw + _i * 8192), 16, 0, 0); } while (0)
#define PG8_LDA(dst, b, h) do { _Pragma("unroll") for (int m = 0; m < 4; ++m) _Pragma("unroll") for (int k = 0; k < 2; ++k) dst[m][k] = *(const PG8_LAS bf16x8*)(lds + PG8_SA(b, h) + aoff + m * 2048 + k * 1024); } while (0)
#define PG8_LDB(dst, b, h) do { _Pragma("unroll") for (int n = 0; n < 2; ++n) _Pragma("unroll") for (int k = 0; k < 2; ++k) dst[n][k] = *(const PG8_LAS bf16x8*)(lds + PG8_SB(b, h) + boff + n * 2048 + k * 1024); } while (0)
#define PG8_MMA(ai, bj, At, Bt) do { __builtin_amdgcn_s_setprio(1); _Pragma("unroll") for (int m = 0; m < 4; ++m) _Pragma("unroll") for (int n = 0; n < 2; ++n) _Pragma("unroll") for (int k = 0; k < 2; ++k) \
        acc[ai][bj][m][n] = __builtin_amdgcn_mfma_f32_16x16x32_bf16(Bt[n][k], At[m][k], acc[ai][bj][m][n], 0, 0, 0); __builtin_amdgcn_s_setprio(0); } while (0)
#define PG8_WAIT_V(n) asm volatile("s_waitcnt vmcnt(" #n ")" ::: "memory")
#define PG8_WAIT_L(n) asm volatile("s_waitcnt lgkmcnt(" #n ")" ::: "memory")
#define PG8_BAR __builtin_amdgcn_s_barrier()
#define PG8_SCHED __builtin_amdgcn_sched_barrier(0)
    Unit cur, nxt; int ui = 0;
    if (!S.next(0, cur)) return;
    f32x4 acc[2][2][4][2];
#pragma unroll
    for (int a = 0; a < 2; ++a)
#pragma unroll
        for (int b = 0; b < 2; ++b)
#pragma unroll
            for (int m = 0; m < 4; ++m)
#pragma unroll
                for (int n = 0; n < 2; ++n) acc[a][b][m][n] = (f32x4){0.f, 0.f, 0.f, 0.f};
    bf16x8 At[4][2], B0[2][2], B1[2][2];
    const char* cA = (const char*)g.A + (size_t)cur.pm * tstep; const char* cB = (const char*)g.Bt + (size_t)cur.pn * tstep;
    S.a_ready(cur);
#define PG8_RSDMA(pm_, par_) __builtin_amdgcn_global_load_lds((const unsigned*)(E.RS + (pm_) * BM + wid * 64 + ((fq << 4) | fr)), (PG8_LAS unsigned*)(lds + 131072 + (par_) * 1024 + wid * 256), 4, 0, 0)
    if constexpr (Epi::RSLDS) { if (wid < 4) PG8_RSDMA(cur.pm, 0); }
    if constexpr (SP2) {
        PG8_STAGE(PG8_SB(0, 0), cB, voffB); PG8_STAGE(PG8_SB(0, 1), cB + hstep, voffB); PG8_STAGE(PG8_SA(0, 0), cA, voffA); PG8_STAGE(PG8_SA(0, 1), cA + hstep, voffA);
        if (wr == 1) PG8_BAR;
        PG8_WAIT_V(2); PG8_BAR;
        PG8_STAGE(PG8_SB(1, 0), cB + kstep, voffB); PG8_STAGE(PG8_SA(1, 0), cA + kstep, voffA); PG8_STAGE(PG8_SB(1, 1), cB + hstep + kstep, voffB);
        PG8_WAIT_V(6); PG8_BAR;
    } else {
        PG8_STAGE(PG8_SB(0, 0), cB, voffB); PG8_STAGE(PG8_SA(0, 0), cA, voffA); PG8_STAGE(PG8_SB(0, 1), cB + hstep, voffB); PG8_STAGE(PG8_SA(0, 1), cA + hstep, voffA);
        if (wr == 1) PG8_BAR;
        PG8_WAIT_V(4); PG8_BAR;
        PG8_STAGE(PG8_SB(1, 0), cB + kstep, voffB); PG8_STAGE(PG8_SA(1, 0), cA + kstep, voffA); PG8_STAGE(PG8_SB(1, 1), cB + hstep + kstep, voffB);
        PG8_WAIT_V(6); PG8_BAR;
    }
    for (;;) {
        const bool has_next = S.next(ui + 1, nxt);
        const char* nA = has_next ? (const char*)g.A + (size_t)nxt.pm * tstep : cA; const char* nB = has_next ? (const char*)g.Bt + (size_t)nxt.pn * tstep : cB;
        for (int t = 0; t < nt; t += 2) {
            const bool last = (t == nt - 2);
            const char* a1 = cA + (size_t)(t + 1) * kstep;
            const char* a2 = last ? nA : cA + (size_t)(t + 2) * kstep; const char* b2 = last ? nB : cB + (size_t)(t + 2) * kstep;
            const char* a3 = a2 + kstep; const char* b3 = b2 + kstep;
            if (last && has_next) S.a_ready(nxt);
            if constexpr (Epi::HOOK) { if (t == Epi::HOOK_T) E.hook(acc, cur, wr, wc, fr, fq); }
            if constexpr (SP2) {
            PG8_LDB(B0, 0, 0); PG8_LDB(B1, 0, 1); PG8_SCHED; PG8_LDA(At, 0, 0); PG8_STAGE(PG8_SA(1, 1), a1 + hstep, voffA);
            PG8_WAIT_V(8); PG8_WAIT_L(0); PG8_BAR; PG8_MMA(0, 0, At, B0); PG8_MMA(0, 1, At, B1); PG8_BAR; PG8_SCHED;
            PG8_LDA(At, 0, 1); PG8_STAGE(PG8_SB(0, 0), b2, voffB); PG8_STAGE(PG8_SB(0, 1), b2 + hstep, voffB); PG8_STAGE(PG8_SA(0, 0), a2, voffA);
            PG8_WAIT_V(8); PG8_WAIT_L(0); PG8_BAR; PG8_MMA(1, 0, At, B0); PG8_MMA(1, 1, At, B1); PG8_BAR; PG8_SCHED;
            PG8_LDB(B0, 1, 0); PG8_LDB(B1, 1, 1); PG8_SCHED; PG8_LDA(At, 1, 0); PG8_STAGE(PG8_SA(0, 1), a2 + hstep, voffA);
            PG8_WAIT_V(8); PG8_WAIT_L(0); PG8_BAR; PG8_MMA(0, 0, At, B0); PG8_MMA(0, 1, At, B1); PG8_BAR; PG8_SCHED;
            PG8_LDA(At, 1, 1); PG8_STAGE(PG8_SB(1, 0), b3, voffB); PG8_STAGE(PG8_SB(1, 1), b3 + hstep, voffB); PG8_STAGE(PG8_SA(1, 0), a3, voffA);
            PG8_WAIT_V(8); PG8_WAIT_L(0); PG8_BAR; PG8_MMA(1, 0, At, B0); PG8_MMA(1, 1, At, B1); PG8_BAR; PG8_SCHED;
            } else {
            PG8_LDB(B0, 0, 0); PG8_SCHED; PG8_LDA(At, 0, 0); PG8_STAGE(PG8_SA(1, 1), a1 + hstep, voffA);
            PG8_WAIT_L(8); PG8_BAR; PG8_WAIT_L(0); PG8_MMA(0, 0, At, B0); PG8_BAR; PG8_SCHED;
            PG8_LDB(B1, 0, 1); PG8_STAGE(PG8_SB(0, 0), b2, voffB);
            PG8_BAR; PG8_WAIT_L(0); PG8_MMA(0, 1, At, B1); PG8_BAR;
            PG8_LDA(At, 0, 1); PG8_STAGE(PG8_SA(0, 0), a2, voffA);
            PG8_BAR; PG8_WAIT_L(0); PG8_MMA(1, 0, At, B0); PG8_BAR; PG8_SCHED;
            PG8_STAGE(PG8_SB(0, 1), b2 + hstep, voffB);
            PG8_WAIT_V(6); PG8_BAR; PG8_MMA(1, 1, At, B1); PG8_BAR;
            PG8_LDB(B0, 1, 0); PG8_SCHED; PG8_LDA(At, 1, 0); PG8_STAGE(PG8_SA(0, 1), a2 + hstep, voffA);
            PG8_WAIT_L(8); PG8_BAR; PG8_WAIT_L(0); PG8_MMA(0, 0, At, B0); PG8_BAR; PG8_SCHED;
            PG8_LDB(B1, 1, 1); PG8_STAGE(PG8_SB(1, 0), b3, voffB);
            PG8_BAR; PG8_WAIT_L(0); PG8_MMA(0, 1, At, B1); PG8_BAR;
            PG8_LDA(At, 1, 1); PG8_STAGE(PG8_SA(1, 0), a3, voffA);
            PG8_BAR; PG8_WAIT_L(0); PG8_MMA(1, 0, At, B0); PG8_BAR; PG8_SCHED;
            PG8_STAGE(PG8_SB(1, 1), b3 + hstep, voffB);
            PG8_WAIT_V(6); PG8_BAR; PG8_MMA(1, 1, At, B1); PG8_BAR;
            }
        }
        if constexpr (ALIGN_EPI) { if (wr == 0) PG8_BAR; }
        if constexpr (!Epi::AFTER_DRAIN) {
            if constexpr (Epi::RSLDS) { float rsv[8]; const PG8_LAS float* rsl = (const PG8_LAS float*)(lds + 131072 + (ui & 1) * 1024) + wr * 64 + fr;
#pragma unroll
                for (int q = 0; q < 8; ++q) rsv[q] = rsl[(q >> 2) * HALF + (q & 3) * 16];
                asm volatile("s_waitcnt lgkmcnt(0)" : "+v"(rsv[0]), "+v"(rsv[1]), "+v"(rsv[2]), "+v"(rsv[3]), "+v"(rsv[4]), "+v"(rsv[5]), "+v"(rsv[6]), "+v"(rsv[7]) :: "memory");
                if (has_next && wid < 4) PG8_RSDMA(nxt.pm, (ui + 1) & 1);
                E(acc, cur, wr, wc, fr, fq, rsv);
            } else E(acc, cur, wr, wc, fr, fq);
            S.done(cur); }
        if (!has_next) break;
#pragma unroll
        for (int a = 0; a < 2; ++a)
#pragma unroll
            for (int b = 0; b < 2; ++b)
#pragma unroll
                for (int m = 0; m < 4; ++m)
#pragma unroll
                    for (int n = 0; n < 2; ++n) acc[a][b][m][n] = (f32x4){0.f, 0.f, 0.f, 0.f};
        cur = nxt; cA = nA; cB = nB; ++ui;
        if constexpr (ALIGN_EPI) { if (wr == 1) PG8_BAR; }
    }
    PG8_WAIT_V(0);
    if constexpr (!ALIGN_EPI) { if (wr == 0) PG8_BAR; }
    PG8_BAR;
    if constexpr (Epi::AFTER_DRAIN) { E.fused(acc, cur, wr, wc, fr, fq, lds, wid, lane); S.done(cur); }
#undef PG8_RSDMA
#undef PG8_SA
#undef PG8_SB
#undef PG8_STAGE
#undef PG8_LDA
#undef PG8_LDB
#undef PG8_MMA
#undef PG8_WAIT_V
#undef PG8_WAIT_L
#undef PG8_BAR
#undef PG8_SCHED
}
}
#define GAS __attribute__((address_space(1)))
#define LAS __attribute__((address_space(3)))
typedef unsigned short bf16;
typedef unsigned v4u __attribute__((ext_vector_type(4)));
typedef float f32x4 __attribute__((ext_vector_type(4)));
typedef short bf16x8 __attribute__((ext_vector_type(8)));
typedef GAS unsigned gu32;
typedef GAS unsigned long long gu64;
#define RLX_AGENT __ATOMIC_RELAXED, __HIP_MEMORY_SCOPE_AGENT
#define LDS_WAIT() asm volatile("s_waitcnt lgkmcnt(0)" ::: "memory")
#define VM_WAIT() asm volatile("s_waitcnt vmcnt(0)" ::: "memory")
__device__ __forceinline__ unsigned long long rt() { return __builtin_amdgcn_s_memrealtime(); }
__device__ __forceinline__ unsigned f2bf(float f) { unsigned u = __builtin_bit_cast(unsigned, f); return (u + 0x7fffu + ((u >> 16) & 1u)) >> 16; }
__device__ __forceinline__ unsigned pk2(float lo, float hi) { return f2bf(lo) | (f2bf(hi) << 16); }

#define XB_TMO      128
#define XB_XCNT(j)  (256  + 64 * (j))
#define XB_XSUB(j)  (1280 + 64 * (j))
#define XB_XGEN(j)  (2304 + 64 * (j))
#define XB_TOP      3328
#define XB_TOPGEN   3392
#define XCD_BAR_WORDS 3456
#define XB_SPIN_CAP (1u << 18)

__device__ __forceinline__ unsigned xb_ld(unsigned* p)              { return __hip_atomic_load(p, __ATOMIC_RELAXED, __HIP_MEMORY_SCOPE_AGENT); }
__device__ __forceinline__ unsigned xb_add(unsigned* p, unsigned v) { return __hip_atomic_fetch_add(p, v, __ATOMIC_RELAXED, __HIP_MEMORY_SCOPE_AGENT); }
__device__ __forceinline__ unsigned xb_xcc_id() { return (unsigned)__builtin_amdgcn_s_getreg((3 << 11) | 20) & 0xFu; }
#define XB_SPIN(cond, bar) do { unsigned _sp = 0; while (cond) { __builtin_amdgcn_s_sleep(1); \
    if ((++_sp & 255u) == 0u) { if (xb_ld(&(bar)[XB_TMO])) break; if (_sp > XB_SPIN_CAP) { atomicAdd(&(bar)[XB_TMO], 1u); break; } } } } while (0)

struct XcdBarrier {
    unsigned* bar; unsigned x;
    volatile LAS unsigned* st;
};

__device__ __forceinline__ XcdBarrier xcd_barrier_post(unsigned* bar, volatile LAS unsigned* st) {
    XcdBarrier b; b.bar = bar; b.x = xb_xcc_id(); b.st = st;
    if (threadIdx.x == 0) (void)xb_add(&bar[XB_XCNT(b.x)], 1u);
    return b;
}
__device__ __forceinline__ void xcd_barrier_complete(unsigned* bar, unsigned x, unsigned& nloc, unsigned& nx) {
    const unsigned G = gridDim.x * gridDim.y * gridDim.z;
    unsigned sum, cnt, mine, sp = 0u;
    for (;;) {
        sum = 0u; cnt = 0u; mine = 0u;
#pragma unroll
        for (unsigned j = 0; j < 16; ++j) { const unsigned c = xb_ld(&bar[XB_XCNT(j)]); sum += c; cnt += (c > 0u) ? 1u : 0u; mine = (j == x) ? c : mine; }
        if (sum == G) break;
        __builtin_amdgcn_s_sleep(1);
        if ((++sp & 255u) == 0u) { if (xb_ld(&bar[XB_TMO])) break; if (sp > XB_SPIN_CAP) { atomicAdd(&bar[XB_TMO], 1u); break; } }
    }
    nloc = mine > 0u ? mine : 1u; nx = cnt > 0u ? cnt : 1u;
}

__device__ __forceinline__ void xcd_barrier(const XcdBarrier& b) {
    asm volatile("s_waitcnt vmcnt(0)" ::: "memory");
    __syncthreads();
    if (threadIdx.x == 0) {
        unsigned* bar = b.bar;
        __builtin_amdgcn_s_waitcnt(0);
        unsigned nloc = b.st[0], nx = b.st[1];
        if (nloc == 0u) { xcd_barrier_complete(bar, b.x, nloc, nx); b.st[0] = nloc; b.st[1] = nx; }
        const unsigned old = xb_add(&bar[XB_XSUB(b.x)], 1u);
        const unsigned gen = old / nloc;
        if (old + 1u == (gen + 1u) * nloc) {
            __builtin_amdgcn_fence(__ATOMIC_RELEASE, "agent");
            asm volatile("s_waitcnt vmcnt(0)" ::: "memory");
            const unsigned og = xb_add(&bar[XB_TOP], 1u);
            const unsigned tg = og / nx;
            if (og + 1u == (tg + 1u) * nx) xb_add(&bar[XB_TOPGEN], 1u);
            else XB_SPIN(xb_ld(&bar[XB_TOPGEN]) == tg, bar);
            __builtin_amdgcn_fence(__ATOMIC_ACQUIRE, "agent");
            xb_add(&bar[XB_XGEN(b.x)], 1u);
            asm volatile("s_waitcnt vmcnt(0)" ::: "memory");
        } else {
            XB_SPIN(xb_ld(&bar[XB_XGEN(b.x)]) == gen, bar);
            __builtin_amdgcn_fence(__ATOMIC_ACQUIRE, "agent");
            asm volatile("s_waitcnt vmcnt(0)" ::: "memory");
        }
    }
    __syncthreads();
}
typedef float f32x16 __attribute__((ext_vector_type(16)));
typedef unsigned u32x2 __attribute__((ext_vector_type(2)));
__device__ __forceinline__ float bf2f(bf16 v) { return __uint_as_float(((unsigned)v) << 16); }
__device__ __forceinline__ float bflo(unsigned w) { return __uint_as_float(w << 16); }
__device__ __forceinline__ float bfhi(unsigned w) { return __uint_as_float(w & 0xffff0000u); }
__device__ __forceinline__ float wave_sum(float v) {
#pragma unroll
    for (int o = 1; o < 64; o <<= 1) v += __shfl_xor(v, o);
    return v;
}
__device__ __forceinline__ float wave_max(float v) {
#pragma unroll
    for (int o = 1; o < 64; o <<= 1) v = fmaxf(v, __shfl_xor(v, o));
    return v;
}
__device__ __forceinline__ float siluf_(float x) { return x * __builtin_amdgcn_rcpf(1.0f + __expf(-x)); }
__device__ __forceinline__ float softplusf_(float x) { return x > 20.0f ? x : log1pf(__expf(x)); }

struct Args { const float* in[23]; float* out; unsigned char* ws; int ph_lo, ph_hi, use_bar, pad; };
typedef const __attribute__((address_space(4))) Args* KArgs;
struct Ctx { LAS unsigned char* lds; int tid, lane, wave, G, bid; KArgs a; };

__device__ __forceinline__ int lane_now() { int t; asm volatile("v_mbcnt_lo_u32_b32 %0, -1, 0\n\tv_mbcnt_hi_u32_b32 %0, -1, %0" : "=v"(t)); return t; }
struct TItem { const float* sp; const float* gn; bf16* WT; int ldn, rowl, K, k0, R0; };
__device__ __forceinline__ void titem_load(const TItem& t, f32x4 (&v)[16], f32x4 (&gv)[4], int) {
    const int kk = lane_now() >> 4;
    if (t.sp) {
#pragma unroll
        for (int i = 0; i < 16; ++i) v[i] = __builtin_nontemporal_load((const GAS f32x4*)(t.sp + (size_t)(t.k0 + 16 * kk + i) * t.ldn));
        if (t.gn) { const GAS f32x4* gp = (const GAS f32x4*)(t.gn + t.k0 + 16 * kk);
#pragma unroll
            for (int q = 0; q < 4; ++q) gv[q] = gp[q]; }
    } else {
#pragma unroll
        for (int i = 0; i < 16; ++i) { float z0 = 0.f; asm volatile("" : "+v"(z0)); v[i] = (f32x4){z0, z0, z0, z0}; }
    }
}
__device__ __forceinline__ void titem_store(const TItem& t, const f32x4 (&vin)[16], const f32x4 (&gv)[4], LAS unsigned short* T, int) {
    const int lane = lane_now(), kk = lane >> 4;
    LAS unsigned char* Tb = (LAS unsigned char*)T;
#pragma unroll
    for (int j = 0; j < 4; ++j) { const int n = t.rowl + j, sw = (n >> 2) & 7; v4u lo, hi;
#define TI_PK(a_) pg8::cvt_pk_bf16(vin[a_][j] * gv[(a_) >> 2].x, vin[(a_) + 1][j] * gv[(a_) >> 2].y)
#define TI_PK2(a_) pg8::cvt_pk_bf16(vin[a_][j] * gv[(a_) >> 2].z, vin[(a_) + 1][j] * gv[(a_) >> 2].w)
#define TI_PN(a_) pg8::cvt_pk_bf16(vin[a_][j], vin[(a_) + 1][j])
        if (t.gn && t.sp) { lo.x = TI_PK(0); lo.y = TI_PK2(2); lo.z = TI_PK(4); lo.w = TI_PK2(6); hi.x = TI_PK(8); hi.y = TI_PK2(10); hi.z = TI_PK(12); hi.w = TI_PK2(14); }
        else { lo.x = TI_PN(0); lo.y = TI_PN(2); lo.z = TI_PN(4); lo.w = TI_PN(6); hi.x = TI_PN(8); hi.y = TI_PN(10); hi.z = TI_PN(12); hi.w = TI_PN(14); }
#undef TI_PK
#undef TI_PK2
#undef TI_PN
        *(LAS v4u*)(Tb + n * 128 + (((2 * kk) ^ sw) << 4)) = lo; *(LAS v4u*)(Tb + n * 128 + (((2 * kk + 1) ^ sw) << 4)) = hi; }
    LDS_WAIT(); asm volatile("" ::: "memory");
    const int ch = lane & 7, nr = lane >> 3;
#pragma unroll
    for (int it = 0; it < 8; ++it) { const int n = nr + 8 * it;
        const v4u o = *(const LAS v4u*)(Tb + n * 128 + ((ch ^ ((n >> 2) & 7)) << 4));
        *(GAS v4u*)(t.WT + (size_t)(t.R0 + n) * t.K + t.k0 + 8 * ch) = o; }
    LDS_WAIT(); asm volatile("" ::: "memory");
}
constexpr int IT_IN = (DM / 64) * (NU / 64), IT_CAT = (KCAT / 64) * (DM / 64), IT_OUT = (DM / 64) * (DM / 64), IT_GU = (DM / 64) * (NGU / 64), IT_DN = (FF / 64) * (DM / 64);
constexpr int IT_LAYER = IT_IN + IT_CAT + IT_OUT + IT_GU + IT_DN;
__device__ __forceinline__ TItem titem_decode(const Ctx& C, int it) {
    const int c4 = lane_now() & 15, l = it / IT_LAYER; int q = it % IT_LAYER; TItem t;
    if (q < IT_IN) { const int nblk = NU / 64, kb = q / nblk, nb = q % nblk, R = 64 * nb + 4 * c4;
        const int col = R < 10240 ? R : (R < 17408 ? R + 64 : (R < 17472 ? 10240 + (R - 17408) : -1));
        t.sp = col >= 0 ? (C.a->in[7]) + (size_t)l * DM * IN_DIM + col : nullptr; t.gn = (C.a->in[6]) + (size_t)l * DM; t.ldn = IN_DIM; t.rowl = 4 * c4; t.K = DM; t.WT = ((bf16*)(C.a->ws + WS_WIN)) + (size_t)l * NU * DM; t.k0 = 64 * kb; t.R0 = 64 * nb; return t; }
    q -= IT_IN;
    if (q < IT_CAT) { const int nblk = DM / 64, kb = q / nblk, nb = q % nblk, R = 64 * nb + 4 * c4, k0 = 64 * kb;
        t.sp = k0 < DI ? (C.a->in[14]) + (size_t)l * DI * DM + R : (C.a->in[15]) + (size_t)l * DM * DM + R - (size_t)DI * DM;
        t.gn = nullptr; t.ldn = DM; t.rowl = 4 * c4; t.K = KCAT; t.WT = ((bf16*)(C.a->ws + WS_WCAT)) + (size_t)l * DM * KCAT; t.k0 = k0; t.R0 = 64 * nb; return t; }
    q -= IT_CAT;
    if (q < IT_OUT) { const int nblk = DM / 64, kb = q / nblk, nb = q % nblk, R = 64 * nb + 4 * c4;
        t.sp = (C.a->in[17]) + (size_t)l * DM * DM + R; t.gn = nullptr; t.ldn = DM; t.rowl = 4 * c4; t.K = DM; t.WT = ((bf16*)(C.a->ws + WS_WOUT)) + (size_t)l * DM * DM; t.k0 = 64 * kb; t.R0 = 64 * nb; return t; }
    q -= IT_OUT;
    if (q < IT_GU) { const int nblk = NGU / 64, kb = q / nblk, nb = q % nblk;
        const int up = c4 >> 3, cg = c4 & 7;
        t.sp = (up ? (C.a->in[20]) : (C.a->in[19])) + (size_t)l * DM * FF + 32 * nb + 4 * cg; t.gn = (C.a->in[18]) + (size_t)l * DM; t.ldn = FF; t.rowl = 8 * cg + 4 * up; t.K = DM; t.WT = ((bf16*)(C.a->ws + WS_WGU)) + (size_t)l * NGU * DM; t.k0 = 64 * kb; t.R0 = 64 * nb; return t; }
    q -= IT_GU;
    { const int nblk = DM / 64, kb = q / nblk, nb = q % nblk, R = 64 * nb + 4 * c4;
        t.sp = (C.a->in[21]) + (size_t)l * FF * DM + R; t.gn = nullptr; t.ldn = DM; t.rowl = 4 * c4; t.K = FF; t.WT = ((bf16*)(C.a->ws + WS_WDN)) + (size_t)l * DM * FF; t.k0 = 64 * kb; t.R0 = 64 * nb; return t; }
}
__device__ __forceinline__ void p0_weights(const Ctx& C, int it_lo, int it_hi, int gw, int NGW) {
    LAS unsigned short* T = (LAS unsigned short*)(C.lds + RING_OFF + C.wave * 16384);
    int it = it_lo + gw; if (it >= it_hi) return;
    TItem cur = titem_decode(C, it); f32x4 va[16], vb[16], ga[4], gb[4];
    titem_load(cur, va, ga, C.lane);
    for (;;) {
        int nit = it + NGW; TItem nxt = cur; const bool hn = nit < it_hi;
        if (hn) { nxt = titem_decode(C, nit); titem_load(nxt, vb, gb, C.lane); }
        titem_store(cur, va, ga, T, C.lane);
        if (!hn) break;
        it = nit + NGW; cur = nxt; const bool hn2 = it < it_hi;
        if (hn2) { cur = titem_decode(C, it); titem_load(cur, va, ga, C.lane); }
        titem_store(nxt, vb, gb, T, C.lane);
        if (!hn2) break;
    }
}
__device__ __forceinline__ void norm_row(const float* src, const float* gain, float* xcopy, bf16* xb, float* rs, float* fdst, int lane) {
    const GAS f32x4* xr = (const GAS f32x4*)src + lane;
    f32x4 v[8]; float s = 0.f;
#pragma unroll
    for (int j = 0; j < 8; ++j) { v[j] = xr[64 * j]; s += (v[j].x * v[j].x + v[j].y * v[j].y) + (v[j].z * v[j].z + v[j].w * v[j].w); }
    s = wave_sum(s);
    if (rs && lane == 0) *rs = s;
    if (xcopy) { GAS f32x4* xc = (GAS f32x4*)xcopy + lane;
#pragma unroll
        for (int j = 0; j < 8; ++j) xc[64 * j] = v[j]; }
    if (xb) {
#pragma unroll
        for (int j = 0; j < 8; ++j) { u32x2 w; w.x = pk2(v[j].x, v[j].y); w.y = pk2(v[j].z, v[j].w); *((GAS u32x2*)xb + lane + 64 * j) = w; } }
    if (fdst) { const float rstd = rsqrtf(s * (1.0f / DM) + EPS); const GAS f32x4* gr = (const GAS f32x4*)gain + lane;
#pragma unroll
        for (int j = 0; j < 8; ++j) { const f32x4 g = gr[64 * j]; f32x4 o = v[j] * rstd; o = o * g; *((GAS f32x4*)fdst + lane + 64 * j) = o; } }
}
__device__ __forceinline__ void p0_xinit(const Ctx& C) {
    const int NGW = C.G * NWAVES, gw = NGW - 1 - (C.bid * NWAVES + C.wave), lane = C.lane;
    int m = gw; if (m >= MV) return;
    f32x4 v[8], w[8];
#define XI_SRC(m_) ((const GAS f32x4*)((m_) < SEQ ? (C.a->in[0]) + (size_t)(m_) * DM : (C.a->in[1]) + (size_t)((m_) - SEQ) * DM) + lane)
    { const GAS f32x4* xr = XI_SRC(m);
#pragma unroll
      for (int j = 0; j < 8; ++j) v[j] = xr[64 * j]; }
    for (;;) {
        const int mn = m + NGW; const bool hn = mn < MV;
        if (hn) { const GAS f32x4* xr = XI_SRC(mn);
#pragma unroll
            for (int j = 0; j < 8; ++j) w[j] = xr[64 * j]; }
        __builtin_amdgcn_sched_barrier(0);
        float s = 0.f;
#pragma unroll
        for (int j = 0; j < 8; ++j) s += (v[j].x * v[j].x + v[j].y * v[j].y) + (v[j].z * v[j].z + v[j].w * v[j].w);
        s = wave_sum(s);
        if (lane == 0) ((float*)(C.a->ws + WS_RSA))[m] = s;
        if (m >= SEQ) { GAS f32x4* xc = (GAS f32x4*)(((float*)(C.a->ws + WS_X)) + (size_t)m * DM) + lane;
#pragma unroll
            for (int j = 0; j < 8; ++j) xc[64 * j] = v[j]; }
        { bf16* xb = ((bf16*)(C.a->ws + WS_XN)) + (size_t)m * DM;
#pragma unroll
          for (int j = 0; j < 8; ++j) { u32x2 o; o.x = pg8::cvt_pk_bf16(v[j].x, v[j].y); o.y = pg8::cvt_pk_bf16(v[j].z, v[j].w); *((GAS u32x2*)xb + lane + 64 * j) = o; } }
        if (!hn) break;
        m = mn;
#pragma unroll
        for (int j = 0; j < 8; ++j) v[j] = w[j];
    }
#undef XI_SRC
}
__device__ __forceinline__ void sample_rows_phase(const Ctx& C, float* RS) {
    const int gw = C.bid * NWAVES + C.wave, NGW = C.G * NWAVES;
    for (int m = SEQ + gw; m < MV; m += NGW) norm_row(((float*)(C.a->ws + WS_X)) + (size_t)m * DM, nullptr, nullptr, ((bf16*)(C.a->ws + WS_XN)) + (size_t)m * DM, RS + m, nullptr, C.lane);
}
__device__ __forceinline__ void final_norm_phase(const Ctx& C) {
    const int gw = C.bid * NWAVES + C.wave, NGW = C.G * NWAVES, lane = C.lane;
    f32x4 gv[8];
    { const GAS f32x4* gr = (const GAS f32x4*)(C.a->in[22]) + 2 * lane;
#pragma unroll
      for (int j = 0; j < 4; ++j) { gv[2 * j] = gr[128 * j]; gv[2 * j + 1] = gr[128 * j + 1]; } }
    for (int m = gw; m < MV; m += NGW) {
        if (m >= SEQ) { norm_row(((float*)(C.a->ws + WS_X)) + (size_t)m * DM, (C.a->in[22]), nullptr, nullptr, nullptr, (C.a->out) + O_YP + (size_t)m * DM, lane); continue; }
        const GAS v4u* xr = (const GAS v4u*)(((bf16*)(C.a->ws + WS_XN)) + (size_t)m * DM) + lane; v4u w[4]; float s = 0.f;
#pragma unroll
        for (int j = 0; j < 4; ++j) { w[j] = xr[64 * j]; const float a0 = bflo(w[j].x), a1 = bfhi(w[j].x), a2 = bflo(w[j].y), a3 = bfhi(w[j].y), a4 = bflo(w[j].z), a5 = bfhi(w[j].z), a6 = bflo(w[j].w), a7 = bfhi(w[j].w);
            s += ((a0 * a0 + a1 * a1) + (a2 * a2 + a3 * a3)) + ((a4 * a4 + a5 * a5) + (a6 * a6 + a7 * a7)); }
        const float rstd = rsqrtf(wave_sum(s) * (1.0f / DM) + EPS);
        GAS f32x4* op = (GAS f32x4*)((C.a->out) + O_YP + (size_t)m * DM) + 2 * lane;
#pragma unroll
        for (int j = 0; j < 4; ++j) { const f32x4 g0 = gv[2 * j], g1 = gv[2 * j + 1];
            op[128 * j] = (f32x4){bflo(w[j].x) * rstd * g0.x, bfhi(w[j].x) * rstd * g0.y, bflo(w[j].y) * rstd * g0.z, bfhi(w[j].y) * rstd * g0.w};
            op[128 * j + 1] = (f32x4){bflo(w[j].z) * rstd * g1.x, bfhi(w[j].z) * rstd * g1.y, bflo(w[j].w) * rstd * g1.z, bfhi(w[j].w) * rstd * g1.w}; }
    }
}
__device__ __forceinline__ void zero_f32(const Ctx& C, float* p, int n, int vb, int nvb) { float z0 = 0.f; asm volatile("" : "+v"(z0)); for (int i = vb * 512 + C.tid; i < n; i += nvb * 512) p[i] = z0; }

__device__ __forceinline__ void sample_ssd_wave_unit(const Ctx& C, int l, int b, int g, LAS float* wsc) {
    const int lane = lane_now();
    const int row = SEQ + b, n4 = lane & 31, prh = lane >> 5;
    LAS float* xs = wsc; LAS float* Bs = wsc + 512; LAS float* ys = wsc + 768;
    const float* cw = (C.a->in[8]) + (size_t)l * CW * CD; const float* cb = (C.a->in[9]) + (size_t)l * CD;
    const float* sc = (C.a->in[3]) + ((size_t)l * NB + b) * 3 * CD; const bf16* U = ((bf16*)(C.a->ws + WS_U));
    { const int ch = g * 512 + 8 * lane; const v4u un = *(const GAS v4u*)(U + UIDX(row, UXBC + ch)); const float nv[8] = {bflo(un.x), bfhi(un.x), bflo(un.y), bfhi(un.y), bflo(un.z), bfhi(un.z), bflo(un.w), bfhi(un.w)};
#pragma unroll
      for (int q = 0; q < 2; ++q) { const f32x4 bb = *(const GAS f32x4*)(cb + ch + 4 * q), w0 = *(const GAS f32x4*)(cw + ch + 4 * q), w1 = *(const GAS f32x4*)(cw + CD + ch + 4 * q), w2 = *(const GAS f32x4*)(cw + 2 * CD + ch + 4 * q), w3 = *(const GAS f32x4*)(cw + 3 * CD + ch + 4 * q);
          const f32x4 s0 = *(const GAS f32x4*)(sc + ch + 4 * q), s1 = *(const GAS f32x4*)(sc + CD + ch + 4 * q), s2 = *(const GAS f32x4*)(sc + 2 * CD + ch + 4 * q);
          f32x4 o;
#pragma unroll
          for (int e = 0; e < 4; ++e) o[e] = siluf_(bb[e] + w0[e] * s0[e] + w1[e] * s1[e] + w2[e] * s2[e] + w3[e] * nv[4 * q + e]);
          *(LAS f32x4*)(xs + 8 * lane + 4 * q) = o; } }
    { const int ch = (lane < 32 ? DI + g * 128 : DI + 1024 + g * 128 - 128) + 4 * lane;
      const u32x2 un = *(const GAS u32x2*)(U + UIDX(row, UXBC + ch)); const float nv[4] = {bflo(un.x), bfhi(un.x), bflo(un.y), bfhi(un.y)};
      const f32x4 bb = *(const GAS f32x4*)(cb + ch), w0 = *(const GAS f32x4*)(cw + ch), w1 = *(const GAS f32x4*)(cw + CD + ch), w2 = *(const GAS f32x4*)(cw + 2 * CD + ch), w3 = *(const GAS f32x4*)(cw + 3 * CD + ch);
      const f32x4 s0 = *(const GAS f32x4*)(sc + ch), s1 = *(const GAS f32x4*)(sc + CD + ch), s2 = *(const GAS f32x4*)(sc + 2 * CD + ch);
      f32x4 o;
#pragma unroll
      for (int e = 0; e < 4; ++e) o[e] = siluf_(bb[e] + w0[e] * s0[e] + w1[e] * s1[e] + w2[e] * s2[e] + w3[e] * nv[e]);
      *(LAS f32x4*)(Bs + 4 * lane) = o; }
    LDS_WAIT(); asm volatile("" ::: "memory");
    const f32x4 Bv = *((const LAS f32x4*)Bs + n4), Cv = *((const LAS f32x4*)(Bs + 128) + n4);
    const size_t sbase = (((size_t)l * NB + b) * NH + 8 * g) * HP * DS;
    for (int j = 0; j < 8; ++j) { const int h = 8 * g + j;
        const GAS f32x4* sp = (const GAS f32x4*)((C.a->in[2]) + sbase + (size_t)j * HP * DS + (size_t)prh * DS) + n4;
        GAS f32x4* op = (GAS f32x4*)((C.a->out) + O_SSSM + sbase + (size_t)j * HP * DS + (size_t)prh * DS) + n4;
        f32x4 hv[32];
#pragma unroll
        for (int i = 0; i < 32; ++i) hv[i] = __builtin_nontemporal_load(sp + (size_t)i * (2 * DS / 4));
        const float dt = ((float*)(C.a->ws + WS_DT))[(size_t)row * 64 + h], dA = __expf(-__expf((C.a->in[11])[l * NH + h]) * dt), Dh = (C.a->in[12])[l * NH + h];
#pragma unroll
        for (int i = 0; i < 32; ++i) { const int p = prh + 2 * i; const float xv = xs[j * 64 + p], dtx = dt * xv; const f32x4 h0 = hv[i];
            f32x4 hn; hn.x = dA * h0.x + dtx * Bv.x; hn.y = dA * h0.y + dtx * Bv.y; hn.z = dA * h0.z + dtx * Bv.z; hn.w = dA * h0.w + dtx * Bv.w;
            __builtin_nontemporal_store(hn, op + (size_t)i * (2 * DS / 4));
            float yp = (hn.x * Cv.x + hn.y * Cv.y) + (hn.z * Cv.z + hn.w * Cv.w);
#pragma unroll
            for (int o = 1; o < 32; o <<= 1) yp += __shfl_xor(yp, o);
            if (n4 == 0) ys[j * 64 + p] = yp + Dh * xv; }
    }
    LDS_WAIT(); asm volatile("" ::: "memory");
    { const int ch = g * 512 + 8 * lane; const v4u zw = *(const GAS v4u*)(U + UIDX(row, UZ + ch)); const f32x4 y0 = *(const LAS f32x4*)(ys + 8 * lane), y1 = *(const LAS f32x4*)(ys + 8 * lane + 4);
      float gv[8] = {y0.x * bflo(zw.x), y0.y * bfhi(zw.x), y0.z * bflo(zw.y), y0.w * bfhi(zw.y), y1.x * bflo(zw.z), y1.y * bfhi(zw.z), y1.z * bflo(zw.w), y1.w * bfhi(zw.w)};
      float ss = 0.f;
#pragma unroll
      for (int e = 0; e < 8; ++e) ss += gv[e] * gv[e];
      const float rstd = rsqrtf(wave_sum(ss) * (1.0f / 512.0f) + EPS);
      const f32x4 n0 = *(const GAS f32x4*)((C.a->in[13]) + (size_t)l * DI + ch), n1 = *(const GAS f32x4*)((C.a->in[13]) + (size_t)l * DI + ch + 4);
      v4u o; o.x = pk2(gv[0] * rstd * n0.x, gv[1] * rstd * n0.y); o.y = pk2(gv[2] * rstd * n0.z, gv[3] * rstd * n0.w); o.z = pk2(gv[4] * rstd * n1.x, gv[5] * rstd * n1.y); o.w = pk2(gv[6] * rstd * n1.z, gv[7] * rstd * n1.w);
      *(GAS v4u*)(((bf16*)(C.a->ws + WS_YO)) + (size_t)row * KCAT + ch) = o; }
    LDS_WAIT(); asm volatile("" ::: "memory");
}

__device__ __forceinline__ void sample_attn_phase(const Ctx& C, int l) {
    const int tid = C.tid;
    constexpr int KP = 68;
    LAS float* Ks = (LAS float*)(C.lds + RING_OFF); LAS float* Vs = Ks + 128 * KP; LAS float* qs = Vs + 128 * KP; LAS float* sc = qs + 256; LAS float* knew = sc + 4 * 132; LAS float* vnew = knew + 64;
    const bf16* U = ((bf16*)(C.a->ws + WS_U));
    f32x4 kv[4], vv[4]; float qx = 0.f;
#define SA_LOAD(u_) do { const int b_ = (u_) >> 3, kh_ = (u_) & 7, row_ = SEQ + b_; const size_t cb_ = ((size_t)l * NB + b_) * WIN * (KVH * AD) + (size_t)kh_ * AD; \
        _Pragma("unroll") for (int i = 0; i < 4; ++i) { const int idx = tid + 512 * i, w = idx >> 4, c4 = idx & 15; \
            kv[i] = __builtin_nontemporal_load((const GAS f32x4*)((C.a->in[4]) + cb_ + (size_t)w * (KVH * AD)) + c4); vv[i] = __builtin_nontemporal_load((const GAS f32x4*)((C.a->in[5]) + cb_ + (size_t)w * (KVH * AD)) + c4); } \
        if (tid < 256) qx = bf2f(U[UIDX(row_, UQ + kh_ * 256 + tid)]); else if (tid < 320) qx = bf2f(U[UIDX(row_, UK + kh_ * 64 + (tid - 256))]); else if (tid < 384) qx = bf2f(U[UIDX(row_, UV + kh_ * 64 + (tid - 320))]); } while (0)
    int u = C.bid; if (u >= NB * KVH) return;
    SA_LOAD(u);
    for (; u < NB * KVH; u += C.G) {
        const int b = u >> 3, kh = u & 7, row = SEQ + b;
        const size_t cbase = ((size_t)l * NB + b) * WIN * (KVH * AD) + (size_t)kh * AD;
        if (tid < 256) qs[tid] = qx; else if (tid < 320) knew[tid - 256] = qx; else if (tid < 384) vnew[tid - 320] = qx;
#pragma unroll
        for (int i = 0; i < 4; ++i) { const int idx = tid + 512 * i, w = idx >> 4, c4 = idx & 15; *((LAS f32x4*)(Ks + w * KP) + c4) = kv[i]; *((LAS f32x4*)(Vs + w * KP) + c4) = vv[i]; }
        __syncthreads();
        if (u + C.G < NB * KVH) SA_LOAD(u + C.G);
        if (tid < 16) { *((GAS f32x4*)((C.a->out) + O_SK + cbase + (size_t)(WIN - 1) * (KVH * AD)) + tid) = *((const LAS f32x4*)knew + tid); }
        else if (tid < 32) { *((GAS f32x4*)((C.a->out) + O_SV + cbase + (size_t)(WIN - 1) * (KVH * AD)) + (tid - 16)) = *((const LAS f32x4*)vnew + (tid - 16)); }
        { const int w = tid >> 2, hq = tid & 3; const LAS f32x4* kp = (const LAS f32x4*)(Ks + w * KP); const LAS f32x4* qp = (const LAS f32x4*)(qs + hq * 64);
          float s = 0.f;
    #pragma unroll
          for (int c = 0; c < 16; ++c) { const f32x4 kv = kp[c], qv = qp[c]; s += (kv.x * qv.x + kv.y * qv.y) + (kv.z * qv.z + kv.w * qv.w); }
          sc[hq * 132 + w] = s * 0.125f; }
        if (tid < 4) { float s = 0.f;
          for (int d = 0; d < 64; ++d) s += qs[tid * 64 + d] * knew[d];
          sc[tid * 132 + 128] = s * 0.125f; }
        __syncthreads();
        if (C.wave < 4) { const int hq = C.wave; const float sink = (C.a->in[16])[l * AH + 4 * kh + hq];
          const float v0 = sc[hq * 132 + C.lane], v1 = sc[hq * 132 + 64 + C.lane], v2 = C.lane == 0 ? sc[hq * 132 + 128] : -__builtin_inff();
          const float m = fmaxf(wave_max(fmaxf(fmaxf(v0, v1), v2)), sink);
          const float e0 = __expf(v0 - m), e1 = __expf(v1 - m), e2 = C.lane == 0 ? __expf(v2 - m) : 0.f;
          const float inv = 1.0f / (wave_sum(e0 + e1 + e2) + __expf(sink - m));
          sc[hq * 132 + C.lane] = e0 * inv; sc[hq * 132 + 64 + C.lane] = e1 * inv; if (C.lane == 0) sc[hq * 132 + 128] = e2 * inv; }
        __syncthreads();
        if (tid < 256) { const int hq = tid >> 6, d = tid & 63; float o = sc[hq * 132 + 128] * vnew[d];
    #pragma unroll 16
          for (int w = 0; w < WIN; ++w) o += sc[hq * 132 + w] * Vs[w * KP + d];
          ((bf16*)(C.a->ws + WS_YO))[(size_t)row * KCAT + DI + (4 * kh + hq) * 64 + d] = (bf16)f2bf(o); }
        __syncthreads();
    }
#undef SA_LOAD
}

__device__ __forceinline__ void cache_shift(const Ctx& C, int l, int vb, int nvb) {
    constexpr int ROWF4 = (WIN - 1) * KVH * AD / 4;
    for (int u = vb; u < NB * 2; u += nvb) { const int b = u >> 1, kv = u & 1;
        const GAS f32x4* src = (const GAS f32x4*)((kv ? (C.a->in[5]) : (C.a->in[4])) + ((size_t)l * NB + b) * WIN * (KVH * AD) + KVH * AD);
        GAS f32x4* dst = (GAS f32x4*)((C.a->out) + (kv ? O_SV : O_SK) + ((size_t)l * NB + b) * WIN * (KVH * AD));
        for (int i = C.tid; i < ROWF4; i += 512 * 8) { f32x4 v[8];
#pragma unroll
            for (int j = 0; j < 8; ++j) if (i + 512 * j < ROWF4) v[j] = __builtin_nontemporal_load(src + i + 512 * j);
#pragma unroll
            for (int j = 0; j < 8; ++j) if (i + 512 * j < ROWF4) __builtin_nontemporal_store(v[j], dst + i + 512 * j); } }
}

__device__ __forceinline__ void copy_outs(const Ctx& C, int l, int vb, int nvb) {
    const bf16* U = ((bf16*)(C.a->ws + WS_U)); const int gt = vb * 512 + C.tid, NT = nvb * 512;
    for (int i = gt; i < WIN * KVH * AD / 8; i += NT) { const int w = i >> 6, c = (i & 63) * 8, ur = SEQ - WIN + w;
        const v4u kw = *(const GAS v4u*)(U + UIDX(ur, UK + c)), vw = *(const GAS v4u*)(U + UIDX(ur, UV + c));
        GAS f32x4* pk = (GAS f32x4*)((C.a->out) + O_PK + (size_t)l * WIN * KVH * AD + (size_t)w * (KVH * AD) + c); GAS f32x4* pv = (GAS f32x4*)((C.a->out) + O_PV + (size_t)l * WIN * KVH * AD + (size_t)w * (KVH * AD) + c);
        pk[0] = (f32x4){bflo(kw.x), bfhi(kw.x), bflo(kw.y), bfhi(kw.y)}; pk[1] = (f32x4){bflo(kw.z), bfhi(kw.z), bflo(kw.w), bfhi(kw.w)};
        pv[0] = (f32x4){bflo(vw.x), bfhi(vw.x), bflo(vw.y), bfhi(vw.y)}; pv[1] = (f32x4){bflo(vw.z), bfhi(vw.z), bflo(vw.w), bfhi(vw.w)}; }
    constexpr int C8 = CD / 8;
    for (int i = gt; i < 3 * C8; i += NT) { const int j = i / C8, ch = (i - j * C8) * 8; const v4u w = *(const GAS v4u*)(U + UIDX(SEQ - 3 + j, UXBC + ch));
        GAS f32x4* po = (GAS f32x4*)((C.a->out) + O_PCONV + (size_t)l * 3 * CD + (size_t)j * CD + ch);
        po[0] = (f32x4){bflo(w.x), bfhi(w.x), bflo(w.y), bfhi(w.y)}; po[1] = (f32x4){bflo(w.z), bfhi(w.z), bflo(w.w), bfhi(w.w)}; }
    for (int i = gt; i < NB * C8; i += NT) { const int b = i / C8, ch = (i - b * C8) * 8;
        const GAS f32x4* si = (const GAS f32x4*)((C.a->in[3]) + ((size_t)l * NB + b) * 3 * CD + ch); GAS f32x4* so = (GAS f32x4*)((C.a->out) + O_SCONV + ((size_t)l * NB + b) * 3 * CD + ch);
        const f32x4 r10 = si[CD / 4], r11 = si[CD / 4 + 1], r20 = si[2 * CD / 4], r21 = si[2 * CD / 4 + 1]; const v4u w = *(const GAS v4u*)(U + UIDX(SEQ + b, UXBC + ch));
        so[0] = r10; so[1] = r11; so[CD / 4] = r20; so[CD / 4 + 1] = r21;
        so[2 * CD / 4] = (f32x4){bflo(w.x), bfhi(w.x), bflo(w.y), bfhi(w.y)}; so[2 * CD / 4 + 1] = (f32x4){bflo(w.z), bfhi(w.z), bflo(w.w), bfhi(w.w)}; }
}
typedef float f32x2_t __attribute__((ext_vector_type(2))); typedef __bf16 bf16x2_t __attribute__((ext_vector_type(2)));
__device__ __forceinline__ unsigned cvtpk(float lo, float hi) { f32x2_t v = {lo, hi}; bf16x2_t b = __builtin_convertvector(v, bf16x2_t); return __builtin_bit_cast(unsigned, b); }
__device__ __forceinline__ int crow(int reg, int hh) { return (reg & 3) + 8 * (reg >> 2) + 4 * hh; }
#define MFMA32(a, b, c) __builtin_amdgcn_mfma_f32_32x32x16_bf16((a), (b), (c), 0, 0, 0)
__device__ __forceinline__ bf16x8 ld16(const bf16* p) { return *(const GAS bf16x8*)p; }
__device__ __forceinline__ bf16x8 ld8x2(const bf16* p) {
    const u32x2 lo = *(const GAS u32x2*)p, hi = *(const GAS u32x2*)(p + 8); v4u w; w.x = lo.x; w.y = lo.y; w.z = hi.x; w.w = hi.y; return __builtin_bit_cast(bf16x8, w); }
#define PACK8(X, s) __builtin_bit_cast(bf16x8, (v4u){cvtpk((X)[8 * (s)], (X)[8 * (s) + 1]), cvtpk((X)[8 * (s) + 2], (X)[8 * (s) + 3]), cvtpk((X)[8 * (s) + 4], (X)[8 * (s) + 5]), cvtpk((X)[8 * (s) + 6], (X)[8 * (s) + 7])})

__device__ __forceinline__ void reformat_conv_item(const Ctx& C, int l, int c, int cblk) {
    const int co = C.lane & 7, rg = C.lane >> 3, ch0 = cblk * 64 + co * 8;
    const float* cw = (C.a->in[8]) + (size_t)l * CW * CD + ch0; const float* cb = (C.a->in[9]) + (size_t)l * CD + ch0;
    float w0[8], w1[8], w2[8], w3[8], bs[8];
#pragma unroll
    for (int j = 0; j < 8; ++j) { w0[j] = cw[j]; w1[j] = cw[CD + j]; w2[j] = cw[2 * CD + j]; w3[j] = cw[3 * CD + j]; bs[j] = cb[j]; }
    const bf16* U = ((bf16*)(C.a->ws + WS_U));
    const int row0 = 128 * c + 16 * rg;
    v4u raw[19];
    unsigned zu = 0u; asm volatile("" : "+v"(zu));
#pragma unroll
    for (int i = 0; i < 19; ++i) { const int rr = row0 - 3 + i; raw[i] = *(const GAS v4u*)(U + UIDX(rr < 0 ? 0 : rr, UXBC + ch0)); }
    __builtin_amdgcn_sched_barrier(0);
#pragma unroll
    for (int i = 0; i < 3; ++i) { if (row0 - 3 + i < 0) raw[i] = (v4u){zu, zu, zu, zu}; }
    unsigned tp[8][8];
    bf16* rm = nullptr; bf16* tr = nullptr;
    if (cblk < 64) tr = ((bf16*)(C.a->ws + WS_XT)) + (((size_t)c * 64 + cblk) * 64 + co * 8) * 128 + 16 * rg;
    else if (cblk < 80) { const int g = (cblk - 64) >> 1, hf = (cblk - 64) & 1;
        rm = ((bf16*)(C.a->ws + WS_BRM)) + (((size_t)c * 8 + g) * 128 + 16 * rg) * 128 + hf * 64 + co * 8;
        tr = ((bf16*)(C.a->ws + WS_BT)) + (((size_t)c * 8 + g) * 128 + hf * 64 + co * 8) * 128 + 16 * rg; }
    else { const int g = (cblk - 80) >> 1, hf = (cblk - 80) & 1;
        rm = ((bf16*)(C.a->ws + WS_CRM)) + (((size_t)c * 8 + g) * 128 + 16 * rg) * 128 + hf * 64 + co * 8; }
#define RAWF(i, j) (((j) & 1) ? bfhi(((j) >> 1) == 0 ? raw[i].x : (((j) >> 1) == 1 ? raw[i].y : (((j) >> 1) == 2 ? raw[i].z : raw[i].w))) : bflo(((j) >> 1) == 0 ? raw[i].x : (((j) >> 1) == 1 ? raw[i].y : (((j) >> 1) == 2 ? raw[i].z : raw[i].w))))
#pragma unroll
    for (int i2 = 0; i2 < 8; ++i2) {
        float oa[8], ob[8];
#pragma unroll
        for (int j = 0; j < 8; ++j) { oa[j] = siluf_(bs[j] + w0[j] * RAWF(2 * i2, j) + w1[j] * RAWF(2 * i2 + 1, j) + w2[j] * RAWF(2 * i2 + 2, j) + w3[j] * RAWF(2 * i2 + 3, j));
                                      ob[j] = siluf_(bs[j] + w0[j] * RAWF(2 * i2 + 1, j) + w1[j] * RAWF(2 * i2 + 2, j) + w2[j] * RAWF(2 * i2 + 3, j) + w3[j] * RAWF(2 * i2 + 4, j)); }
        if (rm) { v4u w; w.x = cvtpk(oa[0], oa[1]); w.y = cvtpk(oa[2], oa[3]); w.z = cvtpk(oa[4], oa[5]); w.w = cvtpk(oa[6], oa[7]); *(GAS v4u*)(rm + (size_t)(2 * i2) * 128) = w;
                  w.x = cvtpk(ob[0], ob[1]); w.y = cvtpk(ob[2], ob[3]); w.z = cvtpk(ob[4], ob[5]); w.w = cvtpk(ob[6], ob[7]); *(GAS v4u*)(rm + (size_t)(2 * i2 + 1) * 128) = w; }
#pragma unroll
        for (int j = 0; j < 8; ++j) tp[j][i2] = cvtpk(oa[j], ob[j]);
    }
#undef RAWF
    if (tr) {
#pragma unroll
        for (int j = 0; j < 8; ++j) { *(GAS v4u*)(tr + (size_t)j * 128) = (v4u){tp[j][0], tp[j][1], tp[j][2], tp[j][3]}; *(GAS v4u*)(tr + (size_t)j * 128 + 8) = (v4u){tp[j][4], tp[j][5], tp[j][6], tp[j][7]}; }
    }
}
__device__ __forceinline__ void reformat_dt_item(const Ctx& C, int l, int c) {
    const int h = C.lane; const float A = -__expf((C.a->in[11])[l * NH + h]);
    const float* D = ((float*)(C.a->ws + WS_DT)) + (size_t)(128 * c) * 64 + h;
    float* dto = ((float*)(C.a->ws + WS_DTT)) + ((size_t)c * 64 + h) * 128; float* aco = ((float*)(C.a->ws + WS_ACS)) + ((size_t)c * 64 + h) * 128;
    float cs = 0.f;
#pragma unroll
    for (int l0 = 0; l0 < 128; l0 += 64) { float dv[64];
#pragma unroll
        for (int i = 0; i < 64; ++i) dv[i] = D[(size_t)(l0 + i) * 64];
        __builtin_amdgcn_sched_barrier(0);
#pragma unroll
        for (int q = 0; q < 16; ++q) { f32x4 av;
#pragma unroll
            for (int e = 0; e < 4; ++e) { cs += dv[4 * q + e] * A; av[e] = cs; }
            *(GAS f32x4*)(dto + l0 + 4 * q) = (f32x4){dv[4 * q], dv[4 * q + 1], dv[4 * q + 2], dv[4 * q + 3]}; *(GAS f32x4*)(aco + l0 + 4 * q) = av; } }
}
__device__ __forceinline__ void reformat_vt_item(const Ctx& C, int tb, int kh) {
    const int co = C.lane & 7, rg = C.lane >> 3; const bf16* U = ((bf16*)(C.a->ws + WS_U)) + UIDX(128 * tb + 16 * rg, UV + kh * 64 + co * 8);
    unsigned tp[8][8]; v4u rv[16];
#pragma unroll
    for (int i = 0; i < 16; ++i) rv[i] = *(const GAS v4u*)(U + (size_t)i * 64);
    __builtin_amdgcn_sched_barrier(0);
#pragma unroll
    for (int i = 0; i < 16; ++i) { const v4u a = rv[i]; const unsigned w[4] = {a.x, a.y, a.z, a.w};
#pragma unroll
        for (int j = 0; j < 8; ++j) { const unsigned hb = (j & 1) ? (w[j >> 1] >> 16) : (w[j >> 1] & 0xffffu); if (i & 1) tp[j][i >> 1] |= hb << 16; else tp[j][i >> 1] = hb; } }
    bf16* tr = ((bf16*)(C.a->ws + WS_VT)) + ((size_t)kh * 64 + co * 8) * SEQ + 128 * tb + 16 * rg;
#pragma unroll
    for (int j = 0; j < 8; ++j) { *(GAS v4u*)(tr + (size_t)j * SEQ) = (v4u){tp[j][0], tp[j][1], tp[j][2], tp[j][3]}; *(GAS v4u*)(tr + (size_t)j * SEQ + 8) = (v4u){tp[j][4], tp[j][5], tp[j][6], tp[j][7]}; }
}
constexpr int RF_ITEMS = 64 * 96 + 64 + 64 * 8;
__device__ __forceinline__ void reformat_item(const Ctx& C, int l, int it) {
    constexpr int N1 = 64 * 96, N2 = 64;
    if (it < N1) reformat_conv_item(C, l, it / 96, it % 96);
    else if (it < N1 + N2) reformat_dt_item(C, l, it - N1);
    else reformat_vt_item(C, (it - N1 - N2) >> 3, (it - N1 - N2) & 7);
}

constexpr int AT_K = 0, AT_V = 36864, AT_KP = 144, AT_VP = 528;
__device__ __forceinline__ void attn_prompt_unit(const Ctx& C, int l, int qb, int kh) {
    const int lane_ = lane_now();
    const int r = lane_ & 31, hh = lane_ >> 5, hq = 4 * kh + (C.wave >> 1), rh = C.wave & 1, tid = C.wave * 64 + lane_;
    const bf16* U = ((bf16*)(C.a->ws + WS_U)); const bf16* VT = ((bf16*)(C.a->ws + WS_VT)) + (size_t)kh * 64 * SEQ; bf16* YO = ((bf16*)(C.a->ws + WS_YO));
    LAS unsigned char* Ks = C.lds + AT_K; LAS unsigned char* Vs = C.lds + AT_V;
    const int key0 = 128 * (qb - 1);
    bf16x8 bq[2][4];
    { v4u tk[4], tv[4]; unsigned zu = 0u; asm volatile("" : "+v"(zu));
#pragma unroll
      for (int i = 0; i < 4; ++i) { const int idx = tid + 512 * i, kr = idx >> 3, ch = idx & 7, key = key0 + kr;
          tk[i] = *(const GAS v4u*)(U + UIDX(key < 0 ? 0 : key, UK + kh * 64 + 8 * ch));
          const int d = idx >> 5, c5 = idx & 31, kk = key0 + 8 * c5;
          tv[i] = *(const GAS v4u*)(VT + (size_t)d * SEQ + (kk < 0 ? 0 : kk)); }
#pragma unroll
      for (int qt = 0; qt < 2; ++qt)
#pragma unroll
          for (int ks = 0; ks < 4; ++ks) bq[qt][ks] = ld16(U + UIDX(128 * qb + 32 * (2 * rh + qt) + r, UQ + hq * 64 + 16 * ks + 8 * hh));
      __builtin_amdgcn_sched_barrier(0);
#pragma unroll
      for (int i = 0; i < 4; ++i) { const int idx = tid + 512 * i; if (key0 + (idx >> 3) < 0) tk[i] = (v4u){zu, zu, zu, zu}; if (key0 + 8 * (idx & 31) < 0) tv[i] = (v4u){zu, zu, zu, zu}; }
#pragma unroll
      for (int i = 0; i < 4; ++i) { const int idx = tid + 512 * i; *(LAS v4u*)(Ks + (idx >> 3) * AT_KP + (idx & 7) * 16) = tk[i]; *(LAS v4u*)(Vs + (idx >> 5) * AT_VP + (idx & 31) * 16) = tv[i]; } }
    const float sink = (C.a->in[16])[l * AH + hq];
    __syncthreads();
#pragma unroll
    for (int qt = 0; qt < 2; ++qt) {
        const int ai = 2 * rh + qt, q0 = 128 * qb + 32 * ai, t = q0 + r;
        f32x16 S[5]; float mx = sink;
#pragma unroll
        for (int v = 0; v < 5; ++v) { const int kt = ai + v; const bool vis = qb > 0 || kt >= 4;
            if (vis) { const int kb = key0 + 32 * kt; f32x16 s;
#pragma unroll
                for (int e = 0; e < 16; ++e) s[e] = 0.f;
                const LAS unsigned char* kp = Ks + (32 * kt + r) * AT_KP + 16 * hh;
#pragma unroll
                for (int ks = 0; ks < 4; ++ks) { const bf16x8 a = *(const LAS bf16x8*)(kp + 32 * ks); s = MFMA32(a, bq[qt][ks], s); }
#pragma unroll
                for (int e = 0; e < 16; ++e) { const int j = kb + crow(e, hh); const bool ok = (j <= t) && (j >= t - WIN); const float x = ok ? s[e] * 0.125f : -__builtin_inff(); s[e] = x; mx = fmaxf(mx, x); }
                S[v] = s; }
        }
        mx = fmaxf(mx, __shfl_xor(mx, 32));
        float sum = 0.f;
#pragma unroll
        for (int v = 0; v < 5; ++v) { const int kt = ai + v; const bool vis = qb > 0 || kt >= 4;
            if (vis) {
#pragma unroll
                for (int e = 0; e < 16; ++e) { const float p = __expf(S[v][e] - mx); S[v][e] = p; sum += p; } } }
        sum += __shfl_xor(sum, 32); sum += __expf(sink - mx);
        f32x16 O[2];
#pragma unroll
        for (int e = 0; e < 16; ++e) { O[0][e] = 0.f; O[1][e] = 0.f; }
#pragma unroll
        for (int v = 0; v < 5; ++v) { const int kt = ai + v; const bool vis = qb > 0 || kt >= 4;
            if (vis) {
#pragma unroll
                for (int ss = 0; ss < 2; ++ss) { const bf16x8 pb = PACK8(S[v], ss);
#pragma unroll
                    for (int dt = 0; dt < 2; ++dt) { const LAS unsigned char* vp = Vs + (32 * dt + r) * AT_VP + (32 * kt + 16 * ss + 4 * hh) * 2;
                        const u32x2 lo = *(const LAS u32x2*)vp, hi = *(const LAS u32x2*)(vp + 16);
                        const bf16x8 va = __builtin_bit_cast(bf16x8, (v4u){lo.x, lo.y, hi.x, hi.y}); O[dt] = MFMA32(va, pb, O[dt]); } } } }
        const float inv = 1.0f / sum;
        bf16* op = YO + (size_t)t * KCAT + DI + hq * 64;
#pragma unroll
        for (int dt = 0; dt < 2; ++dt)
#pragma unroll
            for (int g4 = 0; g4 < 4; ++g4) { u32x2 w; w.x = cvtpk(O[dt][4 * g4] * inv, O[dt][4 * g4 + 1] * inv); w.y = cvtpk(O[dt][4 * g4 + 2] * inv, O[dt][4 * g4 + 3] * inv);
                *(GAS u32x2*)(op + 32 * dt + 8 * g4 + 4 * hh) = w; }
    }
    __syncthreads();
}

__device__ __forceinline__ void ssd_states_unit(const Ctx& C, int c, int g) {
    const int lane_ = lane_now();
    const int r = lane_ & 31, hh = lane_ >> 5, h = 8 * g + C.wave, tid = C.wave * 64 + lane_;
    const bf16* xT = ((bf16*)(C.a->ws + WS_XT)) + ((size_t)c * 64 + h) * 64 * 128; const bf16* bT = ((bf16*)(C.a->ws + WS_BT)) + ((size_t)c * 8 + g) * 128 * 128;
    const float* dtT = ((float*)(C.a->ws + WS_DTT)) + ((size_t)c * 64 + h) * 128; const float* acs = ((float*)(C.a->ws + WS_ACS)) + ((size_t)c * 64 + h) * 128;
    LAS unsigned char* Bs = C.lds + PC_B; LAS float* scs = (LAS float*)(C.lds + PC_C) + C.wave * 128;
    v4u tb[4], raw[2][8];
#pragma unroll
    for (int i = 0; i < 4; ++i) tb[i] = *(const GAS v4u*)(bT + (size_t)(tid + 512 * i) * 8);
    const float dl0 = dtT[lane_], dl1 = dtT[64 + lane_], al0 = acs[lane_], al1 = acs[64 + lane_], aend = acs[127];
#pragma unroll
    for (int ks = 0; ks < 8; ++ks)
#pragma unroll
        for (int pt = 0; pt < 2; ++pt) raw[pt][ks] = *(const GAS v4u*)(xT + (size_t)(32 * pt + r) * 128 + 16 * ks + 8 * hh);
    __builtin_amdgcn_sched_barrier(0);
#pragma unroll
    for (int i = 0; i < 4; ++i) { const int idx = tid + 512 * i; *(LAS v4u*)(Bs + (idx >> 4) * 272 + (idx & 15) * 16) = tb[i]; }
    scs[lane_] = dl0 * __expf(aend - al0); scs[64 + lane_] = dl1 * __expf(aend - al1);
    LDS_WAIT(); asm volatile("" ::: "memory");
    bf16x8 a[2][8];
#pragma unroll
    for (int ks = 0; ks < 8; ++ks) { const f32x4 s0 = *(const LAS f32x4*)(scs + 16 * ks + 8 * hh), s1 = *(const LAS f32x4*)(scs + 16 * ks + 8 * hh + 4);
#pragma unroll
        for (int pt = 0; pt < 2; ++pt) { const v4u w = raw[pt][ks];
            v4u o; o.x = cvtpk(bflo(w.x) * s0.x, bfhi(w.x) * s0.y); o.y = cvtpk(bflo(w.y) * s0.z, bfhi(w.y) * s0.w); o.z = cvtpk(bflo(w.z) * s1.x, bfhi(w.z) * s1.y); o.w = cvtpk(bflo(w.w) * s1.z, bfhi(w.w) * s1.w);
            a[pt][ks] = __builtin_bit_cast(bf16x8, o); } }
    __syncthreads();
    bf16* st = ((bf16*)(C.a->ws + WS_ST)) + ((size_t)c * 64 + h) * 64 * 128;
#pragma unroll
    for (int nt = 0; nt < 4; ++nt) {
        f32x16 acc[2];
#pragma unroll
        for (int e = 0; e < 16; ++e) { acc[0][e] = 0.f; acc[1][e] = 0.f; }
        const LAS unsigned char* bp = Bs + (32 * nt + r) * 272 + 16 * hh;
#pragma unroll
        for (int ks = 0; ks < 8; ++ks) { const bf16x8 b = *(const LAS bf16x8*)(bp + 32 * ks); acc[0] = MFMA32(b, a[0][ks], acc[0]); acc[1] = MFMA32(b, a[1][ks], acc[1]); }
#pragma unroll
        for (int pt = 0; pt < 2; ++pt)
#pragma unroll
            for (int q4 = 0; q4 < 4; ++q4) { u32x2 w; w.x = cvtpk(acc[pt][4 * q4], acc[pt][4 * q4 + 1]); w.y = cvtpk(acc[pt][4 * q4 + 2], acc[pt][4 * q4 + 3]);
                *(GAS u32x2*)(st + (size_t)(32 * pt + r) * 128 + 32 * nt + 8 * q4 + 4 * hh) = w; }
    }
    __syncthreads();
}

__device__ __forceinline__ void ssd_scan_phase(const Ctx& C, int l) {
    const bf16* ST = ((bf16*)(C.a->ws + WS_ST)); bf16* HS = ((bf16*)(C.a->ws + WS_HS)); const float* acs = ((float*)(C.a->ws + WS_ACS));
    for (int idx = C.bid * 512 + C.tid; idx < 64 * 64 * 128 / 4; idx += C.G * 512) { const int h = idx >> 11;
        f32x4 hc = (f32x4){0.f, 0.f, 0.f, 0.f};
        for (int c0 = 0; c0 < 64; c0 += 16) { u32x2 sw[16]; float av[16];
#pragma unroll
            for (int j = 0; j < 16; ++j) { sw[j] = *((const GAS u32x2*)(ST + (size_t)(c0 + j) * 64 * 64 * 128) + idx); av[j] = acs[((size_t)(c0 + j) * 64 + h) * 128 + 127]; }
#pragma unroll
            for (int j = 0; j < 16; ++j) {
                u32x2 w; w.x = cvtpk(hc.x, hc.y); w.y = cvtpk(hc.z, hc.w); *((GAS u32x2*)(HS + (size_t)(c0 + j) * 64 * 64 * 128) + idx) = w;
                const f32x4 s = (f32x4){bflo(sw[j].x), bfhi(sw[j].x), bflo(sw[j].y), bfhi(sw[j].y)}; const float dec = __expf(av[j]);
                hc = hc * dec + s; } }
        *((GAS f32x4*)((C.a->out) + O_PSSM + (size_t)l * NH * HP * DS) + idx) = hc; }
}

__device__ __forceinline__ void ssd_out_unit(const Ctx& C, int l, int c, int g) {
    const int lane_ = lane_now();
    const int r = lane_ & 31, hh = lane_ >> 5, h = 8 * g + C.wave, tid = C.wave * 64 + lane_;
    LAS unsigned char* Bs = C.lds + PC_B; LAS unsigned char* Cs = C.lds + PC_C; LAS float* Ysm = (LAS float*)(C.lds + PC_Y + C.wave * 8704);
    LAS float* ssq = (LAS float*)(C.lds + PC_SSQ); LAS float* acsS = (LAS float*)(C.lds + PC_AD + C.wave * 1024); LAS float* dtS = acsS + 128;
    const bf16* cR = ((bf16*)(C.a->ws + WS_CRM)) + ((size_t)c * 8 + g) * 128 * 128; const bf16* bR = ((bf16*)(C.a->ws + WS_BRM)) + ((size_t)c * 8 + g) * 128 * 128;
    const bf16* hS = ((bf16*)(C.a->ws + WS_HS)) + ((size_t)c * 64 + h) * 64 * 128; const bf16* xT = ((bf16*)(C.a->ws + WS_XT)) + ((size_t)c * 64 + h) * 64 * 128;
    LAS float* nws = (LAS float*)(C.lds + 152576) + C.wave * 64;
    bf16x8 hb[2][8], xb[4][2][2];
    { v4u tb[4], tc[4];
#pragma unroll
      for (int i = 0; i < 4; ++i) { const int idx = tid + 512 * i; tb[i] = *(const GAS v4u*)(bR + (size_t)idx * 8); tc[i] = *(const GAS v4u*)(cR + (size_t)idx * 8); }
      const float a0 = (((float*)(C.a->ws + WS_ACS)) + ((size_t)c * 64 + h) * 128)[lane_], a1 = (((float*)(C.a->ws + WS_ACS)) + ((size_t)c * 64 + h) * 128)[64 + lane_];
      const float d0 = (((float*)(C.a->ws + WS_DTT)) + ((size_t)c * 64 + h) * 128)[lane_], d1 = (((float*)(C.a->ws + WS_DTT)) + ((size_t)c * 64 + h) * 128)[64 + lane_];
      const float nwv = ((C.a->in[13]) + (size_t)l * DI + h * 64)[lane_];
#pragma unroll
      for (int pt = 0; pt < 2; ++pt)
#pragma unroll
          for (int ks = 0; ks < 8; ++ks) hb[pt][ks] = ld16(hS + (size_t)(32 * pt + r) * 128 + 16 * ks + 8 * hh);
#pragma unroll
      for (int st = 0; st < 4; ++st)
#pragma unroll
          for (int ss = 0; ss < 2; ++ss)
#pragma unroll
              for (int pt = 0; pt < 2; ++pt) xb[st][ss][pt] = ld8x2(xT + (size_t)(32 * pt + r) * 128 + 32 * st + 16 * ss + 4 * hh);
      __builtin_amdgcn_sched_barrier(0);
#pragma unroll
      for (int i = 0; i < 4; ++i) { const int idx = tid + 512 * i, row = idx >> 4, ch = idx & 15; *(LAS v4u*)(Bs + row * 272 + ch * 16) = tb[i]; *(LAS v4u*)(Cs + row * 272 + ch * 16) = tc[i]; }
      acsS[lane_] = a0; acsS[64 + lane_] = a1; dtS[lane_] = d0; dtS[64 + lane_] = d1; nws[lane_] = nwv; }
    const float Dh = (C.a->in[12])[l * NH + h];
    __syncthreads();
    const bf16* Uz = ((bf16*)(C.a->ws + WS_U)) + UIDX(128 * c + (lane_ >> 1), UZ + h * 64 + 32 * (lane_ & 1));
    bf16* YOw = ((bf16*)(C.a->ws + WS_YO)) + (size_t)(128 * c + (lane_ >> 1)) * KCAT + h * 64 + 32 * (lane_ & 1);
    const LAS float* nwp = nws + 32 * (lane_ & 1);
#pragma unroll
    for (int lt = 0; lt < 4; ++lt) {
        v4u zw[4];
        { const GAS v4u* zp = (const GAS v4u*)(Uz + (size_t)(32 * lt) * 64);
#pragma unroll
          for (int i = 0; i < 4; ++i) zw[i] = zp[i]; }
        f32x16 y[2];
#pragma unroll
        for (int e = 0; e < 16; ++e) { y[0][e] = 0.f; y[1][e] = 0.f; }
        const LAS unsigned char* crow_p = Cs + (32 * lt + r) * 272 + 16 * hh;
#pragma unroll
        for (int ks = 0; ks < 8; ++ks) { if ((ks & 3) == 0) asm volatile("" ::: "memory");
            const bf16x8 a = *(const LAS bf16x8*)(crow_p + 32 * ks); y[0] = MFMA32(a, hb[0][ks], y[0]); y[1] = MFMA32(a, hb[1][ks], y[1]); }
#pragma unroll
        for (int q4 = 0; q4 < 4; ++q4) { const f32x4 av = *(const LAS f32x4*)(acsS + 32 * lt + 8 * q4 + 4 * hh);
#pragma unroll
            for (int e = 0; e < 4; ++e) { const float f = __expf(av[e]); y[0][4 * q4 + e] *= f; y[1][4 * q4 + e] *= f; } }
        const float al = acsS[32 * lt + r];
#pragma unroll
        for (int st = 0; st < 4; ++st) { if (st > lt) continue;
            f32x16 X;
#pragma unroll
            for (int e = 0; e < 16; ++e) X[e] = 0.f;
            const LAS unsigned char* brow_p = Bs + (32 * st + r) * 272 + 16 * hh;
#pragma unroll
            for (int ks = 0; ks < 8; ++ks) { if ((ks & 1) == 0) asm volatile("" ::: "memory");
                const bf16x8 a = *(const LAS bf16x8*)(brow_p + 32 * ks), b = *(const LAS bf16x8*)(crow_p + 32 * ks); X = MFMA32(a, b, X); }
#pragma unroll
            for (int q4 = 0; q4 < 4; ++q4) { const f32x4 as = *(const LAS f32x4*)(acsS + 32 * st + 8 * q4 + 4 * hh), ds = *(const LAS f32x4*)(dtS + 32 * st + 8 * q4 + 4 * hh);
#pragma unroll
                for (int e = 0; e < 4; ++e) { const int s = 32 * st + 8 * q4 + 4 * hh + e, lrow = 32 * lt + r; const float wgt = (s <= lrow) ? ds[e] * __expf(al - as[e]) : 0.f; X[4 * q4 + e] *= wgt; } }
#pragma unroll
            for (int ss = 0; ss < 2; ++ss) { const bf16x8 xa = PACK8(X, ss); y[0] = MFMA32(xa, xb[st][ss][0], y[0]); y[1] = MFMA32(xa, xb[st][ss][1], y[1]); }
        }
#pragma unroll
        for (int pt = 0; pt < 2; ++pt)
#pragma unroll
            for (int e = 0; e < 16; ++e) { const int q4 = e >> 2; const v4u xw = __builtin_bit_cast(v4u, xb[lt][q4 >> 1][pt]); const unsigned w = (q4 & 1) ? ((e & 2) ? xw.w : xw.z) : ((e & 2) ? xw.y : xw.x);
                const float xv = (e & 1) ? bfhi(w) : bflo(w);
                Ysm[crow(e, hh) * 68 + 32 * pt + r] = y[pt][e] + Dh * xv; }
        { const LAS f32x4* yr = (const LAS f32x4*)(Ysm + (lane_ >> 1) * 68 + 32 * (lane_ & 1));
          float gq[32]; float sq = 0.f;
#pragma unroll
          for (int i = 0; i < 4; ++i) { const f32x4 ya = yr[2 * i], yb = yr[2 * i + 1];
              gq[8 * i + 0] = ya.x * bflo(zw[i].x); gq[8 * i + 1] = ya.y * bfhi(zw[i].x); gq[8 * i + 2] = ya.z * bflo(zw[i].y); gq[8 * i + 3] = ya.w * bfhi(zw[i].y);
              gq[8 * i + 4] = yb.x * bflo(zw[i].z); gq[8 * i + 5] = yb.y * bfhi(zw[i].z); gq[8 * i + 6] = yb.z * bflo(zw[i].w); gq[8 * i + 7] = yb.w * bfhi(zw[i].w);
#pragma unroll
              for (int e = 0; e < 8; ++e) sq += gq[8 * i + e] * gq[8 * i + e]; }
          sq += __shfl_xor(sq, 1);
          if ((lane_ & 1) == 0) ssq[(32 * lt + (lane_ >> 1)) * 8 + C.wave] = sq;
          __syncthreads();
          const LAS f32x4* sp = (const LAS f32x4*)(ssq + (32 * lt + (lane_ >> 1)) * 8); const f32x4 s0 = sp[0], s1 = sp[1];
          const float rstd = rsqrtf(((s0.x + s0.y) + (s0.z + s0.w) + (s1.x + s1.y) + (s1.z + s1.w)) * (1.0f / 512.0f) + EPS);
          GAS v4u* op = (GAS v4u*)(YOw + (size_t)(32 * lt) * KCAT);
#pragma unroll
          for (int i = 0; i < 4; ++i) { const f32x4 na = *(const LAS f32x4*)(nwp + 8 * i), nb = *(const LAS f32x4*)(nwp + 8 * i + 4);
              op[i] = (v4u){cvtpk(gq[8 * i] * rstd * na.x, gq[8 * i + 1] * rstd * na.y), cvtpk(gq[8 * i + 2] * rstd * na.z, gq[8 * i + 3] * rstd * na.w), cvtpk(gq[8 * i + 4] * rstd * nb.x, gq[8 * i + 5] * rstd * nb.y), cvtpk(gq[8 * i + 6] * rstd * nb.z, gq[8 * i + 7] * rstd * nb.w)}; } }
    }
    __syncthreads();
}

template <int MODE, int NBG> __device__ __forceinline__ void mini_group(f32x16& acc, const bf16* Ab, int lda, const float* Af, const bf16* Bt, int K, int kofs, LAS unsigned char* WLA, LAS unsigned char* WLB, int lane_) {
    constexpr int NLA = MODE == 1 ? 8 : 4;
    const int r = lane_ & 31, hh = lane_ >> 5, lrow = lane_ >> 3, lch = lane_ & 7, frow = lane_ >> 4, fch = lane_ & 15;
    v4u bv[NBG][4], av[NBG][NLA];
#pragma unroll
    for (int g = 0; g < NBG; ++g) {
#pragma unroll
        for (int j = 0; j < 4; ++j) bv[g][j] = *(const GAS v4u*)(Bt + (size_t)(8 * j + lrow) * K + kofs + 64 * g + 8 * lch);
        if (MODE == 1) {
#pragma unroll
            for (int j = 0; j < 8; ++j) av[g][j] = *(const GAS v4u*)(Af + (size_t)(4 * j + frow) * DM + kofs + 64 * g + 4 * fch);
        } else {
#pragma unroll
            for (int j = 0; j < 4; ++j) av[g][j] = *(const GAS v4u*)(Ab + (size_t)(8 * j + lrow) * lda + kofs + 64 * g + 8 * lch);
        }
    }
    __builtin_amdgcn_sched_barrier(0);
#pragma unroll
    for (int g = 0; g < NBG; ++g) {
#pragma unroll
        for (int j = 0; j < 4; ++j) *(LAS v4u*)(WLB + (8 * j + lrow) * 144 + lch * 16) = bv[g][j];
        if (MODE == 1) {
#pragma unroll
            for (int j = 0; j < 8; ++j) { const v4u w = av[g][j]; u32x2 o; o.x = cvtpk(__uint_as_float(w.x), __uint_as_float(w.y)); o.y = cvtpk(__uint_as_float(w.z), __uint_as_float(w.w)); *(LAS u32x2*)(WLA + (4 * j + frow) * 144 + fch * 8) = o; }
        } else {
#pragma unroll
            for (int j = 0; j < 4; ++j) *(LAS v4u*)(WLA + (8 * j + lrow) * 144 + lch * 16) = av[g][j];
        }
        LDS_WAIT(); asm volatile("" ::: "memory");
        bf16x8 fa[4], fb[4];
#pragma unroll
        for (int ks = 0; ks < 4; ++ks) { fa[ks] = *(const LAS bf16x8*)(WLA + r * 144 + (2 * ks + hh) * 16); fb[ks] = *(const LAS bf16x8*)(WLB + r * 144 + (2 * ks + hh) * 16); }
#pragma unroll
        for (int ks = 0; ks < 4; ++ks) acc = MFMA32(fa[ks], fb[ks], acc);
        asm volatile("" ::: "memory");
    }
    __builtin_amdgcn_sched_barrier(0);
}
template <int MODE> __device__ __forceinline__ void mini_unit(const Ctx& C, int l, int mu) {
    constexpr int K = MODE == 0 ? KCAT : (MODE == 1 ? DM : FF), KS = MODE == 0 ? 1024 : (MODE == 1 ? 256 : 704);
    const int lane_ = lane_now();
    const int r = lane_ & 31, hh = lane_ >> 5, ct = mu & 31, sp = mu >> 5, rt = C.wave & 3, n0 = 64 * ct + 32 * (C.wave >> 2), k0 = KS * sp;
    const bf16* Bt = (MODE == 0 ? ((bf16*)(C.a->ws + WS_WCAT)) + (size_t)l * DM * KCAT : (MODE == 1 ? ((bf16*)(C.a->ws + WS_WOUT)) + (size_t)l * DM * DM : ((bf16*)(C.a->ws + WS_WDN)) + (size_t)l * DM * FF)) + (size_t)n0 * K + k0;
    const bf16* Ab = (MODE == 0 ? ((bf16*)(C.a->ws + WS_YO)) + (size_t)(SEQ + 32 * rt) * KCAT : ((bf16*)(C.a->ws + WS_HB)) + (size_t)(SEQ + 32 * rt) * FF) + k0;
    const float* Af = ((float*)(C.a->ws + WS_MS)) + (size_t)(32 * rt) * DM + k0;
    constexpr int lda = MODE == 0 ? KCAT : FF;
    LAS unsigned char* WLA = C.lds + RING_OFF + C.wave * 9216; LAS unsigned char* WLB = WLA + 4608;
    f32x16 acc;
#pragma unroll
    for (int e = 0; e < 16; ++e) acc[e] = 0.f;
    if (MODE == 0) {
#pragma unroll 1
        for (int gq = 0; gq < 4; ++gq) mini_group<0, 4>(acc, Ab, lda, Af, Bt, K, 256 * gq, WLA, WLB, lane_);
    } else if (MODE == 1) {
#pragma unroll 1
        for (int gq = 0; gq < 2; ++gq) mini_group<1, 2>(acc, Ab, lda, Af, Bt, K, 128 * gq, WLA, WLB, lane_);
    } else {
#pragma unroll 1
        for (int gq = 0; gq < 2; ++gq) mini_group<2, 4>(acc, Ab, lda, Af, Bt, K, 256 * gq, WLA, WLB, lane_);
        mini_group<2, 3>(acc, Ab, lda, Af, Bt, K, 512, WLA, WLB, lane_);
    }
    float* dst = (MODE == 0 ? ((float*)(C.a->ws + WS_MS)) : ((float*)(C.a->ws + WS_X)) + (size_t)SEQ * DM) + n0 + r;
    if (MODE == 0) { const bf16* gp = ((bf16*)(C.a->ws + WS_U)) + UIDX(SEQ, (sp < 4 ? UGS : UGA) + n0 + r);
        bf16 gv[16];
#pragma unroll
        for (int e = 0; e < 16; ++e) gv[e] = gp[(size_t)(32 * rt + crow(e, hh)) * 64];
        __builtin_amdgcn_sched_barrier(0);
#pragma unroll
        for (int e = 0; e < 16; ++e) acc[e] *= bf2f(gv[e]); }
#pragma unroll
    for (int e = 0; e < 16; ++e) unsafeAtomicAdd(dst + (size_t)(32 * rt + crow(e, hh)) * DM, acc[e]);
}
template <int MODE> __device__ __forceinline__ void mini_phase(const Ctx& C, int l) {
    constexpr int NMU = 32 * (MODE == 0 ? 6 : 8);
    for (int mu = C.bid; mu < NMU; mu += C.G) mini_unit<MODE>(C, l, mu);
}
constexpr int NPL = 11;
constexpr int NPH = 1 + DEPTH * NPL;
#ifndef REP_P0
#define REP_P0 1
#endif
#ifndef REP_0
#define REP_0 1
#endif
#ifndef REP_1
#define REP_1 1
#endif
#ifndef REP_2
#define REP_2 1
#endif
#ifndef REP_3
#define REP_3 1
#endif
#ifndef REP_4
#define REP_4 1
#endif
#ifndef REP_5
#define REP_5 1
#endif
#ifndef REP_6
#define REP_6 1
#endif
#ifndef REP_7
#define REP_7 1
#endif
#ifndef REP_8
#define REP_8 1
#endif
#ifndef REP_9
#define REP_9 1
#endif
#ifndef REP_10
#define REP_10 1
#endif
#ifndef REP_RF
#define REP_RF 1
#endif
#ifndef REP_SSD
#define REP_SSD 1
#endif
#ifndef REP_SATT
#define REP_SATT 1
#endif
#ifndef GEMM_ALIGN
#define GEMM_ALIGN true
#endif
#ifndef GEMM_SP2
#define GEMM_SP2 true
#endif
#ifndef PROBE_LO
#define PROBE_LO -1
#define PROBE_HI -1
#endif
#ifndef PROBE_AMP
#define PROBE_AMP 2
#endif
#ifndef NW_SSD
#define NW_SSD 2
#endif
#ifndef PROBE_SUB
#define PROBE_SUB 0
#endif
#ifndef PROBE_CLK
#define PROBE_CLK 0
#endif
#ifndef REP_ATT
#define REP_ATT 1
#endif
#ifndef REP_PA
#define REP_PA 1
#endif
#ifndef NSP_G1
#define NSP_G1 49
#endif
#ifndef MK_SPLIT
#define MK_SPLIT 0
#endif
__global__ void __launch_bounds__(NWAVES * 64, 2) fwd(Args args) {
    extern __shared__ __attribute__((aligned(16))) unsigned char lds_raw[];
    LAS unsigned char* const lds = (LAS unsigned char*)lds_raw;
    const int wave_s = __builtin_amdgcn_readfirstlane(threadIdx.x >> 6);
    unsigned char* ws = args.ws;
#define FRESH_CTX() Ctx C; { int t_; asm volatile("v_mbcnt_lo_u32_b32 %0, -1, 0\n\tv_mbcnt_hi_u32_b32 %0, -1, %0" : "=v"(t_)); t_ += wave_s * 64; int b_ = blockIdx.x, g_ = gridDim.x; asm volatile("" : "+s"(b_), "+s"(g_)); \
        KArgs kp_ = (KArgs)__builtin_amdgcn_kernarg_segment_ptr(); asm volatile("" : "+s"(kp_)); \
        C.lds = lds; C.tid = t_; C.lane = t_ & 63; C.wave = __builtin_amdgcn_readfirstlane(t_ >> 6); C.G = g_; C.bid = b_; C.a = kp_; }
    for (int u = threadIdx.x; u < (LDS_BYTES - LDSCTL_OFF) / 4; u += NWAVES * 64) ((LAS unsigned*)(lds + LDSCTL_OFF))[u] = 0u;
    __syncthreads();
    volatile LAS unsigned* MISC = (volatile LAS unsigned*)(lds + MISC_OFF);
    unsigned* barw = (unsigned*)(ws + WS_CTL) + CW_BAR;
    XcdBarrier bar; bar.bar = barw; bar.x = 0; bar.st = nullptr;
    if (args.use_bar) bar = xcd_barrier_post(barw, MISC + 8);
    const int lo = args.ph_lo, hi = args.ph_hi;
#define IN(k) (lo <= (k) && (k) < hi)
#define SEAM(k) do { if (IN((k) + 1)) xcd_barrier(bar); } while (0)

#ifndef NO_P0
    if (IN(0)) { for (int rep_ = 0; rep_ < REP_P0; ++rep_) { FRESH_CTX(); p0_weights(C, 0, (C.G >= 64 && NSP_G1 > 0) ? IT_IN : DEPTH * IT_LAYER, C.bid * NWAVES + C.wave, C.G * NWAVES); p0_xinit(C); if (rep_ + 1 < REP_P0) xcd_barrier(bar); } SEAM(0); }
#endif

    unsigned long long probe_acc = 0ull, probe_t0 = 0ull;
    if (PROBE_CLK && threadIdx.x == 0) { const unsigned long long c0_ = __builtin_amdgcn_s_memtime(), r0_ = __builtin_amdgcn_s_memrealtime(); MISC[16] = (unsigned)c0_; MISC[17] = (unsigned)(c0_ >> 32); MISC[18] = (unsigned)r0_; MISC[19] = (unsigned)(r0_ >> 32); }
#define PROBE_BEGIN(j) do { if (PROBE_LO >= 0 && (j) == PROBE_LO) probe_t0 = __builtin_amdgcn_s_memrealtime(); } while (0)
#define PROBE_END(j) do { if (PROBE_LO >= 0 && (j) == PROBE_HI) probe_acc += __builtin_amdgcn_s_memrealtime() - probe_t0; } while (0)
#pragma nounroll
    for (int l = 0; l < DEPTH; ++l) {
        const int pb = 1 + l * NPL;
#ifndef NO_G1
        PROBE_BEGIN(0);
        if (IN(pb + 0)) { for (int rep_ = 0; rep_ < REP_0; ++rep_) {
            FRESH_CTX();
            const int nsp = (l == 0 && C.G >= 64) ? (C.G * NSP_G1) / 256 : 0, gG = C.G - nsp;
            if (C.bid < gG) {
            pg8::Gemm g{((bf16*)(C.a->ws + WS_XN)), ((bf16*)(C.a->ws + WS_WIN)) + (size_t)l * NU * DM, MP, NU, DM}; pg8::StaticOrder S; S.init(MP, NU, gG, C.bid);
            pg8::EpiU E{((bf16*)(C.a->ws + WS_U)), ((float*)(C.a->ws + WS_DT)), (C.a->in[10]) + l * NH, ((float*)(C.a->ws + WS_RSA))};
            pg8::gemm_phase<pg8::EpiU, pg8::StaticOrder, GEMM_ALIGN, GEMM_SP2>(C.lds + RING_OFF, g, S, E, C.tid);
            } else p0_weights(C, IT_IN, DEPTH * IT_LAYER, (C.bid - gG) * NWAVES + C.wave, nsp * NWAVES);
            if (rep_ + 1 < REP_0) xcd_barrier(bar); }
            SEAM(pb + 0);
        }
        PROBE_END(0);
#endif
        PROBE_BEGIN(1);
        if (IN(pb + 1)) { for (int rep_ = 0; rep_ < REP_1; ++rep_) {
            FRESH_CTX();
            { volatile LAS unsigned* qctr = (volatile LAS unsigned*)(C.lds + MISC_OFF) + 24;
              if (C.tid == 0) qctr[0] = 0u;
              __syncthreads();
              const int nS = (NB * NG - C.bid + C.G - 1) / C.G, nR = (RF_ITEMS - C.bid + C.G - 1) / C.G;
              LAS float* wsc = (LAS float*)(C.lds + RING_OFF + C.wave * 8192);
              for (;;) { unsigned idx = 0u; if (C.lane == 0) idx = __hip_atomic_fetch_add((LAS unsigned*)qctr, 1u, __ATOMIC_RELAXED, __HIP_MEMORY_SCOPE_WORKGROUP);
                  idx = (unsigned)__builtin_amdgcn_readfirstlane((int)idx);
                  if ((int)idx >= nS + nR) break;
                  if ((int)idx < nS) { const int u = C.bid + C.G * (int)idx; sample_ssd_wave_unit(C, l, u >> 3, u & 7, wsc); }
                  else reformat_item(C, l, C.bid + C.G * ((int)idx - nS)); } }
            __syncthreads();
            if (PROBE_SUB == 1) probe_acc += __builtin_amdgcn_s_memrealtime() - probe_t0;
            if (PROBE_SUB == 2) probe_t0 = __builtin_amdgcn_s_memrealtime();
            zero_f32(C, ((float*)(C.a->ws + WS_RSB)), SEQ, C.bid, C.G);
            { float z0 = 0.f; asm volatile("" : "+v"(z0));
              for (int i = C.bid * 512 + C.tid; i < NB * DM / 4; i += C.G * 512) ((GAS f32x4*)(C.a->ws + WS_MS))[i] = (f32x4){z0, z0, z0, z0}; }
            for (int rr_ = 0; rr_ < REP_SATT; ++rr_) sample_attn_phase(C, l);
            if (PROBE_SUB == 2) probe_acc += __builtin_amdgcn_s_memrealtime() - probe_t0;
            if (PROBE_SUB == 3) probe_t0 = __builtin_amdgcn_s_memrealtime();
            if (PROBE_SUB == 3) { __syncthreads(); probe_acc += __builtin_amdgcn_s_memrealtime() - probe_t0; }
            if (rep_ + 1 < REP_1) xcd_barrier(bar); }
            SEAM(pb + 1);
        }
        PROBE_END(1);
        PROBE_BEGIN(2);
        if (IN(pb + 2)) { for (int rep_ = 0; rep_ < REP_2; ++rep_) {
            FRESH_CTX();
#ifdef USE_NSSD
            if (C.bid < NG) naive_ssd_prompt(C, l, C.bid);
            else {
                const int vb = C.bid - NG, nvb = C.G - NG;
                for (int u = vb; u < 64 * KVH; u += nvb) attn_prompt_unit(C, l, u >> 3, u & 7);
                for (int u = vb; u < 64 * NG; u += nvb) ssd_states_unit(C, u >> 3, u & 7);
            }
#else
            for (int rr_ = 0; rr_ < REP_ATT; ++rr_) for (int u = C.bid; u < 64 * KVH; u += C.G) attn_prompt_unit(C, l, u >> 3, u & 7);
            for (int rr_ = 0; rr_ < REP_PA; ++rr_) for (int u = C.bid; u < 64 * NG; u += C.G) ssd_states_unit(C, u >> 3, u & 7);
#endif
            if (rep_ + 1 < REP_2) xcd_barrier(bar); }
            SEAM(pb + 2);
        }
        PROBE_END(2);
        PROBE_BEGIN(3);
        if (IN(pb + 3)) { for (int rep_ = 0; rep_ < REP_3; ++rep_) { FRESH_CTX(); ssd_scan_phase(C, l); if (rep_ + 1 < REP_3) xcd_barrier(bar); } SEAM(pb + 3); }
        PROBE_END(3);
        PROBE_BEGIN(4);
        if (IN(pb + 4)) { for (int rep_ = 0; rep_ < REP_4; ++rep_) {
            FRESH_CTX();
#ifndef USE_NSSD
            for (int u = C.bid; u < 64 * NG; u += C.G) ssd_out_unit(C, l, u >> 3, u & 7);
#endif
            if (rep_ + 1 < REP_4) xcd_barrier(bar); }
            SEAM(pb + 4);
        }
        PROBE_END(4);
#ifndef NO_G2
        PROBE_BEGIN(5);
        if (IN(pb + 5)) { for (int rep_ = 0; rep_ < REP_5; ++rep_) {
            FRESH_CTX();
            pg8::Gemm g{((bf16*)(C.a->ws + WS_YO)), ((bf16*)(C.a->ws + WS_WCAT)) + (size_t)l * DM * KCAT, SEQ, DM, KCAT}; pg8::StaticOrder S; S.init(SEQ, DM, C.G, C.bid);
            pg8::EpiMerge E{((bf16*)(C.a->ws + WS_U)), ((bf16*)(C.a->ws + WS_MRG))};
            pg8::gemm_phase<pg8::EpiMerge, pg8::StaticOrder, true, true>(C.lds + RING_OFF, g, S, E, C.tid);
            mini_phase<0>(C, l);
            if (rep_ + 1 < REP_5) xcd_barrier(bar); }
            SEAM(pb + 5);
        }
        PROBE_END(5);
#endif
#ifndef NO_G3
        PROBE_BEGIN(6);
        if (IN(pb + 6)) { for (int rep_ = 0; rep_ < REP_6; ++rep_) {
            FRESH_CTX();
            pg8::Gemm g{((bf16*)(C.a->ws + WS_MRG)), ((bf16*)(C.a->ws + WS_WOUT)) + (size_t)l * DM * DM, SEQ, DM, DM}; pg8::StaticOrder S; S.init(SEQ, DM, C.G, C.bid);
            pg8::EpiResid E{l == 0 ? (C.a->in[0]) : (const float*)nullptr, ((bf16*)(C.a->ws + WS_XN)), ((float*)(C.a->ws + WS_RSB))};
            pg8::gemm_phase<pg8::EpiResid, pg8::StaticOrder, true, true>(C.lds + RING_OFF, g, S, E, C.tid);
            mini_phase<1>(C, l);
            if (rep_ + 1 < REP_6) xcd_barrier(bar); }
            SEAM(pb + 6);
        }
        PROBE_END(6);
#endif
        PROBE_BEGIN(7);
        if (IN(pb + 7)) { for (int rep_ = 0; rep_ < REP_7; ++rep_) { FRESH_CTX(); sample_rows_phase(C, ((float*)(C.a->ws + WS_RSB))); if (rep_ + 1 < REP_7) xcd_barrier(bar); } SEAM(pb + 7); }
        PROBE_END(7);
#ifndef NO_G4
        PROBE_BEGIN(8);
        if (IN(pb + 8)) { for (int rep_ = 0; rep_ < REP_8; ++rep_) {
            FRESH_CTX();
            const int nsp = C.G >= 64 ? (C.G * 14) / 256 : 0, gG = C.G - nsp;
            if (C.bid < gG) {
            pg8::Gemm g{((bf16*)(C.a->ws + WS_XN)), ((bf16*)(C.a->ws + WS_WGU)) + (size_t)l * NGU * DM, MP, NGU, DM}; pg8::StaticOrder S; S.init(MP, NGU, gG, C.bid);
            pg8::EpiSwiGLU E{((bf16*)(C.a->ws + WS_HB)), ((float*)(C.a->ws + WS_RSB))};
            pg8::gemm_phase<pg8::EpiSwiGLU, pg8::StaticOrder, GEMM_ALIGN, GEMM_SP2>(C.lds + RING_OFF, g, S, E, C.tid);
            } else { zero_f32(C, ((float*)(C.a->ws + WS_RSA)), SEQ, C.bid - gG, nsp); copy_outs(C, l, C.bid - gG, nsp); cache_shift(C, l, C.bid - gG, nsp); }
            if (nsp == 0) { zero_f32(C, ((float*)(C.a->ws + WS_RSA)), SEQ, C.bid, C.G); copy_outs(C, l, C.bid, C.G); cache_shift(C, l, C.bid, C.G); }
            if (rep_ + 1 < REP_8) xcd_barrier(bar); }
            SEAM(pb + 8);
        }
        PROBE_END(8);
#endif
#ifndef NO_G5
        PROBE_BEGIN(9);
        if (IN(pb + 9)) { for (int rep_ = 0; rep_ < REP_9; ++rep_) {
            FRESH_CTX();
            pg8::Gemm g{((bf16*)(C.a->ws + WS_HB)), ((bf16*)(C.a->ws + WS_WDN)) + (size_t)l * DM * FF, SEQ, DM, FF}; pg8::StaticOrder S; S.init(SEQ, DM, C.G, C.bid);
            pg8::EpiResid E{(const float*)nullptr, ((bf16*)(C.a->ws + WS_XN)), ((float*)(C.a->ws + WS_RSA))};
            pg8::gemm_phase<pg8::EpiResid, pg8::StaticOrder, true, true>(C.lds + RING_OFF, g, S, E, C.tid);
            mini_phase<2>(C, l);
            if (rep_ + 1 < REP_9) xcd_barrier(bar); }
            SEAM(pb + 9);
        }
        PROBE_END(9);
#endif
        PROBE_BEGIN(10);
        if (IN(pb + 10)) { for (int rep_ = 0; rep_ < REP_10; ++rep_) {
            FRESH_CTX();
            if (l + 1 < DEPTH) sample_rows_phase(C, ((float*)(C.a->ws + WS_RSA))); else final_norm_phase(C);
            if (rep_ + 1 < REP_10) xcd_barrier(bar); }
            SEAM(pb + 10);
        }
        PROBE_END(10);
    }
    if (PROBE_CLK && blockIdx.x == 0 && wave_s == 0 && lane_now() == 0) { const unsigned long long c1 = __builtin_amdgcn_s_memtime(), r1 = __builtin_amdgcn_s_memrealtime(); const unsigned long long clk_c0 = ((unsigned long long)MISC[17] << 32) | MISC[16], clk_r0 = ((unsigned long long)MISC[19] << 32) | MISC[18]; const unsigned long long dc = (c1 - clk_c0) * 10000ull, dr = r1 - clk_r0;
        while ((__builtin_amdgcn_s_memrealtime() - r1) * dr < dc) __builtin_amdgcn_s_sleep(8); }
    if (PROBE_LO >= 0 && blockIdx.x == 0 && wave_s == 0 && lane_now() == 0) { const unsigned long long t1 = __builtin_amdgcn_s_memrealtime(); while (__builtin_amdgcn_s_memrealtime() - t1 < (unsigned long long)PROBE_AMP * probe_acc) __builtin_amdgcn_s_sleep(8); }
#undef IN
#undef SEAM
}

extern "C" void kernel_launch(void* const* d_in, const int* in_sizes, int n_in, void* d_out, int out_size, void* d_ws, size_t ws_size, hipStream_t stream) {
    static int grid = 0;
    if (grid == 0) {
        if (n_in != 23 || (size_t)out_size != O_END || ws_size < WS_END) { fprintf(stderr, "kernel_launch: unexpected problem (n_in %d, out %d, ws %zu; need ws >= %zu); nothing launched\n", n_in, out_size, ws_size, (size_t)WS_END); grid = -1; return; }
        int dev = 0, cus = 0, per_cu = 0;
        if (hipGetDevice(&dev) != hipSuccess || hipDeviceGetAttribute(&cus, hipDeviceAttributeMultiprocessorCount, dev) != hipSuccess) { grid = -1; return; }
        if (hipFuncSetAttribute((const void*)fwd, hipFuncAttributeMaxDynamicSharedMemorySize, LDS_BYTES) != hipSuccess) { fprintf(stderr, "kernel_launch: hipFuncSetAttribute failed\n"); grid = -1; return; }
        if (hipOccupancyMaxActiveBlocksPerMultiprocessor(&per_cu, (const void*)fwd, NWAVES * 64, LDS_BYTES) != hipSuccess || per_cu < 1) { fprintf(stderr, "kernel_launch: occupancy query says %d blocks per CU\n", per_cu); }
        (void)hipGetLastError();
        grid = cus;
    }
    if (grid < 0) return;
    if (hipMemsetAsync((char*)d_ws + WS_CTL, 0, CTL_ZERO_BYTES, stream) != hipSuccess) return;
    Args a{};
    for (int i = 0; i < 23; ++i) a.in[i] = (const float*)d_in[i];
    a.out = (float*)d_out; a.ws = (unsigned char*)d_ws; a.pad = 0;
#if MK_SPLIT
    for (int p = 0; p < NPH; ++p) { a.ph_lo = p; a.ph_hi = p + 1; a.use_bar = 0; hipLaunchKernelGGL(fwd, dim3(grid), dim3(NWAVES * 64), LDS_BYTES, stream, a); }
#else
    a.ph_lo = 0; a.ph_hi = NPH; a.use_bar = 1;
    hipLaunchKernelGGL(fwd, dim3(grid), dim3(NWAVES * 64), LDS_BYTES, stream, a);
#endif
    const hipError_t le = hipPeekAtLastError();
    if (le != hipSuccess) fprintf(stderr, "kernel_launch: launch failed: %s\n", hipGetErrorName(le));
}
```

```cpp
#include <hip/hip_runtime.h>
#include <cstdio>
#include <cstdint>

constexpr int DM = 2048, SEQ = 8192, NB = 128, DEPTH = 2;
constexpr int MV = SEQ + NB;
constexpr int MP = 8448;
constexpr int DI = 4096, NH = 64, HP = 64, DS = 128, NG = 8, CD = 6144, CW = 4;
constexpr int AH = 32, KVH = 8, AD = 64, WIN = 128;
constexpr int FF = 5632;
constexpr int IN_DIM = 17472;
constexpr float EPS = 1e-6f;
constexpr int UZ = 0, UXBC = 4096, UQ = 10240, UK = 12288, UV = 12800, UGS = 13312, UGA = 15360, LDU = 17408;
__host__ __device__ __forceinline__ constexpr size_t UIDX(int row, int col) { return ((size_t)(row >> 7) * (LDU / 64) + (size_t)(col >> 6)) * 8192 + (size_t)(((row & 127) << 6) + (col & 63)); }
constexpr int NU = 17664;
constexpr int KCAT = DI + DM;
constexpr int NGU = 2 * FF;

constexpr size_t O_YP = 0;
constexpr size_t O_YS = O_YP + (size_t)SEQ * DM;
constexpr size_t O_PSSM = O_YS + (size_t)NB * DM;
constexpr size_t O_PCONV = O_PSSM + (size_t)DEPTH * NH * HP * DS;
constexpr size_t O_PK = O_PCONV + (size_t)DEPTH * 3 * CD;
constexpr size_t O_PV = O_PK + (size_t)DEPTH * WIN * KVH * AD;
constexpr size_t O_SSSM = O_PV + (size_t)DEPTH * WIN * KVH * AD;
constexpr size_t O_SCONV = O_SSSM + (size_t)DEPTH * NB * NH * HP * DS;
constexpr size_t O_SK = O_SCONV + (size_t)DEPTH * NB * 3 * CD;
constexpr size_t O_SV = O_SK + (size_t)DEPTH * NB * WIN * KVH * AD;
constexpr size_t O_END = O_SV + (size_t)DEPTH * NB * WIN * KVH * AD;
static_assert(O_END == 190877696ull, "output size");

constexpr size_t al256(size_t x) { return (x + 255) & ~(size_t)255; }
constexpr size_t WS_CTL = 0, CTL_ZERO_BYTES = 1u << 20;
constexpr size_t SZ_WIN = (size_t)NU * DM * 2, SZ_WCAT = (size_t)DM * KCAT * 2, SZ_WOUT = (size_t)DM * DM * 2, SZ_WGU = (size_t)NGU * DM * 2, SZ_WDN = (size_t)DM * FF * 2;
constexpr size_t WS_WIN = 1u << 20;
constexpr size_t WS_WCAT = WS_WIN + DEPTH * SZ_WIN;
constexpr size_t WS_WOUT = WS_WCAT + DEPTH * SZ_WCAT;
constexpr size_t WS_WGU = WS_WOUT + DEPTH * SZ_WOUT;
constexpr size_t WS_WDN = WS_WGU + DEPTH * SZ_WGU;
constexpr size_t WS_X = WS_WDN + DEPTH * SZ_WDN;
constexpr size_t WS_XN = WS_X + (size_t)MP * DM * 4;
constexpr size_t WS_U = WS_XN + (size_t)MP * DM * 2;
constexpr size_t WS_DT = WS_U + (size_t)MP * LDU * 2;
constexpr size_t WS_YO = WS_DT + (size_t)MP * 64 * 4;
constexpr size_t WS_MRG = WS_YO + (size_t)MP * KCAT * 2;
constexpr size_t WS_HB = WS_MRG + (size_t)MP * DM * 2;
constexpr size_t WS_XT = WS_HB + (size_t)MP * FF * 2;
constexpr size_t WS_BRM = WS_XT + (size_t)64 * 64 * 64 * 128 * 2;
constexpr size_t WS_BT = WS_BRM + (size_t)64 * 8 * 128 * 128 * 2;
constexpr size_t WS_CRM = WS_BT + (size_t)64 * 8 * 128 * 128 * 2;
constexpr size_t WS_DTT = WS_CRM + (size_t)64 * 8 * 128 * 128 * 2;
constexpr size_t WS_ACS = WS_DTT + (size_t)64 * 64 * 128 * 4;
constexpr size_t WS_VT = WS_ACS + (size_t)64 * 64 * 128 * 4;
constexpr size_t WS_ST = WS_VT + (size_t)8 * 64 * 8192 * 2;
constexpr size_t WS_HS = WS_ST + (size_t)64 * 64 * 64 * 128 * 4;
constexpr size_t WS_MS = WS_HS + (size_t)64 * 64 * 64 * 128 * 2;
constexpr size_t WS_RSA = WS_MS + (size_t)NB * DM * 4;
constexpr size_t WS_RSB = WS_RSA + (size_t)MP * 4;
constexpr size_t WS_END = WS_RSB + (size_t)MP * 4;
static_assert(WS_WIN % 256 == 0 && WS_X % 256 == 0 && WS_U % 256 == 0 && WS_YO % 256 == 0 && WS_HB % 256 == 0 && WS_XT % 256 == 0 && WS_ST % 256 == 0, "ws alignment");
constexpr int CW_BAR = 4096;

constexpr int RING_OFF = 0, RING_BYTES = 131072;
constexpr int PC_B = 0, PC_C = 34816, PC_Y = 69632, PC_SSQ = 139264, PC_AD = 143360, PC_END = 151552;
constexpr int LDSCTL_OFF = PC_END, MISC_OFF = LDSCTL_OFF + 320;
constexpr int LDS_BYTES = 155648;
constexpr int NWAVES = 8;
#define MK_SPLIT 0
namespace pg8 {
#define PG8_LAS __attribute__((address_space(3)))
typedef unsigned short bf16_t;
typedef short bf16x8 __attribute__((ext_vector_type(8)));
typedef float f32x4 __attribute__((ext_vector_type(4)));
typedef unsigned u32x4 __attribute__((ext_vector_type(4)));
constexpr int BM = 256, BK = 64, HALF = 128, HTB = HALF * BK * 2  , STAGE_BYTES = 8 * HTB, NXCD = 8, WGM = 8;

__host__ __device__ __forceinline__ int lds_byte(int r, int c) { const int st = (r >> 4) * 2 + (c >> 5), rr = r & 15, cc = c & 31, ob = rr * 64 + cc * 2; return st * 1024 + (ob ^ (((ob >> 9) & 1) << 5)); }
__host__ __device__ __forceinline__ void stage_rc(int b, int& R, int& C) { const int st = b / 1024, sb = b % 1024, swz = sb ^ (((sb >> 9) & 1) << 5); R = (st >> 1) * 16 + swz / 64; C = (st & 1) * 32 + (swz % 64) / 2; }
__host__ __device__ __forceinline__ int perm32(int rho) { const int n = rho >> 4, i = rho & 15; return 8 * (i >> 2) + 4 * n + (i & 3); }

struct Unit { int pm, pn; };
struct Gemm { const bf16_t* A; const bf16_t* Bt; int M, N, K; };

struct StaticOrder {
    int nM, nN, nwg, G, c;
    __host__ __device__ void init(int M, int N, int G_, int c_) { nM = M / BM; nN = N / BM; nwg = nM * nN; G = G_; c = c_; }
    __host__ __device__ bool next(int i, Unit& u) const {
        const long L = (long)i * G + c; if (L >= nwg) return false;
        int wgid = (int)L; { const int q = nwg / NXCD, r = nwg % NXCD, xcd = wgid % NXCD, off = wgid / NXCD; wgid = (xcd < r ? xcd * (q + 1) : r * (q + 1) + (xcd - r) * q) + off; }
        const int nig = WGM * nN, gid = wgid / nig, fm = gid * WGM, gsz = (nM - fm) < WGM ? (nM - fm) : WGM;
        u.pm = fm + ((wgid % nig) % gsz); u.pn = (wgid % nig) / gsz; return true;
    }
    __device__ __forceinline__ void a_ready(const Unit&) const {}
    __device__ __forceinline__ void done(const Unit&) const {}
};
__device__ __forceinline__ unsigned cvt_pk_bf16(float lo, float hi) { unsigned r; asm volatile("v_cvt_pk_bf16_f32 %0, %1, %2" : "=v"(r) : "v"(lo), "v"(hi)); return r; }
__device__ __forceinline__ float bf_lo(unsigned w) { return __uint_as_float(w << 16); }
__device__ __forceinline__ float bf_hi(unsigned w) { return __uint_as_float(w & 0xffff0000u); }
__device__ __forceinline__ float sigmoidf_(float x) { return __builtin_amdgcn_rcpf(1.0f + __expf(-x)); }
constexpr int E_MV = 8320, E_LDU = 17408, E_UGS = 13312, E_UGA = 15360;
__device__ __forceinline__ size_t e_uidx(int row, int col) { return ((size_t)(row >> 7) * (E_LDU / 64) + (size_t)(col >> 6)) * 8192 + (size_t)(((row & 127) << 6) + (col & 63)); }
struct EpiU {
    static constexpr bool PERM = true, AFTER_DRAIN = false, HOOK = false, RSLDS = true; static constexpr int HOOK_T = -1;
    bf16_t* U; float* DT; const float* dtb; const float* RS;
    __device__ __forceinline__ void hook(f32x4 (&)[2][2][4][2], const Unit&, int, int, int, int) const {}
    __device__ __forceinline__ static float softplus_(float x) { return x > 20.0f ? x : log1pf(__expf(x)); }
    __device__ __forceinline__ void operator()(const f32x4 (&acc)[2][2][4][2], const Unit& u, int wr, int wc, int fr, int fq, const float (&rsv)[8]) const {
        const int row0 = u.pm * BM + wr * 64 + fr;
        auto rstd_ = [&](int q) { return rsqrtf(rsv[q] * (1.0f / 2048.0f) + 1e-6f); };
        if (u.pn == 68) {
            if (wc < 2) { const f32x4 b0 = *(const f32x4*)(dtb + wc * 32 + 8 * fq), b1 = *(const f32x4*)(dtb + wc * 32 + 8 * fq + 4);
#pragma unroll
                for (int ai = 0; ai < 2; ++ai) { if (u.pm * BM + ai * HALF >= E_MV) continue;
#pragma unroll
                    for (int m = 0; m < 4; ++m) { float* p = DT + (size_t)(row0 + ai * HALF + m * 16) * 64 + wc * 32 + 8 * fq; const float rs = rstd_(ai * 4 + m); f32x4 v0 = acc[ai][0][m][0] * rs + b0, v1 = acc[ai][0][m][1] * rs + b1;
#pragma unroll
                        for (int e = 0; e < 4; ++e) { v0[e] = softplus_(v0[e]); v1[e] = softplus_(v1[e]); }
                        *(f32x4*)p = v0; *(f32x4*)(p + 4) = v1; } }
            }
            return;
        }
        const bool sig = u.pn >= 52, zsilu = u.pn < 16;
        const int col0 = u.pn * BM + wc * 32 + 8 * fq;
#pragma unroll
        for (int ai = 0; ai < 2; ++ai) { if (u.pm * BM + ai * HALF >= E_MV) continue;
#pragma unroll
            for (int m = 0; m < 4; ++m) { const int rr = row0 + ai * HALF + m * 16; const float rs = rstd_(ai * 4 + m);
#pragma unroll
                for (int bj = 0; bj < 2; ++bj) { f32x4 v0 = acc[ai][bj][m][0] * rs, v1 = acc[ai][bj][m][1] * rs;
                    if (sig) {
#pragma unroll
                        for (int e = 0; e < 4; ++e) { v0[e] = sigmoidf_(v0[e]); v1[e] = sigmoidf_(v1[e]); } }
                    if (zsilu) {
#pragma unroll
                        for (int e = 0; e < 4; ++e) { v0[e] = v0[e] * sigmoidf_(v0[e]); v1[e] = v1[e] * sigmoidf_(v1[e]); } }
                    u32x4 w; w.x = cvt_pk_bf16(v0[0], v0[1]); w.y = cvt_pk_bf16(v0[2], v0[3]); w.z = cvt_pk_bf16(v1[0], v1[1]); w.w = cvt_pk_bf16(v1[2], v1[3]);
                    *(u32x4*)(U + e_uidx(rr, col0 + bj * HALF)) = w; } } }
    }
};
struct EpiMerge {
    static constexpr bool PERM = true, AFTER_DRAIN = false, HOOK = true, RSLDS = false; static constexpr int HOOK_T = 64;
    const bf16_t* U; bf16_t* O;
    __device__ __forceinline__ void hook(f32x4 (&acc)[2][2][4][2], const Unit& u, int wr, int wc, int fr, int fq) const {
        asm volatile("" : "+v"(fr), "+v"(fq));
        const int row0 = u.pm * BM + wr * 64 + fr, col0 = u.pn * BM + wc * 32 + 8 * fq;
        u32x4 gsA[2][2], gaA[2][2], gsB[2][2], gaB[2][2];
#define HK_LOAD(gs_, ga_, q_) do { _Pragma("unroll") for (int mm = 0; mm < 2; ++mm) { const int rr = row0 + ((q_) >> 1) * HALF + (2 * ((q_) & 1) + mm) * 16; \
            _Pragma("unroll") for (int bj = 0; bj < 2; ++bj) { gs_[mm][bj] = *(const u32x4*)(U + e_uidx(rr, E_UGS + col0 + bj * HALF)); ga_[mm][bj] = *(const u32x4*)(U + e_uidx(rr, E_UGA + col0 + bj * HALF)); } } } while (0)
#define HK_APPLY(gs_, ga_, q_) do { _Pragma("unroll") for (int mm = 0; mm < 2; ++mm) { const int ai = (q_) >> 1, m = 2 * ((q_) & 1) + mm; \
            _Pragma("unroll") for (int bj = 0; bj < 2; ++bj) { const u32x4 s = gs_[mm][bj], a = ga_[mm][bj]; f32x4 r0, r1; \
                r0[0] = bf_lo(s.x) * __builtin_amdgcn_rcpf(fmaxf(bf_lo(a.x), 1e-20f)); r0[1] = bf_hi(s.x) * __builtin_amdgcn_rcpf(fmaxf(bf_hi(a.x), 1e-20f)); r0[2] = bf_lo(s.y) * __builtin_amdgcn_rcpf(fmaxf(bf_lo(a.y), 1e-20f)); r0[3] = bf_hi(s.y) * __builtin_amdgcn_rcpf(fmaxf(bf_hi(a.y), 1e-20f)); \
                r1[0] = bf_lo(s.z) * __builtin_amdgcn_rcpf(fmaxf(bf_lo(a.z), 1e-20f)); r1[1] = bf_hi(s.z) * __builtin_amdgcn_rcpf(fmaxf(bf_hi(a.z), 1e-20f)); r1[2] = bf_lo(s.w) * __builtin_amdgcn_rcpf(fmaxf(bf_lo(a.w), 1e-20f)); r1[3] = bf_hi(s.w) * __builtin_amdgcn_rcpf(fmaxf(bf_hi(a.w), 1e-20f)); \
                acc[ai][bj][m][0] *= r0; acc[ai][bj][m][1] *= r1; } \
            asm volatile("" : "+v"(acc[ai][0][m][0]), "+v"(acc[ai][0][m][1]), "+v"(acc[ai][1][m][0]), "+v"(acc[ai][1][m][1]) :: "memory"); } } while (0)
        HK_LOAD(gsA, gaA, 0); HK_LOAD(gsB, gaB, 1); __builtin_amdgcn_sched_barrier(0);
        HK_APPLY(gsA, gaA, 0); HK_LOAD(gsA, gaA, 2); __builtin_amdgcn_sched_barrier(0);
        HK_APPLY(gsB, gaB, 1); HK_LOAD(gsB, gaB, 3); __builtin_amdgcn_sched_barrier(0);
        HK_APPLY(gsA, gaA, 2); __builtin_amdgcn_sched_barrier(0);
        HK_APPLY(gsB, gaB, 3);
#undef HK_LOAD
#undef HK_APPLY
    }
    __device__ __forceinline__ void operator()(const f32x4 (&acc)[2][2][4][2], const Unit& u, int wr, int wc, int fr, int fq) const {
        const int row0 = u.pm * BM + wr * 64 + fr, col0 = u.pn * BM + wc * 32 + 8 * fq;
        u32x4 gav[2][4][2];
#pragma unroll
        for (int ai = 0; ai < 2; ++ai)
#pragma unroll
            for (int m = 0; m < 4; ++m)
#pragma unroll
                for (int bj = 0; bj < 2; ++bj) gav[ai][m][bj] = *(const u32x4*)(U + e_uidx(row0 + ai * HALF + m * 16, E_UGA + col0 + bj * HALF));
#pragma unroll
        for (int ai = 0; ai < 2; ++ai)
#pragma unroll
            for (int m = 0; m < 4; ++m) { const size_t r = (size_t)(row0 + ai * HALF + m * 16);
#pragma unroll
                for (int bj = 0; bj < 2; ++bj) { const u32x4 ga = gav[ai][m][bj];
                    const f32x4 v0 = acc[ai][bj][m][0], v1 = acc[ai][bj][m][1];
                    u32x4 w; w.x = cvt_pk_bf16(v0[0] * bf_lo(ga.x), v0[1] * bf_hi(ga.x)); w.y = cvt_pk_bf16(v0[2] * bf_lo(ga.y), v0[3] * bf_hi(ga.y));
                    w.z = cvt_pk_bf16(v1[0] * bf_lo(ga.z), v1[1] * bf_hi(ga.z)); w.w = cvt_pk_bf16(v1[2] * bf_lo(ga.w), v1[3] * bf_hi(ga.w));
                    *(u32x4*)(O + r * 2048 + col0 + bj * HALF) = w; } }
    }
};
struct EpiResid {
    static constexpr bool PERM = true, AFTER_DRAIN = false, HOOK = false, RSLDS = false; static constexpr int HOOK_T = -1;
    const float* Xf; bf16_t* XB; float* RS;
    __device__ __forceinline__ void hook(f32x4 (&)[2][2][4][2], const Unit&, int, int, int, int) const {}
    __device__ __forceinline__ void tail_(f32x4 x0, f32x4 x1, float& ss, bf16_t* dst) const {
        ss += ((x0[0] * x0[0] + x0[1] * x0[1]) + (x0[2] * x0[2] + x0[3] * x0[3])) + ((x1[0] * x1[0] + x1[1] * x1[1]) + (x1[2] * x1[2] + x1[3] * x1[3]));
        u32x4 o; o.x = cvt_pk_bf16(x0[0], x0[1]); o.y = cvt_pk_bf16(x0[2], x0[3]); o.z = cvt_pk_bf16(x1[0], x1[1]); o.w = cvt_pk_bf16(x1[2], x1[3]);
        *(u32x4*)dst = o;
    }
    __device__ __forceinline__ void operator()(const f32x4 (&acc)[2][2][4][2], const Unit& u, int wr, int wc, int fr, int fq) const {
        const int row0 = u.pm * BM + wr * 64 + fr, col0 = u.pn * BM + wc * 32 + 8 * fq;
        if (Xf) {
#pragma unroll
            for (int ai = 0; ai < 2; ++ai) { f32x4 xo[4][2][2];
#pragma unroll
                for (int m = 0; m < 4; ++m)
#pragma unroll
                    for (int bj = 0; bj < 2; ++bj) { const float* p = Xf + (size_t)(row0 + ai * HALF + m * 16) * 2048 + col0 + bj * HALF; xo[m][bj][0] = *(const f32x4*)p; xo[m][bj][1] = *(const f32x4*)(p + 4); }
#pragma unroll
                for (int m = 0; m < 4; ++m) { const size_t ro = (size_t)(row0 + ai * HALF + m * 16) * 2048 + col0; float ss = 0.f;
#pragma unroll
                    for (int bj = 0; bj < 2; ++bj) tail_(xo[m][bj][0] + acc[ai][bj][m][0], xo[m][bj][1] + acc[ai][bj][m][1], ss, XB + ro + bj * HALF);
                    ss += __shfl_xor(ss, 16); ss += __shfl_xor(ss, 32);
                    if (fq == 0) unsafeAtomicAdd(RS + row0 + ai * HALF + m * 16, ss); } }
        } else {
            u32x4 xw[2][4][2];
#pragma unroll
            for (int ai = 0; ai < 2; ++ai)
#pragma unroll
                for (int m = 0; m < 4; ++m)
#pragma unroll
                    for (int bj = 0; bj < 2; ++bj) xw[ai][m][bj] = *(const u32x4*)(XB + (size_t)(row0 + ai * HALF + m * 16) * 2048 + col0 + bj * HALF);
#pragma unroll
            for (int ai = 0; ai < 2; ++ai)
#pragma unroll
                for (int m = 0; m < 4; ++m) { const size_t ro = (size_t)(row0 + ai * HALF + m * 16) * 2048 + col0; float ss = 0.f;
#pragma unroll
                    for (int bj = 0; bj < 2; ++bj) { const u32x4 w = xw[ai][m][bj];
                        tail_((f32x4){bf_lo(w.x), bf_hi(w.x), bf_lo(w.y), bf_hi(w.y)} + acc[ai][bj][m][0], (f32x4){bf_lo(w.z), bf_hi(w.z), bf_lo(w.w), bf_hi(w.w)} + acc[ai][bj][m][1], ss, XB + ro + bj * HALF); }
                    ss += __shfl_xor(ss, 16); ss += __shfl_xor(ss, 32);
                    if (fq == 0) unsafeAtomicAdd(RS + row0 + ai * HALF + m * 16, ss); }
        }
    }
};
struct EpiSwiGLU {
    static constexpr bool PERM = true, AFTER_DRAIN = false, HOOK = false, RSLDS = true; static constexpr int HOOK_T = -1;
    bf16_t* H; const float* RS;
    __device__ __forceinline__ void hook(f32x4 (&)[2][2][4][2], const Unit&, int, int, int, int) const {}
    __device__ __forceinline__ void operator()(const f32x4 (&acc)[2][2][4][2], const Unit& u, int wr, int wc, int fr, int fq, const float (&rsv)[8]) const {
        const int row0 = u.pm * BM + wr * 64 + fr, col0 = u.pn * 128 + wc * 16 + 4 * fq;
#pragma unroll
        for (int ai = 0; ai < 2; ++ai) { if (u.pm * BM + ai * HALF >= E_MV) continue;
#pragma unroll
            for (int m = 0; m < 4; ++m) { bf16_t* rowp = H + (size_t)(row0 + ai * HALF + m * 16) * 5632 + col0; const float rs = rsqrtf(rsv[ai * 4 + m] * (1.0f / 2048.0f) + 1e-6f);
#pragma unroll
                for (int bj = 0; bj < 2; ++bj) { const f32x4 g = acc[ai][bj][m][0] * rs, up = acc[ai][bj][m][1] * rs; float h[4];
#pragma unroll
                    for (int e = 0; e < 4; ++e) h[e] = g[e] * __builtin_amdgcn_rcpf(1.0f + __expf(-g[e])) * up[e];
                    typedef unsigned u32x2v __attribute__((ext_vector_type(2))); u32x2v w; w.x = cvt_pk_bf16(h[0], h[1]); w.y = cvt_pk_bf16(h[2], h[3]);
                    *(u32x2v*)(rowp + bj * 64) = w; } } }
    }
};
template <class Epi, class Sched, bool ALIGN_EPI = false, bool SP2 = false>
__device__ __forceinline__ void gemm_phase(PG8_LAS unsigned char* lds, const Gemm g, const Sched& S, const Epi& E, int tid_in) {
    int tid_l = tid_in; asm volatile("" : "+v"(tid_l));
    const int tid = tid_l, wid = __builtin_amdgcn_readfirstlane(tid >> 6), lane = tid & 63, wr = wid >> 2, wc = wid & 3, fr = lane & 15, fq = lane >> 4;
    const int K = g.K, nt = K / BK;
    unsigned voffA[2], voffB[2];
#pragma unroll
    for (int i = 0; i < 2; ++i) { int R, C; stage_rc(tid * 16 + i * 8192, R, C); const int Rb = Epi::PERM ? ((R & ~31) + perm32(R & 31)) : R;
        voffA[i] = (unsigned)(R * K + C) * 2u; voffB[i] = (unsigned)(Rb * K + C) * 2u; }
    const size_t kstep = (size_t)(BK * 2);
    const size_t hstep = (size_t)HALF * K * 2;
    const size_t tstep = 2 * hstep;
    const unsigned ldsw = (unsigned)wid * 1024u;
    const int aoff = lds_byte(wr * 64 + fr, fq * 8), boff = lds_byte(wc * 32 + fr, fq * 8);
#define PG8_SA(b, h) (((b) * 2 + (h)) * HTB)
#define PG8_SB(b, h) ((4 + (b) * 2 + (h)) * HTB)
#define PG8_STAGE(bufoff, gbase, voff) do { _Pragma("unroll") for (int _i = 0; _i < 2; ++_i) \
        __builtin_amdgcn_global_load_lds((const unsigned*)((const char*)(gbase) + (voff)[_i]), (PG8_LAS unsigned*)(lds + (bufoff) + ldsw + _i * 8192), 16, 0, 0); } while (0)
#define PG8_LDA(dst, b, h) do { _Pragma("unroll") for (int m = 0; m < 4; ++m) _Pragma("unroll") for (int k = 0; k < 2; ++k) dst[m][k] = *(const PG8_LAS bf16x8*)(lds + PG8_SA(b, h) + aoff + m * 2048 + k * 1024); } while (0)
#define PG8_LDB(dst, b, h) do { _Pragma("unroll") for (int n = 0; n < 2; ++n) _Pragma("unroll") for (int k = 0; k < 2; ++k) dst[n][k] = *(const PG8_LAS bf16x8*)(lds + PG8_SB(b, h) + boff + n * 2048 + k * 1024); } while (0)
#define PG8_MMA(ai, bj, At, Bt) do { __builtin_amdgcn_s_setprio(1); _Pragma("unroll") for (int m = 0; m < 4; ++m) _Pragma("unroll") for (int n = 0; n < 2; ++n) _Pragma("unroll") for (int k = 0; k < 2; ++k) \
        acc[ai][bj][m][n] = __builtin_amdgcn_mfma_f32_16x16x32_bf16(Bt[n][k], At[m][k], acc[ai][bj][m][n], 0, 0, 0); __builtin_amdgcn_s_setprio(0); } while (0)
#define PG8_WAIT_V(n) asm volatile("s_waitcnt vmcnt(" #n ")" ::: "memory")
#define PG8_WAIT_L(n) asm volatile("s_waitcnt lgkmcnt(" #n ")" ::: "memory")
#define PG8_BAR __builtin_amdgcn_s_barrier()
#define PG8_SCHED __builtin_amdgcn_sched_barrier(0)
    Unit cur, nxt; int ui = 0;
    if (!S.next(0, cur)) return;
    f32x4 acc[2][2][4][2];
#pragma unroll
    for (int a = 0; a < 2; ++a)
#pragma unroll
        for (int b = 0; b < 2; ++b)
#pragma unroll
            for (int m = 0; m < 4; ++m)
#pragma unroll
                for (int n = 0; n < 2; ++n) acc[a][b][m][n] = (f32x4){0.f, 0.f, 0.f, 0.f};
    bf16x8 At[4][2], B0[2][2], B1[2][2];
    const char* cA = (const char*)g.A + (size_t)cur.pm * tstep; const char* cB = (const char*)g.Bt + (size_t)cur.pn * tstep;
    S.a_ready(cur);
#define PG8_RSDMA(pm_, par_) __builtin_amdgcn_global_load_lds((const unsigned*)(E.RS + (pm_) * BM + wid * 64 + ((fq << 4) | fr)), (PG8_LAS unsigned*)(lds + 131072 + (par_) * 1024 + wid * 256), 4, 0, 0)
    if constexpr (Epi::RSLDS) { if (wid < 4) PG8_RSDMA(cur.pm, 0); }
    if constexpr (SP2) {
        PG8_STAGE(PG8_SB(0, 0), cB, voffB); PG8_STAGE(PG8_SB(0, 1), cB + hstep, voffB); PG8_STAGE(PG8_SA(0, 0), cA, voffA); PG8_STAGE(PG8_SA(0, 1), cA + hstep, voffA);
        if (wr == 1) PG8_BAR;
        PG8_WAIT_V(2); PG8_BAR;
        PG8_STAGE(PG8_SB(1, 0), cB + kstep, voffB); PG8_STAGE(PG8_SA(1, 0), cA + kstep, voffA); PG8_STAGE(PG8_SB(1, 1), cB + hstep + kstep, voffB);
        PG8_WAIT_V(6); PG8_BAR;
    } else {
        PG8_STAGE(PG8_SB(0, 0), cB, voffB); PG8_STAGE(PG8_SA(0, 0), cA, voffA); PG8_STAGE(PG8_SB(0, 1), cB + hstep, voffB); PG8_STAGE(PG8_SA(0, 1), cA + hstep, voffA);
        if (wr == 1) PG8_BAR;
        PG8_WAIT_V(4); PG8_BAR;
        PG8_STAGE(PG8_SB(1, 0), cB + kstep, voffB); PG8_STAGE(PG8_SA(1, 0), cA + kstep, voffA); PG8_STAGE(PG8_SB(1, 1), cB + hstep + kstep, voffB);
        PG8_WAIT_V(6); PG8_BAR;
    }
    for (;;) {
        const bool has_next = S.next(ui + 1, nxt);
        const char* nA = has_next ? (const char*)g.A + (size_t)nxt.pm * tstep : cA; const char* nB = has_next ? (const char*)g.Bt + (size_t)nxt.pn * tstep : cB;
        for (int t = 0; t < nt; t += 2) {
            const bool last = (t == nt - 2);
            const char* a1 = cA + (size_t)(t + 1) * kstep;
            const char* a2 = last ? nA : cA + (size_t)(t + 2) * kstep; const char* b2 = last ? nB : cB + (size_t)(t + 2) * kstep;
            const char* a3 = a2 + kstep; const char* b3 = b2 + kstep;
            if (last && has_next) S.a_ready(nxt);
            if constexpr (Epi::HOOK) { if (t == Epi::HOOK_T) E.hook(acc, cur, wr, wc, fr, fq); }
            if constexpr (SP2) {
            PG8_LDB(B0, 0, 0); PG8_LDB(B1, 0, 1); PG8_SCHED; PG8_LDA(At, 0, 0); PG8_STAGE(PG8_SA(1, 1), a1 + hstep, voffA);
            PG8_WAIT_V(8); PG8_WAIT_L(0); PG8_BAR; PG8_MMA(0, 0, At, B0); PG8_MMA(0, 1, At, B1); PG8_BAR; PG8_SCHED;
            PG8_LDA(At, 0, 1); PG8_STAGE(PG8_SB(0, 0), b2, voffB); PG8_STAGE(PG8_SB(0, 1), b2 + hstep, voffB); PG8_STAGE(PG8_SA(0, 0), a2, voffA);
            PG8_WAIT_V(8); PG8_WAIT_L(0); PG8_BAR; PG8_MMA(1, 0, At, B0); PG8_MMA(1, 1, At, B1); PG8_BAR; PG8_SCHED;
            PG8_LDB(B0, 1, 0); PG8_LDB(B1, 1, 1); PG8_SCHED; PG8_LDA(At, 1, 0); PG8_STAGE(PG8_SA(0, 1), a2 + hstep, voffA);
            PG8_WAIT_V(8); PG8_WAIT_L(0); PG8_BAR; PG8_MMA(0, 0, At, B0); PG8_MMA(0, 1, At, B1); PG8_BAR; PG8_SCHED;
            PG8_LDA(At, 1, 1); PG8_STAGE(PG8_SB(1, 0), b3, voffB); PG8_STAGE(PG8_SB(1, 1), b3 + hstep, voffB); PG8_STAGE(PG8_SA(1, 0), a3, voffA);
            PG8_WAIT_V(8); PG8_WAIT_L(0); PG8_BAR; PG8_MMA(1, 0, At, B0); PG8_MMA(1, 1, At, B1); PG8_BAR; PG8_SCHED;
            } else {
            PG8_LDB(B0, 0, 0); PG8_SCHED; PG8_LDA(At, 0, 0); PG8_STAGE(PG8_SA(1, 1), a1 + hstep, voffA);
            PG8_WAIT_L(8); PG8_BAR; PG8_WAIT_L(0); PG8_MMA(0, 0, At, B0); PG8_BAR; PG8_SCHED;
            PG8_LDB(B1, 0, 1); PG8_STAGE(PG8_SB(0, 0), b2, voffB);
            PG8_BAR; PG8_WAIT_L(0); PG8_MMA(0, 1, At, B1); PG8_BAR;
            PG8_LDA(At, 0, 1); PG8_STAGE(PG8_SA(0, 0), a2, voffA);
            PG8_BAR; PG8_WAIT_L(0); PG8_MMA(1, 0, At, B0); PG8_BAR; PG8_SCHED;
            PG8_STAGE(PG8_SB(0, 1), b2 + hstep, voffB);
            PG8_WAIT_V(6); PG8_BAR; PG8_MMA(1, 1, At, B1); PG8_BAR;
            PG8_LDB(B0, 1, 0); PG8_SCHED; PG8_LDA(At, 1, 0); PG8_STAGE(PG8_SA(0, 1), a2 + hstep, voffA);
            PG8_WAIT_L(8); PG8_BAR; PG8_WAIT_L(0); PG8_MMA(0, 0, At, B0); PG8_BAR; PG8_SCHED;
            PG8_LDB(B1, 1, 1); PG8_STAGE(PG8_SB(1, 0), b3, voffB);
            PG8_BAR; PG8_WAIT_L(0); PG8_MMA(0, 1, At, B1); PG8_BAR;
            PG8_LDA(At, 1, 1); PG8_STAGE(PG8_SA(1, 0), a3, voffA);
            PG8_BAR; PG8_WAIT_L(0); PG8_MMA(1, 0, At, B0); PG8_BAR; PG8_SCHED;
            PG8_STAGE(PG8_SB(1, 1), b3 + hstep, voffB);
            PG8_WAIT_V(6); PG8_BAR; PG8_MMA(1, 1, At, B1); PG8_BAR;
            }
        }
        if constexpr (ALIGN_EPI) { if (wr == 0) PG8_BAR; }
        if constexpr (!Epi::AFTER_DRAIN) {
            if constexpr (Epi::RSLDS) { float rsv[8]; const PG8_LAS float* rsl = (const PG8_LAS float*)(lds + 131072 + (ui & 1) * 1024) + wr * 64 + fr;
#pragma unroll
                for (int q = 0; q < 8; ++q) rsv[q] = rsl[(q >> 2) * HALF + (q & 3) * 16];
                asm volatile("s_waitcnt lgkmcnt(0)" : "+v"(rsv[0]), "+v"(rsv[1]), "+v"(rsv[2]), "+v"(rsv[3]), "+v"(rsv[4]), "+v"(rsv[5]), "+v"(rsv[6]), "+v"(rsv[7]) :: "memory");
                if (has_next && wid < 4) PG8_RSDMA(nxt.pm, (ui + 1) & 1);
                E(acc, cur, wr, wc, fr, fq, rsv);
            } else E(acc, cur, wr, wc, fr, fq);
            S.done(cur); }
        if (!has_next) break;
#pragma unroll
        for (int a = 0; a < 2; ++a)
#pragma unroll
            for (int b = 0; b < 2; ++b)
#pragma unroll
                for (int m = 0; m < 4; ++m)
#pragma unroll
                    for (int n = 0; n < 2; ++n) acc[a][b][m][n] = (f32x4){0.f, 0.f, 0.f, 0.f};
        cur = nxt; cA = nA; cB = nB; ++ui;
        if constexpr (ALIGN_EPI) { if (wr == 1) PG8_BAR; }
    }
    PG8_WAIT_V(0);
    if constexpr (!ALIGN_EPI) { if (wr == 0) PG8_BAR; }
    PG8_BAR;
    if constexpr (Epi::AFTER_DRAIN) { E.fused(acc, cur, wr, wc, fr, fq, lds, wid, lane); S.done(cur); }
#undef PG8_RSDMA
#undef PG8_SA
#undef PG8_SB
#undef PG8_STAGE
#undef PG8_LDA
#undef PG8_LDB
#undef PG8_MMA
#undef PG8_WAIT_V
#undef PG8_WAIT_L
#undef PG8_BAR
#undef PG8_SCHED
}
}
#define GAS __attribute__((address_space(1)))
#define LAS __attribute__((address_space(3)))
typedef unsigned short bf16;
typedef unsigned v4u __attribute__((ext_vector_type(4)));
typedef float f32x4 __attribute__((ext_vector_type(4)));
typedef short bf16x8 __attribute__((ext_vector_type(8)));
typedef GAS unsigned gu32;
typedef GAS unsigned long long gu64;
#define RLX_AGENT __ATOMIC_RELAXED, __HIP_MEMORY_SCOPE_AGENT
#define LDS_WAIT() asm volatile("s_waitcnt lgkmcnt(0)" ::: "memory")
#define VM_WAIT() asm volatile("s_waitcnt vmcnt(0)" ::: "memory")
__device__ __forceinline__ unsigned long long rt() { return __builtin_amdgcn_s_memrealtime(); }
__device__ __forceinline__ unsigned f2bf(float f) { unsigned u = __builtin_bit_cast(unsigned, f); return (u + 0x7fffu + ((u >> 16) & 1u)) >> 16; }
__device__ __forceinline__ unsigned pk2(float lo, float hi) { return f2bf(lo) | (f2bf(hi) << 16); }

#define XB_TMO      128
#define XB_XCNT(j)  (256  + 64 * (j))
#define XB_XSUB(j)  (1280 + 64 * (j))
#define XB_XGEN(j)  (2304 + 64 * (j))
#define XB_TOP      3328
#define XB_TOPGEN   3392
#define XCD_BAR_WORDS 3456
#define XB_SPIN_CAP (1u << 18)

__device__ __forceinline__ unsigned xb_ld(unsigned* p)              { return __hip_atomic_load(p, __ATOMIC_RELAXED, __HIP_MEMORY_SCOPE_AGENT); }
__device__ __forceinline__ unsigned xb_add(unsigned* p, unsigned v) { return __hip_atomic_fetch_add(p, v, __ATOMIC_RELAXED, __HIP_MEMORY_SCOPE_AGENT); }
__device__ __forceinline__ unsigned xb_xcc_id() { return (unsigned)__builtin_amdgcn_s_getreg((3 << 11) | 20) & 0xFu; }
#define XB_SPIN(cond, bar) do { unsigned _sp = 0; while (cond) { __builtin_amdgcn_s_sleep(1); \
    if ((++_sp & 255u) == 0u) { if (xb_ld(&(bar)[XB_TMO])) break; if (_sp > XB_SPIN_CAP) { atomicAdd(&(bar)[XB_TMO], 1u); break; } } } } while (0)

struct XcdBarrier {
    unsigned* bar; unsigned x;
    volatile LAS unsigned* st;
};

__device__ __forceinline__ XcdBarrier xcd_barrier_post(unsigned* bar, volatile LAS unsigned* st) {
    XcdBarrier b; b.bar = bar; b.x = xb_xcc_id(); b.st = st;
    if (threadIdx.x == 0) (void)xb_add(&bar[XB_XCNT(b.x)], 1u);
    return b;
}
__device__ __forceinline__ void xcd_barrier_complete(unsigned* bar, unsigned x, unsigned& nloc, unsigned& nx) {
    const unsigned G = gridDim.x * gridDim.y * gridDim.z;
    unsigned sum, cnt, mine, sp = 0u;
    for (;;) {
        sum = 0u; cnt = 0u; mine = 0u;
#pragma unroll
        for (unsigned j = 0; j < 16; ++j) { const unsigned c = xb_ld(&bar[XB_XCNT(j)]); sum += c; cnt += (c > 0u) ? 1u : 0u; mine = (j == x) ? c : mine; }
        if (sum == G) break;
        __builtin_amdgcn_s_sleep(1);
        if ((++sp & 255u) == 0u) { if (xb_ld(&bar[XB_TMO])) break; if (sp > XB_SPIN_CAP) { atomicAdd(&bar[XB_TMO], 1u); break; } }
    }
    nloc = mine > 0u ? mine : 1u; nx = cnt > 0u ? cnt : 1u;
}

__device__ __forceinline__ void xcd_barrier(const XcdBarrier& b) {
    asm volatile("s_waitcnt vmcnt(0)" ::: "memory");
    __syncthreads();
    if (threadIdx.x == 0) {
        unsigned* bar = b.bar;
        __builtin_amdgcn_s_waitcnt(0);
        unsigned nloc = b.st[0], nx = b.st[1];
        if (nloc == 0u) { xcd_barrier_complete(bar, b.x, nloc, nx); b.st[0] = nloc; b.st[1] = nx; }
        const unsigned old = xb_add(&bar[XB_XSUB(b.x)], 1u);
        const unsigned gen = old / nloc;
        if (old + 1u == (gen + 1u) * nloc) {
            __builtin_amdgcn_fence(__ATOMIC_RELEASE, "agent");
            asm volatile("s_waitcnt vmcnt(0)" ::: "memory");
            const unsigned og = xb_add(&bar[XB_TOP], 1u);
            const unsigned tg = og / nx;
            if (og + 1u == (tg + 1u) * nx) xb_add(&bar[XB_TOPGEN], 1u);
            else XB_SPIN(xb_ld(&bar[XB_TOPGEN]) == tg, bar);
            __builtin_amdgcn_fence(__ATOMIC_ACQUIRE, "agent");
            xb_add(&bar[XB_XGEN(b.x)], 1u);
            asm volatile("s_waitcnt vmcnt(0)" ::: "memory");
        } else {
            XB_SPIN(xb_ld(&bar[XB_XGEN(b.x)]) == gen, bar);
            __builtin_amdgcn_fence(__ATOMIC_ACQUIRE, "agent");
            asm volatile("s_waitcnt vmcnt(0)" ::: "memory");
        }
    }
    __syncthreads();
}
typedef float f32x16 __attribute__((ext_vector_type(16)));
typedef unsigned u32x2 __attribute__((ext_vector_type(2)));
__device__ __forceinline__ float bf2f(bf16 v) { return __uint_as_float(((unsigned)v) << 16); }
__device__ __forceinline__ float bflo(unsigned w) { return __uint_as_float(w << 16); }
__device__ __forceinline__ float bfhi(unsigned w) { return __uint_as_float(w & 0xffff0000u); }
__device__ __forceinline__ float wave_sum(float v) {
#pragma unroll
    for (int o = 1; o < 64; o <<= 1) v += __shfl_xor(v, o);
    return v;
}
__device__ __forceinline__ float wave_max(float v) {
#pragma unroll
    for (int o = 1; o < 64; o <<= 1) v = fmaxf(v, __shfl_xor(v, o));
    return v;
}
__device__ __forceinline__ float siluf_(float x) { return x * __builtin_amdgcn_rcpf(1.0f + __expf(-x)); }
__device__ __forceinline__ float softplusf_(float x) { return x > 20.0f ? x : log1pf(__expf(x)); }

struct Args { const float* in[23]; float* out; unsigned char* ws; int ph_lo, ph_hi, use_bar, pad; };
typedef const __attribute__((address_space(4))) Args* KArgs;
struct Ctx { LAS unsigned char* lds; int tid, lane, wave, G, bid; KArgs a; };

__device__ __forceinline__ int lane_now() { int t; asm volatile("v_mbcnt_lo_u32_b32 %0, -1, 0\n\tv_mbcnt_hi_u32_b32 %0, -1, %0" : "=v"(t)); return t; }
struct TItem { const float* sp; const float* gn; bf16* WT; int ldn, rowl, K, k0, R0; };
__device__ __forceinline__ void titem_load(const TItem& t, f32x4 (&v)[16], f32x4 (&gv)[4], int) {
    const int kk = lane_now() >> 4;
    if (t.sp) {
#pragma unroll
        for (int i = 0; i < 16; ++i) v[i] = __builtin_nontemporal_load((const GAS f32x4*)(t.sp + (size_t)(t.k0 + 16 * kk + i) * t.ldn));
        if (t.gn) { const GAS f32x4* gp = (const GAS f32x4*)(t.gn + t.k0 + 16 * kk);
#pragma unroll
            for (int q = 0; q < 4; ++q) gv[q] = gp[q]; }
    } else {
#pragma unroll
        for (int i = 0; i < 16; ++i) { float z0 = 0.f; asm volatile("" : "+v"(z0)); v[i] = (f32x4){z0, z0, z0, z0}; }
    }
}
__device__ __forceinline__ void titem_store(const TItem& t, const f32x4 (&vin)[16], const f32x4 (&gv)[4], LAS unsigned short* T, int) {
    const int lane = lane_now(), kk = lane >> 4;
    LAS unsigned char* Tb = (LAS unsigned char*)T;
#pragma unroll
    for (int j = 0; j < 4; ++j) { const int n = t.rowl + j, sw = (n >> 2) & 7; v4u lo, hi;
#define TI_PK(a_) pg8::cvt_pk_bf16(vin[a_][j] * gv[(a_) >> 2].x, vin[(a_) + 1][j] * gv[(a_) >> 2].y)
#define TI_PK2(a_) pg8::cvt_pk_bf16(vin[a_][j] * gv[(a_) >> 2].z, vin[(a_) + 1][j] * gv[(a_) >> 2].w)
#define TI_PN(a_) pg8::cvt_pk_bf16(vin[a_][j], vin[(a_) + 1][j])
        if (t.gn && t.sp) { lo.x = TI_PK(0); lo.y = TI_PK2(2); lo.z = TI_PK(4); lo.w = TI_PK2(6); hi.x = TI_PK(8); hi.y = TI_PK2(10); hi.z = TI_PK(12); hi.w = TI_PK2(14); }
        else { lo.x = TI_PN(0); lo.y = TI_PN(2); lo.z = TI_PN(4); lo.w = TI_PN(6); hi.x = TI_PN(8); hi.y = TI_PN(10); hi.z = TI_PN(12); hi.w = TI_PN(14); }
#undef TI_PK
#undef TI_PK2
#undef TI_PN
        *(LAS v4u*)(Tb + n * 128 + (((2 * kk) ^ sw) << 4)) = lo; *(LAS v4u*)(Tb + n * 128 + (((2 * kk + 1) ^ sw) << 4)) = hi; }
    LDS_WAIT(); asm volatile("" ::: "memory");
    const int ch = lane & 7, nr = lane >> 3;
#pragma unroll
    for (int it = 0; it < 8; ++it) { const int n = nr + 8 * it;
        const v4u o = *(const LAS v4u*)(Tb + n * 128 + ((ch ^ ((n >> 2) & 7)) << 4));
        *(GAS v4u*)(t.WT + (size_t)(t.R0 + n) * t.K + t.k0 + 8 * ch) = o; }
    LDS_WAIT(); asm volatile("" ::: "memory");
}
constexpr int IT_IN = (DM / 64) * (NU / 64), IT_CAT = (KCAT / 64) * (DM / 64), IT_OUT = (DM / 64) * (DM / 64), IT_GU = (DM / 64) * (NGU / 64), IT_DN = (FF / 64) * (DM / 64);
constexpr int IT_LAYER = IT_IN + IT_CAT + IT_OUT + IT_GU + IT_DN;
__device__ __forceinline__ TItem titem_decode(const Ctx& C, int it) {
    const int c4 = lane_now() & 15, l = it / IT_LAYER; int q = it % IT_LAYER; TItem t;
    if (q < IT_IN) { const int nblk = NU / 64, kb = q / nblk, nb = q % nblk, R = 64 * nb + 4 * c4;
        const int col = R < 10240 ? R : (R < 17408 ? R + 64 : (R < 17472 ? 10240 + (R - 17408) : -1));
        t.sp = col >= 0 ? (C.a->in[7]) + (size_t)l * DM * IN_DIM + col : nullptr; t.gn = (C.a->in[6]) + (size_t)l * DM; t.ldn = IN_DIM; t.rowl = 4 * c4; t.K = DM; t.WT = ((bf16*)(C.a->ws + WS_WIN)) + (size_t)l * NU * DM; t.k0 = 64 * kb; t.R0 = 64 * nb; return t; }
    q -= IT_IN;
    if (q < IT_CAT) { const int nblk = DM / 64, kb = q / nblk, nb = q % nblk, R = 64 * nb + 4 * c4, k0 = 64 * kb;
        t.sp = k0 < DI ? (C.a->in[14]) + (size_t)l * DI * DM + R : (C.a->in[15]) + (size_t)l * DM * DM + R - (size_t)DI * DM;
        t.gn = nullptr; t.ldn = DM; t.rowl = 4 * c4; t.K = KCAT; t.WT = ((bf16*)(C.a->ws + WS_WCAT)) + (size_t)l * DM * KCAT; t.k0 = k0; t.R0 = 64 * nb; return t; }
    q -= IT_CAT;
    if (q < IT_OUT) { const int nblk = DM / 64, kb = q / nblk, nb = q % nblk, R = 64 * nb + 4 * c4;
        t.sp = (C.a->in[17]) + (size_t)l * DM * DM + R; t.gn = nullptr; t.ldn = DM; t.rowl = 4 * c4; t.K = DM; t.WT = ((bf16*)(C.a->ws + WS_WOUT)) + (size_t)l * DM * DM; t.k0 = 64 * kb; t.R0 = 64 * nb; return t; }
    q -= IT_OUT;
    if (q < IT_GU) { const int nblk = NGU / 64, kb = q / nblk, nb = q % nblk;
        const int up = c4 >> 3, cg = c4 & 7;
        t.sp = (up ? (C.a->in[20]) : (C.a->in[19])) + (size_t)l * DM * FF + 32 * nb + 4 * cg; t.gn = (C.a->in[18]) + (size_t)l * DM; t.ldn = FF; t.rowl = 8 * cg + 4 * up; t.K = DM; t.WT = ((bf16*)(C.a->ws + WS_WGU)) + (size_t)l * NGU * DM; t.k0 = 64 * kb; t.R0 = 64 * nb; return t; }
    q -= IT_GU;
    { const int nblk = DM / 64, kb = q / nblk, nb = q % nblk, R = 64 * nb + 4 * c4;
        t.sp = (C.a->in[21]) + (size_t)l * FF * DM + R; t.gn = nullptr; t.ldn = DM; t.rowl = 4 * c4; t.K = FF; t.WT = ((bf16*)(C.a->ws + WS_WDN)) + (size_t)l * DM * FF; t.k0 = 64 * kb; t.R0 = 64 * nb; return t; }
}
__device__ __forceinline__ void p0_weights(const Ctx& C, int it_lo, int it_hi, int gw, int NGW) {
    LAS unsigned short* T = (LAS unsigned short*)(C.lds + RING_OFF + C.wave * 16384);
    int it = it_lo + gw; if (it >= it_hi) return;
    TItem cur = titem_decode(C, it); f32x4 va[16], vb[16], ga[4], gb[4];
    titem_load(cur, va, ga, C.lane);
    for (;;) {
        int nit = it + NGW; TItem nxt = cur; const bool hn = nit < it_hi;
        if (hn) { nxt = titem_decode(C, nit); titem_load(nxt, vb, gb, C.lane); }
        titem_store(cur, va, ga, T, C.lane);
        if (!hn) break;
        it = nit + NGW; cur = nxt; const bool hn2 = it < it_hi;
        if (hn2) { cur = titem_decode(C, it); titem_load(cur, va, ga, C.lane); }
        titem_store(nxt, vb, gb, T, C.lane);
        if (!hn2) break;
    }
}
__device__ __forceinline__ void norm_row(const float* src, const float* gain, float* xcopy, bf16* xb, float* rs, float* fdst, int lane) {
    const GAS f32x4* xr = (const GAS f32x4*)src + lane;
    f32x4 v[8]; float s = 0.f;
#pragma unroll
    for (int j = 0; j < 8; ++j) { v[j] = xr[64 * j]; s += (v[j].x * v[j].x + v[j].y * v[j].y) + (v[j].z * v[j].z + v[j].w * v[j].w); }
    s = wave_sum(s);
    if (rs && lane == 0) *rs = s;
    if (xcopy) { GAS f32x4* xc = (GAS f32x4*)xcopy + lane;
#pragma unroll
        for (int j = 0; j < 8; ++j) xc[64 * j] = v[j]; }
    if (xb) {
#pragma unroll
        for (int j = 0; j < 8; ++j) { u32x2 w; w.x = pk2(v[j].x, v[j].y); w.y = pk2(v[j].z, v[j].w); *((GAS u32x2*)xb + lane + 64 * j) = w; } }
    if (fdst) { const float rstd = rsqrtf(s * (1.0f / DM) + EPS); const GAS f32x4* gr = (const GAS f32x4*)gain + lane;
#pragma unroll
        for (int j = 0; j < 8; ++j) { const f32x4 g = gr[64 * j]; f32x4 o = v[j] * rstd; o = o * g; *((GAS f32x4*)fdst + lane + 64 * j) = o; } }
}
__device__ __forceinline__ void p0_xinit(const Ctx& C) {
    const int NGW = C.G * NWAVES, gw = NGW - 1 - (C.bid * NWAVES + C.wave), lane = C.lane;
    int m = gw; if (m >= MV) return;
    f32x4 v[8], w[8];
#define XI_SRC(m_) ((const GAS f32x4*)((m_) < SEQ ? (C.a->in[0]) + (size_t)(m_) * DM : (C.a->in[1]) + (size_t)((m_) - SEQ) * DM) + lane)
    { const GAS f32x4* xr = XI_SRC(m);
#pragma unroll
      for (int j = 0; j < 8; ++j) v[j] = xr[64 * j]; }
    for (;;) {
        const int mn = m + NGW; const bool hn = mn < MV;
        if (hn) { const GAS f32x4* xr = XI_SRC(mn);
#pragma unroll
            for (int j = 0; j < 8; ++j) w[j] = xr[64 * j]; }
        __builtin_amdgcn_sched_barrier(0);
        float s = 0.f;
#pragma unroll
        for (int j = 0; j < 8; ++j) s += (v[j].x * v[j].x + v[j].y * v[j].y) + (v[j].z * v[j].z + v[j].w * v[j].w);
        s = wave_sum(s);
        if (lane == 0) ((float*)(C.a->ws + WS_RSA))[m] = s;
        if (m >= SEQ) { GAS f32x4* xc = (GAS f32x4*)(((float*)(C.a->ws + WS_X)) + (size_t)m * DM) + lane;
#pragma unroll
            for (int j = 0; j < 8; ++j) xc[64 * j] = v[j]; }
        { bf16* xb = ((bf16*)(C.a->ws + WS_XN)) + (size_t)m * DM;
#pragma unroll
          for (int j = 0; j < 8; ++j) { u32x2 o; o.x = pg8::cvt_pk_bf16(v[j].x, v[j].y); o.y = pg8::cvt_pk_bf16(v[j].z, v[j].w); *((GAS u32x2*)xb + lane + 64 * j) = o; } }
        if (!hn) break;
        m = mn;
#pragma unroll
        for (int j = 0; j < 8; ++j) v[j] = w[j];
    }
#undef XI_SRC
}
__device__ __forceinline__ void sample_rows_phase(const Ctx& C, float* RS) {
    const int gw = C.bid * NWAVES + C.wave, NGW = C.G * NWAVES;
    for (int m = SEQ + gw; m < MV; m += NGW) norm_row(((float*)(C.a->ws + WS_X)) + (size_t)m * DM, nullptr, nullptr, ((bf16*)(C.a->ws + WS_XN)) + (size_t)m * DM, RS + m, nullptr, C.lane);
}
__device__ __forceinline__ void final_norm_phase(const Ctx& C) {
    const int gw = C.bid * NWAVES + C.wave, NGW = C.G * NWAVES, lane = C.lane;
    f32x4 gv[8];
    { const GAS f32x4* gr = (const GAS f32x4*)(C.a->in[22]) + 2 * lane;
#pragma unroll
      for (int j = 0; j < 4; ++j) { gv[2 * j] = gr[128 * j]; gv[2 * j + 1] = gr[128 * j + 1]; } }
    for (int m = gw; m < MV; m += NGW) {
        if (m >= SEQ) { norm_row(((float*)(C.a->ws + WS_X)) + (size_t)m * DM, (C.a->in[22]), nullptr, nullptr, nullptr, (C.a->out) + O_YP + (size_t)m * DM, lane); continue; }
        const GAS v4u* xr = (const GAS v4u*)(((bf16*)(C.a->ws + WS_XN)) + (size_t)m * DM) + lane; v4u w[4]; float s = 0.f;
#pragma unroll
        for (int j = 0; j < 4; ++j) { w[j] = xr[64 * j]; const float a0 = bflo(w[j].x), a1 = bfhi(w[j].x), a2 = bflo(w[j].y), a3 = bfhi(w[j].y), a4 = bflo(w[j].z), a5 = bfhi(w[j].z), a6 = bflo(w[j].w), a7 = bfhi(w[j].w);
            s += ((a0 * a0 + a1 * a1) + (a2 * a2 + a3 * a3)) + ((a4 * a4 + a5 * a5) + (a6 * a6 + a7 * a7)); }
        const float rstd = rsqrtf(wave_sum(s) * (1.0f / DM) + EPS);
        GAS f32x4* op = (GAS f32x4*)((C.a->out) + O_YP + (size_t)m * DM) + 2 * lane;
#pragma unroll
        for (int j = 0; j < 4; ++j) { const f32x4 g0 = gv[2 * j], g1 = gv[2 * j + 1];
            op[128 * j] = (f32x4){bflo(w[j].x) * rstd * g0.x, bfhi(w[j].x) * rstd * g0.y, bflo(w[j].y) * rstd * g0.z, bfhi(w[j].y) * rstd * g0.w};
            op[128 * j + 1] = (f32x4){bflo(w[j].z) * rstd * g1.x, bfhi(w[j].z) * rstd * g1.y, bflo(w[j].w) * rstd * g1.z, bfhi(w[j].w) * rstd * g1.w}; }
    }
}
__device__ __forceinline__ void zero_f32(const Ctx& C, float* p, int n, int vb, int nvb) { float z0 = 0.f; asm volatile("" : "+v"(z0)); for (int i = vb * 512 + C.tid; i < n; i += nvb * 512) p[i] = z0; }

__device__ __forceinline__ void sample_ssd_wave_unit(const Ctx& C, int l, int b, int g, LAS float* wsc) {
    const int lane = lane_now();
    const int row = SEQ + b, n4 = lane & 31, prh = lane >> 5;
    LAS float* xs = wsc; LAS float* Bs = wsc + 512; LAS float* ys = wsc + 768;
    const float* cw = (C.a->in[8]) + (size_t)l * CW * CD; const float* cb = (C.a->in[9]) + (size_t)l * CD;
    const float* sc = (C.a->in[3]) + ((size_t)l * NB + b) * 3 * CD; const bf16* U = ((bf16*)(C.a->ws + WS_U));
    { const int ch = g * 512 + 8 * lane; const v4u un = *(const GAS v4u*)(U + UIDX(row, UXBC + ch)); const float nv[8] = {bflo(un.x), bfhi(un.x), bflo(un.y), bfhi(un.y), bflo(un.z), bfhi(un.z), bflo(un.w), bfhi(un.w)};
#pragma unroll
      for (int q = 0; q < 2; ++q) { const f32x4 bb = *(const GAS f32x4*)(cb + ch + 4 * q), w0 = *(const GAS f32x4*)(cw + ch + 4 * q), w1 = *(const GAS f32x4*)(cw + CD + ch + 4 * q), w2 = *(const GAS f32x4*)(cw + 2 * CD + ch + 4 * q), w3 = *(const GAS f32x4*)(cw + 3 * CD + ch + 4 * q);
          const f32x4 s0 = *(const GAS f32x4*)(sc + ch + 4 * q), s1 = *(const GAS f32x4*)(sc + CD + ch + 4 * q), s2 = *(const GAS f32x4*)(sc + 2 * CD + ch + 4 * q);
          f32x4 o;
#pragma unroll
          for (int e = 0; e < 4; ++e) o[e] = siluf_(bb[e] + w0[e] * s0[e] + w1[e] * s1[e] + w2[e] * s2[e] + w3[e] * nv[4 * q + e]);
          *(LAS f32x4*)(xs + 8 * lane + 4 * q) = o; } }
    { const int ch = (lane < 32 ? DI + g * 128 : DI + 1024 + g * 128 - 128) + 4 * lane;
      const u32x2 un = *(const GAS u32x2*)(U + UIDX(row, UXBC + ch)); const float nv[4] = {bflo(un.x), bfhi(un.x), bflo(un.y), bfhi(un.y)};
      const f32x4 bb = *(const GAS f32x4*)(cb + ch), w0 = *(const GAS f32x4*)(cw + ch), w1 = *(const GAS f32x4*)(cw + CD + ch), w2 = *(const GAS f32x4*)(cw + 2 * CD + ch), w3 = *(const GAS f32x4*)(cw + 3 * CD + ch);
      const f32x4 s0 = *(const GAS f32x4*)(sc + ch), s1 = *(const GAS f32x4*)(sc + CD + ch), s2 = *(const GAS f32x4*)(sc + 2 * CD + ch);
      f32x4 o;
#pragma unroll
      for (int e = 0; e < 4; ++e) o[e] = siluf_(bb[e] + w0[e] * s0[e] + w1[e] * s1[e] + w2[e] * s2[e] + w3[e] * nv[e]);
      *(LAS f32x4*)(Bs + 4 * lane) = o; }
    LDS_WAIT(); asm volatile("" ::: "memory");
    const f32x4 Bv = *((const LAS f32x4*)Bs + n4), Cv = *((const LAS f32x4*)(Bs + 128) + n4);
    const size_t sbase = (((size_t)l * NB + b) * NH + 8 * g) * HP * DS;
    for (int j = 0; j < 8; ++j) { const int h = 8 * g + j;
        const GAS f32x4* sp = (const GAS f32x4*)((C.a->in[2]) + sbase + (size_t)j * HP * DS + (size_t)prh * DS) + n4;
        GAS f32x4* op = (GAS f32x4*)((C.a->out) + O_SSSM + sbase + (size_t)j * HP * DS + (size_t)prh * DS) + n4;
        f32x4 hv[32];
#pragma unroll
        for (int i = 0; i < 32; ++i) hv[i] = __builtin_nontemporal_load(sp + (size_t)i * (2 * DS / 4));
        const float dt = ((float*)(C.a->ws + WS_DT))[(size_t)row * 64 + h], dA = __expf(-__expf((C.a->in[11])[l * NH + h]) * dt), Dh = (C.a->in[12])[l * NH + h];
#pragma unroll
        for (int i = 0; i < 32; ++i) { const int p = prh + 2 * i; const float xv = xs[j * 64 + p], dtx = dt * xv; const f32x4 h0 = hv[i];
            f32x4 hn; hn.x = dA * h0.x + dtx * Bv.x; hn.y = dA * h0.y + dtx * Bv.y; hn.z = dA * h0.z + dtx * Bv.z; hn.w = dA * h0.w + dtx * Bv.w;
            __builtin_nontemporal_store(hn, op + (size_t)i * (2 * DS / 4));
            float yp = (hn.x * Cv.x + hn.y * Cv.y) + (hn.z * Cv.z + hn.w * Cv.w);
#pragma unroll
            for (int o = 1; o < 32; o <<= 1) yp += __shfl_xor(yp, o);
            if (n4 == 0) ys[j * 64 + p] = yp + Dh * xv; }
    }
    LDS_WAIT(); asm volatile("" ::: "memory");
    { const int ch = g * 512 + 8 * lane; const v4u zw = *(const GAS v4u*)(U + UIDX(row, UZ + ch)); const f32x4 y0 = *(const LAS f32x4*)(ys + 8 * lane), y1 = *(const LAS f32x4*)(ys + 8 * lane + 4);
      float gv[8] = {y0.x * bflo(zw.x), y0.y * bfhi(zw.x), y0.z * bflo(zw.y), y0.w * bfhi(zw.y), y1.x * bflo(zw.z), y1.y * bfhi(zw.z), y1.z * bflo(zw.w), y1.w * bfhi(zw.w)};
      float ss = 0.f;
#pragma unroll
      for (int e = 0; e < 8; ++e) ss += gv[e] * gv[e];
      const float rstd = rsqrtf(wave_sum(ss) * (1.0f / 512.0f) + EPS);
      const f32x4 n0 = *(const GAS f32x4*)((C.a->in[13]) + (size_t)l * DI + ch), n1 = *(const GAS f32x4*)((C.a->in[13]) + (size_t)l * DI + ch + 4);
      v4u o; o.x = pk2(gv[0] * rstd * n0.x, gv[1] * rstd * n0.y); o.y = pk2(gv[2] * rstd * n0.z, gv[3] * rstd * n0.w); o.z = pk2(gv[4] * rstd * n1.x, gv[5] * rstd * n1.y); o.w = pk2(gv[6] * rstd * n1.z, gv[7] * rstd * n1.w);
      *(GAS v4u*)(((bf16*)(C.a->ws + WS_YO)) + (size_t)row * KCAT + ch) = o; }
    LDS_WAIT(); asm volatile("" ::: "memory");
}

__device__ __forceinline__ void sample_attn_phase(const Ctx& C, int l) {
    const int tid = C.tid;
    constexpr int KP = 68;
    LAS float* Ks = (LAS float*)(C.lds + RING_OFF); LAS float* Vs = Ks + 128 * KP; LAS float* qs = Vs + 128 * KP; LAS float* sc = qs + 256; LAS float* knew = sc + 4 * 132; LAS float* vnew = knew + 64;
    const bf16* U = ((bf16*)(C.a->ws + WS_U));
    f32x4 kv[4], vv[4]; float qx = 0.f;
#define SA_LOAD(u_) do { const int b_ = (u_) >> 3, kh_ = (u_) & 7, row_ = SEQ + b_; const size_t cb_ = ((size_t)l * NB + b_) * WIN * (KVH * AD) + (size_t)kh_ * AD; \
        _Pragma("unroll") for (int i = 0; i < 4; ++i) { const int idx = tid + 512 * i, w = idx >> 4, c4 = idx & 15; \
            kv[i] = __builtin_nontemporal_load((const GAS f32x4*)((C.a->in[4]) + cb_ + (size_t)w * (KVH * AD)) + c4); vv[i] = __builtin_nontemporal_load((const GAS f32x4*)((C.a->in[5]) + cb_ + (size_t)w * (KVH * AD)) + c4); } \
        if (tid < 256) qx = bf2f(U[UIDX(row_, UQ + kh_ * 256 + tid)]); else if (tid < 320) qx = bf2f(U[UIDX(row_, UK + kh_ * 64 + (tid - 256))]); else if (tid < 384) qx = bf2f(U[UIDX(row_, UV + kh_ * 64 + (tid - 320))]); } while (0)
    int u = C.bid; if (u >= NB * KVH) return;
    SA_LOAD(u);
    for (; u < NB * KVH; u += C.G) {
        const int b = u >> 3, kh = u & 7, row = SEQ + b;
        const size_t cbase = ((size_t)l * NB + b) * WIN * (KVH * AD) + (size_t)kh * AD;
        if (tid < 256) qs[tid] = qx; else if (tid < 320) knew[tid - 256] = qx; else if (tid < 384) vnew[tid - 320] = qx;
#pragma unroll
        for (int i = 0; i < 4; ++i) { const int idx = tid + 512 * i, w = idx >> 4, c4 = idx & 15; *((LAS f32x4*)(Ks + w * KP) + c4) = kv[i]; *((LAS f32x4*)(Vs + w * KP) + c4) = vv[i]; }
        __syncthreads();
        if (u + C.G < NB * KVH) SA_LOAD(u + C.G);
        if (tid < 16) { *((GAS f32x4*)((C.a->out) + O_SK + cbase + (size_t)(WIN - 1) * (KVH * AD)) + tid) = *((const LAS f32x4*)knew + tid); }
        else if (tid < 32) { *((GAS f32x4*)((C.a->out) + O_SV + cbase + (size_t)(WIN - 1) * (KVH * AD)) + (tid - 16)) = *((const LAS f32x4*)vnew + (tid - 16)); }
        { const int w = tid >> 2, hq = tid & 3; const LAS f32x4* kp = (const LAS f32x4*)(Ks + w * KP); const LAS f32x4* qp = (const LAS f32x4*)(qs + hq * 64);
          float s = 0.f;
    #pragma unroll
          for (int c = 0; c < 16; ++c) { const f32x4 kv = kp[c], qv = qp[c]; s += (kv.x * qv.x + kv.y * qv.y) + (kv.z * qv.z + kv.w * qv.w); }
          sc[hq * 132 + w] = s * 0.125f; }
        if (tid < 4) { float s = 0.f;
          for (int d = 0; d < 64; ++d) s += qs[tid * 64 + d] * knew[d];
          sc[tid * 132 + 128] = s * 0.125f; }
        __syncthreads();
        if (C.wave < 4) { const int hq = C.wave; const float sink = (C.a->in[16])[l * AH + 4 * kh + hq];
          const float v0 = sc[hq * 132 + C.lane], v1 = sc[hq * 132 + 64 + C.lane], v2 = C.lane == 0 ? sc[hq * 132 + 128] : -__builtin_inff();
          const float m = fmaxf(wave_max(fmaxf(fmaxf(v0, v1), v2)), sink);
          const float e0 = __expf(v0 - m), e1 = __expf(v1 - m), e2 = C.lane == 0 ? __expf(v2 - m) : 0.f;
          const float inv = 1.0f / (wave_sum(e0 + e1 + e2) + __expf(sink - m));
          sc[hq * 132 + C.lane] = e0 * inv; sc[hq * 132 + 64 + C.lane] = e1 * inv; if (C.lane == 0) sc[hq * 132 + 128] = e2 * inv; }
        __syncthreads();
        if (tid < 256) { const int hq = tid >> 6, d = tid & 63; float o = sc[hq * 132 + 128] * vnew[d];
    #pragma unroll 16
          for (int w = 0; w < WIN; ++w) o += sc[hq * 132 + w] * Vs[w * KP + d];
          ((bf16*)(C.a->ws + WS_YO))[(size_t)row * KCAT + DI + (4 * kh + hq) * 64 + d] = (bf16)f2bf(o); }
        __syncthreads();
    }
#undef SA_LOAD
}

__device__ __forceinline__ void cache_shift(const Ctx& C, int l, int vb, int nvb) {
    constexpr int ROWF4 = (WIN - 1) * KVH * AD / 4;
    for (int u = vb; u < NB * 2; u += nvb) { const int b = u >> 1, kv = u & 1;
        const GAS f32x4* src = (const GAS f32x4*)((kv ? (C.a->in[5]) : (C.a->in[4])) + ((size_t)l * NB + b) * WIN * (KVH * AD) + KVH * AD);
        GAS f32x4* dst = (GAS f32x4*)((C.a->out) + (kv ? O_SV : O_SK) + ((size_t)l * NB + b) * WIN * (KVH * AD));
        for (int i = C.tid; i < ROWF4; i += 512 * 8) { f32x4 v[8];
#pragma unroll
            for (int j = 0; j < 8; ++j) if (i + 512 * j < ROWF4) v[j] = __builtin_nontemporal_load(src + i + 512 * j);
#pragma unroll
            for (int j = 0; j < 8; ++j) if (i + 512 * j < ROWF4) __builtin_nontemporal_store(v[j], dst + i + 512 * j); } }
}

__device__ __forceinline__ void copy_outs(const Ctx& C, int l, int vb, int nvb) {
    const bf16* U = ((bf16*)(C.a->ws + WS_U)); const int gt = vb * 512 + C.tid, NT = nvb * 512;
    for (int i = gt; i < WIN * KVH * AD / 8; i += NT) { const int w = i >> 6, c = (i & 63) * 8, ur = SEQ - WIN + w;
        const v4u kw = *(const GAS v4u*)(U + UIDX(ur, UK + c)), vw = *(const GAS v4u*)(U + UIDX(ur, UV + c));
        GAS f32x4* pk = (GAS f32x4*)((C.a->out) + O_PK + (size_t)l * WIN * KVH * AD + (size_t)w * (KVH * AD) + c); GAS f32x4* pv = (GAS f32x4*)((C.a->out) + O_PV + (size_t)l * WIN * KVH * AD + (size_t)w * (KVH * AD) + c);
        pk[0] = (f32x4){bflo(kw.x), bfhi(kw.x), bflo(kw.y), bfhi(kw.y)}; pk[1] = (f32x4){bflo(kw.z), bfhi(kw.z), bflo(kw.w), bfhi(kw.w)};
        pv[0] = (f32x4){bflo(vw.x), bfhi(vw.x), bflo(vw.y), bfhi(vw.y)}; pv[1] = (f32x4){bflo(vw.z), bfhi(vw.z), bflo(vw.w), bfhi(vw.w)}; }
    constexpr int C8 = CD / 8;
    for (int i = gt; i < 3 * C8; i += NT) { const int j = i / C8, ch = (i - j * C8) * 8; const v4u w = *(const GAS v4u*)(U + UIDX(SEQ - 3 + j, UXBC + ch));
        GAS f32x4* po = (GAS f32x4*)((C.a->out) + O_PCONV + (size_t)l * 3 * CD + (size_t)j * CD + ch);
        po[0] = (f32x4){bflo(w.x), bfhi(w.x), bflo(w.y), bfhi(w.y)}; po[1] = (f32x4){bflo(w.z), bfhi(w.z), bflo(w.w), bfhi(w.w)}; }
    for (int i = gt; i < NB * C8; i += NT) { const int b = i / C8, ch = (i - b * C8) * 8;
        const GAS f32x4* si = (const GAS f32x4*)((C.a->in[3]) + ((size_t)l * NB + b) * 3 * CD + ch); GAS f32x4* so = (GAS f32x4*)((C.a->out) + O_SCONV + ((size_t)l * NB + b) * 3 * CD + ch);
        const f32x4 r10 = si[CD / 4], r11 = si[CD / 4 + 1], r20 = si[2 * CD / 4], r21 = si[2 * CD / 4 + 1]; const v4u w = *(const GAS v4u*)(U + UIDX(SEQ + b, UXBC + ch));
        so[0] = r10; so[1] = r11; so[CD / 4] = r20; so[CD / 4 + 1] = r21;
        so[2 * CD / 4] = (f32x4){bflo(w.x), bfhi(w.x), bflo(w.y), bfhi(w.y)}; so[2 * CD / 4 + 1] = (f32x4){bflo(w.z), bfhi(w.z), bflo(w.w), bfhi(w.w)}; }
}
typedef float f32x2_t __attribute__((ext_vector_type(2))); typedef __bf16 bf16x2_t __attribute__((ext_vector_type(2)));
__device__ __forceinline__ unsigned cvtpk(float lo, float hi) { f32x2_t v = {lo, hi}; bf16x2_t b = __builtin_convertvector(v, bf16x2_t); return __builtin_bit_cast(unsigned, b); }
__device__ __forceinline__ int crow(int reg, int hh) { return (reg & 3) + 8 * (reg >> 2) + 4 * hh; }
#define MFMA32(a, b, c) __builtin_amdgcn_mfma_f32_32x32x16_bf16((a), (b), (c), 0, 0, 0)
__device__ __forceinline__ bf16x8 ld16(const bf16* p) { return *(const GAS bf16x8*)p; }
__device__ __forceinline__ bf16x8 ld8x2(const bf16* p) {
    const u32x2 lo = *(const GAS u32x2*)p, hi = *(const GAS u32x2*)(p + 8); v4u w; w.x = lo.x; w.y = lo.y; w.z = hi.x; w.w = hi.y; return __builtin_bit_cast(bf16x8, w); }
#define PACK8(X, s) __builtin_bit_cast(bf16x8, (v4u){cvtpk((X)[8 * (s)], (X)[8 * (s) + 1]), cvtpk((X)[8 * (s) + 2], (X)[8 * (s) + 3]), cvtpk((X)[8 * (s) + 4], (X)[8 * (s) + 5]), cvtpk((X)[8 * (s) + 6], (X)[8 * (s) + 7])})

__device__ __forceinline__ void reformat_conv_item(const Ctx& C, int l, int c, int cblk) {
    const int co = C.lane & 7, rg = C.lane >> 3, ch0 = cblk * 64 + co * 8;
    const float* cw = (C.a->in[8]) + (size_t)l * CW * CD + ch0; const float* cb = (C.a->in[9]) + (size_t)l * CD + ch0;
    float w0[8], w1[8], w2[8], w3[8], bs[8];
#pragma unroll
    for (int j = 0; j < 8; ++j) { w0[j] = cw[j]; w1[j] = cw[CD + j]; w2[j] = cw[2 * CD + j]; w3[j] = cw[3 * CD + j]; bs[j] = cb[j]; }
    const bf16* U = ((bf16*)(C.a->ws + WS_U));
    const int row0 = 128 * c + 16 * rg;
    v4u raw[19];
    unsigned zu = 0u; asm volatile("" : "+v"(zu));
#pragma unroll
    for (int i = 0; i < 19; ++i) { const int rr = row0 - 3 + i; raw[i] = *(const GAS v4u*)(U + UIDX(rr < 0 ? 0 : rr, UXBC + ch0)); }
    __builtin_amdgcn_sched_barrier(0);
#pragma unroll
    for (int i = 0; i < 3; ++i) { if (row0 - 3 + i < 0) raw[i] = (v4u){zu, zu, zu, zu}; }
    unsigned tp[8][8];
    bf16* rm = nullptr; bf16* tr = nullptr;
    if (cblk < 64) tr = ((bf16*)(C.a->ws + WS_XT)) + (((size_t)c * 64 + cblk) * 64 + co * 8) * 128 + 16 * rg;
    else if (cblk < 80) { const int g = (cblk - 64) >> 1, hf = (cblk - 64) & 1;
        rm = ((bf16*)(C.a->ws + WS_BRM)) + (((size_t)c * 8 + g) * 128 + 16 * rg) * 128 + hf * 64 + co * 8;
        tr = ((bf16*)(C.a->ws + WS_BT)) + (((size_t)c * 8 + g) * 128 + hf * 64 + co * 8) * 128 + 16 * rg; }
    else { const int g = (cblk - 80) >> 1, hf = (cblk - 80) & 1;
        rm = ((bf16*)(C.a->ws + WS_CRM)) + (((size_t)c * 8 + g) * 128 + 16 * rg) * 128 + hf * 64 + co * 8; }
#define RAWF(i, j) (((j) & 1) ? bfhi(((j) >> 1) == 0 ? raw[i].x : (((j) >> 1) == 1 ? raw[i].y : (((j) >> 1) == 2 ? raw[i].z : raw[i].w))) : bflo(((j) >> 1) == 0 ? raw[i].x : (((j) >> 1) == 1 ? raw[i].y : (((j) >> 1) == 2 ? raw[i].z : raw[i].w))))
#pragma unroll
    for (int i2 = 0; i2 < 8; ++i2) {
        float oa[8], ob[8];
#pragma unroll
        for (int j = 0; j < 8; ++j) { oa[j] = siluf_(bs[j] + w0[j] * RAWF(2 * i2, j) + w1[j] * RAWF(2 * i2 + 1, j) + w2[j] * RAWF(2 * i2 + 2, j) + w3[j] * RAWF(2 * i2 + 3, j));
                                      ob[j] = siluf_(bs[j] + w0[j] * RAWF(2 * i2 + 1, j) + w1[j] * RAWF(2 * i2 + 2, j) + w2[j] * RAWF(2 * i2 + 3, j) + w3[j] * RAWF(2 * i2 + 4, j)); }
        if (rm) { v4u w; w.x = cvtpk(oa[0], oa[1]); w.y = cvtpk(oa[2], oa[3]); w.z = cvtpk(oa[4], oa[5]); w.w = cvtpk(oa[6], oa[7]); *(GAS v4u*)(rm + (size_t)(2 * i2) * 128) = w;
                  w.x = cvtpk(ob[0], ob[1]); w.y = cvtpk(ob[2], ob[3]); w.z = cvtpk(ob[4], ob[5]); w.w = cvtpk(ob[6], ob[7]); *(GAS v4u*)(rm + (size_t)(2 * i2 + 1) * 128) = w; }
#pragma unroll
        for (int j = 0; j < 8; ++j) tp[j][i2] = cvtpk(oa[j], ob[j]);
    }
#undef RAWF
    if (tr) {
#pragma unroll
        for (int j = 0; j < 8; ++j) { *(GAS v4u*)(tr + (size_t)j * 128) = (v4u){tp[j][0], tp[j][1], tp[j][2], tp[j][3]}; *(GAS v4u*)(tr + (size_t)j * 128 + 8) = (v4u){tp[j][4], tp[j][5], tp[j][6], tp[j][7]}; }
    }
}
__device__ __forceinline__ void reformat_dt_item(const Ctx& C, int l, int c) {
    const int h = C.lane; const float A = -__expf((C.a->in[11])[l * NH + h]);
    const float* D = ((float*)(C.a->ws + WS_DT)) + (size_t)(128 * c) * 64 + h;
    float* dto = ((float*)(C.a->ws + WS_DTT)) + ((size_t)c * 64 + h) * 128; float* aco = ((float*)(C.a->ws + WS_ACS)) + ((size_t)c * 64 + h) * 128;
    float cs = 0.f;
#pragma unroll
    for (int l0 = 0; l0 < 128; l0 += 64) { float dv[64];
#pragma unroll
        for (int i = 0; i < 64; ++i) dv[i] = D[(size_t)(l0 + i) * 64];
        __builtin_amdgcn_sched_barrier(0);
#pragma unroll
        for (int q = 0; q < 16; ++q) { f32x4 av;
#pragma unroll
            for (int e = 0; e < 4; ++e) { cs += dv[4 * q + e] * A; av[e] = cs; }
            *(GAS f32x4*)(dto + l0 + 4 * q) = (f32x4){dv[4 * q], dv[4 * q + 1], dv[4 * q + 2], dv[4 * q + 3]}; *(GAS f32x4*)(aco + l0 + 4 * q) = av; } }
}
__device__ __forceinline__ void reformat_vt_item(const Ctx& C, int tb, int kh) {
    const int co = C.lane & 7, rg = C.lane >> 3; const bf16* U = ((bf16*)(C.a->ws + WS_U)) + UIDX(128 * tb + 16 * rg, UV + kh * 64 + co * 8);
    unsigned tp[8][8]; v4u rv[16];
#pragma unroll
    for (int i = 0; i < 16; ++i) rv[i] = *(const GAS v4u*)(U + (size_t)i * 64);
    __builtin_amdgcn_sched_barrier(0);
#pragma unroll
    for (int i = 0; i < 16; ++i) { const v4u a = rv[i]; const unsigned w[4] = {a.x, a.y, a.z, a.w};
#pragma unroll
        for (int j = 0; j < 8; ++j) { const unsigned hb = (j & 1) ? (w[j >> 1] >> 16) : (w[j >> 1] & 0xffffu); if (i & 1) tp[j][i >> 1] |= hb << 16; else tp[j][i >> 1] = hb; } }
    bf16* tr = ((bf16*)(C.a->ws + WS_VT)) + ((size_t)kh * 64 + co * 8) * SEQ + 128 * tb + 16 * rg;
#pragma unroll
    for (int j = 0; j < 8; ++j) { *(GAS v4u*)(tr + (size_t)j * SEQ) = (v4u){tp[j][0], tp[j][1], tp[j][2], tp[j][3]}; *(GAS v4u*)(tr + (size_t)j * SEQ + 8) = (v4u){tp[j][4], tp[j][5], tp[j][6], tp[j][7]}; }
}
constexpr int RF_ITEMS = 64 * 96 + 64 + 64 * 8;
__device__ __forceinline__ void reformat_item(const Ctx& C, int l, int it) {
    constexpr int N1 = 64 * 96, N2 = 64;
    if (it < N1) reformat_conv_item(C, l, it / 96, it % 96);
    else if (it < N1 + N2) reformat_dt_item(C, l, it - N1);
    else reformat_vt_item(C, (it - N1 - N2) >> 3, (it - N1 - N2) & 7);
}

constexpr int AT_K = 0, AT_V = 36864, AT_KP = 144, AT_VP = 528;
__device__ __forceinline__ void attn_prompt_unit(const Ctx& C, int l, int qb, int kh) {
    const int lane_ = lane_now();
    const int r = lane_ & 31, hh = lane_ >> 5, hq = 4 * kh + (C.wave >> 1), rh = C.wave & 1, tid = C.wave * 64 + lane_;
    const bf16* U = ((bf16*)(C.a->ws + WS_U)); const bf16* VT = ((bf16*)(C.a->ws + WS_VT)) + (size_t)kh * 64 * SEQ; bf16* YO = ((bf16*)(C.a->ws + WS_YO));
    LAS unsigned char* Ks = C.lds + AT_K; LAS unsigned char* Vs = C.lds + AT_V;
    const int key0 = 128 * (qb - 1);
    bf16x8 bq[2][4];
    { v4u tk[4], tv[4]; unsigned zu = 0u; asm volatile("" : "+v"(zu));
#pragma unroll
      for (int i = 0; i < 4; ++i) { const int idx = tid + 512 * i, kr = idx >> 3, ch = idx & 7, key = key0 + kr;
          tk[i] = *(const GAS v4u*)(U + UIDX(key < 0 ? 0 : key, UK + kh * 64 + 8 * ch));
          const int d = idx >> 5, c5 = idx & 31, kk = key0 + 8 * c5;
          tv[i] = *(const GAS v4u*)(VT + (size_t)d * SEQ + (kk < 0 ? 0 : kk)); }
#pragma unroll
      for (int qt = 0; qt < 2; ++qt)
#pragma unroll
          for (int ks = 0; ks < 4; ++ks) bq[qt][ks] = ld16(U + UIDX(128 * qb + 32 * (2 * rh + qt) + r, UQ + hq * 64 + 16 * ks + 8 * hh));
      __builtin_amdgcn_sched_barrier(0);
#pragma unroll
      for (int i = 0; i < 4; ++i) { const int idx = tid + 512 * i; if (key0 + (idx >> 3) < 0) tk[i] = (v4u){zu, zu, zu, zu}; if (key0 + 8 * (idx & 31) < 0) tv[i] = (v4u){zu, zu, zu, zu}; }
#pragma unroll
      for (int i = 0; i < 4; ++i) { const int idx = tid + 512 * i; *(LAS v4u*)(Ks + (idx >> 3) * AT_KP + (idx & 7) * 16) = tk[i]; *(LAS v4u*)(Vs + (idx >> 5) * AT_VP + (idx & 31) * 16) = tv[i]; } }
    const float sink = (C.a->in[16])[l * AH + hq];
    __syncthreads();
#pragma unroll
    for (int qt = 0; qt < 2; ++qt) {
        const int ai = 2 * rh + qt, q0 = 128 * qb + 32 * ai, t = q0 + r;
        f32x16 S[5]; float mx = sink;
#pragma unroll
        for (int v = 0; v < 5; ++v) { const int kt = ai + v; const bool vis = qb > 0 || kt >= 4;
            if (vis) { const int kb = key0 + 32 * kt; f32x16 s;
#pragma unroll
                for (int e = 0; e < 16; ++e) s[e] = 0.f;
                const LAS unsigned char* kp = Ks + (32 * kt + r) * AT_KP + 16 * hh;
#pragma unroll
                for (int ks = 0; ks < 4; ++ks) { const bf16x8 a = *(const LAS bf16x8*)(kp + 32 * ks); s = MFMA32(a, bq[qt][ks], s); }
#pragma unroll
                for (int e = 0; e < 16; ++e) { const int j = kb + crow(e, hh); const bool ok = (j <= t) && (j >= t - WIN); const float x = ok ? s[e] * 0.125f : -__builtin_inff(); s[e] = x; mx = fmaxf(mx, x); }
                S[v] = s; }
        }
        mx = fmaxf(mx, __shfl_xor(mx, 32));
        float sum = 0.f;
#pragma unroll
        for (int v = 0; v < 5; ++v) { const int kt = ai + v; const bool vis = qb > 0 || kt >= 4;
            if (vis) {
#pragma unroll
                for (int e = 0; e < 16; ++e) { const float p = __expf(S[v][e] - mx); S[v][e] = p; sum += p; } } }
        sum += __shfl_xor(sum, 32); sum += __expf(sink - mx);
        f32x16 O[2];
#pragma unroll
        for (int e = 0; e < 16; ++e) { O[0][e] = 0.f; O[1][e] = 0.f; }
#pragma unroll
        for (int v = 0; v < 5; ++v) { const int kt = ai + v; const bool vis = qb > 0 || kt >= 4;
            if (vis) {
#pragma unroll
                for (int ss = 0; ss < 2; ++ss) { const bf16x8 pb = PACK8(S[v], ss);
#pragma unroll
                    for (int dt = 0; dt < 2; ++dt) { const LAS unsigned char* vp = Vs + (32 * dt + r) * AT_VP + (32 * kt + 16 * ss + 4 * hh) * 2;
                        const u32x2 lo = *(const LAS u32x2*)vp, hi = *(const LAS u32x2*)(vp + 16);
                        const bf16x8 va = __builtin_bit_cast(bf16x8, (v4u){lo.x, lo.y, hi.x, hi.y}); O[dt] = MFMA32(va, pb, O[dt]); } } } }
        const float inv = 1.0f / sum;
        bf16* op = YO + (size_t)t * KCAT + DI + hq * 64;
#pragma unroll
        for (int dt = 0; dt < 2; ++dt)
#pragma unroll
            for (int g4 = 0; g4 < 4; ++g4) { u32x2 w; w.x = cvtpk(O[dt][4 * g4] * inv, O[dt][4 * g4 + 1] * inv); w.y = cvtpk(O[dt][4 * g4 + 2] * inv, O[dt][4 * g4 + 3] * inv);
                *(GAS u32x2*)(op + 32 * dt + 8 * g4 + 4 * hh) = w; }
    }
    __syncthreads();
}

__device__ __forceinline__ void ssd_states_unit(const Ctx& C, int c, int g) {
    const int lane_ = lane_now();
    const int r = lane_ & 31, hh = lane_ >> 5, h = 8 * g + C.wave, tid = C.wave * 64 + lane_;
    const bf16* xT = ((bf16*)(C.a->ws + WS_XT)) + ((size_t)c * 64 + h) * 64 * 128; const bf16* bT = ((bf16*)(C.a->ws + WS_BT)) + ((size_t)c * 8 + g) * 128 * 128;
    const float* dtT = ((float*)(C.a->ws + WS_DTT)) + ((size_t)c * 64 + h) * 128; const float* acs = ((float*)(C.a->ws + WS_ACS)) + ((size_t)c * 64 + h) * 128;
    LAS unsigned char* Bs = C.lds + PC_B; LAS float* scs = (LAS float*)(C.lds + PC_C) + C.wave * 128;
    v4u tb[4], raw[2][8];
#pragma unroll
    for (int i = 0; i < 4; ++i) tb[i] = *(const GAS v4u*)(bT + (size_t)(tid + 512 * i) * 8);
    const float dl0 = dtT[lane_], dl1 = dtT[64 + lane_], al0 = acs[lane_], al1 = acs[64 + lane_], aend = acs[127];
#pragma unroll
    for (int ks = 0; ks < 8; ++ks)
#pragma unroll
        for (int pt = 0; pt < 2; ++pt) raw[pt][ks] = *(const GAS v4u*)(xT + (size_t)(32 * pt + r) * 128 + 16 * ks + 8 * hh);
    __builtin_amdgcn_sched_barrier(0);
#pragma unroll
    for (int i = 0; i < 4; ++i) { const int idx = tid + 512 * i; *(LAS v4u*)(Bs + (idx >> 4) * 272 + (idx & 15) * 16) = tb[i]; }
    scs[lane_] = dl0 * __expf(aend - al0); scs[64 + lane_] = dl1 * __expf(aend - al1);
    LDS_WAIT(); asm volatile("" ::: "memory");
    bf16x8 a[2][8];
#pragma unroll
    for (int ks = 0; ks < 8; ++ks) { const f32x4 s0 = *(const LAS f32x4*)(scs + 16 * ks + 8 * hh), s1 = *(const LAS f32x4*)(scs + 16 * ks + 8 * hh + 4);
#pragma unroll
        for (int pt = 0; pt < 2; ++pt) { const v4u w = raw[pt][ks];
            v4u o; o.x = cvtpk(bflo(w.x) * s0.x, bfhi(w.x) * s0.y); o.y = cvtpk(bflo(w.y) * s0.z, bfhi(w.y) * s0.w); o.z = cvtpk(bflo(w.z) * s1.x, bfhi(w.z) * s1.y); o.w = cvtpk(bflo(w.w) * s1.z, bfhi(w.w) * s1.w);
            a[pt][ks] = __builtin_bit_cast(bf16x8, o); } }
    __syncthreads();
    bf16* st = ((bf16*)(C.a->ws + WS_ST)) + ((size_t)c * 64 + h) * 64 * 128;
#pragma unroll
    for (int nt = 0; nt < 4; ++nt) {
        f32x16 acc[2];
#pragma unroll
        for (int e = 0; e < 16; ++e) { acc[0][e] = 0.f; acc[1][e] = 0.f; }
        const LAS unsigned char* bp = Bs + (32 * nt + r) * 272 + 16 * hh;
#pragma unroll
        for (int ks = 0; ks < 8; ++ks) { const bf16x8 b = *(const LAS bf16x8*)(bp + 32 * ks); acc[0] = MFMA32(b, a[0][ks], acc[0]); acc[1] = MFMA32(b, a[1][ks], acc[1]); }
#pragma unroll
        for (int pt = 0; pt < 2; ++pt)
#pragma unroll
            for (int j = 0; j < 2; ++j) { v4u w; w.x = cvtpk(acc[pt][8 * j], acc[pt][8 * j + 1]); w.y = cvtpk(acc[pt][8 * j + 2], acc[pt][8 * j + 3]); w.z = cvtpk(acc[pt][8 * j + 4], acc[pt][8 * j + 5]); w.w = cvtpk(acc[pt][8 * j + 6], acc[pt][8 * j + 7]);
                *(GAS v4u*)(st + ((size_t)(((pt * 4 + nt) * 2 + j) * 64 + lane_)) * 8) = w; }
    }
    __syncthreads();
}

__device__ __forceinline__ void ssd_scan_phase(const Ctx& C, int l) {
    const bf16* ST = ((bf16*)(C.a->ws + WS_ST)); bf16* HS = ((bf16*)(C.a->ws + WS_HS)); const float* acs = ((float*)(C.a->ws + WS_ACS));
    for (int idx = C.bid * 512 + C.tid; idx < 64 * 64 * 128 / 4; idx += C.G * 512) { const int h = idx >> 11;
        f32x4 hc = (f32x4){0.f, 0.f, 0.f, 0.f};
        for (int c0 = 0; c0 < 64; c0 += 16) { u32x2 sw[16]; float av[16];
#pragma unroll
            for (int j = 0; j < 16; ++j) { sw[j] = *((const GAS u32x2*)(ST + (size_t)(c0 + j) * 64 * 64 * 128) + idx); av[j] = acs[((size_t)(c0 + j) * 64 + h) * 128 + 127]; }
#pragma unroll
            for (int j = 0; j < 16; ++j) {
                u32x2 w; w.x = cvtpk(hc.x, hc.y); w.y = cvtpk(hc.z, hc.w); *((GAS u32x2*)(HS + (size_t)(c0 + j) * 64 * 64 * 128) + idx) = w;
                const f32x4 s = (f32x4){bflo(sw[j].x), bfhi(sw[j].x), bflo(sw[j].y), bfhi(sw[j].y)}; const float dec = __expf(av[j]);
                hc = hc * dec + s; } }
        { const int g = idx & 2047, vh = g & 1, ln = (g >> 1) & 63, j = (g >> 7) & 1, nt = (g >> 8) & 3, pt = (g >> 10) & 1, p = 32 * pt + (ln & 31), n4 = 8 * nt + 4 * j + 2 * vh + (ln >> 5);
          *((GAS f32x4*)((C.a->out) + O_PSSM + (size_t)l * NH * HP * DS) + (size_t)h * 2048 + p * 32 + n4) = hc; } }
}

__device__ __forceinline__ void ssd_out_unit(const Ctx& C, int l, int c, int g) {
    const int lane_ = lane_now();
    const int r = lane_ & 31, hh = lane_ >> 5, h = 8 * g + C.wave, tid = C.wave * 64 + lane_;
    LAS unsigned char* Bs = C.lds + PC_B; LAS unsigned char* Cs = C.lds + PC_C; LAS float* Ysm = (LAS float*)(C.lds + PC_Y + C.wave * 8704);
    LAS float* ssq = (LAS float*)(C.lds + PC_SSQ); LAS float* acsS = (LAS float*)(C.lds + PC_AD + C.wave * 1024); LAS float* dtS = acsS + 128;
    const bf16* cR = ((bf16*)(C.a->ws + WS_CRM)) + ((size_t)c * 8 + g) * 128 * 128; const bf16* bR = ((bf16*)(C.a->ws + WS_BRM)) + ((size_t)c * 8 + g) * 128 * 128;
    const bf16* hS = ((bf16*)(C.a->ws + WS_HS)) + ((size_t)c * 64 + h) * 64 * 128; const bf16* xT = ((bf16*)(C.a->ws + WS_XT)) + ((size_t)c * 64 + h) * 64 * 128;
    LAS float* nws = (LAS float*)(C.lds + 152576) + C.wave * 64;
    bf16x8 hb[2][8], xb[4][2][2];
    { v4u tb[4], tc[4];
#pragma unroll
      for (int i = 0; i < 4; ++i) { const int idx = tid + 512 * i; tb[i] = *(const GAS v4u*)(bR + (size_t)idx * 8); tc[i] = *(const GAS v4u*)(cR + (size_t)idx * 8); }
      const float a0 = (((float*)(C.a->ws + WS_ACS)) + ((size_t)c * 64 + h) * 128)[lane_], a1 = (((float*)(C.a->ws + WS_ACS)) + ((size_t)c * 64 + h) * 128)[64 + lane_];
      const float d0 = (((float*)(C.a->ws + WS_DTT)) + ((size_t)c * 64 + h) * 128)[lane_], d1 = (((float*)(C.a->ws + WS_DTT)) + ((size_t)c * 64 + h) * 128)[64 + lane_];
      const float nwv = ((C.a->in[13]) + (size_t)l * DI + h * 64)[lane_];
#pragma unroll
      for (int pt = 0; pt < 2; ++pt)
#pragma unroll
          for (int ks = 0; ks < 8; ++ks) hb[pt][ks] = ld16(hS + ((size_t)(pt * 8 + ks) * 64 + lane_) * 8);
#pragma unroll
      for (int st = 0; st < 4; ++st)
#pragma unroll
          for (int ss = 0; ss < 2; ++ss)
#pragma unroll
              for (int pt = 0; pt < 2; ++pt) xb[st][ss][pt] = ld8x2(xT + (size_t)(32 * pt + r) * 128 + 32 * st + 16 * ss + 4 * hh);
      __builtin_amdgcn_sched_barrier(0);
#pragma unroll
      for (int i = 0; i < 4; ++i) { const int idx = tid + 512 * i, row = idx >> 4, ch = idx & 15; *(LAS v4u*)(Bs + row * 272 + ch * 16) = tb[i]; *(LAS v4u*)(Cs + row * 272 + ch * 16) = tc[i]; }
      acsS[lane_] = a0; acsS[64 + lane_] = a1; dtS[lane_] = d0; dtS[64 + lane_] = d1; nws[lane_] = nwv; }
    const float Dh = (C.a->in[12])[l * NH + h];
    __syncthreads();
    const bf16* Uz = ((bf16*)(C.a->ws + WS_U)) + UIDX(128 * c + (lane_ >> 1), UZ + h * 64 + 32 * (lane_ & 1));
    bf16* YOw = ((bf16*)(C.a->ws + WS_YO)) + (size_t)(128 * c + (lane_ >> 1)) * KCAT + h * 64 + 32 * (lane_ & 1);
    const LAS float* nwp = nws + 32 * (lane_ & 1);
#pragma unroll
    for (int lt = 0; lt < 4; ++lt) {
        v4u zw[4];
        { const GAS v4u* zp = (const GAS v4u*)(Uz + (size_t)(32 * lt) * 64);
#pragma unroll
          for (int i = 0; i < 4; ++i) zw[i] = zp[i]; }
        f32x16 y[2];
#pragma unroll
        for (int e = 0; e < 16; ++e) { y[0][e] = 0.f; y[1][e] = 0.f; }
        const LAS unsigned char* crow_p = Cs + (32 * lt + r) * 272 + 16 * hh;
#pragma unroll
        for (int ks = 0; ks < 8; ++ks) { if ((ks & 3) == 0) asm volatile("" ::: "memory");
            const LAS unsigned char* cq = Cs + (32 * lt + r) * 272 + 8 * hh + 32 * ks; const u32x2 lo = *(const LAS u32x2*)cq, hi = *(const LAS u32x2*)(cq + 16);
            v4u aw; aw.x = lo.x; aw.y = lo.y; aw.z = hi.x; aw.w = hi.y; const bf16x8 a = __builtin_bit_cast(bf16x8, aw); y[0] = MFMA32(a, hb[0][ks], y[0]); y[1] = MFMA32(a, hb[1][ks], y[1]); }
#pragma unroll
        for (int q4 = 0; q4 < 4; ++q4) { const f32x4 av = *(const LAS f32x4*)(acsS + 32 * lt + 8 * q4 + 4 * hh);
#pragma unroll
            for (int e = 0; e < 4; ++e) { const float f = __expf(av[e]); y[0][4 * q4 + e] *= f; y[1][4 * q4 + e] *= f; } }
        const float al = acsS[32 * lt + r];
#pragma unroll
        for (int st = 0; st < 4; ++st) { if (st > lt) continue;
            f32x16 X;
#pragma unroll
            for (int e = 0; e < 16; ++e) X[e] = 0.f;
            const LAS unsigned char* brow_p = Bs + (32 * st + r) * 272 + 16 * hh;
#pragma unroll
            for (int ks = 0; ks < 8; ++ks) { if ((ks & 1) == 0) asm volatile("" ::: "memory");
                const bf16x8 a = *(const LAS bf16x8*)(brow_p + 32 * ks), b = *(const LAS bf16x8*)(crow_p + 32 * ks); X = MFMA32(a, b, X); }
#pragma unroll
            for (int q4 = 0; q4 < 4; ++q4) { const f32x4 as = *(const LAS f32x4*)(acsS + 32 * st + 8 * q4 + 4 * hh), ds = *(const LAS f32x4*)(dtS + 32 * st + 8 * q4 + 4 * hh);
#pragma unroll
                for (int e = 0; e < 4; ++e) { const int s = 32 * st + 8 * q4 + 4 * hh + e, lrow = 32 * lt + r; const float wgt = (s <= lrow) ? ds[e] * __expf(al - as[e]) : 0.f; X[4 * q4 + e] *= wgt; } }
#pragma unroll
            for (int ss = 0; ss < 2; ++ss) { const bf16x8 xa = PACK8(X, ss); y[0] = MFMA32(xa, xb[st][ss][0], y[0]); y[1] = MFMA32(xa, xb[st][ss][1], y[1]); }
        }
#pragma unroll
        for (int pt = 0; pt < 2; ++pt)
#pragma unroll
            for (int e = 0; e < 16; ++e) { const int q4 = e >> 2; const v4u xw = __builtin_bit_cast(v4u, xb[lt][q4 >> 1][pt]); const unsigned w = (q4 & 1) ? ((e & 2) ? xw.w : xw.z) : ((e & 2) ? xw.y : xw.x);
                const float xv = (e & 1) ? bfhi(w) : bflo(w);
                Ysm[crow(e, hh) * 68 + 32 * pt + r] = y[pt][e] + Dh * xv; }
        { const LAS f32x4* yr = (const LAS f32x4*)(Ysm + (lane_ >> 1) * 68 + 32 * (lane_ & 1));
          float gq[32]; float sq = 0.f;
#pragma unroll
          for (int i = 0; i < 4; ++i) { const f32x4 ya = yr[2 * i], yb = yr[2 * i + 1];
              gq[8 * i + 0] = ya.x * bflo(zw[i].x); gq[8 * i + 1] = ya.y * bfhi(zw[i].x); gq[8 * i + 2] = ya.z * bflo(zw[i].y); gq[8 * i + 3] = ya.w * bfhi(zw[i].y);
              gq[8 * i + 4] = yb.x * bflo(zw[i].z); gq[8 * i + 5] = yb.y * bfhi(zw[i].z); gq[8 * i + 6] = yb.z * bflo(zw[i].w); gq[8 * i + 7] = yb.w * bfhi(zw[i].w);
#pragma unroll
              for (int e = 0; e < 8; ++e) sq += gq[8 * i + e] * gq[8 * i + e]; }
          sq += __shfl_xor(sq, 1);
          if ((lane_ & 1) == 0) ssq[(32 * lt + (lane_ >> 1)) * 8 + C.wave] = sq;
          __syncthreads();
          const LAS f32x4* sp = (const LAS f32x4*)(ssq + (32 * lt + (lane_ >> 1)) * 8); const f32x4 s0 = sp[0], s1 = sp[1];
          const float rstd = rsqrtf(((s0.x + s0.y) + (s0.z + s0.w) + (s1.x + s1.y) + (s1.z + s1.w)) * (1.0f / 512.0f) + EPS);
          GAS v4u* op = (GAS v4u*)(YOw + (size_t)(32 * lt) * KCAT);
#pragma unroll
          for (int i = 0; i < 4; ++i) { const f32x4 na = *(const LAS f32x4*)(nwp + 8 * i), nb = *(const LAS f32x4*)(nwp + 8 * i + 4);
              op[i] = (v4u){cvtpk(gq[8 * i] * rstd * na.x, gq[8 * i + 1] * rstd * na.y), cvtpk(gq[8 * i + 2] * rstd * na.z, gq[8 * i + 3] * rstd * na.w), cvtpk(gq[8 * i + 4] * rstd * nb.x, gq[8 * i + 5] * rstd * nb.y), cvtpk(gq[8 * i + 6] * rstd * nb.z, gq[8 * i + 7] * rstd * nb.w)}; } }
    }
    __syncthreads();
}

template <int MODE, int NBG> __device__ __forceinline__ void mini_group(f32x16& acc, const bf16* Ab, int lda, const float* Af, const bf16* Bt, int K, int kofs, LAS unsigned char* WLA, LAS unsigned char* WLB, int lane_) {
    constexpr int NLA = MODE == 1 ? 8 : 4;
    const int r = lane_ & 31, hh = lane_ >> 5, lrow = lane_ >> 3, lch = lane_ & 7, frow = lane_ >> 4, fch = lane_ & 15;
    v4u bv[NBG][4], av[NBG][NLA];
#pragma unroll
    for (int g = 0; g < NBG; ++g) {
#pragma unroll
        for (int j = 0; j < 4; ++j) bv[g][j] = *(const GAS v4u*)(Bt + (size_t)(8 * j + lrow) * K + kofs + 64 * g + 8 * lch);
        if (MODE == 1) {
#pragma unroll
            for (int j = 0; j < 8; ++j) av[g][j] = *(const GAS v4u*)(Af + (size_t)(4 * j + frow) * DM + kofs + 64 * g + 4 * fch);
        } else {
#pragma unroll
            for (int j = 0; j < 4; ++j) av[g][j] = *(const GAS v4u*)(Ab + (size_t)(8 * j + lrow) * lda + kofs + 64 * g + 8 * lch);
        }
    }
    __builtin_amdgcn_sched_barrier(0);
#pragma unroll
    for (int g = 0; g < NBG; ++g) {
#pragma unroll
        for (int j = 0; j < 4; ++j) *(LAS v4u*)(WLB + (8 * j + lrow) * 144 + lch * 16) = bv[g][j];
        if (MODE == 1) {
#pragma unroll
            for (int j = 0; j < 8; ++j) { const v4u w = av[g][j]; u32x2 o; o.x = cvtpk(__uint_as_float(w.x), __uint_as_float(w.y)); o.y = cvtpk(__uint_as_float(w.z), __uint_as_float(w.w)); *(LAS u32x2*)(WLA + (4 * j + frow) * 144 + fch * 8) = o; }
        } else {
#pragma unroll
            for (int j = 0; j < 4; ++j) *(LAS v4u*)(WLA + (8 * j + lrow) * 144 + lch * 16) = av[g][j];
        }
        LDS_WAIT(); asm volatile("" ::: "memory");
        bf16x8 fa[4], fb[4];
#pragma unroll
        for (int ks = 0; ks < 4; ++ks) { fa[ks] = *(const LAS bf16x8*)(WLA + r * 144 + (2 * ks + hh) * 16); fb[ks] = *(const LAS bf16x8*)(WLB + r * 144 + (2 * ks + hh) * 16); }
#pragma unroll
        for (int ks = 0; ks < 4; ++ks) acc = MFMA32(fa[ks], fb[ks], acc);
        asm volatile("" ::: "memory");
    }
    __builtin_amdgcn_sched_barrier(0);
}
template <int MODE> __device__ __forceinline__ void mini_unit(const Ctx& C, int l, int mu) {
    constexpr int K = MODE == 0 ? KCAT : (MODE == 1 ? DM : FF), KS = MODE == 0 ? 1024 : (MODE == 1 ? 256 : 704);
    const int lane_ = lane_now();
    const int r = lane_ & 31, hh = lane_ >> 5, ct = mu & 31, sp = mu >> 5, rt = C.wave & 3, n0 = 64 * ct + 32 * (C.wave >> 2), k0 = KS * sp;
    const bf16* Bt = (MODE == 0 ? ((bf16*)(C.a->ws + WS_WCAT)) + (size_t)l * DM * KCAT : (MODE == 1 ? ((bf16*)(C.a->ws + WS_WOUT)) + (size_t)l * DM * DM : ((bf16*)(C.a->ws + WS_WDN)) + (size_t)l * DM * FF)) + (size_t)n0 * K + k0;
    const bf16* Ab = (MODE == 0 ? ((bf16*)(C.a->ws + WS_YO)) + (size_t)(SEQ + 32 * rt) * KCAT : ((bf16*)(C.a->ws + WS_HB)) + (size_t)(SEQ + 32 * rt) * FF) + k0;
    const float* Af = ((float*)(C.a->ws + WS_MS)) + (size_t)(32 * rt) * DM + k0;
    constexpr int lda = MODE == 0 ? KCAT : FF;
    LAS unsigned char* WLA = C.lds + RING_OFF + C.wave * 9216; LAS unsigned char* WLB = WLA + 4608;
    f32x16 acc;
#pragma unroll
    for (int e = 0; e < 16; ++e) acc[e] = 0.f;
    if (MODE == 0) {
#pragma unroll 1
        for (int gq = 0; gq < 4; ++gq) mini_group<0, 4>(acc, Ab, lda, Af, Bt, K, 256 * gq, WLA, WLB, lane_);
    } else if (MODE == 1) {
#pragma unroll 1
        for (int gq = 0; gq < 2; ++gq) mini_group<1, 2>(acc, Ab, lda, Af, Bt, K, 128 * gq, WLA, WLB, lane_);
    } else {
#pragma unroll 1
        for (int gq = 0; gq < 2; ++gq) mini_group<2, 4>(acc, Ab, lda, Af, Bt, K, 256 * gq, WLA, WLB, lane_);
        mini_group<2, 3>(acc, Ab, lda, Af, Bt, K, 512, WLA, WLB, lane_);
    }
    float* dst = (MODE == 0 ? ((float*)(C.a->ws + WS_MS)) : ((float*)(C.a->ws + WS_X)) + (size_t)SEQ * DM) + n0 + r;
    if (MODE == 0) { const bf16* gp = ((bf16*)(C.a->ws + WS_U)) + UIDX(SEQ, (sp < 4 ? UGS : UGA) + n0 + r);
        bf16 gv[16];
#pragma unroll
        for (int e = 0; e < 16; ++e) gv[e] = gp[(size_t)(32 * rt + crow(e, hh)) * 64];
        __builtin_amdgcn_sched_barrier(0);
#pragma unroll
        for (int e = 0; e < 16; ++e) acc[e] *= bf2f(gv[e]); }
#pragma unroll
    for (int e = 0; e < 16; ++e) unsafeAtomicAdd(dst + (size_t)(32 * rt + crow(e, hh)) * DM, acc[e]);
}
template <int MODE> __device__ __forceinline__ void mini_phase(const Ctx& C, int l) {
    constexpr int NMU = 32 * (MODE == 0 ? 6 : 8);
    for (int mu = C.bid; mu < NMU; mu += C.G) mini_unit<MODE>(C, l, mu);
}
constexpr int NPL = 11;
constexpr int NPH = 1 + DEPTH * NPL;
#ifndef REP_P0
#define REP_P0 1
#endif
#ifndef REP_0
#define REP_0 1
#endif
#ifndef REP_1
#define REP_1 1
#endif
#ifndef REP_2
#define REP_2 1
#endif
#ifndef REP_3
#define REP_3 1
#endif
#ifndef REP_4
#define REP_4 1
#endif
#ifndef REP_5
#define REP_5 1
#endif
#ifndef REP_6
#define REP_6 1
#endif
#ifndef REP_7
#define REP_7 1
#endif
#ifndef REP_8
#define REP_8 1
#endif
#ifndef REP_9
#define REP_9 1
#endif
#ifndef REP_10
#define REP_10 1
#endif
#ifndef REP_RF
#define REP_RF 1
#endif
#ifndef REP_SSD
#define REP_SSD 1
#endif
#ifndef REP_SATT
#define REP_SATT 1
#endif
#ifndef GEMM_ALIGN
#define GEMM_ALIGN true
#endif
#ifndef GEMM_SP2
#define GEMM_SP2 true
#endif
#ifndef PROBE_LO
#define PROBE_LO -1
#define PROBE_HI -1
#endif
#ifndef PROBE_AMP
#define PROBE_AMP 2
#endif
#ifndef NW_SSD
#define NW_SSD 2
#endif
#ifndef PROBE_SUB
#define PROBE_SUB 0
#endif
#ifndef PROBE_CLK
#define PROBE_CLK 0
#endif
#ifndef REP_ATT
#define REP_ATT 1
#endif
#ifndef REP_PA
#define REP_PA 1
#endif
#ifndef NSP_G1
#define NSP_G1 49
#endif
#ifndef MK_SPLIT
#define MK_SPLIT 0
#endif
__global__ void __launch_bounds__(NWAVES * 64, 2) fwd(Args args) {
    extern __shared__ __attribute__((aligned(16))) unsigned char lds_raw[];
    LAS unsigned char* const lds = (LAS unsigned char*)lds_raw;
    const int wave_s = __builtin_amdgcn_readfirstlane(threadIdx.x >> 6);
    unsigned char* ws = args.ws;
#define FRESH_CTX() Ctx C; { int t_; asm volatile("v_mbcnt_lo_u32_b32 %0, -1, 0\n\tv_mbcnt_hi_u32_b32 %0, -1, %0" : "=v"(t_)); t_ += wave_s * 64; int b_ = blockIdx.x, g_ = gridDim.x; asm volatile("" : "+s"(b_), "+s"(g_)); \
        KArgs kp_ = (KArgs)__builtin_amdgcn_kernarg_segment_ptr(); asm volatile("" : "+s"(kp_)); \
        C.lds = lds; C.tid = t_; C.lane = t_ & 63; C.wave = __builtin_amdgcn_readfirstlane(t_ >> 6); C.G = g_; C.bid = b_; C.a = kp_; }
    for (int u = threadIdx.x; u < (LDS_BYTES - LDSCTL_OFF) / 4; u += NWAVES * 64) ((LAS unsigned*)(lds + LDSCTL_OFF))[u] = 0u;
    __syncthreads();
    volatile LAS unsigned* MISC = (volatile LAS unsigned*)(lds + MISC_OFF);
    unsigned* barw = (unsigned*)(ws + WS_CTL) + CW_BAR;
    XcdBarrier bar; bar.bar = barw; bar.x = 0; bar.st = nullptr;
    if (args.use_bar) bar = xcd_barrier_post(barw, MISC + 8);
    const int lo = args.ph_lo, hi = args.ph_hi;
#define IN(k) (lo <= (k) && (k) < hi)
#define SEAM(k) do { if (IN((k) + 1)) xcd_barrier(bar); } while (0)

#ifndef NO_P0
    if (IN(0)) { for (int rep_ = 0; rep_ < REP_P0; ++rep_) { FRESH_CTX(); p0_weights(C, 0, (C.G >= 64 && NSP_G1 > 0) ? IT_IN : DEPTH * IT_LAYER, C.bid * NWAVES + C.wave, C.G * NWAVES); p0_xinit(C); if (rep_ + 1 < REP_P0) xcd_barrier(bar); } SEAM(0); }
#endif

    unsigned long long probe_acc = 0ull, probe_t0 = 0ull;
    if (PROBE_CLK && threadIdx.x == 0) { const unsigned long long c0_ = __builtin_amdgcn_s_memtime(), r0_ = __builtin_amdgcn_s_memrealtime(); MISC[16] = (unsigned)c0_; MISC[17] = (unsigned)(c0_ >> 32); MISC[18] = (unsigned)r0_; MISC[19] = (unsigned)(r0_ >> 32); }
#define PROBE_BEGIN(j) do { if (PROBE_LO >= 0 && (j) == PROBE_LO) probe_t0 = __builtin_amdgcn_s_memrealtime(); } while (0)
#define PROBE_END(j) do { if (PROBE_LO >= 0 && (j) == PROBE_HI) probe_acc += __builtin_amdgcn_s_memrealtime() - probe_t0; } while (0)
#pragma nounroll
    for (int l = 0; l < DEPTH; ++l) {
        const int pb = 1 + l * NPL;
#ifndef NO_G1
        PROBE_BEGIN(0);
        if (IN(pb + 0)) { for (int rep_ = 0; rep_ < REP_0; ++rep_) {
            FRESH_CTX();
            const int nsp = (l == 0 && C.G >= 64) ? (C.G * NSP_G1) / 256 : 0, gG = C.G - nsp;
            if (C.bid < gG) {
            pg8::Gemm g{((bf16*)(C.a->ws + WS_XN)), ((bf16*)(C.a->ws + WS_WIN)) + (size_t)l * NU * DM, MP, NU, DM}; pg8::StaticOrder S; S.init(MP, NU, gG, C.bid);
            pg8::EpiU E{((bf16*)(C.a->ws + WS_U)), ((float*)(C.a->ws + WS_DT)), (C.a->in[10]) + l * NH, ((float*)(C.a->ws + WS_RSA))};
            pg8::gemm_phase<pg8::EpiU, pg8::StaticOrder, GEMM_ALIGN, GEMM_SP2>(C.lds + RING_OFF, g, S, E, C.tid);
            } else p0_weights(C, IT_IN, DEPTH * IT_LAYER, (C.bid - gG) * NWAVES + C.wave, nsp * NWAVES);
            if (rep_ + 1 < REP_0) xcd_barrier(bar); }
            SEAM(pb + 0);
        }
        PROBE_END(0);
#endif
        PROBE_BEGIN(1);
        if (IN(pb + 1)) { for (int rep_ = 0; rep_ < REP_1; ++rep_) {
            FRESH_CTX();
            { volatile LAS unsigned* qctr = (volatile LAS unsigned*)(C.lds + MISC_OFF) + 24;
              if (C.tid == 0) qctr[0] = 0u;
              __syncthreads();
              const int nS = (NB * NG - C.bid + C.G - 1) / C.G, nR = (RF_ITEMS - C.bid + C.G - 1) / C.G;
              LAS float* wsc = (LAS float*)(C.lds + RING_OFF + C.wave * 8192);
              for (;;) { unsigned idx = 0u; if (C.lane == 0) idx = __hip_atomic_fetch_add((LAS unsigned*)qctr, 1u, __ATOMIC_RELAXED, __HIP_MEMORY_SCOPE_WORKGROUP);
                  idx = (unsigned)__builtin_amdgcn_readfirstlane((int)idx);
                  if ((int)idx >= nS + nR) break;
                  if ((int)idx < nS) { const int u = C.bid + C.G * (int)idx; sample_ssd_wave_unit(C, l, u >> 3, u & 7, wsc); }
                  else reformat_item(C, l, C.bid + C.G * ((int)idx - nS)); } }
            __syncthreads();
            if (PROBE_SUB == 1) probe_acc += __builtin_amdgcn_s_memrealtime() - probe_t0;
            if (PROBE_SUB == 2) probe_t0 = __builtin_amdgcn_s_memrealtime();
            zero_f32(C, ((float*)(C.a->ws + WS_RSB)), SEQ, C.bid, C.G);
            { float z0 = 0.f; asm volatile("" : "+v"(z0));
              for (int i = C.bid * 512 + C.tid; i < NB * DM / 4; i += C.G * 512) ((GAS f32x4*)(C.a->ws + WS_MS))[i] = (f32x4){z0, z0, z0, z0}; }
            for (int rr_ = 0; rr_ < REP_SATT; ++rr_) sample_attn_phase(C, l);
            if (PROBE_SUB == 2) probe_acc += __builtin_amdgcn_s_memrealtime() - probe_t0;
            if (PROBE_SUB == 3) probe_t0 = __builtin_amdgcn_s_memrealtime();
            if (PROBE_SUB == 3) { __syncthreads(); probe_acc += __builtin_amdgcn_s_memrealtime() - probe_t0; }
            if (rep_ + 1 < REP_1) xcd_barrier(bar); }
            SEAM(pb + 1);
        }
        PROBE_END(1);
        PROBE_BEGIN(2);
        if (IN(pb + 2)) { for (int rep_ = 0; rep_ < REP_2; ++rep_) {
            FRESH_CTX();
#ifdef USE_NSSD
            if (C.bid < NG) naive_ssd_prompt(C, l, C.bid);
            else {
                const int vb = C.bid - NG, nvb = C.G - NG;
                for (int u = vb; u < 64 * KVH; u += nvb) attn_prompt_unit(C, l, u >> 3, u & 7);
                for (int u = vb; u < 64 * NG; u += nvb) ssd_states_unit(C, u >> 3, u & 7);
            }
#else
            for (int rr_ = 0; rr_ < REP_ATT; ++rr_) for (int u = C.bid; u < 64 * KVH; u += C.G) attn_prompt_unit(C, l, u >> 3, u & 7);
            for (int rr_ = 0; rr_ < REP_PA; ++rr_) for (int u = C.bid; u < 64 * NG; u += C.G) ssd_states_unit(C, u >> 3, u & 7);
#endif
            if (rep_ + 1 < REP_2) xcd_barrier(bar); }
            SEAM(pb + 2);
        }
        PROBE_END(2);
        PROBE_BEGIN(3);
        if (IN(pb + 3)) { for (int rep_ = 0; rep_ < REP_3; ++rep_) { FRESH_CTX(); ssd_scan_phase(C, l); if (rep_ + 1 < REP_3) xcd_barrier(bar); } SEAM(pb + 3); }
        PROBE_END(3);
        PROBE_BEGIN(4);
        if (IN(pb + 4)) { for (int rep_ = 0; rep_ < REP_4; ++rep_) {
            FRESH_CTX();
#ifndef USE_NSSD
            for (int u = C.bid; u < 64 * NG; u += C.G) ssd_out_unit(C, l, u >> 3, u & 7);
#endif
            if (rep_ + 1 < REP_4) xcd_barrier(bar); }
            SEAM(pb + 4);
        }
        PROBE_END(4);
#ifndef NO_G2
        PROBE_BEGIN(5);
        if (IN(pb + 5)) { for (int rep_ = 0; rep_ < REP_5; ++rep_) {
            FRESH_CTX();
            pg8::Gemm g{((bf16*)(C.a->ws + WS_YO)), ((bf16*)(C.a->ws + WS_WCAT)) + (size_t)l * DM * KCAT, SEQ, DM, KCAT}; pg8::StaticOrder S; S.init(SEQ, DM, C.G, C.bid);
            pg8::EpiMerge E{((bf16*)(C.a->ws + WS_U)), ((bf16*)(C.a->ws + WS_MRG))};
            pg8::gemm_phase<pg8::EpiMerge, pg8::StaticOrder, true, true>(C.lds + RING_OFF, g, S, E, C.tid);
            mini_phase<0>(C, l);
            if (rep_ + 1 < REP_5) xcd_barrier(bar); }
            SEAM(pb + 5);
        }
        PROBE_END(5);
#endif
#ifndef NO_G3
        PROBE_BEGIN(6);
        if (IN(pb + 6)) { for (int rep_ = 0; rep_ < REP_6; ++rep_) {
            FRESH_CTX();
            pg8::Gemm g{((bf16*)(C.a->ws + WS_MRG)), ((bf16*)(C.a->ws + WS_WOUT)) + (size_t)l * DM * DM, SEQ, DM, DM}; pg8::StaticOrder S; S.init(SEQ, DM, C.G, C.bid);
            pg8::EpiResid E{l == 0 ? (C.a->in[0]) : (const float*)nullptr, ((bf16*)(C.a->ws + WS_XN)), ((float*)(C.a->ws + WS_RSB))};
            pg8::gemm_phase<pg8::EpiResid, pg8::StaticOrder, true, true>(C.lds + RING_OFF, g, S, E, C.tid);
            mini_phase<1>(C, l);
            if (rep_ + 1 < REP_6) xcd_barrier(bar); }
            SEAM(pb + 6);
        }
        PROBE_END(6);
#endif
        PROBE_BEGIN(7);
        if (IN(pb + 7)) { for (int rep_ = 0; rep_ < REP_7; ++rep_) { FRESH_CTX(); sample_rows_phase(C, ((float*)(C.a->ws + WS_RSB))); if (rep_ + 1 < REP_7) xcd_barrier(bar); } SEAM(pb + 7); }
        PROBE_END(7);
#ifndef NO_G4
        PROBE_BEGIN(8);
        if (IN(pb + 8)) { for (int rep_ = 0; rep_ < REP_8; ++rep_) {
            FRESH_CTX();
            const int nsp = C.G >= 64 ? (C.G * 14) / 256 : 0, gG = C.G - nsp;
            if (C.bid < gG) {
            pg8::Gemm g{((bf16*)(C.a->ws + WS_XN)), ((bf16*)(C.a->ws + WS_WGU)) + (size_t)l * NGU * DM, MP, NGU, DM}; pg8::StaticOrder S; S.init(MP, NGU, gG, C.bid);
            pg8::EpiSwiGLU E{((bf16*)(C.a->ws + WS_HB)), ((float*)(C.a->ws + WS_RSB))};
            pg8::gemm_phase<pg8::EpiSwiGLU, pg8::StaticOrder, GEMM_ALIGN, GEMM_SP2>(C.lds + RING_OFF, g, S, E, C.tid);
            } else { zero_f32(C, ((float*)(C.a->ws + WS_RSA)), SEQ, C.bid - gG, nsp); copy_outs(C, l, C.bid - gG, nsp); cache_shift(C, l, C.bid - gG, nsp); }
            if (nsp == 0) { zero_f32(C, ((float*)(C.a->ws + WS_RSA)), SEQ, C.bid, C.G); copy_outs(C, l, C.bid, C.G); cache_shift(C, l, C.bid, C.G); }
            if (rep_ + 1 < REP_8) xcd_barrier(bar); }
            SEAM(pb + 8);
        }
        PROBE_END(8);
#endif
#ifndef NO_G5
        PROBE_BEGIN(9);
        if (IN(pb + 9)) { for (int rep_ = 0; rep_ < REP_9; ++rep_) {
            FRESH_CTX();
            pg8::Gemm g{((bf16*)(C.a->ws + WS_HB)), ((bf16*)(C.a->ws + WS_WDN)) + (size_t)l * DM * FF, SEQ, DM, FF}; pg8::StaticOrder S; S.init(SEQ, DM, C.G, C.bid);
            pg8::EpiResid E{(const float*)nullptr, ((bf16*)(C.a->ws + WS_XN)), ((float*)(C.a->ws + WS_RSA))};
            pg8::gemm_phase<pg8::EpiResid, pg8::StaticOrder, true, true>(C.lds + RING_OFF, g, S, E, C.tid);
            mini_phase<2>(C, l);
            if (rep_ + 1 < REP_9) xcd_barrier(bar); }
            SEAM(pb + 9);
        }
        PROBE_END(9);
#endif
        PROBE_BEGIN(10);
        if (IN(pb + 10)) { for (int rep_ = 0; rep_ < REP_10; ++rep_) {
            FRESH_CTX();
            if (l + 1 < DEPTH) sample_rows_phase(C, ((float*)(C.a->ws + WS_RSA))); else final_norm_phase(C);
            if (rep_ + 1 < REP_10) xcd_barrier(bar); }
            SEAM(pb + 10);
        }
        PROBE_END(10);
    }
    if (PROBE_CLK && blockIdx.x == 0 && wave_s == 0 && lane_now() == 0) { const unsigned long long c1 = __builtin_amdgcn_s_memtime(), r1 = __builtin_amdgcn_s_memrealtime(); const unsigned long long clk_c0 = ((unsigned long long)MISC[17] << 32) | MISC[16], clk_r0 = ((unsigned long long)MISC[19] << 32) | MISC[18]; const unsigned long long dc = (c1 - clk_c0) * 10000ull, dr = r1 - clk_r0;
        while ((__builtin_amdgcn_s_memrealtime() - r1) * dr < dc) __builtin_amdgcn_s_sleep(8); }
    if (PROBE_LO >= 0 && blockIdx.x == 0 && wave_s == 0 && lane_now() == 0) { const unsigned long long t1 = __builtin_amdgcn_s_memrealtime(); while (__builtin_amdgcn_s_memrealtime() - t1 < (unsigned long long)PROBE_AMP * probe_acc) __builtin_amdgcn_s_sleep(8); }
#undef IN
#undef SEAM
}

extern "C" void kernel_launch(void* const* d_in, const int* in_sizes, int n_in, void* d_out, int out_size, void* d_ws, size_t ws_size, hipStream_t stream) {
    static int grid = 0;
    if (grid == 0) {
        if (n_in != 23 || (size_t)out_size != O_END || ws_size < WS_END) { fprintf(stderr, "kernel_launch: unexpected problem (n_in %d, out %d, ws %zu; need ws >= %zu); nothing launched\n", n_in, out_size, ws_size, (size_t)WS_END); grid = -1; return; }
        int dev = 0, cus = 0, per_cu = 0;
        if (hipGetDevice(&dev) != hipSuccess || hipDeviceGetAttribute(&cus, hipDeviceAttributeMultiprocessorCount, dev) != hipSuccess) { grid = -1; return; }
        if (hipFuncSetAttribute((const void*)fwd, hipFuncAttributeMaxDynamicSharedMemorySize, LDS_BYTES) != hipSuccess) { fprintf(stderr, "kernel_launch: hipFuncSetAttribute failed\n"); grid = -1; return; }
        if (hipOccupancyMaxActiveBlocksPerMultiprocessor(&per_cu, (const void*)fwd, NWAVES * 64, LDS_BYTES) != hipSuccess || per_cu < 1) { fprintf(stderr, "kernel_launch: occupancy query says %d blocks per CU\n", per_cu); }
        (void)hipGetLastError();
        grid = cus;
    }
    if (grid < 0) return;
    if (hipMemsetAsync((char*)d_ws + WS_CTL, 0, CTL_ZERO_BYTES, stream) != hipSuccess) return;
    Args a{};
    for (int i = 0; i < 23; ++i) a.in[i] = (const float*)d_in[i];
    a.out = (float*)d_out; a.ws = (unsigned char*)d_ws; a.pad = 0;
#if MK_SPLIT
    for (int p = 0; p < NPH; ++p) { a.ph_lo = p; a.ph_hi = p + 1; a.use_bar = 0; hipLaunchKernelGGL(fwd, dim3(grid), dim3(NWAVES * 64), LDS_BYTES, stream, a); }
#else
    a.ph_lo = 0; a.ph_hi = NPH; a.use_bar = 1;
    hipLaunchKernelGGL(fwd, dim3(grid), dim3(NWAVES * 64), LDS_BYTES, stream, a);
#endif
    const hipError_t le = hipPeekAtLastError();
    if (le != hipSuccess) fprintf(stderr, "kernel_launch: launch failed: %s\n", hipGetErrorName(le));
}
```

```cpp
#include <hip/hip_runtime.h>
#include <cstdio>
#include <cstdint>

constexpr int DM = 2048, SEQ = 8192, NB = 128, DEPTH = 2;
constexpr int MV = SEQ + NB;
constexpr int MP = 8448;
constexpr int DI = 4096, NH = 64, HP = 64, DS = 128, NG = 8, CD = 6144, CW = 4;
constexpr int AH = 32, KVH = 8, AD = 64, WIN = 128;
constexpr int FF = 5632;
constexpr int IN_DIM = 17472;
constexpr float EPS = 1e-6f;
constexpr int UZ = 0, UXBC = 4096, UQ = 10240, UK = 12288, UV = 12800, UGS = 13312, UGA = 15360, LDU = 17408;
__host__ __device__ __forceinline__ constexpr size_t UIDX(int row, int col) { return ((size_t)(row >> 7) * (LDU / 64) + (size_t)(col >> 6)) * 8192 + (size_t)(((row & 127) << 6) + (col & 63)); }
constexpr int NU = 17664;
constexpr int KCAT = DI + DM;
constexpr int NGU = 2 * FF;

constexpr size_t O_YP = 0;
constexpr size_t O_YS = O_YP + (size_t)SEQ * DM;
constexpr size_t O_PSSM = O_YS + (size_t)NB * DM;
constexpr size_t O_PCONV = O_PSSM + (size_t)DEPTH * NH * HP * DS;
constexpr size_t O_PK = O_PCONV + (size_t)DEPTH * 3 * CD;
constexpr size_t O_PV = O_PK + (size_t)DEPTH * WIN * KVH * AD;
constexpr size_t O_SSSM = O_PV + (size_t)DEPTH * WIN * KVH * AD;
constexpr size_t O_SCONV = O_SSSM + (size_t)DEPTH * NB * NH * HP * DS;
constexpr size_t O_SK = O_SCONV + (size_t)DEPTH * NB * 3 * CD;
constexpr size_t O_SV = O_SK + (size_t)DEPTH * NB * WIN * KVH * AD;
constexpr size_t O_END = O_SV + (size_t)DEPTH * NB * WIN * KVH * AD;
static_assert(O_END == 190877696ull, "output size");

constexpr size_t al256(size_t x) { return (x + 255) & ~(size_t)255; }
constexpr size_t WS_CTL = 0, CTL_ZERO_BYTES = 1u << 20;
constexpr size_t SZ_WIN = (size_t)NU * DM * 2, SZ_WCAT = (size_t)DM * KCAT * 2, SZ_WOUT = (size_t)DM * DM * 2, SZ_WGU = (size_t)NGU * DM * 2, SZ_WDN = (size_t)DM * FF * 2;
constexpr size_t WS_WIN = 1u << 20;
constexpr size_t WS_WCAT = WS_WIN + DEPTH * SZ_WIN;
constexpr size_t WS_WOUT = WS_WCAT + DEPTH * SZ_WCAT;
constexpr size_t WS_WGU = WS_WOUT + DEPTH * SZ_WOUT;
constexpr size_t WS_WDN = WS_WGU + DEPTH * SZ_WGU;
constexpr size_t WS_X = WS_WDN + DEPTH * SZ_WDN;
constexpr size_t WS_XN = WS_X + (size_t)MP * DM * 4;
constexpr size_t WS_U = WS_XN + (size_t)MP * DM * 2;
constexpr size_t WS_DT = WS_U + (size_t)MP * LDU * 2;
constexpr size_t WS_YO = WS_DT + (size_t)MP * 64 * 4;
constexpr size_t WS_MRG = WS_YO + (size_t)MP * KCAT * 2;
constexpr size_t WS_HB = WS_MRG + (size_t)MP * DM * 2;
constexpr size_t WS_XT = WS_HB + (size_t)MP * FF * 2;
constexpr size_t WS_BRM = WS_XT + (size_t)64 * 64 * 64 * 128 * 2;
constexpr size_t WS_BT = WS_BRM + (size_t)64 * 8 * 128 * 128 * 2;
constexpr size_t WS_CRM = WS_BT + (size_t)64 * 8 * 128 * 128 * 2;
constexpr size_t WS_DTT = WS_CRM + (size_t)64 * 8 * 128 * 128 * 2;
constexpr size_t WS_ACS = WS_DTT + (size_t)64 * 64 * 128 * 4;
constexpr size_t WS_VT = WS_ACS + (size_t)64 * 64 * 128 * 4;
constexpr size_t WS_ST = WS_VT + (size_t)8 * 64 * 8192 * 2;
constexpr size_t WS_HS = WS_ST + (size_t)64 * 64 * 64 * 128 * 4;
constexpr size_t WS_MS = WS_HS + (size_t)64 * 64 * 64 * 128 * 2;
constexpr size_t WS_RSA = WS_MS + (size_t)NB * DM * 4;
constexpr size_t WS_RSB = WS_RSA + (size_t)MP * 4;
constexpr size_t WS_END = WS_RSB + (size_t)MP * 4;
static_assert(WS_WIN % 256 == 0 && WS_X % 256 == 0 && WS_U % 256 == 0 && WS_YO % 256 == 0 && WS_HB % 256 == 0 && WS_XT % 256 == 0 && WS_ST % 256 == 0, "ws alignment");
constexpr int CW_BAR = 4096;

constexpr int RING_OFF = 0, RING_BYTES = 131072;
constexpr int PC_B = 0, PC_C = 34816, PC_Y = 69632, PC_SSQ = 139264, PC_AD = 143360, PC_END = 151552;
constexpr int LDSCTL_OFF = PC_END, MISC_OFF = LDSCTL_OFF + 320;
constexpr int LDS_BYTES = 155648;
constexpr int NWAVES = 8;
#define MK_SPLIT 0
namespace pg8 {
#define PG8_LAS __attribute__((address_space(3)))
typedef unsigned short bf16_t;
typedef short bf16x8 __attribute__((ext_vector_type(8)));
typedef float f32x4 __attribute__((ext_vector_type(4)));
typedef unsigned u32x4 __attribute__((ext_vector_type(4)));
constexpr int BM = 256, BK = 64, HALF = 128, HTB = HALF * BK * 2  , STAGE_BYTES = 8 * HTB, NXCD = 8, WGM = 8;

__host__ __device__ __forceinline__ int lds_byte(int r, int c) { const int st = (r >> 4) * 2 + (c >> 5), rr = r & 15, cc = c & 31, ob = rr * 64 + cc * 2; return st * 1024 + (ob ^ (((ob >> 9) & 1) << 5)); }
__host__ __device__ __forceinline__ void stage_rc(int b, int& R, int& C) { const int st = b / 1024, sb = b % 1024, swz = sb ^ (((sb >> 9) & 1) << 5); R = (st >> 1) * 16 + swz / 64; C = (st & 1) * 32 + (swz % 64) / 2; }
__host__ __device__ __forceinline__ int perm32(int rho) { const int n = rho >> 4, i = rho & 15; return 8 * (i >> 2) + 4 * n + (i & 3); }

struct Unit { int pm, pn; };
struct Gemm { const bf16_t* A; const bf16_t* Bt; int M, N, K; };

struct StaticOrder {
    int nM, nN, nwg, G, c;
    __host__ __device__ void init(int M, int N, int G_, int c_) { nM = M / BM; nN = N / BM; nwg = nM * nN; G = G_; c = c_; }
    __host__ __device__ bool next(int i, Unit& u) const {
        const long L = (long)i * G + c; if (L >= nwg) return false;
        int wgid = (int)L; { const int q = nwg / NXCD, r = nwg % NXCD, xcd = wgid % NXCD, off = wgid / NXCD; wgid = (xcd < r ? xcd * (q + 1) : r * (q + 1) + (xcd - r) * q) + off; }
        const int nig = WGM * nN, gid = wgid / nig, fm = gid * WGM, gsz = (nM - fm) < WGM ? (nM - fm) : WGM;
        u.pm = fm + ((wgid % nig) % gsz); u.pn = (wgid % nig) / gsz; return true;
    }
    __device__ __forceinline__ void a_ready(const Unit&) const {}
    __device__ __forceinline__ void done(const Unit&) const {}
};
__device__ __forceinline__ unsigned cvt_pk_bf16(float lo, float hi) { unsigned r; asm volatile("v_cvt_pk_bf16_f32 %0, %1, %2" : "=v"(r) : "v"(lo), "v"(hi)); return r; }
__device__ __forceinline__ float bf_lo(unsigned w) { return __uint_as_float(w << 16); }
__device__ __forceinline__ float bf_hi(unsigned w) { return __uint_as_float(w & 0xffff0000u); }
__device__ __forceinline__ float sigmoidf_(float x) { return __builtin_amdgcn_rcpf(1.0f + __expf(-x)); }
constexpr int E_MV = 8320, E_LDU = 17408, E_UGS = 13312, E_UGA = 15360;
__device__ __forceinline__ size_t e_uidx(int row, int col) { return ((size_t)(row >> 7) * (E_LDU / 64) + (size_t)(col >> 6)) * 8192 + (size_t)(((row & 127) << 6) + (col & 63)); }
struct EpiU {
    static constexpr bool PERM = true, AFTER_DRAIN = false, HOOK = false, RSLDS = true; static constexpr int HOOK_T = -1;
    bf16_t* U; float* DT; const float* dtb; const float* RS;
    __device__ __forceinline__ void hook(f32x4 (&)[2][2][4][2], const Unit&, int, int, int, int) const {}
    __device__ __forceinline__ static float softplus_(float x) { return x > 20.0f ? x : log1pf(__expf(x)); }
    __device__ __forceinline__ void operator()(const f32x4 (&acc)[2][2][4][2], const Unit& u, int wr, int wc, int fr, int fq, const float (&rsv)[8]) const {
        const int row0 = u.pm * BM + wr * 64 + fr;
        auto rstd_ = [&](int q) { return rsqrtf(rsv[q] * (1.0f / 2048.0f) + 1e-6f); };
        if (u.pn == 68) {
            if (wc < 2) { const f32x4 b0 = *(const f32x4*)(dtb + wc * 32 + 8 * fq), b1 = *(const f32x4*)(dtb + wc * 32 + 8 * fq + 4);
#pragma unroll
                for (int ai = 0; ai < 2; ++ai) { if (u.pm * BM + ai * HALF >= E_MV) continue;
#pragma unroll
                    for (int m = 0; m < 4; ++m) { float* p = DT + (size_t)(row0 + ai * HALF + m * 16) * 64 + wc * 32 + 8 * fq; const float rs = rstd_(ai * 4 + m); f32x4 v0 = acc[ai][0][m][0] * rs + b0, v1 = acc[ai][0][m][1] * rs + b1;
#pragma unroll
                        for (int e = 0; e < 4; ++e) { v0[e] = softplus_(v0[e]); v1[e] = softplus_(v1[e]); }
                        *(f32x4*)p = v0; *(f32x4*)(p + 4) = v1; } }
            }
            return;
        }
        const bool sig = u.pn >= 52, zsilu = u.pn < 16;
        const int col0 = u.pn * BM + wc * 32 + 8 * fq;
#pragma unroll
        for (int ai = 0; ai < 2; ++ai) { if (u.pm * BM + ai * HALF >= E_MV) continue;
#pragma unroll
            for (int m = 0; m < 4; ++m) { const int rr = row0 + ai * HALF + m * 16; const float rs = rstd_(ai * 4 + m);
#pragma unroll
                for (int bj = 0; bj < 2; ++bj) { f32x4 v0 = acc[ai][bj][m][0] * rs, v1 = acc[ai][bj][m][1] * rs;
                    if (sig) {
#pragma unroll
                        for (int e = 0; e < 4; ++e) { v0[e] = sigmoidf_(v0[e]); v1[e] = sigmoidf_(v1[e]); } }
                    if (zsilu) {
#pragma unroll
                        for (int e = 0; e < 4; ++e) { v0[e] = v0[e] * sigmoidf_(v0[e]); v1[e] = v1[e] * sigmoidf_(v1[e]); } }
                    u32x4 w; w.x = cvt_pk_bf16(v0[0], v0[1]); w.y = cvt_pk_bf16(v0[2], v0[3]); w.z = cvt_pk_bf16(v1[0], v1[1]); w.w = cvt_pk_bf16(v1[2], v1[3]);
                    *(u32x4*)(U + e_uidx(rr, col0 + bj * HALF)) = w; } } }
    }
};
struct EpiMerge {
    static constexpr bool PERM = true, AFTER_DRAIN = false, HOOK = true, RSLDS = false; static constexpr int HOOK_T = 64;
    const bf16_t* U; bf16_t* O;
    __device__ __forceinline__ void hook(f32x4 (&acc)[2][2][4][2], const Unit& u, int wr, int wc, int fr, int fq) const {
        asm volatile("" : "+v"(fr), "+v"(fq));
        const int row0 = u.pm * BM + wr * 64 + fr, col0 = u.pn * BM + wc * 32 + 8 * fq;
        u32x4 gsA[2][2], gaA[2][2], gsB[2][2], gaB[2][2];
#define HK_LOAD(gs_, ga_, q_) do { _Pragma("unroll") for (int mm = 0; mm < 2; ++mm) { const int rr = row0 + ((q_) >> 1) * HALF + (2 * ((q_) & 1) + mm) * 16; \
            _Pragma("unroll") for (int bj = 0; bj < 2; ++bj) { gs_[mm][bj] = *(const u32x4*)(U + e_uidx(rr, E_UGS + col0 + bj * HALF)); ga_[mm][bj] = *(const u32x4*)(U + e_uidx(rr, E_UGA + col0 + bj * HALF)); } } } while (0)
#define HK_APPLY(gs_, ga_, q_) do { _Pragma("unroll") for (int mm = 0; mm < 2; ++mm) { const int ai = (q_) >> 1, m = 2 * ((q_) & 1) + mm; \
            _Pragma("unroll") for (int bj = 0; bj < 2; ++bj) { const u32x4 s = gs_[mm][bj], a = ga_[mm][bj]; f32x4 r0, r1; \
                r0[0] = bf_lo(s.x) * __builtin_amdgcn_rcpf(fmaxf(bf_lo(a.x), 1e-20f)); r0[1] = bf_hi(s.x) * __builtin_amdgcn_rcpf(fmaxf(bf_hi(a.x), 1e-20f)); r0[2] = bf_lo(s.y) * __builtin_amdgcn_rcpf(fmaxf(bf_lo(a.y), 1e-20f)); r0[3] = bf_hi(s.y) * __builtin_amdgcn_rcpf(fmaxf(bf_hi(a.y), 1e-20f)); \
                r1[0] = bf_lo(s.z) * __builtin_amdgcn_rcpf(fmaxf(bf_lo(a.z), 1e-20f)); r1[1] = bf_hi(s.z) * __builtin_amdgcn_rcpf(fmaxf(bf_hi(a.z), 1e-20f)); r1[2] = bf_lo(s.w) * __builtin_amdgcn_rcpf(fmaxf(bf_lo(a.w), 1e-20f)); r1[3] = bf_hi(s.w) * __builtin_amdgcn_rcpf(fmaxf(bf_hi(a.w), 1e-20f)); \
                acc[ai][bj][m][0] *= r0; acc[ai][bj][m][1] *= r1; } \
            asm volatile("" : "+v"(acc[ai][0][m][0]), "+v"(acc[ai][0][m][1]), "+v"(acc[ai][1][m][0]), "+v"(acc[ai][1][m][1]) :: "memory"); } } while (0)
        HK_LOAD(gsA, gaA, 0); HK_LOAD(gsB, gaB, 1); __builtin_amdgcn_sched_barrier(0);
        HK_APPLY(gsA, gaA, 0); HK_LOAD(gsA, gaA, 2); __builtin_amdgcn_sched_barrier(0);
        HK_APPLY(gsB, gaB, 1); HK_LOAD(gsB, gaB, 3); __builtin_amdgcn_sched_barrier(0);
        HK_APPLY(gsA, gaA, 2); __builtin_amdgcn_sched_barrier(0);
        HK_APPLY(gsB, gaB, 3);
#undef HK_LOAD
#undef HK_APPLY
    }
    __device__ __forceinline__ void operator()(const f32x4 (&acc)[2][2][4][2], const Unit& u, int wr, int wc, int fr, int fq) const {
        const int row0 = u.pm * BM + wr * 64 + fr, col0 = u.pn * BM + wc * 32 + 8 * fq;
        u32x4 gav[2][4][2];
#pragma unroll
        for (int ai = 0; ai < 2; ++ai)
#pragma unroll
            for (int m = 0; m < 4; ++m)
#pragma unroll
                for (int bj = 0; bj < 2; ++bj) gav[ai][m][bj] = *(const u32x4*)(U + e_uidx(row0 + ai * HALF + m * 16, E_UGA + col0 + bj * HALF));
#pragma unroll
        for (int ai = 0; ai < 2; ++ai)
#pragma unroll
            for (int m = 0; m < 4; ++m) { const size_t r = (size_t)(row0 + ai * HALF + m * 16);
#pragma unroll
                for (int bj = 0; bj < 2; ++bj) { const u32x4 ga = gav[ai][m][bj];
                    const f32x4 v0 = acc[ai][bj][m][0], v1 = acc[ai][bj][m][1];
                    u32x4 w; w.x = cvt_pk_bf16(v0[0] * bf_lo(ga.x), v0[1] * bf_hi(ga.x)); w.y = cvt_pk_bf16(v0[2] * bf_lo(ga.y), v0[3] * bf_hi(ga.y));
                    w.z = cvt_pk_bf16(v1[0] * bf_lo(ga.z), v1[1] * bf_hi(ga.z)); w.w = cvt_pk_bf16(v1[2] * bf_lo(ga.w), v1[3] * bf_hi(ga.w));
                    *(u32x4*)(O + r * 2048 + col0 + bj * HALF) = w; } }
    }
};
struct EpiResid {
    static constexpr bool PERM = true, AFTER_DRAIN = false, HOOK = false, RSLDS = false; static constexpr int HOOK_T = -1;
    const float* Xf; bf16_t* XB; float* RS;
    __device__ __forceinline__ void hook(f32x4 (&)[2][2][4][2], const Unit&, int, int, int, int) const {}
    __device__ __forceinline__ void tail_(f32x4 x0, f32x4 x1, float& ss, bf16_t* dst) const {
        ss += ((x0[0] * x0[0] + x0[1] * x0[1]) + (x0[2] * x0[2] + x0[3] * x0[3])) + ((x1[0] * x1[0] + x1[1] * x1[1]) + (x1[2] * x1[2] + x1[3] * x1[3]));
        u32x4 o; o.x = cvt_pk_bf16(x0[0], x0[1]); o.y = cvt_pk_bf16(x0[2], x0[3]); o.z = cvt_pk_bf16(x1[0], x1[1]); o.w = cvt_pk_bf16(x1[2], x1[3]);
        *(u32x4*)dst = o;
    }
    __device__ __forceinline__ void operator()(const f32x4 (&acc)[2][2][4][2], const Unit& u, int wr, int wc, int fr, int fq) const {
        const int row0 = u.pm * BM + wr * 64 + fr, col0 = u.pn * BM + wc * 32 + 8 * fq;
        if (Xf) {
#pragma unroll
            for (int ai = 0; ai < 2; ++ai) { f32x4 xo[4][2][2];
#pragma unroll
                for (int m = 0; m < 4; ++m)
#pragma unroll
                    for (int bj = 0; bj < 2; ++bj) { const float* p = Xf + (size_t)(row0 + ai * HALF + m * 16) * 2048 + col0 + bj * HALF; xo[m][bj][0] = *(const f32x4*)p; xo[m][bj][1] = *(const f32x4*)(p + 4); }
#pragma unroll
                for (int m = 0; m < 4; ++m) { const size_t ro = (size_t)(row0 + ai * HALF + m * 16) * 2048 + col0; float ss = 0.f;
#pragma unroll
                    for (int bj = 0; bj < 2; ++bj) tail_(xo[m][bj][0] + acc[ai][bj][m][0], xo[m][bj][1] + acc[ai][bj][m][1], ss, XB + ro + bj * HALF);
                    ss += __shfl_xor(ss, 16); ss += __shfl_xor(ss, 32);
                    if (fq == 0) unsafeAtomicAdd(RS + row0 + ai * HALF + m * 16, ss); } }
        } else {
            u32x4 xw[2][4][2];
#pragma unroll
            for (int ai = 0; ai < 2; ++ai)
#pragma unroll
                for (int m = 0; m < 4; ++m)
#pragma unroll
                    for (int bj = 0; bj < 2; ++bj) xw[ai][m][bj] = *(const u32x4*)(XB + (size_t)(row0 + ai * HALF + m * 16) * 2048 + col0 + bj * HALF);
#pragma unroll
            for (int ai = 0; ai < 2; ++ai)
#pragma unroll
                for (int m = 0; m < 4; ++m) { const size_t ro = (size_t)(row0 + ai * HALF + m * 16) * 2048 + col0; float ss = 0.f;
#pragma unroll
                    for (int bj = 0; bj < 2; ++bj) { const u32x4 w = xw[ai][m][bj];
                        tail_((f32x4){bf_lo(w.x), bf_hi(w.x), bf_lo(w.y), bf_hi(w.y)} + acc[ai][bj][m][0], (f32x4){bf_lo(w.z), bf_hi(w.z), bf_lo(w.w), bf_hi(w.w)} + acc[ai][bj][m][1], ss, XB + ro + bj * HALF); }
                    ss += __shfl_xor(ss, 16); ss += __shfl_xor(ss, 32);
                    if (fq == 0) unsafeAtomicAdd(RS + row0 + ai * HALF + m * 16, ss); }
        }
    }
};
struct EpiSwiGLU {
    static constexpr bool PERM = true, AFTER_DRAIN = false, HOOK = false, RSLDS = true; static constexpr int HOOK_T = -1;
    bf16_t* H; const float* RS;
    __device__ __forceinline__ void hook(f32x4 (&)[2][2][4][2], const Unit&, int, int, int, int) const {}
    __device__ __forceinline__ void operator()(const f32x4 (&acc)[2][2][4][2], const Unit& u, int wr, int wc, int fr, int fq, const float (&rsv)[8]) const {
        const int row0 = u.pm * BM + wr * 64 + fr, col0 = u.pn * 128 + wc * 16 + 4 * fq;
#pragma unroll
        for (int ai = 0; ai < 2; ++ai) { if (u.pm * BM + ai * HALF >= E_MV) continue;
#pragma unroll
            for (int m = 0; m < 4; ++m) { bf16_t* rowp = H + (size_t)(row0 + ai * HALF + m * 16) * 5632 + col0; const float rs = rsqrtf(rsv[ai * 4 + m] * (1.0f / 2048.0f) + 1e-6f);
#pragma unroll
                for (int bj = 0; bj < 2; ++bj) { const f32x4 g = acc[ai][bj][m][0] * rs, up = acc[ai][bj][m][1] * rs; float h[4];
#pragma unroll
                    for (int e = 0; e < 4; ++e) h[e] = g[e] * __builtin_amdgcn_rcpf(1.0f + __expf(-g[e])) * up[e];
                    typedef unsigned u32x2v __attribute__((ext_vector_type(2))); u32x2v w; w.x = cvt_pk_bf16(h[0], h[1]); w.y = cvt_pk_bf16(h[2], h[3]);
                    *(u32x2v*)(rowp + bj * 64) = w; } } }
    }
};
template <class Epi, class Sched, bool ALIGN_EPI = false, bool SP2 = false>
__device__ __forceinline__ void gemm_phase(PG8_LAS unsigned char* lds, const Gemm g, const Sched& S, const Epi& E, int tid_in) {
    int tid_l = tid_in; asm volatile("" : "+v"(tid_l));
    const int tid = tid_l, wid = __builtin_amdgcn_readfirstlane(tid >> 6), lane = tid & 63, wr = wid >> 2, wc = wid & 3, fr = lane & 15, fq = lane >> 4;
    const int K = g.K, nt = K / BK;
    unsigned voffA[2], voffB[2];
#pragma unroll
    for (int i = 0; i < 2; ++i) { int R, C; stage_rc(tid * 16 + i * 8192, R, C); const int Rb = Epi::PERM ? ((R & ~31) + perm32(R & 31)) : R;
        voffA[i] = (unsigned)(R * K + C) * 2u; voffB[i] = (unsigned)(Rb * K + C) * 2u; }
    const size_t kstep = (size_t)(BK * 2);
    const size_t hstep = (size_t)HALF * K * 2;
    const size_t tstep = 2 * hstep;
    const unsigned ldsw = (unsigned)wid * 1024u;
    const int aoff = lds_byte(wr * 64 + fr, fq * 8), boff = lds_byte(wc * 32 + fr, fq * 8);
#define PG8_SA(b, h) (((b) * 2 + (h)) * HTB)
#define PG8_SB(b, h) ((4 + (b) * 2 + (h)) * HTB)
#define PG8_STAGE(bufoff, gbase, voff) do { _Pragma("unroll") for (int _i = 0; _i < 2; ++_i) \
        __builtin_amdgcn_global_load_lds((const unsigned*)((const char*)(gbase) + (voff)[_i]), (PG8_LAS unsigned*)(lds + (bufoff) + ldsw + _i * 8192), 16, 0, 0); } while (0)
#define PG8_LDA(dst, b, h) do { _Pragma("unroll") for (int m = 0; m < 4; ++m) _Pragma("unroll") for (int k = 0; k < 2; ++k) dst[m][k] = *(const PG8_LAS bf16x8*)(lds + PG8_SA(b, h) + aoff + m * 2048 + k * 1024); } while (0)
#define PG8_LDB(dst, b, h) do { _Pragma("unroll") for (int n = 0; n < 2; ++n) _Pragma("unroll") for (int k = 0; k < 2; ++k) dst[n][k] = *(const PG8_LAS bf16x8*)(lds + PG8_SB(b, h) + boff + n * 2048 + k * 1024); } while (0)
#define PG8_MMA(ai, bj, At, Bt) do { __builtin_amdgcn_s_setprio(1); _Pragma("unroll") for (int m = 0; m < 4; ++m) _Pragma("unroll") for (int n = 0; n < 2; ++n) _Pragma("unroll") for (int k = 0; k < 2; ++k) \
        acc[ai][bj][m][n] = __builtin_amdgcn_mfma_f32_16x16x32_bf16(Bt[n][k], At[m][k], acc[ai][bj][m][n], 0, 0, 0); __builtin_amdgcn_s_setprio(0); } while (0)
#define PG8_WAIT_V(n) asm volatile("s_waitcnt vmcnt(" #n ")" ::: "memory")
#define PG8_WAIT_L(n) asm volatile("s_waitcnt lgkmcnt(" #n ")" ::: "memory")
#define PG8_BAR __builtin_amdgcn_s_barrier()
#define PG8_SCHED __builtin_amdgcn_sched_barrier(0)
    Unit cur, nxt; int ui = 0;
    if (!S.next(0, cur)) return;
    f32x4 acc[2][2][4][2];
#pragma unroll
    for (int a = 0; a < 2; ++a)
#pragma unroll
        for (int b = 0; b < 2; ++b)
#pragma unroll
            for (int m = 0; m < 4; ++m)
#pragma unroll
                for (int n = 0; n < 2; ++n) acc[a][b][m][n] = (f32x4){0.f, 0.f, 0.f, 0.f};
    bf16x8 At[4][2], B0[2][2], B1[2][2];
    const char* cA = (const char*)g.A + (size_t)cur.pm * tstep; const char* cB = (const char*)g.Bt + (size_t)cur.pn * tstep;
    S.a_ready(cur);
#define PG8_RSDMA(pm_, par_) __builtin_amdgcn_global_load_lds((const unsigned*)(E.RS + (pm_) * BM + wid * 64 + ((fq << 4) | fr)), (PG8_LAS unsigned*)(lds + 131072 + (par_) * 1024 + wid * 256), 4, 0, 0)
    if constexpr (Epi::RSLDS) { if (wid < 4) PG8_RSDMA(cur.pm, 0); }
    if constexpr (SP2) {
        PG8_STAGE(PG8_SB(0, 0), cB, voffB); PG8_STAGE(PG8_SB(0, 1), cB + hstep, voffB); PG8_STAGE(PG8_SA(0, 0), cA, voffA); PG8_STAGE(PG8_SA(0, 1), cA + hstep, voffA);
        if (wr == 1) PG8_BAR;
        PG8_WAIT_V(2); PG8_BAR;
        PG8_STAGE(PG8_SB(1, 0), cB + kstep, voffB); PG8_STAGE(PG8_SA(1, 0), cA + kstep, voffA); PG8_STAGE(PG8_SB(1, 1), cB + hstep + kstep, voffB);
        PG8_WAIT_V(6); PG8_BAR;
    } else {
        PG8_STAGE(PG8_SB(0, 0), cB, voffB); PG8_STAGE(PG8_SA(0, 0), cA, voffA); PG8_STAGE(PG8_SB(0, 1), cB + hstep, voffB); PG8_STAGE(PG8_SA(0, 1), cA + hstep, voffA);
        if (wr == 1) PG8_BAR;
        PG8_WAIT_V(4); PG8_BAR;
        PG8_STAGE(PG8_SB(1, 0), cB + kstep, voffB); PG8_STAGE(PG8_SA(1, 0), cA + kstep, voffA); PG8_STAGE(PG8_SB(1, 1), cB + hstep + kstep, voffB);
        PG8_WAIT_V(6); PG8_BAR;
    }
    for (;;) {
        const bool has_next = S.next(ui + 1, nxt);
        const char* nA = has_next ? (const char*)g.A + (size_t)nxt.pm * tstep : cA; const char* nB = has_next ? (const char*)g.Bt + (size_t)nxt.pn * tstep : cB;
        for (int t = 0; t < nt; t += 2) {
            const bool last = (t == nt - 2);
            const char* a1 = cA + (size_t)(t + 1) * kstep;
            const char* a2 = last ? nA : cA + (size_t)(t + 2) * kstep; const char* b2 = last ? nB : cB + (size_t)(t + 2) * kstep;
            const char* a3 = a2 + kstep; const char* b3 = b2 + kstep;
            if (last && has_next) S.a_ready(nxt);
            if constexpr (Epi::HOOK) { if (t == Epi::HOOK_T) E.hook(acc, cur, wr, wc, fr, fq); }
            if constexpr (SP2) {
            PG8_LDB(B0, 0, 0); PG8_LDB(B1, 0, 1); PG8_SCHED; PG8_LDA(At, 0, 0); PG8_STAGE(PG8_SA(1, 1), a1 + hstep, voffA);
            PG8_WAIT_V(8); PG8_WAIT_L(0); PG8_BAR; PG8_MMA(0, 0, At, B0); PG8_MMA(0, 1, At, B1); PG8_BAR; PG8_SCHED;
            PG8_LDA(At, 0, 1); PG8_STAGE(PG8_SB(0, 0), b2, voffB); PG8_STAGE(PG8_SB(0, 1), b2 + hstep, voffB); PG8_STAGE(PG8_SA(0, 0), a2, voffA);
            PG8_WAIT_V(8); PG8_WAIT_L(0); PG8_BAR; PG8_MMA(1, 0, At, B0); PG8_MMA(1, 1, At, B1); PG8_BAR; PG8_SCHED;
            PG8_LDB(B0, 1, 0); PG8_LDB(B1, 1, 1); PG8_SCHED; PG8_LDA(At, 1, 0); PG8_STAGE(PG8_SA(0, 1), a2 + hstep, voffA);
            PG8_WAIT_V(8); PG8_WAIT_L(0); PG8_BAR; PG8_MMA(0, 0, At, B0); PG8_MMA(0, 1, At, B1); PG8_BAR; PG8_SCHED;
            PG8_LDA(At, 1, 1); PG8_STAGE(PG8_SB(1, 0), b3, voffB); PG8_STAGE(PG8_SB(1, 1), b3 + hstep, voffB); PG8_STAGE(PG8_SA(1, 0), a3, voffA);
            PG8_WAIT_V(8); PG8_WAIT_L(0); PG8_BAR; PG8_MMA(1, 0, At, B0); PG8_MMA(1, 1, At, B1); PG8_BAR; PG8_SCHED;
            } else {
            PG8_LDB(B0, 0, 0); PG8_SCHED; PG8_LDA(At, 0, 0); PG8_STAGE(PG8_SA(1, 1), a1 + hstep, voffA);
            PG8_WAIT_L(8); PG8_BAR; PG8_WAIT_L(0); PG8_MMA(0, 0, At, B0); PG8_BAR; PG8_SCHED;
            PG8_LDB(B1, 0, 1); PG8_STAGE(PG8_SB(0, 0), b2, voffB);
            PG8_BAR; PG8_WAIT_L(0); PG8_MMA(0, 1, At, B1); PG8_BAR;
            PG8_LDA(At, 0, 1); PG8_STAGE(PG8_SA(0, 0), a2, voffA);
            PG8_BAR; PG8_WAIT_L(0); PG8_MMA(1, 0, At, B0); PG8_BAR; PG8_SCHED;
            PG8_STAGE(PG8_SB(0, 1), b2 + hstep, voffB);
            PG8_WAIT_V(6); PG8_BAR; PG8_MMA(1, 1, At, B1); PG8_BAR;
            PG8_LDB(B0, 1, 0); PG8_SCHED; PG8_LDA(At, 1, 0); PG8_STAGE(PG8_SA(0, 1), a2 + hstep, voffA);
            PG8_WAIT_L(8); PG8_BAR; PG8_WAIT_L(0); PG8_MMA(0, 0, At, B0); PG8_BAR; PG8_SCHED;
            PG8_LDB(B1, 1, 1); PG8_STAGE(PG8_SB(1, 0), b3, voffB);
            PG8_BAR; PG8_WAIT_L(0); PG8_MMA(0, 1, At, B1); PG8_BAR;
            PG8_LDA(At, 1, 1); PG8_STAGE(PG8_SA(1, 0), a3, voffA);
            PG8_BAR; PG8_WAIT_L(0); PG8_MMA(1, 0, At, B0); PG8_BAR; PG8_SCHED;
            PG8_STAGE(PG8_SB(1, 1), b3 + hstep, voffB);
            PG8_WAIT_V(6); PG8_BAR; PG8_MMA(1, 1, At, B1); PG8_BAR;
            }
        }
        if constexpr (ALIGN_EPI) { if (wr == 0) PG8_BAR; }
        if constexpr (!Epi::AFTER_DRAIN) {
            if constexpr (Epi::RSLDS) { float rsv[8]; const PG8_LAS float* rsl = (const PG8_LAS float*)(lds + 131072 + (ui & 1) * 1024) + wr * 64 + fr;
#pragma unroll
                for (int q = 0; q < 8; ++q) rsv[q] = rsl[(q >> 2) * HALF + (q & 3) * 16];
                asm volatile("s_waitcnt lgkmcnt(0)" : "+v"(rsv[0]), "+v"(rsv[1]), "+v"(rsv[2]), "+v"(rsv[3]), "+v"(rsv[4]), "+v"(rsv[5]), "+v"(rsv[6]), "+v"(rsv[7]) :: "memory");
                if (has_next && wid < 4) PG8_RSDMA(nxt.pm, (ui + 1) & 1);
                E(acc, cur, wr, wc, fr, fq, rsv);
            } else E(acc, cur, wr, wc, fr, fq);
            S.done(cur); }
        if (!has_next) break;
#pragma unroll
        for (int a = 0; a < 2; ++a)
#pragma unroll
            for (int b = 0; b < 2; ++b)
#pragma unroll
                for (int m = 0; m < 4; ++m)
#pragma unroll
                    for (int n = 0; n < 2; ++n) acc[a][b][m][n] = (f32x4){0.f, 0.f, 0.f, 0.f};
        cur = nxt; cA = nA; cB = nB; ++ui;
        if constexpr (ALIGN_EPI) { if (wr == 1) PG8_BAR; }
    }
    PG8_WAIT_V(0);
    if constexpr (!ALIGN_EPI) { if (wr == 0) PG8_BAR; }
    PG8_BAR;
    if constexpr (Epi::AFTER_DRAIN) { E.fused(acc, cur, wr, wc, fr, fq, lds, wid, lane); S.done(cur); }
#undef PG8_RSDMA
#undef PG8_SA
#undef PG8_SB
#undef PG8_STAGE
#undef PG8_LDA
#undef PG8_LDB
#undef PG8_MMA
#undef PG8_WAIT_V
#undef PG8_WAIT_L
#undef PG8_BAR
#undef PG8_SCHED
}
}
#define GAS __attribute__((address_space(1)))
#define LAS __attribute__((address_space(3)))
typedef unsigned short bf16;
typedef unsigned v4u __attribute__((ext_vector_type(4)));
typedef float f32x4 __attribute__((ext_vector_type(4)));
typedef short bf16x8 __attribute__((ext_vector_type(8)));
typedef GAS unsigned gu32;
typedef GAS unsigned long long gu64;
#define RLX_AGENT __ATOMIC_RELAXED, __HIP_MEMORY_SCOPE_AGENT
#define LDS_WAIT() asm volatile("s_waitcnt lgkmcnt(0)" ::: "memory")
#define VM_WAIT() asm volatile("s_waitcnt vmcnt(0)" ::: "memory")
__device__ __forceinline__ unsigned long long rt() { return __builtin_amdgcn_s_memrealtime(); }
__device__ __forceinline__ unsigned f2bf(float f) { unsigned u = __builtin_bit_cast(unsigned, f); return (u + 0x7fffu + ((u >> 16) & 1u)) >> 16; }
__device__ __forceinline__ unsigned pk2(float lo, float hi) { return f2bf(lo) | (f2bf(hi) << 16); }

#define XB_TMO      128
#define XB_XCNT(j)  (256  + 64 * (j))
#define XB_XSUB(j)  (1280 + 64 * (j))
#define XB_XGEN(j)  (2304 + 64 * (j))
#define XB_TOP      3328
#define XB_TOPGEN   3392
#define XCD_BAR_WORDS 3456
#define XB_SPIN_CAP (1u << 18)

__device__ __forceinline__ unsigned xb_ld(unsigned* p)              { return __hip_atomic_load(p, __ATOMIC_RELAXED, __HIP_MEMORY_SCOPE_AGENT); }
__device__ __forceinline__ unsigned xb_add(unsigned* p, unsigned v) { return __hip_atomic_fetch_add(p, v, __ATOMIC_RELAXED, __HIP_MEMORY_SCOPE_AGENT); }
__device__ __forceinline__ unsigned xb_xcc_id() { return (unsigned)__builtin_amdgcn_s_getreg((3 << 11) | 20) & 0xFu; }
#define XB_SPIN(cond, bar) do { unsigned _sp = 0; while (cond) { __builtin_amdgcn_s_sleep(1); \
    if ((++_sp & 255u) == 0u) { if (xb_ld(&(bar)[XB_TMO])) break; if (_sp > XB_SPIN_CAP) { atomicAdd(&(bar)[XB_TMO], 1u); break; } } } } while (0)

struct XcdBarrier {
    unsigned* bar; unsigned x;
    volatile LAS unsigned* st;
};

__device__ __forceinline__ XcdBarrier xcd_barrier_post(unsigned* bar, volatile LAS unsigned* st) {
    XcdBarrier b; b.bar = bar; b.x = xb_xcc_id(); b.st = st;
    if (threadIdx.x == 0) (void)xb_add(&bar[XB_XCNT(b.x)], 1u);
    return b;
}
__device__ __forceinline__ void xcd_barrier_complete(unsigned* bar, unsigned x, unsigned& nloc, unsigned& nx) {
    const unsigned G = gridDim.x * gridDim.y * gridDim.z;
    unsigned sum, cnt, mine, sp = 0u;
    for (;;) {
        sum = 0u; cnt = 0u; mine = 0u;
#pragma unroll
        for (unsigned j = 0; j < 16; ++j) { const unsigned c = xb_ld(&bar[XB_XCNT(j)]); sum += c; cnt += (c > 0u) ? 1u : 0u; mine = (j == x) ? c : mine; }
        if (sum == G) break;
        __builtin_amdgcn_s_sleep(1);
        if ((++sp & 255u) == 0u) { if (xb_ld(&bar[XB_TMO])) break; if (sp > XB_SPIN_CAP) { atomicAdd(&bar[XB_TMO], 1u); break; } }
    }
    nloc = mine > 0u ? mine : 1u; nx = cnt > 0u ? cnt : 1u;
}

__device__ __forceinline__ void xcd_barrier(const XcdBarrier& b) {
    asm volatile("s_waitcnt vmcnt(0)" ::: "memory");
    __syncthreads();
    if (threadIdx.x == 0) {
        unsigned* bar = b.bar;
        __builtin_amdgcn_s_waitcnt(0);
        unsigned nloc = b.st[0], nx = b.st[1];
        if (nloc == 0u) { xcd_barrier_complete(bar, b.x, nloc, nx); b.st[0] = nloc; b.st[1] = nx; }
        const unsigned old = xb_add(&bar[XB_XSUB(b.x)], 1u);
        const unsigned gen = old / nloc;
        if (old + 1u == (gen + 1u) * nloc) {
            __builtin_amdgcn_fence(__ATOMIC_RELEASE, "agent");
            asm volatile("s_waitcnt vmcnt(0)" ::: "memory");
            const unsigned og = xb_add(&bar[XB_TOP], 1u);
            const unsigned tg = og / nx;
            if (og + 1u == (tg + 1u) * nx) xb_add(&bar[XB_TOPGEN], 1u);
            else XB_SPIN(xb_ld(&bar[XB_TOPGEN]) == tg, bar);
            __builtin_amdgcn_fence(__ATOMIC_ACQUIRE, "agent");
            xb_add(&bar[XB_XGEN(b.x)], 1u);
            asm volatile("s_waitcnt vmcnt(0)" ::: "memory");
        } else {
            XB_SPIN(xb_ld(&bar[XB_XGEN(b.x)]) == gen, bar);
            __builtin_amdgcn_fence(__ATOMIC_ACQUIRE, "agent");
            asm volatile("s_waitcnt vmcnt(0)" ::: "memory");
        }
    }
    __syncthreads();
}
typedef float f32x16 __attribute__((ext_vector_type(16)));
typedef unsigned u32x2 __attribute__((ext_vector_type(2)));
__device__ __forceinline__ float bf2f(bf16 v) { return __uint_as_float(((unsigned)v) << 16); }
__device__ __forceinline__ float bflo(unsigned w) { return __uint_as_float(w << 16); }
__device__ __forceinline__ float bfhi(unsigned w) { return __uint_as_float(w & 0xffff0000u); }
__device__ __forceinline__ float wave_sum(float v) {
#pragma unroll
    for (int o = 1; o < 64; o <<= 1) v += __shfl_xor(v, o);
    return v;
}
__device__ __forceinline__ float wave_max(float v) {
#pragma unroll
    for (int o = 1; o < 64; o <<= 1) v = fmaxf(v, __shfl_xor(v, o));
    return v;
}
__device__ __forceinline__ float siluf_(float x) { return x * __builtin_amdgcn_rcpf(1.0f + __expf(-x)); }
__device__ __forceinline__ float softplusf_(float x) { return x > 20.0f ? x : log1pf(__expf(x)); }

struct Args { const float* in[23]; float* out; unsigned char* ws; int ph_lo, ph_hi, use_bar, pad; };
typedef const __attribute__((address_space(4))) Args* KArgs;
struct Ctx { LAS unsigned char* lds; int tid, lane, wave, G, bid; KArgs a; };

__device__ __forceinline__ int lane_now() { int t; asm volatile("v_mbcnt_lo_u32_b32 %0, -1, 0\n\tv_mbcnt_hi_u32_b32 %0, -1, %0" : "=v"(t)); return t; }
struct TItem { const float* sp; const float* gn; bf16* WT; int ldn, rowl, K, k0, R0; };
__device__ __forceinline__ void titem_load(const TItem& t, f32x4 (&v)[16], f32x4 (&gv)[4], int) {
    const int kk = lane_now() >> 4;
    if (t.sp) {
#pragma unroll
        for (int i = 0; i < 16; ++i) v[i] = __builtin_nontemporal_load((const GAS f32x4*)(t.sp + (size_t)(t.k0 + 16 * kk + i) * t.ldn));
        if (t.gn) { const GAS f32x4* gp = (const GAS f32x4*)(t.gn + t.k0 + 16 * kk);
#pragma unroll
            for (int q = 0; q < 4; ++q) gv[q] = gp[q]; }
    } else {
#pragma unroll
        for (int i = 0; i < 16; ++i) { float z0 = 0.f; asm volatile("" : "+v"(z0)); v[i] = (f32x4){z0, z0, z0, z0}; }
    }
}
__device__ __forceinline__ void titem_store(const TItem& t, const f32x4 (&vin)[16], const f32x4 (&gv)[4], LAS unsigned short* T, int) {
    const int lane = lane_now(), kk = lane >> 4;
    LAS unsigned char* Tb = (LAS unsigned char*)T;
#pragma unroll
    for (int j = 0; j < 4; ++j) { const int n = t.rowl + j, sw = (n >> 2) & 7; v4u lo, hi;
#define TI_PK(a_) pg8::cvt_pk_bf16(vin[a_][j] * gv[(a_) >> 2].x, vin[(a_) + 1][j] * gv[(a_) >> 2].y)
#define TI_PK2(a_) pg8::cvt_pk_bf16(vin[a_][j] * gv[(a_) >> 2].z, vin[(a_) + 1][j] * gv[(a_) >> 2].w)
#define TI_PN(a_) pg8::cvt_pk_bf16(vin[a_][j], vin[(a_) + 1][j])
        if (t.gn && t.sp) { lo.x = TI_PK(0); lo.y = TI_PK2(2); lo.z = TI_PK(4); lo.w = TI_PK2(6); hi.x = TI_PK(8); hi.y = TI_PK2(10); hi.z = TI_PK(12); hi.w = TI_PK2(14); }
        else { lo.x = TI_PN(0); lo.y = TI_PN(2); lo.z = TI_PN(4); lo.w = TI_PN(6); hi.x = TI_PN(8); hi.y = TI_PN(10); hi.z = TI_PN(12); hi.w = TI_PN(14); }
#undef TI_PK
#undef TI_PK2
#undef TI_PN
        *(LAS v4u*)(Tb + n * 128 + (((2 * kk) ^ sw) << 4)) = lo; *(LAS v4u*)(Tb + n * 128 + (((2 * kk + 1) ^ sw) << 4)) = hi; }
    LDS_WAIT(); asm volatile("" ::: "memory");
    const int ch = lane & 7, nr = lane >> 3;
#pragma unroll
    for (int it = 0; it < 8; ++it) { const int n = nr + 8 * it;
        const v4u o = *(const LAS v4u*)(Tb + n * 128 + ((ch ^ ((n >> 2) & 7)) << 4));
        *(GAS v4u*)(t.WT + (size_t)(t.R0 + n) * t.K + t.k0 + 8 * ch) = o; }
    LDS_WAIT(); asm volatile("" ::: "memory");
}
constexpr int IT_IN = (DM / 64) * (NU / 64), IT_CAT = (KCAT / 64) * (DM / 64), IT_OUT = (DM / 64) * (DM / 64), IT_GU = (DM / 64) * (NGU / 64), IT_DN = (FF / 64) * (DM / 64);
constexpr int IT_LAYER = IT_IN + IT_CAT + IT_OUT + IT_GU + IT_DN;
__device__ __forceinline__ TItem titem_decode(const Ctx& C, int it) {
    const int c4 = lane_now() & 15, l = it / IT_LAYER; int q = it % IT_LAYER; TItem t;
    if (q < IT_IN) { const int nblk = NU / 64, kb = q / nblk, nb = q % nblk, R = 64 * nb + 4 * c4;
        const int col = R < 10240 ? R : (R < 17408 ? R + 64 : (R < 17472 ? 10240 + (R - 17408) : -1));
        t.sp = col >= 0 ? (C.a->in[7]) + (size_t)l * DM * IN_DIM + col : nullptr; t.gn = (C.a->in[6]) + (size_t)l * DM; t.ldn = IN_DIM; t.rowl = 4 * c4; t.K = DM; t.WT = ((bf16*)(C.a->ws + WS_WIN)) + (size_t)l * NU * DM; t.k0 = 64 * kb; t.R0 = 64 * nb; return t; }
    q -= IT_IN;
    if (q < IT_CAT) { const int nblk = DM / 64, kb = q / nblk, nb = q % nblk, R = 64 * nb + 4 * c4, k0 = 64 * kb;
        t.sp = k0 < DI ? (C.a->in[14]) + (size_t)l * DI * DM + R : (C.a->in[15]) + (size_t)l * DM * DM + R - (size_t)DI * DM;
        t.gn = nullptr; t.ldn = DM; t.rowl = 4 * c4; t.K = KCAT; t.WT = ((bf16*)(C.a->ws + WS_WCAT)) + (size_t)l * DM * KCAT; t.k0 = k0; t.R0 = 64 * nb; return t; }
    q -= IT_CAT;
    if (q < IT_OUT) { const int nblk = DM / 64, kb = q / nblk, nb = q % nblk, R = 64 * nb + 4 * c4;
        t.sp = (C.a->in[17]) + (size_t)l * DM * DM + R; t.gn = nullptr; t.ldn = DM; t.rowl = 4 * c4; t.K = DM; t.WT = ((bf16*)(C.a->ws + WS_WOUT)) + (size_t)l * DM * DM; t.k0 = 64 * kb; t.R0 = 64 * nb; return t; }
    q -= IT_OUT;
    if (q < IT_GU) { const int nblk = NGU / 64, kb = q / nblk, nb = q % nblk;
        const int up = c4 >> 3, cg = c4 & 7;
        t.sp = (up ? (C.a->in[20]) : (C.a->in[19])) + (size_t)l * DM * FF + 32 * nb + 4 * cg; t.gn = (C.a->in[18]) + (size_t)l * DM; t.ldn = FF; t.rowl = 8 * cg + 4 * up; t.K = DM; t.WT = ((bf16*)(C.a->ws + WS_WGU)) + (size_t)l * NGU * DM; t.k0 = 64 * kb; t.R0 = 64 * nb; return t; }
    q -= IT_GU;
    { const int nblk = DM / 64, kb = q / nblk, nb = q % nblk, R = 64 * nb + 4 * c4;
        t.sp = (C.a->in[21]) + (size_t)l * FF * DM + R; t.gn = nullptr; t.ldn = DM; t.rowl = 4 * c4; t.K = FF; t.WT = ((bf16*)(C.a->ws + WS_WDN)) + (size_t)l * DM * FF; t.k0 = 64 * kb; t.R0 = 64 * nb; return t; }
}
__device__ __forceinline__ void p0_weights(const Ctx& C, int it_lo, int it_hi, int gw, int NGW) {
    LAS unsigned short* T = (LAS unsigned short*)(C.lds + RING_OFF + C.wave * 16384);
    int it = it_lo + gw; if (it >= it_hi) return;
    TItem cur = titem_decode(C, it); f32x4 va[16], vb[16], ga[4], gb[4];
    titem_load(cur, va, ga, C.lane);
    for (;;) {
        int nit = it + NGW; TItem nxt = cur; const bool hn = nit < it_hi;
        if (hn) { nxt = titem_decode(C, nit); titem_load(nxt, vb, gb, C.lane); }
        titem_store(cur, va, ga, T, C.lane);
        if (!hn) break;
        it = nit + NGW; cur = nxt; const bool hn2 = it < it_hi;
        if (hn2) { cur = titem_decode(C, it); titem_load(cur, va, ga, C.lane); }
        titem_store(nxt, vb, gb, T, C.lane);
        if (!hn2) break;
    }
}
__device__ __forceinline__ void norm_row(const float* src, const float* gain, float* xcopy, bf16* xb, float* rs, float* fdst, int lane) {
    const GAS f32x4* xr = (const GAS f32x4*)src + lane;
    f32x4 v[8]; float s = 0.f;
#pragma unroll
    for (int j = 0; j < 8; ++j) { v[j] = xr[64 * j]; s += (v[j].x * v[j].x + v[j].y * v[j].y) + (v[j].z * v[j].z + v[j].w * v[j].w); }
    s = wave_sum(s);
    if (rs && lane == 0) *rs = s;
    if (xcopy) { GAS f32x4* xc = (GAS f32x4*)xcopy + lane;
#pragma unroll
        for (int j = 0; j < 8; ++j) xc[64 * j] = v[j]; }
    if (xb) {
#pragma unroll
        for (int j = 0; j < 8; ++j) { u32x2 w; w.x = pk2(v[j].x, v[j].y); w.y = pk2(v[j].z, v[j].w); *((GAS u32x2*)xb + lane + 64 * j) = w; } }
    if (fdst) { const float rstd = rsqrtf(s * (1.0f / DM) + EPS); const GAS f32x4* gr = (const GAS f32x4*)gain + lane;
#pragma unroll
        for (int j = 0; j < 8; ++j) { const f32x4 g = gr[64 * j]; f32x4 o = v[j] * rstd; o = o * g; *((GAS f32x4*)fdst + lane + 64 * j) = o; } }
}
__device__ __forceinline__ void p0_xinit(const Ctx& C) {
    const int NGW = C.G * NWAVES, gw = NGW - 1 - (C.bid * NWAVES + C.wave), lane = C.lane;
    int m = gw; if (m >= MV) return;
    f32x4 v[8], w[8];
#define XI_SRC(m_) ((const GAS f32x4*)((m_) < SEQ ? (C.a->in[0]) + (size_t)(m_) * DM : (C.a->in[1]) + (size_t)((m_) - SEQ) * DM) + lane)
    { const GAS f32x4* xr = XI_SRC(m);
#pragma unroll
      for (int j = 0; j < 8; ++j) v[j] = xr[64 * j]; }
    for (;;) {
        const int mn = m + NGW; const bool hn = mn < MV;
        if (hn) { const GAS f32x4* xr = XI_SRC(mn);
#pragma unroll
            for (int j = 0; j < 8; ++j) w[j] = xr[64 * j]; }
        __builtin_amdgcn_sched_barrier(0);
        float s = 0.f;
#pragma unroll
        for (int j = 0; j < 8; ++j) s += (v[j].x * v[j].x + v[j].y * v[j].y) + (v[j].z * v[j].z + v[j].w * v[j].w);
        s = wave_sum(s);
        if (lane == 0) ((float*)(C.a->ws + WS_RSA))[m] = s;
        if (m >= SEQ) { GAS f32x4* xc = (GAS f32x4*)(((float*)(C.a->ws + WS_X)) + (size_t)m * DM) + lane;
#pragma unroll
            for (int j = 0; j < 8; ++j) xc[64 * j] = v[j]; }
        { bf16* xb = ((bf16*)(C.a->ws + WS_XN)) + (size_t)m * DM;
#pragma unroll
          for (int j = 0; j < 8; ++j) { u32x2 o; o.x = pg8::cvt_pk_bf16(v[j].x, v[j].y); o.y = pg8::cvt_pk_bf16(v[j].z, v[j].w); *((GAS u32x2*)xb + lane + 64 * j) = o; } }
        if (!hn) break;
        m = mn;
#pragma unroll
        for (int j = 0; j < 8; ++j) v[j] = w[j];
    }
#undef XI_SRC
}
__device__ __forceinline__ void sample_rows_phase(const Ctx& C, float* RS) {
    const int gw = C.bid * NWAVES + C.wave, NGW = C.G * NWAVES;
    for (int m = SEQ + gw; m < MV; m += NGW) norm_row(((float*)(C.a->ws + WS_X)) + (size_t)m * DM, nullptr, nullptr, ((bf16*)(C.a->ws + WS_XN)) + (size_t)m * DM, RS + m, nullptr, C.lane);
}
__device__ __forceinline__ void final_norm_phase(const Ctx& C) {
    const int gw = C.bid * NWAVES + C.wave, NGW = C.G * NWAVES, lane = C.lane;
    f32x4 gv[8];
    { const GAS f32x4* gr = (const GAS f32x4*)(C.a->in[22]) + 2 * lane;
#pragma unroll
      for (int j = 0; j < 4; ++j) { gv[2 * j] = gr[128 * j]; gv[2 * j + 1] = gr[128 * j + 1]; } }
    for (int m = gw; m < MV; m += NGW) {
        if (m >= SEQ) { norm_row(((float*)(C.a->ws + WS_X)) + (size_t)m * DM, (C.a->in[22]), nullptr, nullptr, nullptr, (C.a->out) + O_YP + (size_t)m * DM, lane); continue; }
        const GAS v4u* xr = (const GAS v4u*)(((bf16*)(C.a->ws + WS_XN)) + (size_t)m * DM) + lane; v4u w[4]; float s = 0.f;
#pragma unroll
        for (int j = 0; j < 4; ++j) { w[j] = xr[64 * j]; const float a0 = bflo(w[j].x), a1 = bfhi(w[j].x), a2 = bflo(w[j].y), a3 = bfhi(w[j].y), a4 = bflo(w[j].z), a5 = bfhi(w[j].z), a6 = bflo(w[j].w), a7 = bfhi(w[j].w);
            s += ((a0 * a0 + a1 * a1) + (a2 * a2 + a3 * a3)) + ((a4 * a4 + a5 * a5) + (a6 * a6 + a7 * a7)); }
        const float rstd = rsqrtf(wave_sum(s) * (1.0f / DM) + EPS);
        GAS f32x4* op = (GAS f32x4*)((C.a->out) + O_YP + (size_t)m * DM) + 2 * lane;
#pragma unroll
        for (int j = 0; j < 4; ++j) { const f32x4 g0 = gv[2 * j], g1 = gv[2 * j + 1];
            op[128 * j] = (f32x4){bflo(w[j].x) * rstd * g0.x, bfhi(w[j].x) * rstd * g0.y, bflo(w[j].y) * rstd * g0.z, bfhi(w[j].y) * rstd * g0.w};
            op[128 * j + 1] = (f32x4){bflo(w[j].z) * rstd * g1.x, bfhi(w[j].z) * rstd * g1.y, bflo(w[j].w) * rstd * g1.z, bfhi(w[j].w) * rstd * g1.w}; }
    }
}
__device__ __forceinline__ void zero_f32(const Ctx& C, float* p, int n, int vb, int nvb) { float z0 = 0.f; asm volatile("" : "+v"(z0)); for (int i = vb * 512 + C.tid; i < n; i += nvb * 512) p[i] = z0; }

__device__ __forceinline__ void sample_ssd_wave_unit(const Ctx& C, int l, int b, int g, LAS float* wsc) {
    const int lane = lane_now();
    const int row = SEQ + b, n4 = lane & 31, prh = lane >> 5;
    LAS float* xs = wsc; LAS float* Bs = wsc + 512; LAS float* ys = wsc + 768;
    const float* cw = (C.a->in[8]) + (size_t)l * CW * CD; const float* cb = (C.a->in[9]) + (size_t)l * CD;
    const float* sc = (C.a->in[3]) + ((size_t)l * NB + b) * 3 * CD; const bf16* U = ((bf16*)(C.a->ws + WS_U));
    { const int ch = g * 512 + 8 * lane; const v4u un = *(const GAS v4u*)(U + UIDX(row, UXBC + ch)); const float nv[8] = {bflo(un.x), bfhi(un.x), bflo(un.y), bfhi(un.y), bflo(un.z), bfhi(un.z), bflo(un.w), bfhi(un.w)};
#pragma unroll
      for (int q = 0; q < 2; ++q) { const f32x4 bb = *(const GAS f32x4*)(cb + ch + 4 * q), w0 = *(const GAS f32x4*)(cw + ch + 4 * q), w1 = *(const GAS f32x4*)(cw + CD + ch + 4 * q), w2 = *(const GAS f32x4*)(cw + 2 * CD + ch + 4 * q), w3 = *(const GAS f32x4*)(cw + 3 * CD + ch + 4 * q);
          const f32x4 s0 = *(const GAS f32x4*)(sc + ch + 4 * q), s1 = *(const GAS f32x4*)(sc + CD + ch + 4 * q), s2 = *(const GAS f32x4*)(sc + 2 * CD + ch + 4 * q);
          f32x4 o;
#pragma unroll
          for (int e = 0; e < 4; ++e) o[e] = siluf_(bb[e] + w0[e] * s0[e] + w1[e] * s1[e] + w2[e] * s2[e] + w3[e] * nv[4 * q + e]);
          *(LAS f32x4*)(xs + 8 * lane + 4 * q) = o; } }
    { const int ch = (lane < 32 ? DI + g * 128 : DI + 1024 + g * 128 - 128) + 4 * lane;
      const u32x2 un = *(const GAS u32x2*)(U + UIDX(row, UXBC + ch)); const float nv[4] = {bflo(un.x), bfhi(un.x), bflo(un.y), bfhi(un.y)};
      const f32x4 bb = *(const GAS f32x4*)(cb + ch), w0 = *(const GAS f32x4*)(cw + ch), w1 = *(const GAS f32x4*)(cw + CD + ch), w2 = *(const GAS f32x4*)(cw + 2 * CD + ch), w3 = *(const GAS f32x4*)(cw + 3 * CD + ch);
      const f32x4 s0 = *(const GAS f32x4*)(sc + ch), s1 = *(const GAS f32x4*)(sc + CD + ch), s2 = *(const GAS f32x4*)(sc + 2 * CD + ch);
      f32x4 o;
#pragma unroll
      for (int e = 0; e < 4; ++e) o[e] = siluf_(bb[e] + w0[e] * s0[e] + w1[e] * s1[e] + w2[e] * s2[e] + w3[e] * nv[e]);
      *(LAS f32x4*)(Bs + 4 * lane) = o; }
    LDS_WAIT(); asm volatile("" ::: "memory");
    const f32x4 Bv = *((const LAS f32x4*)Bs + n4), Cv = *((const LAS f32x4*)(Bs + 128) + n4);
    const size_t sbase = (((size_t)l * NB + b) * NH + 8 * g) * HP * DS;
    for (int j = 0; j < 8; ++j) { const int h = 8 * g + j;
        const GAS f32x4* sp = (const GAS f32x4*)((C.a->in[2]) + sbase + (size_t)j * HP * DS + (size_t)prh * DS) + n4;
        GAS f32x4* op = (GAS f32x4*)((C.a->out) + O_SSSM + sbase + (size_t)j * HP * DS + (size_t)prh * DS) + n4;
        f32x4 hv[32];
#pragma unroll
        for (int i = 0; i < 32; ++i) hv[i] = __builtin_nontemporal_load(sp + (size_t)i * (2 * DS / 4));
        const float dt = ((float*)(C.a->ws + WS_DT))[(size_t)row * 64 + h], dA = __expf(-__expf((C.a->in[11])[l * NH + h]) * dt), Dh = (C.a->in[12])[l * NH + h];
#pragma unroll
        for (int i = 0; i < 32; ++i) { const int p = prh + 2 * i; const float xv = xs[j * 64 + p], dtx = dt * xv; const f32x4 h0 = hv[i];
            f32x4 hn; hn.x = dA * h0.x + dtx * Bv.x; hn.y = dA * h0.y + dtx * Bv.y; hn.z = dA * h0.z + dtx * Bv.z; hn.w = dA * h0.w + dtx * Bv.w;
            __builtin_nontemporal_store(hn, op + (size_t)i * (2 * DS / 4));
            float yp = (hn.x * Cv.x + hn.y * Cv.y) + (hn.z * Cv.z + hn.w * Cv.w);
#pragma unroll
            for (int o = 1; o < 32; o <<= 1) yp += __shfl_xor(yp, o);
            if (n4 == 0) ys[j * 64 + p] = yp + Dh * xv; }
    }
    LDS_WAIT(); asm volatile("" ::: "memory");
    { const int ch = g * 512 + 8 * lane; const v4u zw = *(const GAS v4u*)(U + UIDX(row, UZ + ch)); const f32x4 y0 = *(const LAS f32x4*)(ys + 8 * lane), y1 = *(const LAS f32x4*)(ys + 8 * lane + 4);
      float gv[8] = {y0.x * bflo(zw.x), y0.y * bfhi(zw.x), y0.z * bflo(zw.y), y0.w * bfhi(zw.y), y1.x * bflo(zw.z), y1.y * bfhi(zw.z), y1.z * bflo(zw.w), y1.w * bfhi(zw.w)};
      float ss = 0.f;
#pragma unroll
      for (int e = 0; e < 8; ++e) ss += gv[e] * gv[e];
      const float rstd = rsqrtf(wave_sum(ss) * (1.0f / 512.0f) + EPS);
      const f32x4 n0 = *(const GAS f32x4*)((C.a->in[13]) + (size_t)l * DI + ch), n1 = *(const GAS f32x4*)((C.a->in[13]) + (size_t)l * DI + ch + 4);
      v4u o; o.x = pk2(gv[0] * rstd * n0.x, gv[1] * rstd * n0.y); o.y = pk2(gv[2] * rstd * n0.z, gv[3] * rstd * n0.w); o.z = pk2(gv[4] * rstd * n1.x, gv[5] * rstd * n1.y); o.w = pk2(gv[6] * rstd * n1.z, gv[7] * rstd * n1.w);
      *(GAS v4u*)(((bf16*)(C.a->ws + WS_YO)) + (size_t)row * KCAT + ch) = o; }
    LDS_WAIT(); asm volatile("" ::: "memory");
}

__device__ __forceinline__ void sample_attn_phase(const Ctx& C, int l) {
    const int tid = C.tid;
    constexpr int KP = 68;
    LAS float* Ks = (LAS float*)(C.lds + RING_OFF); LAS float* Vs = Ks + 128 * KP; LAS float* qs = Vs + 128 * KP; LAS float* sc = qs + 256; LAS float* knew = sc + 4 * 132; LAS float* vnew = knew + 64;
    const bf16* U = ((bf16*)(C.a->ws + WS_U));
    f32x4 kv[4], vv[4]; float qx = 0.f;
#define SA_LOAD(u_) do { const int b_ = (u_) >> 3, kh_ = (u_) & 7, row_ = SEQ + b_; const size_t cb_ = ((size_t)l * NB + b_) * WIN * (KVH * AD) + (size_t)kh_ * AD; \
        _Pragma("unroll") for (int i = 0; i < 4; ++i) { const int idx = tid + 512 * i, w = idx >> 4, c4 = idx & 15; \
            kv[i] = __builtin_nontemporal_load((const GAS f32x4*)((C.a->in[4]) + cb_ + (size_t)w * (KVH * AD)) + c4); vv[i] = __builtin_nontemporal_load((const GAS f32x4*)((C.a->in[5]) + cb_ + (size_t)w * (KVH * AD)) + c4); } \
        if (tid < 256) qx = bf2f(U[UIDX(row_, UQ + kh_ * 256 + tid)]); else if (tid < 320) qx = bf2f(U[UIDX(row_, UK + kh_ * 64 + (tid - 256))]); else if (tid < 384) qx = bf2f(U[UIDX(row_, UV + kh_ * 64 + (tid - 320))]); } while (0)
    int u = C.bid; if (u >= NB * KVH) return;
    SA_LOAD(u);
    for (; u < NB * KVH; u += C.G) {
        const int b = u >> 3, kh = u & 7, row = SEQ + b;
        const size_t cbase = ((size_t)l * NB + b) * WIN * (KVH * AD) + (size_t)kh * AD;
        if (tid < 256) qs[tid] = qx; else if (tid < 320) knew[tid - 256] = qx; else if (tid < 384) vnew[tid - 320] = qx;
#pragma unroll
        for (int i = 0; i < 4; ++i) { const int idx = tid + 512 * i, w = idx >> 4, c4 = idx & 15; *((LAS f32x4*)(Ks + w * KP) + c4) = kv[i]; *((LAS f32x4*)(Vs + w * KP) + c4) = vv[i]; }
        __syncthreads();
        if (u + C.G < NB * KVH) SA_LOAD(u + C.G);
        if (tid < 16) { *((GAS f32x4*)((C.a->out) + O_SK + cbase + (size_t)(WIN - 1) * (KVH * AD)) + tid) = *((const LAS f32x4*)knew + tid); }
        else if (tid < 32) { *((GAS f32x4*)((C.a->out) + O_SV + cbase + (size_t)(WIN - 1) * (KVH * AD)) + (tid - 16)) = *((const LAS f32x4*)vnew + (tid - 16)); }
        { const int w = tid >> 2, hq = tid & 3; const LAS f32x4* kp = (const LAS f32x4*)(Ks + w * KP); const LAS f32x4* qp = (const LAS f32x4*)(qs + hq * 64);
          float s = 0.f;
    #pragma unroll
          for (int c = 0; c < 16; ++c) { const f32x4 kv = kp[c], qv = qp[c]; s += (kv.x * qv.x + kv.y * qv.y) + (kv.z * qv.z + kv.w * qv.w); }
          sc[hq * 132 + w] = s * 0.125f; }
        if (tid < 4) { float s = 0.f;
          for (int d = 0; d < 64; ++d) s += qs[tid * 64 + d] * knew[d];
          sc[tid * 132 + 128] = s * 0.125f; }
        __syncthreads();
        if (C.wave < 4) { const int hq = C.wave; const float sink = (C.a->in[16])[l * AH + 4 * kh + hq];
          const float v0 = sc[hq * 132 + C.lane], v1 = sc[hq * 132 + 64 + C.lane], v2 = C.lane == 0 ? sc[hq * 132 + 128] : -__builtin_inff();
          const float m = fmaxf(wave_max(fmaxf(fmaxf(v0, v1), v2)), sink);
          const float e0 = __expf(v0 - m), e1 = __expf(v1 - m), e2 = C.lane == 0 ? __expf(v2 - m) : 0.f;
          const float inv = 1.0f / (wave_sum(e0 + e1 + e2) + __expf(sink - m));
          sc[hq * 132 + C.lane] = e0 * inv; sc[hq * 132 + 64 + C.lane] = e1 * inv; if (C.lane == 0) sc[hq * 132 + 128] = e2 * inv; }
        __syncthreads();
        if (tid < 256) { const int hq = tid >> 6, d = tid & 63; float o = sc[hq * 132 + 128] * vnew[d];
    #pragma unroll 16
          for (int w = 0; w < WIN; ++w) o += sc[hq * 132 + w] * Vs[w * KP + d];
          ((bf16*)(C.a->ws + WS_YO))[(size_t)row * KCAT + DI + (4 * kh + hq) * 64 + d] = (bf16)f2bf(o); }
        __syncthreads();
    }
#undef SA_LOAD
}

__device__ __forceinline__ void cache_shift(const Ctx& C, int l, int vb, int nvb) {
    constexpr int ROWF4 = (WIN - 1) * KVH * AD / 4;
    for (int u = vb; u < NB * 2; u += nvb) { const int b = u >> 1, kv = u & 1;
        const GAS f32x4* src = (const GAS f32x4*)((kv ? (C.a->in[5]) : (C.a->in[4])) + ((size_t)l * NB + b) * WIN * (KVH * AD) + KVH * AD);
        GAS f32x4* dst = (GAS f32x4*)((C.a->out) + (kv ? O_SV : O_SK) + ((size_t)l * NB + b) * WIN * (KVH * AD));
        for (int i = C.tid; i < ROWF4; i += 512 * 8) { f32x4 v[8];
#pragma unroll
            for (int j = 0; j < 8; ++j) if (i + 512 * j < ROWF4) v[j] = __builtin_nontemporal_load(src + i + 512 * j);
#pragma unroll
            for (int j = 0; j < 8; ++j) if (i + 512 * j < ROWF4) __builtin_nontemporal_store(v[j], dst + i + 512 * j); } }
}

__device__ __forceinline__ void copy_outs(const Ctx& C, int l, int vb, int nvb) {
    const bf16* U = ((bf16*)(C.a->ws + WS_U)); const int gt = vb * 512 + C.tid, NT = nvb * 512;
    for (int i = gt; i < WIN * KVH * AD / 8; i += NT) { const int w = i >> 6, c = (i & 63) * 8, ur = SEQ - WIN + w;
        const v4u kw = *(const GAS v4u*)(U + UIDX(ur, UK + c)), vw = *(const GAS v4u*)(U + UIDX(ur, UV + c));
        GAS f32x4* pk = (GAS f32x4*)((C.a->out) + O_PK + (size_t)l * WIN * KVH * AD + (size_t)w * (KVH * AD) + c); GAS f32x4* pv = (GAS f32x4*)((C.a->out) + O_PV + (size_t)l * WIN * KVH * AD + (size_t)w * (KVH * AD) + c);
        pk[0] = (f32x4){bflo(kw.x), bfhi(kw.x), bflo(kw.y), bfhi(kw.y)}; pk[1] = (f32x4){bflo(kw.z), bfhi(kw.z), bflo(kw.w), bfhi(kw.w)};
        pv[0] = (f32x4){bflo(vw.x), bfhi(vw.x), bflo(vw.y), bfhi(vw.y)}; pv[1] = (f32x4){bflo(vw.z), bfhi(vw.z), bflo(vw.w), bfhi(vw.w)}; }
    constexpr int C8 = CD / 8;
    for (int i = gt; i < 3 * C8; i += NT) { const int j = i / C8, ch = (i - j * C8) * 8; const v4u w = *(const GAS v4u*)(U + UIDX(SEQ - 3 + j, UXBC + ch));
        GAS f32x4* po = (GAS f32x4*)((C.a->out) + O_PCONV + (size_t)l * 3 * CD + (size_t)j * CD + ch);
        po[0] = (f32x4){bflo(w.x), bfhi(w.x), bflo(w.y), bfhi(w.y)}; po[1] = (f32x4){bflo(w.z), bfhi(w.z), bflo(w.w), bfhi(w.w)}; }
    for (int i = gt; i < NB * C8; i += NT) { const int b = i / C8, ch = (i - b * C8) * 8;
        const GAS f32x4* si = (const GAS f32x4*)((C.a->in[3]) + ((size_t)l * NB + b) * 3 * CD + ch); GAS f32x4* so = (GAS f32x4*)((C.a->out) + O_SCONV + ((size_t)l * NB + b) * 3 * CD + ch);
        const f32x4 r10 = si[CD / 4], r11 = si[CD / 4 + 1], r20 = si[2 * CD / 4], r21 = si[2 * CD / 4 + 1]; const v4u w = *(const GAS v4u*)(U + UIDX(SEQ + b, UXBC + ch));
        so[0] = r10; so[1] = r11; so[CD / 4] = r20; so[CD / 4 + 1] = r21;
        so[2 * CD / 4] = (f32x4){bflo(w.x), bfhi(w.x), bflo(w.y), bfhi(w.y)}; so[2 * CD / 4 + 1] = (f32x4){bflo(w.z), bfhi(w.z), bflo(w.w), bfhi(w.w)}; }
}
typedef float f32x2_t __attribute__((ext_vector_type(2))); typedef __bf16 bf16x2_t __attribute__((ext_vector_type(2)));
__device__ __forceinline__ unsigned cvtpk(float lo, float hi) { f32x2_t v = {lo, hi}; bf16x2_t b = __builtin_convertvector(v, bf16x2_t); return __builtin_bit_cast(unsigned, b); }
__device__ __forceinline__ int crow(int reg, int hh) { return (reg & 3) + 8 * (reg >> 2) + 4 * hh; }
#define MFMA32(a, b, c) __builtin_amdgcn_mfma_f32_32x32x16_bf16((a), (b), (c), 0, 0, 0)
__device__ __forceinline__ bf16x8 ld16(const bf16* p) { return *(const GAS bf16x8*)p; }
__device__ __forceinline__ bf16x8 ld8x2(const bf16* p) {
    const u32x2 lo = *(const GAS u32x2*)p, hi = *(const GAS u32x2*)(p + 8); v4u w; w.x = lo.x; w.y = lo.y; w.z = hi.x; w.w = hi.y; return __builtin_bit_cast(bf16x8, w); }
#define PACK8(X, s) __builtin_bit_cast(bf16x8, (v4u){cvtpk((X)[8 * (s)], (X)[8 * (s) + 1]), cvtpk((X)[8 * (s) + 2], (X)[8 * (s) + 3]), cvtpk((X)[8 * (s) + 4], (X)[8 * (s) + 5]), cvtpk((X)[8 * (s) + 6], (X)[8 * (s) + 7])})

__device__ __forceinline__ void reformat_conv_item(const Ctx& C, int l, int c, int cblk) {
    const int co = C.lane & 7, rg = C.lane >> 3, ch0 = cblk * 64 + co * 8;
    const float* cw = (C.a->in[8]) + (size_t)l * CW * CD + ch0; const float* cb = (C.a->in[9]) + (size_t)l * CD + ch0;
    float w0[8], w1[8], w2[8], w3[8], bs[8];
#pragma unroll
    for (int j = 0; j < 8; ++j) { w0[j] = cw[j]; w1[j] = cw[CD + j]; w2[j] = cw[2 * CD + j]; w3[j] = cw[3 * CD + j]; bs[j] = cb[j]; }
    const bf16* U = ((bf16*)(C.a->ws + WS_U));
    const int row0 = 128 * c + 16 * rg;
    v4u raw[19];
    unsigned zu = 0u; asm volatile("" : "+v"(zu));
#pragma unroll
    for (int i = 0; i < 19; ++i) { const int rr = row0 - 3 + i; raw[i] = *(const GAS v4u*)(U + UIDX(rr < 0 ? 0 : rr, UXBC + ch0)); }
    __builtin_amdgcn_sched_barrier(0);
#pragma unroll
    for (int i = 0; i < 3; ++i) { if (row0 - 3 + i < 0) raw[i] = (v4u){zu, zu, zu, zu}; }
    unsigned tp[8][8];
    bf16* rm = nullptr; bf16* tr = nullptr;
    if (cblk < 64) tr = ((bf16*)(C.a->ws + WS_XT)) + (((size_t)c * 64 + cblk) * 64 + co * 8) * 128 + 16 * rg;
    else if (cblk < 80) { const int g = (cblk - 64) >> 1, hf = (cblk - 64) & 1;
        rm = ((bf16*)(C.a->ws + WS_BRM)) + (((size_t)c * 8 + g) * 128 + 16 * rg) * 128 + hf * 64 + co * 8;
        tr = ((bf16*)(C.a->ws + WS_BT)) + (((size_t)c * 8 + g) * 128 + hf * 64 + co * 8) * 128 + 16 * rg; }
    else { const int g = (cblk - 80) >> 1, hf = (cblk - 80) & 1;
        rm = ((bf16*)(C.a->ws + WS_CRM)) + (((size_t)c * 8 + g) * 128 + 16 * rg) * 128 + hf * 64 + co * 8; }
#define RAWF(i, j) (((j) & 1) ? bfhi(((j) >> 1) == 0 ? raw[i].x : (((j) >> 1) == 1 ? raw[i].y : (((j) >> 1) == 2 ? raw[i].z : raw[i].w))) : bflo(((j) >> 1) == 0 ? raw[i].x : (((j) >> 1) == 1 ? raw[i].y : (((j) >> 1) == 2 ? raw[i].z : raw[i].w))))
#pragma unroll
    for (int i2 = 0; i2 < 8; ++i2) {
        float oa[8], ob[8];
#pragma unroll
        for (int j = 0; j < 8; ++j) { oa[j] = siluf_(bs[j] + w0[j] * RAWF(2 * i2, j) + w1[j] * RAWF(2 * i2 + 1, j) + w2[j] * RAWF(2 * i2 + 2, j) + w3[j] * RAWF(2 * i2 + 3, j));
                                      ob[j] = siluf_(bs[j] + w0[j] * RAWF(2 * i2 + 1, j) + w1[j] * RAWF(2 * i2 + 2, j) + w2[j] * RAWF(2 * i2 + 3, j) + w3[j] * RAWF(2 * i2 + 4, j)); }
        if (rm) { v4u w; w.x = cvtpk(oa[0], oa[1]); w.y = cvtpk(oa[2], oa[3]); w.z = cvtpk(oa[4], oa[5]); w.w = cvtpk(oa[6], oa[7]); *(GAS v4u*)(rm + (size_t)(2 * i2) * 128) = w;
                  w.x = cvtpk(ob[0], ob[1]); w.y = cvtpk(ob[2], ob[3]); w.z = cvtpk(ob[4], ob[5]); w.w = cvtpk(ob[6], ob[7]); *(GAS v4u*)(rm + (size_t)(2 * i2 + 1) * 128) = w; }
#pragma unroll
        for (int j = 0; j < 8; ++j) tp[j][i2] = cvtpk(oa[j], ob[j]);
    }
#undef RAWF
    if (cblk < 64) {
        bf16* xh = ((bf16*)(C.a->ws + WS_XT)) + ((size_t)c * 64 + cblk) * 64 * 128;
#pragma unroll
        for (int j = 0; j < 8; ++j) { const int p = co * 8 + j; bf16* fp = xh + ((size_t)(((p >> 5) * 8 + rg) * 64 + (p & 31))) * 8;
            *(GAS v4u*)fp = (v4u){tp[j][0], tp[j][1], tp[j][4], tp[j][5]}; *(GAS v4u*)(fp + 32 * 8) = (v4u){tp[j][2], tp[j][3], tp[j][6], tp[j][7]}; }
    } else if (tr) {
#pragma unroll
        for (int j = 0; j < 8; ++j) { *(GAS v4u*)(tr + (size_t)j * 128) = (v4u){tp[j][0], tp[j][1], tp[j][2], tp[j][3]}; *(GAS v4u*)(tr + (size_t)j * 128 + 8) = (v4u){tp[j][4], tp[j][5], tp[j][6], tp[j][7]}; }
    }
}
__device__ __forceinline__ void reformat_dt_item(const Ctx& C, int l, int c) {
    const int h = C.lane; const float A = -__expf((C.a->in[11])[l * NH + h]);
    const float* D = ((float*)(C.a->ws + WS_DT)) + (size_t)(128 * c) * 64 + h;
    float* dto = ((float*)(C.a->ws + WS_DTT)) + ((size_t)c * 64 + h) * 128; float* aco = ((float*)(C.a->ws + WS_ACS)) + ((size_t)c * 64 + h) * 128;
    float cs = 0.f;
#pragma unroll
    for (int l0 = 0; l0 < 128; l0 += 64) { float dv[64];
#pragma unroll
        for (int i = 0; i < 64; ++i) dv[i] = D[(size_t)(l0 + i) * 64];
        __builtin_amdgcn_sched_barrier(0);
#pragma unroll
        for (int q = 0; q < 16; ++q) { f32x4 av;
#pragma unroll
            for (int e = 0; e < 4; ++e) { cs += dv[4 * q + e] * A; av[e] = cs; }
            *(GAS f32x4*)(dto + l0 + 4 * q) = (f32x4){dv[4 * q], dv[4 * q + 1], dv[4 * q + 2], dv[4 * q + 3]}; *(GAS f32x4*)(aco + l0 + 4 * q) = av; } }
}
__device__ __forceinline__ void reformat_vt_item(const Ctx& C, int tb, int kh) {
    const int co = C.lane & 7, rg = C.lane >> 3; const bf16* U = ((bf16*)(C.a->ws + WS_U)) + UIDX(128 * tb + 16 * rg, UV + kh * 64 + co * 8);
    unsigned tp[8][8]; v4u rv[16];
#pragma unroll
    for (int i = 0; i < 16; ++i) rv[i] = *(const GAS v4u*)(U + (size_t)i * 64);
    __builtin_amdgcn_sched_barrier(0);
#pragma unroll
    for (int i = 0; i < 16; ++i) { const v4u a = rv[i]; const unsigned w[4] = {a.x, a.y, a.z, a.w};
#pragma unroll
        for (int j = 0; j < 8; ++j) { const unsigned hb = (j & 1) ? (w[j >> 1] >> 16) : (w[j >> 1] & 0xffffu); if (i & 1) tp[j][i >> 1] |= hb << 16; else tp[j][i >> 1] = hb; } }
    bf16* tr = ((bf16*)(C.a->ws + WS_VT)) + ((size_t)kh * 64 + co * 8) * SEQ + 128 * tb + 16 * rg;
#pragma unroll
    for (int j = 0; j < 8; ++j) { *(GAS v4u*)(tr + (size_t)j * SEQ) = (v4u){tp[j][0], tp[j][1], tp[j][2], tp[j][3]}; *(GAS v4u*)(tr + (size_t)j * SEQ + 8) = (v4u){tp[j][4], tp[j][5], tp[j][6], tp[j][7]}; }
}
constexpr int RF_ITEMS = 64 * 96 + 64 + 64 * 8;
__device__ __forceinline__ void reformat_item(const Ctx& C, int l, int it) {
    constexpr int N1 = 64 * 96, N2 = 64;
    if (it < N1) reformat_conv_item(C, l, it / 96, it % 96);
    else if (it < N1 + N2) reformat_dt_item(C, l, it - N1);
    else reformat_vt_item(C, (it - N1 - N2) >> 3, (it - N1 - N2) & 7);
}

constexpr int AT_K = 0, AT_V = 36864, AT_KP = 144, AT_VP = 528;
__device__ __forceinline__ void attn_prompt_unit(const Ctx& C, int l, int qb, int kh) {
    const int lane_ = lane_now();
    const int r = lane_ & 31, hh = lane_ >> 5, hq = 4 * kh + (C.wave >> 1), rh = C.wave & 1, tid = C.wave * 64 + lane_;
    const bf16* U = ((bf16*)(C.a->ws + WS_U)); const bf16* VT = ((bf16*)(C.a->ws + WS_VT)) + (size_t)kh * 64 * SEQ; bf16* YO = ((bf16*)(C.a->ws + WS_YO));
    LAS unsigned char* Ks = C.lds + AT_K; LAS unsigned char* Vs = C.lds + AT_V;
    const int key0 = 128 * (qb - 1);
    bf16x8 bq[2][4];
    { v4u tk[4], tv[4]; unsigned zu = 0u; asm volatile("" : "+v"(zu));
#pragma unroll
      for (int i = 0; i < 4; ++i) { const int idx = tid + 512 * i, kr = idx >> 3, ch = idx & 7, key = key0 + kr;
          tk[i] = *(const GAS v4u*)(U + UIDX(key < 0 ? 0 : key, UK + kh * 64 + 8 * ch));
          const int d = idx >> 5, c5 = idx & 31, kk = key0 + 8 * c5;
          tv[i] = *(const GAS v4u*)(VT + (size_t)d * SEQ + (kk < 0 ? 0 : kk)); }
#pragma unroll
      for (int qt = 0; qt < 2; ++qt)
#pragma unroll
          for (int ks = 0; ks < 4; ++ks) bq[qt][ks] = ld16(U + UIDX(128 * qb + 32 * (2 * rh + qt) + r, UQ + hq * 64 + 16 * ks + 8 * hh));
      __builtin_amdgcn_sched_barrier(0);
#pragma unroll
      for (int i = 0; i < 4; ++i) { const int idx = tid + 512 * i; if (key0 + (idx >> 3) < 0) tk[i] = (v4u){zu, zu, zu, zu}; if (key0 + 8 * (idx & 31) < 0) tv[i] = (v4u){zu, zu, zu, zu}; }
#pragma unroll
      for (int i = 0; i < 4; ++i) { const int idx = tid + 512 * i; *(LAS v4u*)(Ks + (idx >> 3) * AT_KP + (idx & 7) * 16) = tk[i]; *(LAS v4u*)(Vs + (idx >> 5) * AT_VP + (idx & 31) * 16) = tv[i]; } }
    const float sink = (C.a->in[16])[l * AH + hq];
    __syncthreads();
#pragma unroll
    for (int qt = 0; qt < 2; ++qt) {
        const int ai = 2 * rh + qt, q0 = 128 * qb + 32 * ai, t = q0 + r;
        f32x16 S[5]; float mx = sink;
#pragma unroll
        for (int v = 0; v < 5; ++v) { const int kt = ai + v; const bool vis = qb > 0 || kt >= 4;
            if (vis) { const int kb = key0 + 32 * kt; f32x16 s;
#pragma unroll
                for (int e = 0; e < 16; ++e) s[e] = 0.f;
                const LAS unsigned char* kp = Ks + (32 * kt + r) * AT_KP + 16 * hh;
#pragma unroll
                for (int ks = 0; ks < 4; ++ks) { const bf16x8 a = *(const LAS bf16x8*)(kp + 32 * ks); s = MFMA32(a, bq[qt][ks], s); }
#pragma unroll
                for (int e = 0; e < 16; ++e) { const int j = kb + crow(e, hh); const bool ok = (j <= t) && (j >= t - WIN); const float x = ok ? s[e] * 0.125f : -__builtin_inff(); s[e] = x; mx = fmaxf(mx, x); }
                S[v] = s; }
        }
        mx = fmaxf(mx, __shfl_xor(mx, 32));
        float sum = 0.f;
#pragma unroll
        for (int v = 0; v < 5; ++v) { const int kt = ai + v; const bool vis = qb > 0 || kt >= 4;
            if (vis) {
#pragma unroll
                for (int e = 0; e < 16; ++e) { const float p = __expf(S[v][e] - mx); S[v][e] = p; sum += p; } } }
        sum += __shfl_xor(sum, 32); sum += __expf(sink - mx);
        f32x16 O[2];
#pragma unroll
        for (int e = 0; e < 16; ++e) { O[0][e] = 0.f; O[1][e] = 0.f; }
#pragma unroll
        for (int v = 0; v < 5; ++v) { const int kt = ai + v; const bool vis = qb > 0 || kt >= 4;
            if (vis) {
#pragma unroll
                for (int ss = 0; ss < 2; ++ss) { const bf16x8 pb = PACK8(S[v], ss);
#pragma unroll
                    for (int dt = 0; dt < 2; ++dt) { const LAS unsigned char* vp = Vs + (32 * dt + r) * AT_VP + (32 * kt + 16 * ss + 4 * hh) * 2;
                        const u32x2 lo = *(const LAS u32x2*)vp, hi = *(const LAS u32x2*)(vp + 16);
                        const bf16x8 va = __builtin_bit_cast(bf16x8, (v4u){lo.x, lo.y, hi.x, hi.y}); O[dt] = MFMA32(va, pb, O[dt]); } } } }
        const float inv = 1.0f / sum;
        bf16* op = YO + (size_t)t * KCAT + DI + hq * 64;
#pragma unroll
        for (int dt = 0; dt < 2; ++dt)
#pragma unroll
            for (int g4 = 0; g4 < 4; ++g4) { u32x2 w; w.x = cvtpk(O[dt][4 * g4] * inv, O[dt][4 * g4 + 1] * inv); w.y = cvtpk(O[dt][4 * g4 + 2] * inv, O[dt][4 * g4 + 3] * inv);
                *(GAS u32x2*)(op + 32 * dt + 8 * g4 + 4 * hh) = w; }
    }
    __syncthreads();
}

__device__ __forceinline__ void ssd_states_unit(const Ctx& C, int c, int g) {
    const int lane_ = lane_now();
    const int r = lane_ & 31, hh = lane_ >> 5, h = 8 * g + C.wave, tid = C.wave * 64 + lane_;
    const bf16* xT = ((bf16*)(C.a->ws + WS_XT)) + ((size_t)c * 64 + h) * 64 * 128; const bf16* bT = ((bf16*)(C.a->ws + WS_BT)) + ((size_t)c * 8 + g) * 128 * 128;
    const float* dtT = ((float*)(C.a->ws + WS_DTT)) + ((size_t)c * 64 + h) * 128; const float* acs = ((float*)(C.a->ws + WS_ACS)) + ((size_t)c * 64 + h) * 128;
    LAS unsigned char* Bs = C.lds + PC_B; LAS float* scs = (LAS float*)(C.lds + PC_C) + C.wave * 128;
    v4u tb[4], raw[2][8];
#pragma unroll
    for (int i = 0; i < 4; ++i) tb[i] = *(const GAS v4u*)(bT + (size_t)(tid + 512 * i) * 8);
    const float dl0 = dtT[lane_], dl1 = dtT[64 + lane_], al0 = acs[lane_], al1 = acs[64 + lane_], aend = acs[127];
#pragma unroll
    for (int ks = 0; ks < 8; ++ks)
#pragma unroll
        for (int pt = 0; pt < 2; ++pt) raw[pt][ks] = *(const GAS v4u*)(xT + ((size_t)(pt * 8 + ks) * 64 + lane_) * 8);
    __builtin_amdgcn_sched_barrier(0);
#pragma unroll
    for (int i = 0; i < 4; ++i) { const int idx = tid + 512 * i; *(LAS v4u*)(Bs + (idx >> 4) * 272 + (idx & 15) * 16) = tb[i]; }
    scs[lane_] = dl0 * __expf(aend - al0); scs[64 + lane_] = dl1 * __expf(aend - al1);
    LDS_WAIT(); asm volatile("" ::: "memory");
    bf16x8 a[2][8];
#pragma unroll
    for (int ks = 0; ks < 8; ++ks) { const f32x4 s0 = *(const LAS f32x4*)(scs + 16 * ks + 4 * hh), s1 = *(const LAS f32x4*)(scs + 16 * ks + 8 + 4 * hh);
#pragma unroll
        for (int pt = 0; pt < 2; ++pt) { const v4u w = raw[pt][ks];
            v4u o; o.x = cvtpk(bflo(w.x) * s0.x, bfhi(w.x) * s0.y); o.y = cvtpk(bflo(w.y) * s0.z, bfhi(w.y) * s0.w); o.z = cvtpk(bflo(w.z) * s1.x, bfhi(w.z) * s1.y); o.w = cvtpk(bflo(w.w) * s1.z, bfhi(w.w) * s1.w);
            a[pt][ks] = __builtin_bit_cast(bf16x8, o); } }
    __syncthreads();
    bf16* st = ((bf16*)(C.a->ws + WS_ST)) + ((size_t)c * 64 + h) * 64 * 128;
#pragma unroll
    for (int nt = 0; nt < 4; ++nt) {
        f32x16 acc[2];
#pragma unroll
        for (int e = 0; e < 16; ++e) { acc[0][e] = 0.f; acc[1][e] = 0.f; }
        const LAS unsigned char* bp = Bs + (32 * nt + r) * 272 + 16 * hh;
#pragma unroll
        for (int ks = 0; ks < 8; ++ks) { const LAS unsigned char* bq = Bs + (32 * nt + r) * 272 + 8 * hh + 32 * ks; const u32x2 lo = *(const LAS u32x2*)bq, hi = *(const LAS u32x2*)(bq + 16);
            v4u bw; bw.x = lo.x; bw.y = lo.y; bw.z = hi.x; bw.w = hi.y; const bf16x8 b = __builtin_bit_cast(bf16x8, bw); acc[0] = MFMA32(b, a[0][ks], acc[0]); acc[1] = MFMA32(b, a[1][ks], acc[1]); }
#pragma unroll
        for (int pt = 0; pt < 2; ++pt)
#pragma unroll
            for (int j = 0; j < 2; ++j) { v4u w; w.x = cvtpk(acc[pt][8 * j], acc[pt][8 * j + 1]); w.y = cvtpk(acc[pt][8 * j + 2], acc[pt][8 * j + 3]); w.z = cvtpk(acc[pt][8 * j + 4], acc[pt][8 * j + 5]); w.w = cvtpk(acc[pt][8 * j + 6], acc[pt][8 * j + 7]);
                *(GAS v4u*)(st + ((size_t)(((pt * 4 + nt) * 2 + j) * 64 + lane_)) * 8) = w; }
    }
    __syncthreads();
}

__device__ __forceinline__ void ssd_scan_phase(const Ctx& C, int l) {
    const bf16* ST = ((bf16*)(C.a->ws + WS_ST)); bf16* HS = ((bf16*)(C.a->ws + WS_HS)); const float* acs = ((float*)(C.a->ws + WS_ACS));
    for (int idx = C.bid * 512 + C.tid; idx < 64 * 64 * 128 / 4; idx += C.G * 512) { const int h = idx >> 11;
        f32x4 hc = (f32x4){0.f, 0.f, 0.f, 0.f};
        for (int c0 = 0; c0 < 64; c0 += 16) { u32x2 sw[16]; float av[16];
#pragma unroll
            for (int j = 0; j < 16; ++j) { sw[j] = *((const GAS u32x2*)(ST + (size_t)(c0 + j) * 64 * 64 * 128) + idx); av[j] = acs[((size_t)(c0 + j) * 64 + h) * 128 + 127]; }
#pragma unroll
            for (int j = 0; j < 16; ++j) {
                u32x2 w; w.x = cvtpk(hc.x, hc.y); w.y = cvtpk(hc.z, hc.w); *((GAS u32x2*)(HS + (size_t)(c0 + j) * 64 * 64 * 128) + idx) = w;
                const f32x4 s = (f32x4){bflo(sw[j].x), bfhi(sw[j].x), bflo(sw[j].y), bfhi(sw[j].y)}; const float dec = __expf(av[j]);
                hc = hc * dec + s; } }
        { const int g = idx & 2047, vh = g & 1, ln = (g >> 1) & 63, j = (g >> 7) & 1, nt = (g >> 8) & 3, pt = (g >> 10) & 1, p = 32 * pt + (ln & 31), n4 = 8 * nt + 4 * j + 2 * vh + (ln >> 5);
          *((GAS f32x4*)((C.a->out) + O_PSSM + (size_t)l * NH * HP * DS) + (size_t)h * 2048 + p * 32 + n4) = hc; } }
}

__device__ __forceinline__ void ssd_out_unit(const Ctx& C, int l, int c, int g) {
    const int lane_ = lane_now();
    const int r = lane_ & 31, hh = lane_ >> 5, h = 8 * g + C.wave, tid = C.wave * 64 + lane_;
    LAS unsigned char* Bs = C.lds + PC_B; LAS unsigned char* Cs = C.lds + PC_C; LAS float* Ysm = (LAS float*)(C.lds + PC_Y + C.wave * 8704);
    LAS float* ssq = (LAS float*)(C.lds + PC_SSQ); LAS float* acsS = (LAS float*)(C.lds + PC_AD + C.wave * 1024); LAS float* dtS = acsS + 128;
    const bf16* cR = ((bf16*)(C.a->ws + WS_CRM)) + ((size_t)c * 8 + g) * 128 * 128; const bf16* bR = ((bf16*)(C.a->ws + WS_BRM)) + ((size_t)c * 8 + g) * 128 * 128;
    const bf16* hS = ((bf16*)(C.a->ws + WS_HS)) + ((size_t)c * 64 + h) * 64 * 128; const bf16* xT = ((bf16*)(C.a->ws + WS_XT)) + ((size_t)c * 64 + h) * 64 * 128;
    LAS float* nws = (LAS float*)(C.lds + 152576) + C.wave * 64;
    bf16x8 hb[2][8], xb[4][2][2];
    { v4u tb[4], tc[4];
#pragma unroll
      for (int i = 0; i < 4; ++i) { const int idx = tid + 512 * i; tb[i] = *(const GAS v4u*)(bR + (size_t)idx * 8); tc[i] = *(const GAS v4u*)(cR + (size_t)idx * 8); }
      const float a0 = (((float*)(C.a->ws + WS_ACS)) + ((size_t)c * 64 + h) * 128)[lane_], a1 = (((float*)(C.a->ws + WS_ACS)) + ((size_t)c * 64 + h) * 128)[64 + lane_];
      const float d0 = (((float*)(C.a->ws + WS_DTT)) + ((size_t)c * 64 + h) * 128)[lane_], d1 = (((float*)(C.a->ws + WS_DTT)) + ((size_t)c * 64 + h) * 128)[64 + lane_];
      const float nwv = ((C.a->in[13]) + (size_t)l * DI + h * 64)[lane_];
#pragma unroll
      for (int pt = 0; pt < 2; ++pt)
#pragma unroll
          for (int ks = 0; ks < 8; ++ks) hb[pt][ks] = ld16(hS + ((size_t)(pt * 8 + ks) * 64 + lane_) * 8);
#pragma unroll
      for (int st = 0; st < 4; ++st)
#pragma unroll
          for (int ss = 0; ss < 2; ++ss)
#pragma unroll
              for (int pt = 0; pt < 2; ++pt) xb[st][ss][pt] = ld16(xT + ((size_t)(pt * 8 + 2 * st + ss) * 64 + lane_) * 8);
      __builtin_amdgcn_sched_barrier(0);
#pragma unroll
      for (int i = 0; i < 4; ++i) { const int idx = tid + 512 * i, row = idx >> 4, ch = idx & 15; *(LAS v4u*)(Bs + row * 272 + ch * 16) = tb[i]; *(LAS v4u*)(Cs + row * 272 + ch * 16) = tc[i]; }
      acsS[lane_] = a0; acsS[64 + lane_] = a1; dtS[lane_] = d0; dtS[64 + lane_] = d1; nws[lane_] = nwv; }
    const float Dh = (C.a->in[12])[l * NH + h];
    __syncthreads();
    const bf16* Uz = ((bf16*)(C.a->ws + WS_U)) + UIDX(128 * c + (lane_ >> 1), UZ + h * 64 + 32 * (lane_ & 1));
    bf16* YOw = ((bf16*)(C.a->ws + WS_YO)) + (size_t)(128 * c + (lane_ >> 1)) * KCAT + h * 64 + 32 * (lane_ & 1);
    const LAS float* nwp = nws + 32 * (lane_ & 1);
#pragma unroll
    for (int lt = 0; lt < 4; ++lt) {
        v4u zw[4];
        { const GAS v4u* zp = (const GAS v4u*)(Uz + (size_t)(32 * lt) * 64);
#pragma unroll
          for (int i = 0; i < 4; ++i) zw[i] = zp[i]; }
        f32x16 y[2];
#pragma unroll
        for (int e = 0; e < 16; ++e) { y[0][e] = 0.f; y[1][e] = 0.f; }
        const LAS unsigned char* crow_p = Cs + (32 * lt + r) * 272 + 16 * hh;
#pragma unroll
        for (int ks = 0; ks < 8; ++ks) { if ((ks & 3) == 0) asm volatile("" ::: "memory");
            const LAS unsigned char* cq = Cs + (32 * lt + r) * 272 + 8 * hh + 32 * ks; const u32x2 lo = *(const LAS u32x2*)cq, hi = *(const LAS u32x2*)(cq + 16);
            v4u aw; aw.x = lo.x; aw.y = lo.y; aw.z = hi.x; aw.w = hi.y; const bf16x8 a = __builtin_bit_cast(bf16x8, aw); y[0] = MFMA32(a, hb[0][ks], y[0]); y[1] = MFMA32(a, hb[1][ks], y[1]); }
#pragma unroll
        for (int q4 = 0; q4 < 4; ++q4) { const f32x4 av = *(const LAS f32x4*)(acsS + 32 * lt + 8 * q4 + 4 * hh);
#pragma unroll
            for (int e = 0; e < 4; ++e) { const float f = __expf(av[e]); y[0][4 * q4 + e] *= f; y[1][4 * q4 + e] *= f; } }
        const float al = acsS[32 * lt + r];
#pragma unroll
        for (int st = 0; st < 4; ++st) { if (st > lt) continue;
            f32x16 X;
#pragma unroll
            for (int e = 0; e < 16; ++e) X[e] = 0.f;
            const LAS unsigned char* brow_p = Bs + (32 * st + r) * 272 + 16 * hh;
#pragma unroll
            for (int ks = 0; ks < 8; ++ks) { if ((ks & 1) == 0) asm volatile("" ::: "memory");
                const bf16x8 a = *(const LAS bf16x8*)(brow_p + 32 * ks), b = *(const LAS bf16x8*)(crow_p + 32 * ks); X = MFMA32(a, b, X); }
#pragma unroll
            for (int q4 = 0; q4 < 4; ++q4) { const f32x4 as = *(const LAS f32x4*)(acsS + 32 * st + 8 * q4 + 4 * hh), ds = *(const LAS f32x4*)(dtS + 32 * st + 8 * q4 + 4 * hh);
#pragma unroll
                for (int e = 0; e < 4; ++e) { const int s = 32 * st + 8 * q4 + 4 * hh + e, lrow = 32 * lt + r; const float wgt = (s <= lrow) ? ds[e] * __expf(al - as[e]) : 0.f; X[4 * q4 + e] *= wgt; } }
#pragma unroll
            for (int ss = 0; ss < 2; ++ss) { const bf16x8 xa = PACK8(X, ss); y[0] = MFMA32(xa, xb[st][ss][0], y[0]); y[1] = MFMA32(xa, xb[st][ss][1], y[1]); }
        }
#pragma unroll
        for (int pt = 0; pt < 2; ++pt)
#pragma unroll
            for (int e = 0; e < 16; ++e) { const int q4 = e >> 2; const v4u xw = __builtin_bit_cast(v4u, xb[lt][q4 >> 1][pt]); const unsigned w = (q4 & 1) ? ((e & 2) ? xw.w : xw.z) : ((e & 2) ? xw.y : xw.x);
                const float xv = (e & 1) ? bfhi(w) : bflo(w);
                Ysm[crow(e, hh) * 68 + 32 * pt + r] = y[pt][e] + Dh * xv; }
        { const LAS f32x4* yr = (const LAS f32x4*)(Ysm + (lane_ >> 1) * 68 + 32 * (lane_ & 1));
          float gq[32]; float sq = 0.f;
#pragma unroll
          for (int i = 0; i < 4; ++i) { const f32x4 ya = yr[2 * i], yb = yr[2 * i + 1];
              gq[8 * i + 0] = ya.x * bflo(zw[i].x); gq[8 * i + 1] = ya.y * bfhi(zw[i].x); gq[8 * i + 2] = ya.z * bflo(zw[i].y); gq[8 * i + 3] = ya.w * bfhi(zw[i].y);
              gq[8 * i + 4] = yb.x * bflo(zw[i].z); gq[8 * i + 5] = yb.y * bfhi(zw[i].z); gq[8 * i + 6] = yb.z * bflo(zw[i].w); gq[8 * i + 7] = yb.w * bfhi(zw[i].w);
#pragma unroll
              for (int e = 0; e < 8; ++e) sq += gq[8 * i + e] * gq[8 * i + e]; }
          sq += __shfl_xor(sq, 1);
          if ((lane_ & 1) == 0) ssq[(32 * lt + (lane_ >> 1)) * 8 + C.wave] = sq;
          __syncthreads();
          const LAS f32x4* sp = (const LAS f32x4*)(ssq + (32 * lt + (lane_ >> 1)) * 8); const f32x4 s0 = sp[0], s1 = sp[1];
          const float rstd = rsqrtf(((s0.x + s0.y) + (s0.z + s0.w) + (s1.x + s1.y) + (s1.z + s1.w)) * (1.0f / 512.0f) + EPS);
          GAS v4u* op = (GAS v4u*)(YOw + (size_t)(32 * lt) * KCAT);
#pragma unroll
          for (int i = 0; i < 4; ++i) { const f32x4 na = *(const LAS f32x4*)(nwp + 8 * i), nb = *(const LAS f32x4*)(nwp + 8 * i + 4);
              op[i] = (v4u){cvtpk(gq[8 * i] * rstd * na.x, gq[8 * i + 1] * rstd * na.y), cvtpk(gq[8 * i + 2] * rstd * na.z, gq[8 * i + 3] * rstd * na.w), cvtpk(gq[8 * i + 4] * rstd * nb.x, gq[8 * i + 5] * rstd * nb.y), cvtpk(gq[8 * i + 6] * rstd * nb.z, gq[8 * i + 7] * rstd * nb.w)}; } }
    }
    __syncthreads();
}

template <int MODE, int NBG> __device__ __forceinline__ void mini_group(f32x16& acc, const bf16* Ab, int lda, const float* Af, const bf16* Bt, int K, int kofs, LAS unsigned char* WLA, LAS unsigned char* WLB, int lane_) {
    constexpr int NLA = MODE == 1 ? 8 : 4;
    const int r = lane_ & 31, hh = lane_ >> 5, lrow = lane_ >> 3, lch = lane_ & 7, frow = lane_ >> 4, fch = lane_ & 15;
    v4u bv[NBG][4], av[NBG][NLA];
#pragma unroll
    for (int g = 0; g < NBG; ++g) {
#pragma unroll
        for (int j = 0; j < 4; ++j) bv[g][j] = *(const GAS v4u*)(Bt + (size_t)(8 * j + lrow) * K + kofs + 64 * g + 8 * lch);
        if (MODE == 1) {
#pragma unroll
            for (int j = 0; j < 8; ++j) av[g][j] = *(const GAS v4u*)(Af + (size_t)(4 * j + frow) * DM + kofs + 64 * g + 4 * fch);
        } else {
#pragma unroll
            for (int j = 0; j < 4; ++j) av[g][j] = *(const GAS v4u*)(Ab + (size_t)(8 * j + lrow) * lda + kofs + 64 * g + 8 * lch);
        }
    }
    __builtin_amdgcn_sched_barrier(0);
#pragma unroll
    for (int g = 0; g < NBG; ++g) {
#pragma unroll
        for (int j = 0; j < 4; ++j) *(LAS v4u*)(WLB + (8 * j + lrow) * 144 + lch * 16) = bv[g][j];
        if (MODE == 1) {
#pragma unroll
            for (int j = 0; j < 8; ++j) { const v4u w = av[g][j]; u32x2 o; o.x = cvtpk(__uint_as_float(w.x), __uint_as_float(w.y)); o.y = cvtpk(__uint_as_float(w.z), __uint_as_float(w.w)); *(LAS u32x2*)(WLA + (4 * j + frow) * 144 + fch * 8) = o; }
        } else {
#pragma unroll
            for (int j = 0; j < 4; ++j) *(LAS v4u*)(WLA + (8 * j + lrow) * 144 + lch * 16) = av[g][j];
        }
        LDS_WAIT(); asm volatile("" ::: "memory");
        bf16x8 fa[4], fb[4];
#pragma unroll
        for (int ks = 0; ks < 4; ++ks) { fa[ks] = *(const LAS bf16x8*)(WLA + r * 144 + (2 * ks + hh) * 16); fb[ks] = *(const LAS bf16x8*)(WLB + r * 144 + (2 * ks + hh) * 16); }
#pragma unroll
        for (int ks = 0; ks < 4; ++ks) acc = MFMA32(fa[ks], fb[ks], acc);
        asm volatile("" ::: "memory");
    }
    __builtin_amdgcn_sched_barrier(0);
}
template <int MODE> __device__ __forceinline__ void mini_unit(const Ctx& C, int l, int mu) {
    constexpr int K = MODE == 0 ? KCAT : (MODE == 1 ? DM : FF), KS = MODE == 0 ? 1024 : (MODE == 1 ? 256 : 704);
    const int lane_ = lane_now();
    const int r = lane_ & 31, hh = lane_ >> 5, ct = mu & 31, sp = mu >> 5, rt = C.wave & 3, n0 = 64 * ct + 32 * (C.wave >> 2), k0 = KS * sp;
    const bf16* Bt = (MODE == 0 ? ((bf16*)(C.a->ws + WS_WCAT)) + (size_t)l * DM * KCAT : (MODE == 1 ? ((bf16*)(C.a->ws + WS_WOUT)) + (size_t)l * DM * DM : ((bf16*)(C.a->ws + WS_WDN)) + (size_t)l * DM * FF)) + (size_t)n0 * K + k0;
    const bf16* Ab = (MODE == 0 ? ((bf16*)(C.a->ws + WS_YO)) + (size_t)(SEQ + 32 * rt) * KCAT : ((bf16*)(C.a->ws + WS_HB)) + (size_t)(SEQ + 32 * rt) * FF) + k0;
    const float* Af = ((float*)(C.a->ws + WS_MS)) + (size_t)(32 * rt) * DM + k0;
    constexpr int lda = MODE == 0 ? KCAT : FF;
    LAS unsigned char* WLA = C.lds + RING_OFF + C.wave * 9216; LAS unsigned char* WLB = WLA + 4608;
    f32x16 acc;
#pragma unroll
    for (int e = 0; e < 16; ++e) acc[e] = 0.f;
    if (MODE == 0) {
#pragma unroll 1
        for (int gq = 0; gq < 4; ++gq) mini_group<0, 4>(acc, Ab, lda, Af, Bt, K, 256 * gq, WLA, WLB, lane_);
    } else if (MODE == 1) {
#pragma unroll 1
        for (int gq = 0; gq < 2; ++gq) mini_group<1, 2>(acc, Ab, lda, Af, Bt, K, 128 * gq, WLA, WLB, lane_);
    } else {
#pragma unroll 1
        for (int gq = 0; gq < 2; ++gq) mini_group<2, 4>(acc, Ab, lda, Af, Bt, K, 256 * gq, WLA, WLB, lane_);
        mini_group<2, 3>(acc, Ab, lda, Af, Bt, K, 512, WLA, WLB, lane_);
    }
    float* dst = (MODE == 0 ? ((float*)(C.a->ws + WS_MS)) : ((float*)(C.a->ws + WS_X)) + (size_t)SEQ * DM) + n0 + r;
    if (MODE == 0) { const bf16* gp = ((bf16*)(C.a->ws + WS_U)) + UIDX(SEQ, (sp < 4 ? UGS : UGA) + n0 + r);
        bf16 gv[16];
#pragma unroll
        for (int e = 0; e < 16; ++e) gv[e] = gp[(size_t)(32 * rt + crow(e, hh)) * 64];
        __builtin_amdgcn_sched_barrier(0);
#pragma unroll
        for (int e = 0; e < 16; ++e) acc[e] *= bf2f(gv[e]); }
#pragma unroll
    for (int e = 0; e < 16; ++e) unsafeAtomicAdd(dst + (size_t)(32 * rt + crow(e, hh)) * DM, acc[e]);
}
template <int MODE> __device__ __forceinline__ void mini_phase(const Ctx& C, int l) {
    constexpr int NMU = 32 * (MODE == 0 ? 6 : 8);
    for (int mu = C.bid; mu < NMU; mu += C.G) mini_unit<MODE>(C, l, mu);
}
constexpr int NPL = 11;
constexpr int NPH = 1 + DEPTH * NPL;
#ifndef REP_P0
#define REP_P0 1
#endif
#ifndef REP_0
#define REP_0 1
#endif
#ifndef REP_1
#define REP_1 1
#endif
#ifndef REP_2
#define REP_2 1
#endif
#ifndef REP_3
#define REP_3 1
#endif
#ifndef REP_4
#define REP_4 1
#endif
#ifndef REP_5
#define REP_5 1
#endif
#ifndef REP_6
#define REP_6 1
#endif
#ifndef REP_7
#define REP_7 1
#endif
#ifndef REP_8
#define REP_8 1
#endif
#ifndef REP_9
#define REP_9 1
#endif
#ifndef REP_10
#define REP_10 1
#endif
#ifndef REP_RF
#define REP_RF 1
#endif
#ifndef REP_SSD
#define REP_SSD 1
#endif
#ifndef REP_SATT
#define REP_SATT 1
#endif
#ifndef GEMM_ALIGN
#define GEMM_ALIGN true
#endif
#ifndef GEMM_SP2
#define GEMM_SP2 true
#endif
#ifndef PROBE_LO
#define PROBE_LO -1
#define PROBE_HI -1
#endif
#ifndef PROBE_AMP
#define PROBE_AMP 2
#endif
#ifndef NW_SSD
#define NW_SSD 2
#endif
#ifndef PROBE_SUB
#define PROBE_SUB 0
#endif
#ifndef PROBE_CLK
#define PROBE_CLK 0
#endif
#ifndef REP_ATT
#define REP_ATT 1
#endif
#ifndef REP_PA
#define REP_PA 1
#endif
#ifndef NSP_G1
#define NSP_G1 49
#endif
#ifndef MK_SPLIT
#define MK_SPLIT 0
#endif
__global__ void __launch_bounds__(NWAVES * 64, 2) fwd(Args args) {
    extern __shared__ __attribute__((aligned(16))) unsigned char lds_raw[];
    LAS unsigned char* const lds = (LAS unsigned char*)lds_raw;
    const int wave_s = __builtin_amdgcn_readfirstlane(threadIdx.x >> 6);
    unsigned char* ws = args.ws;
#define FRESH_CTX() Ctx C; { int t_; asm volatile("v_mbcnt_lo_u32_b32 %0, -1, 0\n\tv_mbcnt_hi_u32_b32 %0, -1, %0" : "=v"(t_)); t_ += wave_s * 64; int b_ = blockIdx.x, g_ = gridDim.x; asm volatile("" : "+s"(b_), "+s"(g_)); \
        KArgs kp_ = (KArgs)__builtin_amdgcn_kernarg_segment_ptr(); asm volatile("" : "+s"(kp_)); \
        C.lds = lds; C.tid = t_; C.lane = t_ & 63; C.wave = __builtin_amdgcn_readfirstlane(t_ >> 6); C.G = g_; C.bid = b_; C.a = kp_; }
    for (int u = threadIdx.x; u < (LDS_BYTES - LDSCTL_OFF) / 4; u += NWAVES * 64) ((LAS unsigned*)(lds + LDSCTL_OFF))[u] = 0u;
    __syncthreads();
    volatile LAS unsigned* MISC = (volatile LAS unsigned*)(lds + MISC_OFF);
    unsigned* barw = (unsigned*)(ws + WS_CTL) + CW_BAR;
    XcdBarrier bar; bar.bar = barw; bar.x = 0; bar.st = nullptr;
    if (args.use_bar) bar = xcd_barrier_post(barw, MISC + 8);
    const int lo = args.ph_lo, hi = args.ph_hi;
#define IN(k) (lo <= (k) && (k) < hi)
#define SEAM(k) do { if (IN((k) + 1)) xcd_barrier(bar); } while (0)

#ifndef NO_P0
    if (IN(0)) { for (int rep_ = 0; rep_ < REP_P0; ++rep_) { FRESH_CTX(); p0_weights(C, 0, (C.G >= 64 && NSP_G1 > 0) ? IT_IN : DEPTH * IT_LAYER, C.bid * NWAVES + C.wave, C.G * NWAVES); p0_xinit(C); if (rep_ + 1 < REP_P0) xcd_barrier(bar); } SEAM(0); }
#endif

    unsigned long long probe_acc = 0ull, probe_t0 = 0ull;
    if (PROBE_CLK && threadIdx.x == 0) { const unsigned long long c0_ = __builtin_amdgcn_s_memtime(), r0_ = __builtin_amdgcn_s_memrealtime(); MISC[16] = (unsigned)c0_; MISC[17] = (unsigned)(c0_ >> 32); MISC[18] = (unsigned)r0_; MISC[19] = (unsigned)(r0_ >> 32); }
#define PROBE_BEGIN(j) do { if (PROBE_LO >= 0 && (j) == PROBE_LO) probe_t0 = __builtin_amdgcn_s_memrealtime(); } while (0)
#define PROBE_END(j) do { if (PROBE_LO >= 0 && (j) == PROBE_HI) probe_acc += __builtin_amdgcn_s_memrealtime() - probe_t0; } while (0)
#pragma nounroll
    for (int l = 0; l < DEPTH; ++l) {
        const int pb = 1 + l * NPL;
#ifndef NO_G1
        PROBE_BEGIN(0);
        if (IN(pb + 0)) { for (int rep_ = 0; rep_ < REP_0; ++rep_) {
            FRESH_CTX();
            const int nsp = (l == 0 && C.G >= 64) ? (C.G * NSP_G1) / 256 : 0, gG = C.G - nsp;
            if (C.bid < gG) {
            pg8::Gemm g{((bf16*)(C.a->ws + WS_XN)), ((bf16*)(C.a->ws + WS_WIN)) + (size_t)l * NU * DM, MP, NU, DM}; pg8::StaticOrder S; S.init(MP, NU, gG, C.bid);
            pg8::EpiU E{((bf16*)(C.a->ws + WS_U)), ((float*)(C.a->ws + WS_DT)), (C.a->in[10]) + l * NH, ((float*)(C.a->ws + WS_RSA))};
            pg8::gemm_phase<pg8::EpiU, pg8::StaticOrder, GEMM_ALIGN, GEMM_SP2>(C.lds + RING_OFF, g, S, E, C.tid);
            } else p0_weights(C, IT_IN, DEPTH * IT_LAYER, (C.bid - gG) * NWAVES + C.wave, nsp * NWAVES);
            if (rep_ + 1 < REP_0) xcd_barrier(bar); }
            SEAM(pb + 0);
        }
        PROBE_END(0);
#endif
        PROBE_BEGIN(1);
        if (IN(pb + 1)) { for (int rep_ = 0; rep_ < REP_1; ++rep_) {
            FRESH_CTX();
            { volatile LAS unsigned* qctr = (volatile LAS unsigned*)(C.lds + MISC_OFF) + 24;
              if (C.tid == 0) qctr[0] = 0u;
              __syncthreads();
              const int nS = (NB * NG - C.bid + C.G - 1) / C.G, nR = (RF_ITEMS - C.bid + C.G - 1) / C.G;
              LAS float* wsc = (LAS float*)(C.lds + RING_OFF + C.wave * 8192);
              for (;;) { unsigned idx = 0u; if (C.lane == 0) idx = __hip_atomic_fetch_add((LAS unsigned*)qctr, 1u, __ATOMIC_RELAXED, __HIP_MEMORY_SCOPE_WORKGROUP);
                  idx = (unsigned)__builtin_amdgcn_readfirstlane((int)idx);
                  if ((int)idx >= nS + nR) break;
                  if ((int)idx < nS) { const int u = C.bid + C.G * (int)idx; sample_ssd_wave_unit(C, l, u >> 3, u & 7, wsc); }
                  else reformat_item(C, l, C.bid + C.G * ((int)idx - nS)); } }
            __syncthreads();
            if (PROBE_SUB == 1) probe_acc += __builtin_amdgcn_s_memrealtime() - probe_t0;
            if (PROBE_SUB == 2) probe_t0 = __builtin_amdgcn_s_memrealtime();
            zero_f32(C, ((float*)(C.a->ws + WS_RSB)), SEQ, C.bid, C.G);
            { float z0 = 0.f; asm volatile("" : "+v"(z0));
              for (int i = C.bid * 512 + C.tid; i < NB * DM / 4; i += C.G * 512) ((GAS f32x4*)(C.a->ws + WS_MS))[i] = (f32x4){z0, z0, z0, z0}; }
            for (int rr_ = 0; rr_ < REP_SATT; ++rr_) sample_attn_phase(C, l);
            if (PROBE_SUB == 2) probe_acc += __builtin_amdgcn_s_memrealtime() - probe_t0;
            if (PROBE_SUB == 3) probe_t0 = __builtin_amdgcn_s_memrealtime();
            if (PROBE_SUB == 3) { __syncthreads(); probe_acc += __builtin_amdgcn_s_memrealtime() - probe_t0; }
            if (rep_ + 1 < REP_1) xcd_barrier(bar); }
            SEAM(pb + 1);
        }
        PROBE_END(1);
        PROBE_BEGIN(2);
        if (IN(pb + 2)) { for (int rep_ = 0; rep_ < REP_2; ++rep_) {
            FRESH_CTX();
#ifdef USE_NSSD
            if (C.bid < NG) naive_ssd_prompt(C, l, C.bid);
            else {
                const int vb = C.bid - NG, nvb = C.G - NG;
                for (int u = vb; u < 64 * KVH; u += nvb) attn_prompt_unit(C, l, u >> 3, u & 7);
                for (int u = vb; u < 64 * NG; u += nvb) ssd_states_unit(C, u >> 3, u & 7);
            }
#else
            for (int rr_ = 0; rr_ < REP_ATT; ++rr_) for (int u = C.bid; u < 64 * KVH; u += C.G) attn_prompt_unit(C, l, u >> 3, u & 7);
            for (int rr_ = 0; rr_ < REP_PA; ++rr_) for (int u = C.bid; u < 64 * NG; u += C.G) ssd_states_unit(C, u >> 3, u & 7);
#endif
            if (rep_ + 1 < REP_2) xcd_barrier(bar); }
            SEAM(pb + 2);
        }
        PROBE_END(2);
        PROBE_BEGIN(3);
        if (IN(pb + 3)) { for (int rep_ = 0; rep_ < REP_3; ++rep_) { FRESH_CTX(); ssd_scan_phase(C, l); if (rep_ + 1 < REP_3) xcd_barrier(bar); } SEAM(pb + 3); }
        PROBE_END(3);
        PROBE_BEGIN(4);
        if (IN(pb + 4)) { for (int rep_ = 0; rep_ < REP_4; ++rep_) {
            FRESH_CTX();
#ifndef USE_NSSD
            for (int u = C.bid; u < 64 * NG; u += C.G) ssd_out_unit(C, l, u >> 3, u & 7);
#endif
            if (rep_ + 1 < REP_4) xcd_barrier(bar); }
            SEAM(pb + 4);
        }
        PROBE_END(4);
#ifndef NO_G2
        PROBE_BEGIN(5);
        if (IN(pb + 5)) { for (int rep_ = 0; rep_ < REP_5; ++rep_) {
            FRESH_CTX();
            pg8::Gemm g{((bf16*)(C.a->ws + WS_YO)), ((bf16*)(C.a->ws + WS_WCAT)) + (size_t)l * DM * KCAT, SEQ, DM, KCAT}; pg8::StaticOrder S; S.init(SEQ, DM, C.G, C.bid);
            pg8::EpiMerge E{((bf16*)(C.a->ws + WS_U)), ((bf16*)(C.a->ws + WS_MRG))};
            pg8::gemm_phase<pg8::EpiMerge, pg8::StaticOrder, true, true>(C.lds + RING_OFF, g, S, E, C.tid);
            mini_phase<0>(C, l);
            if (rep_ + 1 < REP_5) xcd_barrier(bar); }
            SEAM(pb + 5);
        }
        PROBE_END(5);
#endif
#ifndef NO_G3
        PROBE_BEGIN(6);
        if (IN(pb + 6)) { for (int rep_ = 0; rep_ < REP_6; ++rep_) {
            FRESH_CTX();
            pg8::Gemm g{((bf16*)(C.a->ws + WS_MRG)), ((bf16*)(C.a->ws + WS_WOUT)) + (size_t)l * DM * DM, SEQ, DM, DM}; pg8::StaticOrder S; S.init(SEQ, DM, C.G, C.bid);
            pg8::EpiResid E{l == 0 ? (C.a->in[0]) : (const float*)nullptr, ((bf16*)(C.a->ws + WS_XN)), ((float*)(C.a->ws + WS_RSB))};
            pg8::gemm_phase<pg8::EpiResid, pg8::StaticOrder, true, true>(C.lds + RING_OFF, g, S, E, C.tid);
            mini_phase<1>(C, l);
            if (rep_ + 1 < REP_6) xcd_barrier(bar); }
            SEAM(pb + 6);
        }
        PROBE_END(6);
#endif
        PROBE_BEGIN(7);
        if (IN(pb + 7)) { for (int rep_ = 0; rep_ < REP_7; ++rep_) { FRESH_CTX(); sample_rows_phase(C, ((float*)(C.a->ws + WS_RSB))); if (rep_ + 1 < REP_7) xcd_barrier(bar); } SEAM(pb + 7); }
        PROBE_END(7);
#ifndef NO_G4
        PROBE_BEGIN(8);
        if (IN(pb + 8)) { for (int rep_ = 0; rep_ < REP_8; ++rep_) {
            FRESH_CTX();
            const int nsp = C.G >= 64 ? (C.G * 14) / 256 : 0, gG = C.G - nsp;
            if (C.bid < gG) {
            pg8::Gemm g{((bf16*)(C.a->ws + WS_XN)), ((bf16*)(C.a->ws + WS_WGU)) + (size_t)l * NGU * DM, MP, NGU, DM}; pg8::StaticOrder S; S.init(MP, NGU, gG, C.bid);
            pg8::EpiSwiGLU E{((bf16*)(C.a->ws + WS_HB)), ((float*)(C.a->ws + WS_RSB))};
            pg8::gemm_phase<pg8::EpiSwiGLU, pg8::StaticOrder, GEMM_ALIGN, GEMM_SP2>(C.lds + RING_OFF, g, S, E, C.tid);
            } else { zero_f32(C, ((float*)(C.a->ws + WS_RSA)), SEQ, C.bid - gG, nsp); copy_outs(C, l, C.bid - gG, nsp); cache_shift(C, l, C.bid - gG, nsp); }
            if (nsp == 0) { zero_f32(C, ((float*)(C.a->ws + WS_RSA)), SEQ, C.bid, C.G); copy_outs(C, l, C.bid, C.G); cache_shift(C, l, C.bid, C.G); }
            if (rep_ + 1 < REP_8) xcd_barrier(bar); }
            SEAM(pb + 8);
        }
        PROBE_END(8);
#endif
#ifndef NO_G5
        PROBE_BEGIN(9);
        if (IN(pb + 9)) { for (int rep_ = 0; rep_ < REP_9; ++rep_) {
            FRESH_CTX();
            pg8::Gemm g{((bf16*)(C.a->ws + WS_HB)), ((bf16*)(C.a->ws + WS_WDN)) + (size_t)l * DM * FF, SEQ, DM, FF}; pg8::StaticOrder S; S.init(SEQ, DM, C.G, C.bid);
            pg8::EpiResid E{(const float*)nullptr, ((bf16*)(C.a->ws + WS_XN)), ((float*)(C.a->ws + WS_RSA))};
            pg8::gemm_phase<pg8::EpiResid, pg8::StaticOrder, true, true>(C.lds + RING_OFF, g, S, E, C.tid);
            mini_phase<2>(C, l);
            if (rep_ + 1 < REP_9) xcd_barrier(bar); }
            SEAM(pb + 9);
        }
        PROBE_END(9);
#endif
        PROBE_BEGIN(10);
        if (IN(pb + 10)) { for (int rep_ = 0; rep_ < REP_10; ++rep_) {
            FRESH_CTX();
            if (l + 1 < DEPTH) sample_rows_phase(C, ((float*)(C.a->ws + WS_RSA))); else final_norm_phase(C);
            if (rep_ + 1 < REP_10) xcd_barrier(bar); }
            SEAM(pb + 10);
        }
        PROBE_END(10);
    }
    if (PROBE_CLK && blockIdx.x == 0 && wave_s == 0 && lane_now() == 0) { const unsigned long long c1 = __builtin_amdgcn_s_memtime(), r1 = __builtin_amdgcn_s_memrealtime(); const unsigned long long clk_c0 = ((unsigned long long)MISC[17] << 32) | MISC[16], clk_r0 = ((unsigned long long)MISC[19] << 32) | MISC[18]; const unsigned long long dc = (c1 - clk_c0) * 10000ull, dr = r1 - clk_r0;
        while ((__builtin_amdgcn_s_memrealtime() - r1) * dr < dc) __builtin_amdgcn_s_sleep(8); }
    if (PROBE_LO >= 0 && blockIdx.x == 0 && wave_s == 0 && lane_now() == 0) { const unsigned long long t1 = __builtin_amdgcn_s_memrealtime(); while (__builtin_amdgcn_s_memrealtime() - t1 < (unsigned long long)PROBE_AMP * probe_acc) __builtin_amdgcn_s_sleep(8); }
#undef IN
#undef SEAM
}

extern "C" void kernel_launch(void* const* d_in, const int* in_sizes, int n_in, void* d_out, int out_size, void* d_ws, size_t ws_size, hipStream_t stream) {
    static int grid = 0;
    if (grid == 0) {
        if (n_in != 23 || (size_t)out_size != O_END || ws_size < WS_END) { fprintf(stderr, "kernel_launch: unexpected problem (n_in %d, out %d, ws %zu; need ws >= %zu); nothing launched\n", n_in, out_size, ws_size, (size_t)WS_END); grid = -1; return; }
        int dev = 0, cus = 0, per_cu = 0;
        if (hipGetDevice(&dev) != hipSuccess || hipDeviceGetAttribute(&cus, hipDeviceAttributeMultiprocessorCount, dev) != hipSuccess) { grid = -1; return; }
        if (hipFuncSetAttribute((const void*)fwd, hipFuncAttributeMaxDynamicSharedMemorySize, LDS_BYTES) != hipSuccess) { fprintf(stderr, "kernel_launch: hipFuncSetAttribute failed\n"); grid = -1; return; }
        if (hipOccupancyMaxActiveBlocksPerMultiprocessor(&per_cu, (const void*)fwd, NWAVES * 64, LDS_BYTES) != hipSuccess || per_cu < 1) { fprintf(stderr, "kernel_launch: occupancy query says %d blocks per CU\n", per_cu); }
        (void)hipGetLastError();
        grid = cus;
    }
    if (grid < 0) return;
    if (hipMemsetAsync((char*)d_ws + WS_CTL, 0, CTL_ZERO_BYTES, stream) != hipSuccess) return;
    Args a{};
    for (int i = 0; i < 23; ++i) a.in[i] = (const float*)d_in[i];
    a.out = (float*)d_out; a.ws = (unsigned char*)d_ws; a.pad = 0;
#if MK_SPLIT
    for (int p = 0; p < NPH; ++p) { a.ph_lo = p; a.ph_hi = p + 1; a.use_bar = 0; hipLaunchKernelGGL(fwd, dim3(grid), dim3(NWAVES * 64), LDS_BYTES, stream, a); }
#else
    a.ph_lo = 0; a.ph_hi = NPH; a.use_bar = 1;
    hipLaunchKernelGGL(fwd, dim3(grid), dim3(NWAVES * 64), LDS_BYTES, stream, a);
#endif
    const hipError_t le = hipPeekAtLastError();
    if (le != hipSuccess) fprintf(stderr, "kernel_launch: launch failed: %s\n", hipGetErrorName(le));
}
```
